# Optimizing an MI355X kernel written in HIP

```python
import jax
import jax.numpy as jnp
from jax import lax
import numpy as np

D_MODEL = 1024
BATCH = 16
SEQ = 4096
DEPTH = 2
DEC_BATCH = 32
DEC_SEQ = 16
PAST_LEN = 2048

CHUNK = 64
Q_BLOCK = 128
EPS = 1e-6
NEG_INF = -1e30

LRU_WIDTH = D_MODEL
LRU_BLOCKS = 8
LRU_BLOCK_W = LRU_WIDTH // LRU_BLOCKS
CONV_W = 4
LRU_C = 8.0

MLA_HEADS = 8
QK_NOPE = 128
QK_ROPE = 64
V_DIM = 128
Q_RANK = 768
KV_RANK = 256
MLA_WIDTH = MLA_HEADS * V_DIM
ROPE_THETA = 10000.0
SOFTMAX_SCALE = (QK_NOPE + QK_ROPE) ** -0.5

IN_COLS = (LRU_WIDTH, LRU_WIDTH, Q_RANK, KV_RANK, QK_ROPE, MLA_WIDTH, D_MODEL, D_MODEL)
IN_DIM = LRU_WIDTH * 2 + Q_RANK + KV_RANK + QK_ROPE + MLA_WIDTH + D_MODEL * 2

kernel_name = 'hybrid_rglru_mla_stream_step'


def _rmsnorm(x, g):
    x32 = x.astype(jnp.float32)
    y = x32 * lax.rsqrt(jnp.mean(x32 * x32, axis=-1, keepdims=True) + EPS)
    return (y * g.astype(jnp.float32)).astype(x.dtype)


def _split_cols(z):
    outs = []
    start = 0
    for w in IN_COLS:
        outs.append(z[..., start:start + w])
        start += w
    return outs


def _rope(x, pos):
    half = QK_ROPE // 2
    inv = ROPE_THETA ** (-jnp.arange(half, dtype=jnp.float32) / half)
    ang = pos.astype(jnp.float32)[:, None] * inv[None, :]
    cos = jnp.cos(ang)[None, :, None, :]
    sin = jnp.sin(ang)[None, :, None, :]
    x32 = x.astype(jnp.float32)
    x1, x2 = x32[..., :half], x32[..., half:]
    return jnp.concatenate([x1 * cos - x2 * sin, x1 * sin + x2 * cos], axis=-1).astype(x.dtype)


def _rglru(xc, h0, wa, ba, wx, bx, lam):
    B, S, W = xc.shape
    xb = xc.reshape(B, S, LRU_BLOCKS, LRU_BLOCK_W)
    r = jax.nn.sigmoid(jnp.einsum('bsnk,nkj->bsnj', xb, wa).reshape(B, S, W) + ba)
    i = jax.nn.sigmoid(jnp.einsum('bsnk,nkj->bsnj', xb, wx).reshape(B, S, W) + bx)
    log_a = (-LRU_C * r.astype(jnp.float32)) * jax.nn.softplus(-lam.astype(jnp.float32))
    a = jnp.exp(log_a)
    mult = jnp.sqrt(-jnp.expm1(2.0 * log_a))
    b = mult * (i * xc).astype(jnp.float32)
    b = b.at[:, 0].add(a[:, 0] * h0.astype(jnp.float32))

    def combine(left, right):
        a_l, b_l = left
        a_r, b_r = right
        return a_l * a_r, a_r * b_l + b_r

    _, hs = lax.associative_scan(combine, (a, b), axis=1)
    return hs.astype(xc.dtype), hs[:, -1].astype(xc.dtype)


def _mla_attention(q_nope, q_pe, ckv, kpe, q_pos, k_pos, w_uk, w_uv):
    B, Sq = q_nope.shape[0], q_nope.shape[1]
    blk = min(Q_BLOCK, Sq)
    nb = Sq // blk
    k_chunk = k_pos // CHUNK

    def to_blocks(t):
        return t.reshape((B, nb, blk) + t.shape[2:]).swapaxes(0, 1)

    def attend(args):
        qn, qp, qpos = args
        q_lat = jnp.einsum('bqhn,rhn->bqhr', qn, w_uk)
        s = jnp.einsum('bqhr,bkr->bhqk', q_lat, ckv) + jnp.einsum('bqhp,bkp->bhqk', qp, kpe)
        s = s.astype(jnp.float32) * SOFTMAX_SCALE
        mask = k_chunk[None, :] <= (qpos // CHUNK)[:, None]
        s = jnp.where(mask, s, NEG_INF)
        pr = jax.nn.softmax(s, axis=-1).astype(ckv.dtype)
        o_lat = jnp.einsum('bhqk,bkr->bqhr', pr, ckv)
        return jnp.einsum('bqhr,rhv->bqhv', o_lat, w_uv)

    out = lax.map(attend, (to_blocks(q_nope), to_blocks(q_pe), q_pos.reshape(nb, blk)))
    return out.swapaxes(0, 1).reshape(B, Sq, MLA_HEADS, V_DIM)


def _layer(x, c, pos, k_pos_past, ckv_past, kpe_past, conv_state, h0, lp):
    B, S, _ = x.shape
    mod = jnp.einsum('bd,de->be', jax.nn.silu(c), lp['ada_w']) + lp['ada_b']
    shift, scale, gate = jnp.split(mod[:, None, :], 3, axis=-1)
    h = _rmsnorm(x, lp['pre_norm']) * (1.0 + scale) + shift
    z = jnp.einsum('bsd,de->bse', h, lp['w_in'])
    xa, ga, cq, ckv, kpe, gb, ua, ub = _split_cols(z)

    conv_in = jnp.concatenate([conv_state.astype(xa.dtype), xa], axis=1)
    xc = lp['conv_b'] + conv_in[:, 0:S] * lp['conv_w'][0]
    for k in range(1, CONV_W):
        xc = xc + conv_in[:, k:k + S] * lp['conv_w'][k]
    new_conv = conv_in[:, S:]
    y_lru, h_last = _rglru(xc, h0, lp['lru_wa'], lp['lru_ba'], lp['lru_wx'], lp['lru_bx'], lp['lru_lambda'])
    ya = y_lru * jax.nn.silu(ga)

    q = jnp.einsum('bsr,re->bse', _rmsnorm(cq, lp['q_norm']), lp['w_q_up'])
    q = q.reshape(B, S, MLA_HEADS, QK_NOPE + QK_ROPE)
    q_nope = q[..., :QK_NOPE]
    q_pe = _rope(q[..., QK_NOPE:], pos)
    ckv = _rmsnorm(ckv, lp['kv_norm'])
    kpe = _rope(kpe[:, :, None, :], pos)[:, :, 0, :]
    if ckv_past is None:
        ckv_all, kpe_all, k_pos = ckv, kpe, pos
    else:
        ckv_all = jnp.concatenate([ckv_past.astype(ckv.dtype), ckv], axis=1)
        kpe_all = jnp.concatenate([kpe_past.astype(kpe.dtype), kpe], axis=1)
        k_pos = jnp.concatenate([k_pos_past, pos])
    attn = _mla_attention(q_nope, q_pe, ckv_all, kpe_all, pos, k_pos, lp['w_uk'], lp['w_uv'])
    yb = attn.reshape(B, S, MLA_WIDTH) * jax.nn.silu(gb)

    merged = (jax.nn.sigmoid(ua) * jnp.einsum('bsw,wd->bsd', ya, lp['w_branch_a'])
              + jax.nn.sigmoid(ub) * jnp.einsum('bsw,wd->bsd', yb, lp['w_branch_b']))
    o = jnp.einsum('bsd,de->bse', merged, lp['w_out'])
    x = x + gate * _rmsnorm(o, lp['post_norm'])
    return x, ckv, kpe, new_conv, h_last


def setup_inputs(seed: int = 0) -> dict:
    key = jax.random.key(seed)
    ks = jax.random.split(key, 32)
    f32 = jnp.float32

    def nrm(k, shape, scale):
        return jax.random.normal(k, shape, f32) * scale

    a0 = jax.random.uniform(ks[31], (DEPTH, LRU_WIDTH), f32, 0.9, 0.999)
    p = a0 ** (1.0 / LRU_C)
    lru_lambda = jnp.log(p) - jnp.log1p(-p)

    return {
        'x_prompt': nrm(ks[0], (BATCH, SEQ, D_MODEL), 1.0),
        'x_sample': nrm(ks[1], (DEC_BATCH, DEC_SEQ, D_MODEL), 1.0),
        'c_prompt': nrm(ks[2], (BATCH, D_MODEL), 1.0),
        'c_sample': nrm(ks[3], (DEC_BATCH, D_MODEL), 1.0),
        'cache_ckv': nrm(ks[4], (DEPTH, DEC_BATCH, PAST_LEN, KV_RANK), 1.0),
        'cache_kpe': nrm(ks[5], (DEPTH, DEC_BATCH, PAST_LEN, QK_ROPE), 1.0),
        'state_conv': nrm(ks[6], (DEPTH, DEC_BATCH, CONV_W - 1, LRU_WIDTH), 1.0),
        'state_lru': nrm(ks[7], (DEPTH, DEC_BATCH, LRU_WIDTH), 0.5),
        'ada_w': nrm(ks[8], (DEPTH, D_MODEL, 3 * D_MODEL), 0.5 * D_MODEL ** -0.5),
        'ada_b': nrm(ks[9], (DEPTH, 3 * D_MODEL), 0.02),
        'pre_norm': 1.0 + nrm(ks[10], (DEPTH, D_MODEL), 0.05),
        'post_norm': 1.0 + nrm(ks[11], (DEPTH, D_MODEL), 0.05),
        'w_in': nrm(ks[12], (DEPTH, D_MODEL, IN_DIM), D_MODEL ** -0.5),
        'conv_w': nrm(ks[13], (DEPTH, CONV_W, LRU_WIDTH), 0.5),
        'conv_b': nrm(ks[14], (DEPTH, LRU_WIDTH), 0.02),
        'lru_wa': nrm(ks[15], (DEPTH, LRU_BLOCKS, LRU_BLOCK_W, LRU_BLOCK_W), LRU_BLOCK_W ** -0.5),
        'lru_ba': nrm(ks[16], (DEPTH, LRU_WIDTH), 0.02),
        'lru_wx': nrm(ks[17], (DEPTH, LRU_BLOCKS, LRU_BLOCK_W, LRU_BLOCK_W), LRU_BLOCK_W ** -0.5),
        'lru_bx': nrm(ks[18], (DEPTH, LRU_WIDTH), 0.02),
        'lru_lambda': lru_lambda,
        'q_norm': 1.0 + nrm(ks[19], (DEPTH, Q_RANK), 0.05),
        'w_q_up': nrm(ks[20], (DEPTH, Q_RANK, MLA_HEADS * (QK_NOPE + QK_ROPE)), Q_RANK ** -0.5),
        'kv_norm': 1.0 + nrm(ks[21], (DEPTH, KV_RANK), 0.05),
        'w_uk': nrm(ks[22], (DEPTH, KV_RANK, MLA_HEADS, QK_NOPE), KV_RANK ** -0.5),
        'w_uv': nrm(ks[23], (DEPTH, KV_RANK, MLA_HEADS, V_DIM), KV_RANK ** -0.5),
        'w_branch_a': nrm(ks[24], (DEPTH, LRU_WIDTH, D_MODEL), LRU_WIDTH ** -0.5),
        'w_branch_b': nrm(ks[25], (DEPTH, MLA_WIDTH, D_MODEL), MLA_WIDTH ** -0.5),
        'w_out': nrm(ks[26], (DEPTH, D_MODEL, D_MODEL), D_MODEL ** -0.5),
    }


def reference(x_prompt, x_sample, c_prompt, c_sample, cache_ckv, cache_kpe, state_conv, state_lru,
              ada_w, ada_b, pre_norm, post_norm, w_in, conv_w, conv_b, lru_wa, lru_ba, lru_wx, lru_bx,
              lru_lambda, q_norm, w_q_up, kv_norm, w_uk, w_uv, w_branch_a, w_branch_b, w_out):
    b_p, s_p = x_prompt.shape[0], x_prompt.shape[1]
    past_len = cache_ckv.shape[2]
    s_s = x_sample.shape[1]
    pos_p = jnp.arange(s_p, dtype=jnp.int32)
    pos_s = past_len + jnp.arange(s_s, dtype=jnp.int32)
    k_pos_past = jnp.arange(past_len, dtype=jnp.int32)
    conv0 = jnp.zeros((b_p, CONV_W - 1, LRU_WIDTH), x_prompt.dtype)
    h0 = jnp.zeros((b_p, LRU_WIDTH), x_prompt.dtype)

    yp, ys = x_prompt, x_sample
    ckv_p, kpe_p, conv_p, lru_p = [], [], [], []
    ckv_s, kpe_s, conv_s, lru_s = [], [], [], []
    for l in range(DEPTH):
        lp = {
            'ada_w': ada_w[l], 'ada_b': ada_b[l], 'pre_norm': pre_norm[l], 'post_norm': post_norm[l],
            'w_in': w_in[l], 'conv_w': conv_w[l], 'conv_b': conv_b[l],
            'lru_wa': lru_wa[l], 'lru_ba': lru_ba[l], 'lru_wx': lru_wx[l], 'lru_bx': lru_bx[l],
            'lru_lambda': lru_lambda[l], 'q_norm': q_norm[l], 'w_q_up': w_q_up[l], 'kv_norm': kv_norm[l],
            'w_uk': w_uk[l], 'w_uv': w_uv[l], 'w_branch_a': w_branch_a[l], 'w_branch_b': w_branch_b[l],
            'w_out': w_out[l],
        }
        yp, a1, a2, a3, a4 = _layer(yp, c_prompt, pos_p, None, None, None, conv0, h0, lp)
        ckv_p.append(a1); kpe_p.append(a2); conv_p.append(a3); lru_p.append(a4)
        ys, b1, b2, b3, b4 = _layer(ys, c_sample, pos_s, k_pos_past, cache_ckv[l], cache_kpe[l],
                                    state_conv[l], state_lru[l], lp)
        ckv_s.append(b1); kpe_s.append(b2); conv_s.append(b3); lru_s.append(b4)

    new_ckv_prompt = jnp.stack(ckv_p)
    new_kpe_prompt = jnp.stack(kpe_p)
    new_conv_prompt = jnp.stack(conv_p)
    new_lru_prompt = jnp.stack(lru_p)
    new_ckv_sample = jnp.stack(ckv_s)
    new_kpe_sample = jnp.stack(kpe_s)
    new_conv_sample = jnp.stack(conv_s)
    new_lru_sample = jnp.stack(lru_s)
    return (yp, ys, new_ckv_prompt, new_kpe_prompt, new_conv_prompt, new_lru_prompt,
            new_ckv_sample, new_kpe_sample, new_conv_sample, new_lru_sample)
```

```cpp
#include <hip/hip_runtime.h>
#include <hip/hip_cooperative_groups.h>
#include <cstdio>
namespace cg = cooperative_groups;

typedef unsigned short u16;
typedef __attribute__((ext_vector_type(8))) short bf16x8;
typedef __attribute__((ext_vector_type(16))) float f32x16;

#define DEV __device__ __forceinline__
#define NT 256

constexpr int MP = 65536, MS = 512, MT = 66048;
constexpr int IN_DIM = 6208;
constexpr float EPS = 1e-6f;
constexpr float QSCALE = 0.07216878364870322f * 1.4426950408889634f;

constexpr size_t SZ_ACT = (size_t)MT * 1024 * 2;
constexpr size_t OFF_H = 0;
constexpr size_t OFF_R1 = OFF_H + SZ_ACT;
constexpr size_t OFF_R2 = OFF_R1 + SZ_ACT;
constexpr size_t OFF_R3 = OFF_R2 + SZ_ACT;
constexpr size_t OFF_R4 = OFF_R3 + (size_t)MP * 1536 * 2;
constexpr size_t OFF_KPE = OFF_R4 + SZ_ACT;
constexpr size_t OFF_VT = OFF_KPE + (size_t)MT * 64 * 2;
constexpr size_t OFF_SKV = OFF_VT + (size_t)16 * 1024 * 4096 * 2;
constexpr size_t OFF_SVT = OFF_SKV + (size_t)32 * 2112 * 320 * 2;
constexpr size_t OFF_QS = OFF_SVT + (size_t)32 * 256 * 2112 * 2;
constexpr size_t OFF_OLAT = OFF_QS + (size_t)MS * 2560 * 2;
constexpr size_t OFF_MOD = OFF_OLAT + (size_t)MS * 2048 * 2;
constexpr size_t OFF_ROPE = OFF_MOD + (size_t)2 * 48 * 3072 * 4;
constexpr size_t OFF_CNT = OFF_ROPE + (size_t)4096 * 32 * 2 * 4;
constexpr size_t OFF_W = OFF_CNT + 256;
constexpr size_t WO_W1 = 0;
constexpr size_t WO_G = WO_W1 + (size_t)2176 * 1024;
constexpr size_t WO_QP = WO_G + (size_t)4096 * 1024;
constexpr size_t WO_QS = WO_QP + (size_t)1536 * 768;
constexpr size_t WO_UK = WO_QS + (size_t)2560 * 768;
constexpr size_t WO_UVS = WO_UK + 262144;
constexpr size_t WO_UVP = WO_UVS + 262144;
constexpr size_t WO_BA = WO_UVP + 262144;
constexpr size_t WO_BB = WO_BA + 1048576;
constexpr size_t WO_OUT = WO_BB + 1048576;
constexpr size_t WO_LA = WO_OUT + 1048576;
constexpr size_t WO_LX = WO_LA + 131072;
constexpr size_t W_LAYER = WO_LX + 131072;
constexpr size_t OFF_BAR = OFF_W + 2 * W_LAYER * 2;
constexpr size_t WS_NEED = OFF_BAR + 16384;

constexpr size_t OUT_YP = 0;
constexpr size_t OUT_YS = 67108864;
constexpr size_t OUT_CKVP = 67633152;
constexpr size_t OUT_KPEP = 101187584;
constexpr size_t OUT_CONVP = 109576192;
constexpr size_t OUT_LRUP = 109674496;
constexpr size_t OUT_CKVS = 109707264;
constexpr size_t OUT_KPES = 109969408;
constexpr size_t OUT_CONVS = 110034944;
constexpr size_t OUT_LRUS = 110231552;

struct Params {
  const float *x_p, *x_s, *c_p, *c_s, *cache_ckv, *cache_kpe, *state_conv, *state_lru;
  const float *ada_w, *ada_b, *pre_norm, *post_norm, *w_in, *conv_w, *conv_b, *lru_wa, *lru_ba, *lru_wx, *lru_bx;
  const float *lru_lambda, *q_norm, *w_q_up, *kv_norm, *w_uk, *w_uv, *w_ba, *w_bb, *w_out;
  float* out;
  unsigned char* ws;
};

DEV int TIDX() {
  int t = threadIdx.x;
  asm volatile("" : "+v"(t));
  return t;
}
typedef __attribute__((ext_vector_type(2))) float f32x2_t;
typedef __attribute__((ext_vector_type(2))) __bf16 bf16x2_t;
DEV unsigned pk2bf(float a, float b) {
  f32x2_t v = {a, b};
  bf16x2_t r = __builtin_convertvector(v, bf16x2_t);
  return __builtin_bit_cast(unsigned, r);
}
DEV u16 f2bf(float f) { return (u16)(pk2bf(f, 0.f) & 0xffffu); }
DEV float bf2f(u16 h) { return __uint_as_float(((unsigned)h) << 16); }
DEV float sigmoidf_(float x) { return 1.0f / (1.0f + __expf(-x)); }
DEV float siluf_(float x) { return x / (1.0f + __expf(-x)); }
DEV float wave_sum(float v) {
#pragma unroll
  for (int o = 32; o > 0; o >>= 1) v += __shfl_xor(v, o, 64);
  return v;
}
DEV int vbid() {
  const int b = blockIdx.x, n = gridDim.x;
  return ((n & 7) == 0) ? (b & 7) * (n >> 3) + (b >> 3) : b;
}
DEV int mod_row(int m) { return m < MP ? (m >> 12) : 16 + ((m - MP) >> 4); }
DEV int pos_of(int m) { return m < MP ? (m & 4095) : 2048 + ((m - MP) & 15); }

constexpr int LDT = 72;
#ifndef P5_DEPTH
#define P5_DEPTH 1
#endif
template <int SS, int DEPTH = 1, bool PIPE = false>
DEV void gemm_main(f32x16 (&acc)[2][2], const u16* __restrict__ A, int lda, const u16* __restrict__ B, int ldb,
                   int K, unsigned char* smem) {
  u16* sA = (u16*)smem;
  u16* sB = sA + 128 * LDT;
  float* ss = (float*)(sB + 128 * LDT);
  const int tid = TIDX(), lane = tid & 63, w = tid >> 6, wm = w >> 1, wn = w & 1;
  const int srow = tid >> 3, scol = (tid & 7) * 8;
  const u16* ap = A + (size_t)srow * lda + scol;
  const u16* bp = B + (size_t)srow * ldb + scol;
  bf16x8 ra[DEPTH][4], rb[DEPTH][4];
  float ssq[4] = {0.f, 0.f, 0.f, 0.f};
  const int nk = K >> 6;
#pragma unroll
  for (int d = 0; d < DEPTH; ++d)
#pragma unroll
    for (int i = 0; i < 4; ++i) {
      ra[d][i] = *(const bf16x8*)(ap + d * 64 + (size_t)(32 * i) * lda);
      rb[d][i] = *(const bf16x8*)(bp + d * 64 + (size_t)(32 * i) * ldb);
    }
  ap += DEPTH * 64;
  bp += DEPTH * 64;
  const int fro = (lane & 31) * LDT + (lane >> 5) * 8;
#pragma unroll 1
  for (int kt = 0; kt < nk; kt += DEPTH) {
#pragma unroll
    for (int d = 0; d < DEPTH; ++d) {
      __syncthreads();
#pragma unroll
      for (int i = 0; i < 4; ++i) {
        *(bf16x8*)(sA + (srow + 32 * i) * LDT + scol) = ra[d][i];
        *(bf16x8*)(sB + (srow + 32 * i) * LDT + scol) = rb[d][i];
        if (SS) {
          bf16x8 v = (SS == 1) ? ra[d][i] : rb[d][i];
#pragma unroll
          for (int j = 0; j < 8; ++j) {
            float f = bf2f((u16)v[j]);
            ssq[i] += f * f;
          }
        }
      }
      __syncthreads();
      if (kt + d + DEPTH < nk) {
#pragma unroll
        for (int i = 0; i < 4; ++i) {
          ra[d][i] = *(const bf16x8*)(ap + (size_t)(32 * i) * lda);
          rb[d][i] = *(const bf16x8*)(bp + (size_t)(32 * i) * ldb);
        }
        ap += 64;
        bp += 64;
      }
      if constexpr (PIPE) {
      bf16x8 af[2][2], bfr[2][2];
#pragma unroll
      for (int i = 0; i < 2; ++i) {
        af[0][i] = *(const bf16x8*)(sA + (wm * 64 + i * 32) * LDT + fro);
        bfr[0][i] = *(const bf16x8*)(sB + (wn * 64 + i * 32) * LDT + fro);
      }
#pragma unroll
      for (int ks = 0; ks < 4; ++ks) {
        if (ks + 1 < 4) {
#pragma unroll
          for (int i = 0; i < 2; ++i) {
            af[(ks + 1) & 1][i] = *(const bf16x8*)(sA + (wm * 64 + i * 32) * LDT + fro + (ks + 1) * 16);
            bfr[(ks + 1) & 1][i] = *(const bf16x8*)(sB + (wn * 64 + i * 32) * LDT + fro + (ks + 1) * 16);
          }
        }
        __builtin_amdgcn_sched_barrier(0);
        __builtin_amdgcn_s_setprio(1);
#pragma unroll
        for (int mi = 0; mi < 2; ++mi)
#pragma unroll
          for (int ni = 0; ni < 2; ++ni)
            acc[mi][ni] = __builtin_amdgcn_mfma_f32_32x32x16_bf16(af[ks & 1][mi], bfr[ks & 1][ni], acc[mi][ni], 0, 0, 0);
        __builtin_amdgcn_s_setprio(0);
        __builtin_amdgcn_sched_barrier(0);
      }
      } else {
#pragma unroll
      for (int ks = 0; ks < 4; ++ks) {
        bf16x8 af[2], bfr[2];
#pragma unroll
        for (int i = 0; i < 2; ++i) {
          af[i] = *(const bf16x8*)(sA + (wm * 64 + i * 32) * LDT + fro + ks * 16);
          bfr[i] = *(const bf16x8*)(sB + (wn * 64 + i * 32) * LDT + fro + ks * 16);
        }
        __builtin_amdgcn_s_setprio(1);
#pragma unroll
        for (int mi = 0; mi < 2; ++mi)
#pragma unroll
          for (int ni = 0; ni < 2; ++ni)
            acc[mi][ni] = __builtin_amdgcn_mfma_f32_32x32x16_bf16(af[mi], bfr[ni], acc[mi][ni], 0, 0, 0);
        __builtin_amdgcn_s_setprio(0);
      }
      }
    }
  }
  if (SS) {
#pragma unroll
    for (int i = 0; i < 4; ++i) {
      float v = ssq[i];
      v += __shfl_xor(v, 1, 64);
      v += __shfl_xor(v, 2, 64);
      v += __shfl_xor(v, 4, 64);
      if ((tid & 7) == 0) ss[srow + 32 * i] = v;
    }
    __syncthreads();
  }
}
DEV void zero_acc(f32x16 (&acc)[2][2]) {
#pragma unroll
  for (int a = 0; a < 2; ++a)
#pragma unroll
    for (int b = 0; b < 2; ++b)
#pragma unroll
      for (int r = 0; r < 16; ++r) acc[a][b][r] = 0.f;
}
DEV float* gemm_ss(unsigned char* smem) { return (float*)(smem + 2 * 128 * LDT * 2); }

template <class F>
DEV void acc_foreach(F f) {
  const int tid_ = TIDX();
  const int lane = tid_ & 63, w = tid_ >> 6;
#pragma unroll
  for (int mi = 0; mi < 2; ++mi)
#pragma unroll
    for (int ni = 0; ni < 2; ++ni)
#pragma unroll
      for (int r = 0; r < 16; ++r)
        f(mi, ni, r, (w >> 1) * 64 + mi * 32 + (r & 3) + 8 * (r >> 2) + 4 * (lane >> 5), (w & 1) * 64 + ni * 32 + (lane & 31));
}
constexpr int LDC = 136;
DEV void tile_store(unsigned char* smem, u16* dst, size_t ldd) {
  const u16* sC = (const u16*)smem;
  __syncthreads();
  const int tid_ = TIDX();
#pragma unroll
  for (int i = 0; i < 8; ++i) {
    const int c = tid_ + 256 * i, row = c >> 4, cc = (c & 15) * 8;
    *(bf16x8*)(dst + (size_t)row * ldd + cc) = *(const bf16x8*)(sC + row * LDC + cc);
  }
}


template <int MI>
DEV void gemm_mm(f32x16 (&acc)[MI][2], const u16* __restrict__ A, int lda, const u16* __restrict__ B, int ldb, int K,
                 unsigned char* smem) {
  constexpr int BM = MI * 64;
  u16* sA = (u16*)smem;
  u16* sB = sA + BM * LDT;
  const int tid = TIDX(), lane = tid & 63, w = tid >> 6, wm = w >> 1, wn = w & 1;
  const int srow = tid >> 3, scol = (tid & 7) * 8;
  const u16* ap = A + (size_t)srow * lda + scol;
  const u16* bp = B + (size_t)srow * ldb + scol;
  bf16x8 ra[MI * 2], rb[4];
#pragma unroll
  for (int i = 0; i < MI * 2; ++i) ra[i] = *(const bf16x8*)(ap + (size_t)(32 * i) * lda);
#pragma unroll
  for (int i = 0; i < 4; ++i) rb[i] = *(const bf16x8*)(bp + (size_t)(32 * i) * ldb);
  const int nk = K >> 6;
  const int fro = (lane & 31) * LDT + (lane >> 5) * 8;
#pragma unroll 1
  for (int kt = 0; kt < nk; ++kt) {
    __syncthreads();
#pragma unroll
    for (int i = 0; i < MI * 2; ++i) *(bf16x8*)(sA + (srow + 32 * i) * LDT + scol) = ra[i];
#pragma unroll
    for (int i = 0; i < 4; ++i) *(bf16x8*)(sB + (srow + 32 * i) * LDT + scol) = rb[i];
    __syncthreads();
    if (kt + 1 < nk) {
      ap += 64;
      bp += 64;
#pragma unroll
      for (int i = 0; i < MI * 2; ++i) ra[i] = *(const bf16x8*)(ap + (size_t)(32 * i) * lda);
#pragma unroll
      for (int i = 0; i < 4; ++i) rb[i] = *(const bf16x8*)(bp + (size_t)(32 * i) * ldb);
    }
    bf16x8 af[2][MI], bfr[2][2];
#pragma unroll
    for (int i = 0; i < MI; ++i) af[0][i] = *(const bf16x8*)(sA + (wm * (MI * 32) + i * 32) * LDT + fro);
#pragma unroll
    for (int i = 0; i < 2; ++i) bfr[0][i] = *(const bf16x8*)(sB + (wn * 64 + i * 32) * LDT + fro);
#pragma unroll
    for (int ks = 0; ks < 4; ++ks) {
      if (ks + 1 < 4) {
#pragma unroll
        for (int i = 0; i < MI; ++i)
          af[(ks + 1) & 1][i] = *(const bf16x8*)(sA + (wm * (MI * 32) + i * 32) * LDT + fro + (ks + 1) * 16);
#pragma unroll
        for (int i = 0; i < 2; ++i)
          bfr[(ks + 1) & 1][i] = *(const bf16x8*)(sB + (wn * 64 + i * 32) * LDT + fro + (ks + 1) * 16);
      }
      __builtin_amdgcn_sched_barrier(0);
      __builtin_amdgcn_s_setprio(1);
#pragma unroll
      for (int mi = 0; mi < MI; ++mi)
#pragma unroll
        for (int ni = 0; ni < 2; ++ni)
          acc[mi][ni] = __builtin_amdgcn_mfma_f32_32x32x16_bf16(af[ks & 1][mi], bfr[ks & 1][ni], acc[mi][ni], 0, 0, 0);
      __builtin_amdgcn_s_setprio(0);
      __builtin_amdgcn_sched_barrier(0);
    }
  }
  __syncthreads();
}
template <int MI>
DEV void zero_acc_t(f32x16 (&acc)[MI][2]) {
#pragma unroll
  for (int a = 0; a < MI; ++a)
#pragma unroll
    for (int b = 0; b < 2; ++b)
#pragma unroll
      for (int r = 0; r < 16; ++r) acc[a][b][r] = 0.f;
}
template <int MI, class F>
DEV void acc_foreach_t(F f) {
  const int tid_ = TIDX();
  const int lane = tid_ & 63, w = tid_ >> 6;
#pragma unroll
  for (int mi = 0; mi < MI; ++mi)
#pragma unroll
    for (int ni = 0; ni < 2; ++ni)
#pragma unroll
      for (int r = 0; r < 16; ++r)
        f(mi, ni, r, (w >> 1) * (MI * 32) + mi * 32 + (r & 3) + 8 * (r >> 2) + 4 * (lane >> 5), (w & 1) * 64 + ni * 32 + (lane & 31));
}
template <int MI>
DEV void tile_store_t(unsigned char* smem, u16* dst, size_t ldd) {
  const u16* sC = (const u16*)smem;
  __syncthreads();
  const int tid_ = TIDX();
#pragma unroll
  for (int i = 0; i < MI * 4; ++i) {
    const int c = tid_ + 256 * i, row = c >> 4, cc = (c & 15) * 8;
    *(bf16x8*)(dst + (size_t)row * ldd + cc) = *(const bf16x8*)(sC + row * LDC + cc);
  }
}

#define XB_TMO      128
#define XB_XCNT(j)  (256  + 64 * (j))
#define XB_XSUB(j)  (1280 + 64 * (j))
#define XB_XGEN(j)  (2304 + 64 * (j))
#define XB_TOP      3328
#define XB_TOPGEN   3392
#define XCD_BAR_WORDS 3456
#define XB_SPIN_CAP (1u << 20)
#define LAS __attribute__((address_space(3)))
DEV unsigned xb_ld(unsigned* p) { return __hip_atomic_load(p, __ATOMIC_RELAXED, __HIP_MEMORY_SCOPE_AGENT); }
DEV unsigned xb_add(unsigned* p, unsigned v) { return __hip_atomic_fetch_add(p, v, __ATOMIC_RELAXED, __HIP_MEMORY_SCOPE_AGENT); }
DEV unsigned xb_xcc_id() { return (unsigned)__builtin_amdgcn_s_getreg((3 << 11) | 20) & 0xFu; }
#define XB_SPIN(cond, bar) do { unsigned _sp = 0; while (cond) { __builtin_amdgcn_s_sleep(1); \
    if ((++_sp & 255u) == 0u) { if (xb_ld(&(bar)[XB_TMO])) break; if (_sp > XB_SPIN_CAP) { atomicAdd(&(bar)[XB_TMO], 1u); break; } } } } while (0)
struct XcdBarrier {
  unsigned* bar;
  unsigned x;
  volatile LAS unsigned* st;
};
DEV XcdBarrier xcd_barrier_post(unsigned* bar, volatile LAS unsigned* st) {
  XcdBarrier b;
  b.bar = bar;
  b.x = xb_xcc_id();
  b.st = st;
  if (threadIdx.x == 0) (void)xb_add(&bar[XB_XCNT(b.x)], 1u);
  return b;
}
DEV void xcd_barrier_complete(unsigned* bar, unsigned x, unsigned& nloc, unsigned& nx) {
  const unsigned G = gridDim.x * gridDim.y * gridDim.z;
  unsigned sum, cnt, mine, sp = 0u;
  for (;;) {
    sum = 0u; cnt = 0u; mine = 0u;
#pragma unroll
    for (unsigned j = 0; j < 16; ++j) {
      const unsigned c = xb_ld(&bar[XB_XCNT(j)]);
      sum += c;
      cnt += (c > 0u) ? 1u : 0u;
      mine = (j == x) ? c : mine;
    }
    if (sum == G) break;
    __builtin_amdgcn_s_sleep(1);
    if ((++sp & 255u) == 0u) {
      if (xb_ld(&bar[XB_TMO])) break;
      if (sp > XB_SPIN_CAP) { atomicAdd(&bar[XB_TMO], 1u); break; }
    }
  }
  nloc = mine > 0u ? mine : 1u;
  nx = cnt > 0u ? cnt : 1u;
}
DEV void xcd_barrier(unsigned* bar_, volatile LAS unsigned* st_) {
  asm volatile("s_waitcnt vmcnt(0)" ::: "memory");
  __syncthreads();
  if (threadIdx.x == 0) {
    XcdBarrier b;
    b.bar = bar_;
    b.x = xb_xcc_id();
    b.st = st_;
    unsigned* bar = b.bar;
    __builtin_amdgcn_s_waitcnt(0);
    unsigned nloc = b.st[0], nx = b.st[1];
    if (nloc == 0u) {
      xcd_barrier_complete(bar, b.x, nloc, nx);
      b.st[0] = nloc;
      b.st[1] = nx;
    }
    const unsigned old = xb_add(&bar[XB_XSUB(b.x)], 1u);
    const unsigned gen = old / nloc;
    if (old + 1u == (gen + 1u) * nloc) {
      __builtin_amdgcn_fence(__ATOMIC_RELEASE, "agent");
      asm volatile("s_waitcnt vmcnt(0)" ::: "memory");
      const unsigned og = xb_add(&bar[XB_TOP], 1u);
      const unsigned tg = og / nx;
      if (og + 1u == (tg + 1u) * nx) xb_add(&bar[XB_TOPGEN], 1u);
      else XB_SPIN(xb_ld(&bar[XB_TOPGEN]) == tg, bar);
      __builtin_amdgcn_fence(__ATOMIC_ACQUIRE, "agent");
      xb_add(&bar[XB_XGEN(b.x)], 1u);
      asm volatile("s_waitcnt vmcnt(0)" ::: "memory");
    } else {
      XB_SPIN(xb_ld(&bar[XB_XGEN(b.x)]) == gen, bar);
      __builtin_amdgcn_fence(__ATOMIC_ACQUIRE, "agent");
      asm volatile("s_waitcnt vmcnt(0)" ::: "memory");
    }
  }
  __syncthreads();
}

DEV void transpose_tile(const float* __restrict__ src, int lds_, u16* __restrict__ dst, int ldd, const float* scale,
                        int k0, int n0, unsigned char* smem) {
  float* s = (float*)smem;
  const int tid = TIDX();
  __syncthreads();
  {
    const int n = tid & 63, kq = tid >> 6;
#pragma unroll 4
    for (int i = 0; i < 16; ++i) {
      int kk = kq * 16 + i;
      s[kk * 65 + n] = src[(size_t)(k0 + kk) * lds_ + n0 + n];
    }
  }
  __syncthreads();
  {
    const int k = tid & 63, nq = tid >> 6;
    const float sc = scale ? scale[k0 + k] : 1.0f;
#pragma unroll 4
    for (int i = 0; i < 16; ++i) {
      int n = nq * 16 + i;
      dst[(size_t)(n0 + n) * ldd + k0 + k] = f2bf(s[k * 65 + n] * sc);
    }
  }
}

DEV void qlat_tile(const float* __restrict__ wq, const float* __restrict__ wuk, const float* __restrict__ g,
                   u16* __restrict__ dst, int h, int r0, int k0, unsigned char* smem) {
  float* sQ = (float*)smem;
  float* sU = sQ + 64 * 65;
  const int tid = TIDX();
  float acc[16];
#pragma unroll
  for (int i = 0; i < 16; ++i) acc[i] = 0.f;
  for (int nh = 0; nh < 2; ++nh) {
    __syncthreads();
    {
      const int n = tid & 63, q = tid >> 6;
      for (int i = 0; i < 16; ++i) {
        int rr = q * 16 + i;
        sQ[rr * 65 + n] = wq[(size_t)(k0 + rr) * 1536 + h * 192 + nh * 64 + n];
        sU[rr * 65 + n] = wuk[(size_t)(r0 + rr) * 1024 + h * 128 + nh * 64 + n];
      }
    }
    __syncthreads();
    const int k = tid & 63, rq = tid >> 6;
    for (int n = 0; n < 64; ++n) {
      float qv = sQ[k * 65 + n];
#pragma unroll
      for (int i = 0; i < 16; ++i) acc[i] += qv * sU[(rq * 16 + i) * 65 + n];
    }
  }
  const int k = tid & 63, rq = tid >> 6;
  const float sc = g[k0 + k];
#pragma unroll
  for (int i = 0; i < 16; ++i) dst[(size_t)(h * 320 + r0 + rq * 16 + i) * 768 + k0 + k] = f2bf(acc[i] * sc);
}

DEV void mod_item(const Params& p, int item, unsigned char* smem) {
  const int l = item / 48, cg_ = item % 48;
  float* sc = (float*)smem;
  float* red = sc + 48 * 256;
  (void)red;
  const int tid = TIDX(), col = tid & 63, kq = tid >> 6;
  const float* W = p.ada_w + (size_t)l * 1024 * 3072 + cg_ * 64 + col;
  float acc[48];
#pragma unroll
  for (int b = 0; b < 48; ++b) acc[b] = 0.f;
  for (int kc = 0; kc < 4; ++kc) {
    __syncthreads();
    for (int e = tid; e < 48 * 256; e += NT) {
      int b = e >> 8, k = e & 255;
      float c = b < 16 ? p.c_p[b * 1024 + kc * 256 + k] : p.c_s[(b - 16) * 1024 + kc * 256 + k];
      sc[e] = siluf_(c);
    }
    __syncthreads();
#pragma unroll 1
    for (int i0 = 0; i0 < 64; i0 += 8) {
      float wv[8];
#pragma unroll
      for (int i = 0; i < 8; ++i) wv[i] = W[(size_t)(kc * 256 + kq * 64 + i0 + i) * 3072];
#pragma unroll
      for (int i = 0; i < 8; ++i) {
        const int k = kq * 64 + i0 + i;
#pragma unroll
        for (int b = 0; b < 48; ++b) acc[b] += sc[b * 256 + k] * wv[i];
      }
    }
  }
  __syncthreads();
#pragma unroll
  for (int b = 0; b < 48; ++b) sc[(kq * 48 + b) * 64 + col] = acc[b];
  __syncthreads();
  float* MOD = (float*)(p.ws + OFF_MOD);
  for (int e = tid; e < 48 * 64; e += NT) {
    int b = e >> 6, c = e & 63;
    float v = sc[(0 * 48 + b) * 64 + c] + sc[(1 * 48 + b) * 64 + c] + sc[(2 * 48 + b) * 64 + c] + sc[(3 * 48 + b) * 64 + c];
    int gc = cg_ * 64 + c;
    MOD[((size_t)l * 48 + b) * 3072 + gc] = v + p.ada_b[l * 3072 + gc];
  }
}

DEV void phase_prep(const Params& p, unsigned char* smem) {
  const int tid = TIDX();
  const int nb = gridDim.x;
  int idx = blockIdx.x, base = 0;
  if (blockIdx.x == 0) {
    if (tid < 64) ((unsigned*)(p.ws + OFF_CNT))[tid] = 0u;
    for (int e = tid; e < XCD_BAR_WORDS; e += NT) ((unsigned*)(p.ws + OFF_BAR))[e] = 0u;
  }
  for (; idx < base + 96; idx += nb) mod_item(p, idx - base, smem);
  base += 96;
  for (int l = 0; l < 2; ++l) {
    u16* WL = (u16*)(p.ws + OFF_W) + (size_t)l * W_LAYER;
    const float* win = p.w_in + (size_t)l * 1024 * IN_DIM;
#define TJOB(SRC, LDS_, KK, NN, DST, LDD, SCALE)                                     \
  {                                                                                  \
    const int nkt = (KK) / 64, ntl = nkt * ((NN) / 64);                              \
    for (; idx < base + ntl; idx += nb) {                                            \
      int t = idx - base;                                                            \
      transpose_tile((SRC), (LDS_), (DST), (LDD), (SCALE), (t % nkt) * 64, (t / nkt) * 64, smem); \
    }                                                                                \
    base += ntl;                                                                     \
  }
    TJOB(win, IN_DIM, 1024, 1024, WL + WO_W1, 1024, nullptr);
    TJOB(win + 2048, IN_DIM, 1024, 1088, WL + WO_W1 + (size_t)1024 * 1024, 1024, nullptr);
    TJOB(win + 1024, IN_DIM, 1024, 1024, WL + WO_G, 1024, nullptr);
    TJOB(win + 3136, IN_DIM, 1024, 3072, WL + WO_G + (size_t)1024 * 1024, 1024, nullptr);
    TJOB(p.w_q_up + (size_t)l * 768 * 1536, 1536, 768, 1536, WL + WO_QP, 768, p.q_norm + l * 768);
    for (int h = 0; h < 8; ++h)
      TJOB(p.w_q_up + (size_t)l * 768 * 1536 + h * 192 + 128, 1536, 768, 64, WL + WO_QS + (size_t)(h * 320 + 256) * 768, 768,
           p.q_norm + l * 768);
    TJOB(p.w_uk + (size_t)l * 262144, 1024, 256, 1024, WL + WO_UK, 256, p.kv_norm + l * 256);
    TJOB(p.w_uv + (size_t)l * 262144, 1024, 256, 1024, WL + WO_UVS, 256, p.kv_norm + l * 256);
    TJOB(p.w_uv + (size_t)l * 262144, 1024, 256, 1024, WL + WO_UVP, 256, nullptr);
    TJOB(p.w_ba + (size_t)l * 1048576, 1024, 1024, 1024, WL + WO_BA, 1024, nullptr);
    TJOB(p.w_bb + (size_t)l * 1048576, 1024, 1024, 1024, WL + WO_BB, 1024, nullptr);
    TJOB(p.w_out + (size_t)l * 1048576, 1024, 1024, 1024, WL + WO_OUT, 1024, nullptr);
    for (int b8 = 0; b8 < 8; ++b8) {
      TJOB(p.lru_wa + (size_t)l * 131072 + b8 * 16384, 128, 128, 128, WL + WO_LA + b8 * 16384, 128, nullptr);
      TJOB(p.lru_wx + (size_t)l * 131072 + b8 * 16384, 128, 128, 128, WL + WO_LX + b8 * 16384, 128, nullptr);
    }
    for (; idx < base + 384; idx += nb) {
      int t = idx - base;
      int h = t / 48, rt = (t % 48) / 12, kt = t % 12;
      qlat_tile(p.w_q_up + (size_t)l * 768 * 1536, p.w_uk + (size_t)l * 262144, p.q_norm + l * 768, WL + WO_QS, h,
                rt * 64, kt * 64, smem);
    }
    base += 384;
    for (; idx < base + 16; idx += nb) {
      int t = idx - base;
      u16* d = WL + WO_W1 + (size_t)2112 * 1024 + t * 4096;
      for (int e = tid; e < 4096; e += NT) d[e] = 0;
    }
    base += 16;
  }
  float* ROPE = (float*)(p.ws + OFF_ROPE);
  for (; idx < base + 512; idx += nb) {
    int e = (idx - base) * 256 + tid;
    int pos = e >> 5, j = e & 31;
    float inv = exp2f(-(float)j * (13.287712379549449f / 32.0f));
    float ang = (float)pos * inv;
    ROPE[2 * e] = cosf(ang);
    ROPE[2 * e + 1] = sinf(ang);
  }
  base += 512;
}

DEV void norm_row(const Params& p, int l, int m, const float (&xv)[16], int lane) {
  float ss = 0.f;
#pragma unroll
  for (int i = 0; i < 16; ++i) ss += xv[i] * xv[i];
  ss = wave_sum(ss);
  const float rstd = rsqrtf(ss * (1.0f / 1024.0f) + EPS);
  const float* MOD = (const float*)(p.ws + OFF_MOD) + ((size_t)l * 48 + mod_row(m)) * 3072;
  u16* H = (u16*)(p.ws + OFF_H) + (size_t)m * 1024;
#pragma unroll
  for (int i = 0; i < 4; ++i) {
    int c = i * 256 + lane * 4;
    float4 g = *(const float4*)(p.pre_norm + l * 1024 + c);
    float4 sh = *(const float4*)(MOD + c);
    float4 sc = *(const float4*)(MOD + 1024 + c);
    ushort4 o;
    o.x = f2bf(xv[i * 4 + 0] * rstd * g.x * (1.f + sc.x) + sh.x);
    o.y = f2bf(xv[i * 4 + 1] * rstd * g.y * (1.f + sc.y) + sh.y);
    o.z = f2bf(xv[i * 4 + 2] * rstd * g.z * (1.f + sc.z) + sh.z);
    o.w = f2bf(xv[i * 4 + 3] * rstd * g.w * (1.f + sc.w) + sh.w);
    *(ushort4*)(H + c) = o;
  }
}

DEV void phase_norm0(const Params& p) {
  const int tid_ = TIDX();
  const int lane = tid_ & 63, wv = tid_ >> 6;
  for (int m = blockIdx.x * 4 + wv; m < MT; m += gridDim.x * 4) {
    const float* x = m < MP ? p.x_p + (size_t)m * 1024 : p.x_s + (size_t)(m - MP) * 1024;
    float xv[16];
#pragma unroll
    for (int i = 0; i < 4; ++i) {
      float4 v = *(const float4*)(x + i * 256 + lane * 4);
      xv[i * 4] = v.x; xv[i * 4 + 1] = v.y; xv[i * 4 + 2] = v.z; xv[i * 4 + 3] = v.w;
    }
    norm_row(p, 0, m, xv, lane);
  }
}

DEV void phase_final(const Params& p, int l) {
  const int tid_ = TIDX();
  const int lane = tid_ & 63, wv = tid_ >> 6;
  const u16* O = (const u16*)(p.ws + OFF_R4);
  for (int m = blockIdx.x * 4 + wv; m < MT; m += gridDim.x * 4) {
    float* y = m < MP ? p.out + OUT_YP + (size_t)m * 1024 : p.out + OUT_YS + (size_t)(m - MP) * 1024;
    const float* x = (l == 0) ? (m < MP ? p.x_p + (size_t)m * 1024 : p.x_s + (size_t)(m - MP) * 1024) : y;
    float xv[16], ov[16];
    float ss = 0.f;
#pragma unroll
    for (int i = 0; i < 4; ++i) {
      int c = i * 256 + lane * 4;
      float4 v = *(const float4*)(x + c);
      xv[i * 4] = v.x; xv[i * 4 + 1] = v.y; xv[i * 4 + 2] = v.z; xv[i * 4 + 3] = v.w;
      ushort4 o = *(const ushort4*)(O + (size_t)m * 1024 + c);
      ov[i * 4] = bf2f(o.x); ov[i * 4 + 1] = bf2f(o.y); ov[i * 4 + 2] = bf2f(o.z); ov[i * 4 + 3] = bf2f(o.w);
    }
#pragma unroll
    for (int i = 0; i < 16; ++i) ss += ov[i] * ov[i];
    ss = wave_sum(ss);
    const float rstd = rsqrtf(ss * (1.0f / 1024.0f) + EPS);
    const float* MOD = (const float*)(p.ws + OFF_MOD) + ((size_t)l * 48 + mod_row(m)) * 3072 + 2048;
#pragma unroll
    for (int i = 0; i < 4; ++i) {
      int c = i * 256 + lane * 4;
      float4 g = *(const float4*)(p.post_norm + l * 1024 + c);
      float4 gt = *(const float4*)(MOD + c);
      xv[i * 4 + 0] += gt.x * ov[i * 4 + 0] * rstd * g.x;
      xv[i * 4 + 1] += gt.y * ov[i * 4 + 1] * rstd * g.y;
      xv[i * 4 + 2] += gt.z * ov[i * 4 + 2] * rstd * g.z;
      xv[i * 4 + 3] += gt.w * ov[i * 4 + 3] * rstd * g.w;
      *(float4*)(y + c) = make_float4(xv[i * 4], xv[i * 4 + 1], xv[i * 4 + 2], xv[i * 4 + 3]);
    }
    if (l == 0) norm_row(p, 1, m, xv, lane);
  }
}

template <int MI>
DEV void gemm1_tile(const Params& p, int l, int m0, int nt, unsigned char* smem) {
  constexpr int BM = MI * 64;
  const u16* H = (const u16*)(p.ws + OFF_H);
  const u16* W1 = (const u16*)(p.ws + OFF_W) + (size_t)l * W_LAYER + WO_W1;
  u16* XA = (u16*)(p.ws + OFF_R1);
  u16* CQ = (u16*)(p.ws + OFF_R2);
  u16* CKVR = CQ + (size_t)MT * 768;
  u16* sC = (u16*)smem;
  f32x16 acc[MI][2];
  zero_acc_t<MI>(acc);
  gemm_mm<MI>(acc, H + (size_t)m0 * 1024, 1024, W1 + (size_t)nt * 128 * 1024, 1024, 1024, smem);
  if (nt < 14) {
    acc_foreach_t<MI>([&](int mi, int ni, int r, int row, int col) __attribute__((always_inline)) {
      sC[row * LDC + col] = f2bf(acc[mi][ni][r]);
    });
    if (nt < 8) tile_store_t<MI>(smem, XA + (size_t)m0 * 1024 + nt * 128, 1024);
    else tile_store_t<MI>(smem, CQ + (size_t)m0 * 768 + (nt - 8) * 128, 768);
    if (nt < 8 && (m0 >= MP || ((m0 + BM) & 4095) == 0)) {
      acc_foreach_t<MI>([&](int mi, int ni, int r, int row, int col) __attribute__((always_inline)) {
        const int m = m0 + row, n = nt * 128 + col;
        const float v = acc[mi][ni][r];
        if (m < MP) {
          int j = (m & 4095) - 4093;
          if (j >= 0) p.out[OUT_CONVP + ((size_t)(l * 16 + (m >> 12)) * 3 + j) * 1024 + n] = v;
        } else {
          int j = ((m - MP) & 15) - 13;
          if (j >= 0) p.out[OUT_CONVS + ((size_t)(l * 32 + ((m - MP) >> 4)) * 3 + j) * 1024 + n] = v;
        }
      });
    }
  } else if (nt < 16) {
    float* ob = m0 < MP ? p.out + OUT_CKVP + ((size_t)l * MP + m0) * 256 + (nt - 14) * 128
                        : p.out + OUT_CKVS + ((size_t)l * MS + (m0 - MP)) * 256 + (nt - 14) * 128;
    acc_foreach_t<MI>([&](int mi, int ni, int r, int row, int col) __attribute__((always_inline)) {
      const float v = acc[mi][ni][r];
      sC[row * LDC + col] = f2bf(v);
      ob[(size_t)row * 256 + col] = v;
    });
    tile_store_t<MI>(smem, CKVR + (size_t)m0 * 256 + (nt - 14) * 128, 256);
  } else {
    float* ob = m0 < MP ? p.out + OUT_KPEP + ((size_t)l * MP + m0) * 64 : p.out + OUT_KPES + ((size_t)l * MS + (m0 - MP)) * 64;
    acc_foreach_t<MI>([&](int mi, int ni, int r, int row, int col) __attribute__((always_inline)) {
      if (col < 64) ob[(size_t)row * 64 + col] = acc[mi][ni][r];
    });
  }
}
DEV void phase_gemm1(const Params& p, int l, unsigned char* smem) {
  const int nb = gridDim.x;
  int idx = vbid(), base = 0;
#pragma unroll 1
  for (; idx < base + 256 * 17; idx += nb) {
    const int t = idx - base;
    gemm1_tile<4>(p, l, (t / 17) * 256, t % 17, smem);
  }
  base += 256 * 17;
#pragma unroll 1
  for (; idx < base + 4 * 17; idx += nb) {
    const int t = idx - base;
    gemm1_tile<2>(p, l, MP + (t / 17) * 128, t % 17, smem);
  }
}

DEV void post1_rows(const Params& p, int l, int item) {
  const int tid_ = TIDX();
  const int lane = tid_ & 63, wv = tid_ >> 6;
  const float* ROPE = (const float*)(p.ws + OFF_ROPE);
  float4 v[2];
  float kx[2];
  float2 cs[2];
  float* ckvp[2];
  float* kpep[2];
#pragma unroll
  for (int u = 0; u < 2; ++u) {
    const int m = item * 8 + wv * 2 + u;
    ckvp[u] = m < MP ? p.out + OUT_CKVP + ((size_t)l * MP + m) * 256 : p.out + OUT_CKVS + ((size_t)l * MS + (m - MP)) * 256;
    kpep[u] = m < MP ? p.out + OUT_KPEP + ((size_t)l * MP + m) * 64 : p.out + OUT_KPES + ((size_t)l * MS + (m - MP)) * 64;
    v[u] = *(const float4*)(ckvp[u] + lane * 4);
    kx[u] = kpep[u][lane];
    cs[u] = *(const float2*)(ROPE + ((size_t)pos_of(m) * 32 + (lane & 31)) * 2);
  }
  const float4 g = *(const float4*)(p.kv_norm + l * 256 + lane * 4);
#pragma unroll
  for (int u = 0; u < 2; ++u) {
    const int m = item * 8 + wv * 2 + u;
    const float ss = wave_sum(v[u].x * v[u].x + v[u].y * v[u].y + v[u].z * v[u].z + v[u].w * v[u].w);
    const float rstd = rsqrtf(ss * (1.0f / 256.0f) + EPS);
    float4 o4 = v[u];
    o4.x *= rstd * g.x; o4.y *= rstd * g.y; o4.z *= rstd * g.z; o4.w *= rstd * g.w;
    *(float4*)(ckvp[u] + lane * 4) = o4;
    const float other = __shfl_xor(kx[u], 32, 64);
    const float c = cs[u].x, sn = cs[u].y;
    const float ro = (lane < 32) ? (kx[u] * c - other * sn) : (other * sn + kx[u] * c);
    kpep[u][lane] = ro;
    if (m < MP) {
      u16* KPE = (u16*)(p.ws + OFF_KPE) + (size_t)m * 64;
      KPE[lane] = f2bf(ro);
    } else {
      const int b = (m - MP) >> 4, t = (m - MP) & 15;
      u16* SKV = (u16*)(p.ws + OFF_SKV) + ((size_t)b * 2112 + 2048 + t) * 320;
      u16* SVT = (u16*)(p.ws + OFF_SVT) + (size_t)b * 256 * 2112 + 2048 + t;
      ushort4 o;
      o.x = f2bf(o4.x); o.y = f2bf(o4.y); o.z = f2bf(o4.z); o.w = f2bf(o4.w);
      *(ushort4*)(SKV + lane * 4) = o;
      SVT[(size_t)(lane * 4 + 0) * 2112] = o.x;
      SVT[(size_t)(lane * 4 + 1) * 2112] = o.y;
      SVT[(size_t)(lane * 4 + 2) * 2112] = o.z;
      SVT[(size_t)(lane * 4 + 3) * 2112] = o.w;
      SKV[256 + lane] = f2bf(ro);
    }
  }
}

DEV void cache_item(const Params& p, int l, int item, unsigned char* smem) {
  const int tid = TIDX();
  const int b = item / 33, kt = item % 33;
  u16* SKV = (u16*)(p.ws + OFF_SKV) + (size_t)b * 2112 * 320;
  u16* SVT = (u16*)(p.ws + OFF_SVT) + (size_t)b * 256 * 2112;
  if (kt == 32) {
    for (int e = tid; e < 48 * 320; e += NT) SKV[(size_t)2064 * 320 + e] = 0;
    for (int e = tid; e < 256 * 48; e += NT) SVT[(size_t)(e / 48) * 2112 + 2064 + (e % 48)] = 0;
    return;
  }
  float* s = (float*)smem;
  const float* src = p.cache_ckv + (((size_t)l * 32 + b) * 2048 + kt * 64) * 256;
  const float* srck = p.cache_kpe + (((size_t)l * 32 + b) * 2048 + kt * 64) * 64;
  for (int dh = 0; dh < 2; ++dh) {
    __syncthreads();
    for (int e = tid; e < 64 * 128; e += NT) {
      int key = e >> 7, d = e & 127;
      float v = src[(size_t)key * 256 + dh * 128 + d];
      s[key * 129 + d] = v;
      SKV[(size_t)(kt * 64 + key) * 320 + dh * 128 + d] = f2bf(v);
    }
    __syncthreads();
    const int k = tid & 63, dq = tid >> 6;
    for (int i = 0; i < 32; ++i) {
      int d = dq * 32 + i;
      SVT[(size_t)(dh * 128 + d) * 2112 + kt * 64 + k] = f2bf(s[k * 129 + d]);
    }
  }
  for (int e = tid; e < 64 * 64; e += NT) {
    int key = e >> 6, d = e & 63;
    SKV[(size_t)(kt * 64 + key) * 320 + 256 + d] = f2bf(srck[(size_t)key * 64 + d]);
  }
}

DEV void phase_p2(const Params& p, int l, unsigned char* smem) {
  const int tid = TIDX(), lane = tid & 63, w = tid >> 6;
  const int nb = gridDim.x;
  const u16* WL = (const u16*)(p.ws + OFF_W) + (size_t)l * W_LAYER;
  const u16* CQ = (const u16*)(p.ws + OFF_R2);
  const u16* CKVR = CQ + (size_t)MT * 768;
  u16* Q = (u16*)(p.ws + OFF_R3);
  u16* QS = (u16*)(p.ws + OFF_QS);
  u16* Kb = (u16*)(p.ws + OFF_R4);
  u16* VT = (u16*)(p.ws + OFF_VT);
  const float* ROPE = (const float*)(p.ws + OFF_ROPE);
  float* ss = gemm_ss(smem);
  int idx = vbid(), base = 0;
  const int nq = 512 * 12 + 4 * 20;
  for (; idx < base + nq; idx += nb) {
    int t = idx - base;
    int mt, nt;
    const u16* Wt;
    bool samp = t >= 512 * 12;
    if (!samp) { mt = t / 12; nt = t % 12; Wt = WL + WO_QP; }
    else { t -= 512 * 12; mt = 512 + t / 20; nt = t % 20; Wt = WL + WO_QS; }
    f32x16 acc[2][2];
    zero_acc(acc);
    gemm_main<1, 1, true>(acc, CQ + (size_t)mt * 128 * 768, 768, Wt + (size_t)nt * 128 * 768, 768, 768, smem);
    const int g = nt * 2 + (w & 1);
    const bool rope = samp ? (g % 5 == 4) : (g % 3 == 2);
    u16* sC = (u16*)smem;
#pragma unroll
    for (int mi = 0; mi < 2; ++mi)
#pragma unroll
      for (int r = 0; r < 16; ++r) {
        const int row = (w >> 1) * 64 + mi * 32 + (r & 3) + 8 * (r >> 2) + 4 * (lane >> 5);
        const int m = mt * 128 + row;
        const float rs = rsqrtf(ss[row] * (1.0f / 768.0f) + EPS) * QSCALE;
        float v0 = acc[mi][0][r] * rs, v1 = acc[mi][1][r] * rs;
        if (rope) {
          const int pos = pos_of(m);
          const float c = ROPE[(pos * 32 + (lane & 31)) * 2], s = ROPE[(pos * 32 + (lane & 31)) * 2 + 1];
          const float a = v0 * c - v1 * s, b = v0 * s + v1 * c;
          v0 = a; v1 = b;
        }
        const int col = (w & 1) * 64 + (lane & 31);
        sC[row * LDC + col] = f2bf(v0);
        sC[row * LDC + col + 32] = f2bf(v1);
      }
    if (!samp) tile_store(smem, Q + (size_t)mt * 128 * 1536 + nt * 128, 1536);
    else tile_store(smem, QS + (size_t)(mt - 512) * 128 * 2560 + nt * 128, 2560);
  }
  base += nq;
  for (; idx < base + 4096; idx += nb) {
    int t = idx - base;
    int mt = t >> 3, nt = t & 7;
    f32x16 acc[2][2];
    zero_acc(acc);
    gemm_main<1, 2, true>(acc, CKVR + (size_t)mt * 128 * 256, 256, WL + WO_UK + (size_t)nt * 128 * 256, 256, 256, smem);
    {
      u16* sC = (u16*)smem;
      acc_foreach([&](int mi, int ni, int r, int row, int col) __attribute__((always_inline)) {
        const float rs = rsqrtf(ss[row] * (1.0f / 256.0f) + EPS);
        sC[row * LDC + col] = f2bf(acc[mi][ni][r] * rs);
      });
      tile_store(smem, Kb + (size_t)mt * 128 * 1024 + nt * 128, 1024);
    }
  }
  base += 4096;
  for (; idx < base + 4096; idx += nb) {
    int t = idx - base;
    int b = t >> 8, mt = (t >> 5) & 7, nt = t & 31;
    f32x16 acc[2][2];
    zero_acc(acc);
    gemm_main<2, 2, true>(acc, WL + WO_UVS + (size_t)mt * 128 * 256, 256, CKVR + ((size_t)b * 4096 + nt * 128) * 256, 256, 256, smem);
    {
      u16* sC = (u16*)smem;
      acc_foreach([&](int mi, int ni, int r, int row, int col) __attribute__((always_inline)) {
        const float rs = rsqrtf(ss[col] * (1.0f / 256.0f) + EPS);
        sC[row * LDC + col] = f2bf(acc[mi][ni][r] * rs);
      });
      tile_store(smem, VT + ((size_t)b * 1024 + mt * 128) * 4096 + nt * 128, 4096);
    }
  }
  base += 4096;
  for (; idx < base + MT / 8; idx += nb) post1_rows(p, l, idx - base);
  base += MT / 8;
  for (; idx < base + 32 * 33; idx += nb) cache_item(p, l, idx - base, smem);
  base += 32 * 33;
}

#ifndef ATT_PF
#define ATT_PF true
#endif
template <int DK, bool PF>
DEV void attn_item(const u16* __restrict__ qrow, const u16* __restrict__ ka, int ldka, const u16* __restrict__ kb, int ldkb,
                   const u16* __restrict__ vt, int ldvt, int ntiles, int my_tiles, int kvlen, u16* orow,
                   unsigned char* smem) {
  constexpr int DKA = DK - 64, KST = DK + 8, VST = 68;
  u16* sK = (u16*)smem;
  u16* sV = sK + 64 * KST;
  const int tid = TIDX(), lane = tid & 63, hh = lane >> 5, l31 = lane & 31;
  constexpr bool QREG = (DK <= 192);
  bf16x8 qf[DK / 16];
  if (QREG) {
#pragma unroll
    for (int ks = 0; ks < DK / 16; ++ks) qf[ks] = *(const bf16x8*)(qrow + ks * 16 + hh * 8);
  }
  f32x16 o[4];
#pragma unroll
  for (int d = 0; d < 4; ++d)
#pragma unroll
    for (int r = 0; r < 16; ++r) o[d][r] = 0.f;
  float mrun = -1e30f, lrun = 0.f;
  constexpr int CA = DKA / 32;
  bf16x8 rk[CA + 2], rv[4];
  const int skey = tid >> 2, sq = tid & 3;
  const u16* gka = ka + (size_t)skey * ldka + sq * CA * 8;
  const u16* gkb = kb + (size_t)skey * ldkb + sq * 16;
  const u16* gv = vt + (size_t)(tid >> 1) * ldvt + (tid & 1) * 32;
  u16* lka = sK + skey * KST + sq * CA * 8;
  u16* lkb = sK + skey * KST + DKA + sq * 16;
  u16* lv = sV + (tid >> 1) * VST + (tid & 1) * 32;
  auto load_tile = [&](int t) __attribute__((always_inline)) {
    const size_t ko = (size_t)t * 64;
#pragma unroll
    for (int i = 0; i < CA; ++i) rk[i] = *(const bf16x8*)(gka + ko * ldka + i * 8);
#pragma unroll
    for (int i = 0; i < 2; ++i) rk[CA + i] = *(const bf16x8*)(gkb + ko * ldkb + i * 8);
#pragma unroll
    for (int i = 0; i < 4; ++i) rv[i] = *(const bf16x8*)(gv + ko + i * 8);
  };
  auto store_tile = [&]() __attribute__((always_inline)) {
#pragma unroll
    for (int i = 0; i < CA; ++i) *(bf16x8*)(lka + i * 8) = rk[i];
#pragma unroll
    for (int i = 0; i < 2; ++i) *(bf16x8*)(lkb + i * 8) = rk[CA + i];
#pragma unroll
    for (int i = 0; i < 4; ++i) {
      union { bf16x8 v; uint2 u[2]; } cv;
      cv.v = rv[i];
      *(uint2*)(lv + i * 8) = cv.u[0];
      *(uint2*)(lv + i * 8 + 4) = cv.u[1];
    }
  };
  if (PF) load_tile(0);
#pragma unroll 1
  for (int t = 0; t < ntiles; ++t) {
    __syncthreads();
    if (!PF) load_tile(t);
    store_tile();
    __syncthreads();
    if (PF && t + 1 < ntiles) load_tile(t + 1);
    if (t < my_tiles) {
      const u16* qp = qrow + hh * 8;
      if (!QREG) asm volatile("" : "+v"(qp));
      const int key0 = t * 64;
#pragma unroll 1
      for (int mi = 0; mi < 2; ++mi) {
        f32x16 s;
#pragma unroll
        for (int r = 0; r < 16; ++r) s[r] = 0.f;
        const u16* kp = sK + (mi * 32 + l31) * KST + hh * 8;
        constexpr int KB = QREG ? 6 : 4;
#pragma unroll
        for (int k0 = 0; k0 < DK / 16; k0 += KB) {
          bf16x8 kf[KB];
#pragma unroll
          for (int i = 0; i < KB; ++i) kf[i] = *(const bf16x8*)(kp + (k0 + i) * 16);
          __builtin_amdgcn_sched_barrier(0);
#pragma unroll
          for (int i = 0; i < KB; ++i) {
            bf16x8 qv;
            if (QREG) qv = qf[k0 + i];
            else qv = *(const bf16x8*)(qp + (k0 + i) * 16);
            s = __builtin_amdgcn_mfma_f32_32x32x16_bf16(kf[i], qv, s, 0, 0, 0);
          }
        }
        bf16x8 vf[8];
        {
          const u16* vp = sV + l31 * VST + mi * 32 + 4 * hh;
#pragma unroll
          for (int oc = 0; oc < 2; ++oc)
#pragma unroll
            for (int d = 0; d < 4; ++d) {
              union { bf16x8 v; uint2 u[2]; } cv;
              cv.u[0] = *(const uint2*)(vp + d * 32 * VST + oc * 16);
              cv.u[1] = *(const uint2*)(vp + d * 32 * VST + oc * 16 + 8);
              vf[oc * 4 + d] = cv.v;
            }
          __builtin_amdgcn_sched_barrier(0);
        }
        if (key0 + 64 > kvlen) {
#pragma unroll
          for (int r = 0; r < 16; ++r) {
            int key = key0 + mi * 32 + (r & 3) + 8 * (r >> 2) + 4 * hh;
            if (key >= kvlen) s[r] = -1e30f;
          }
        }
        float mx = -1e30f;
#pragma unroll
        for (int r = 0; r < 16; ++r) mx = fmaxf(mx, s[r]);
        mx = fmaxf(mx, __shfl_xor(mx, 32, 64));
        if (__builtin_amdgcn_ballot_w64(mx > mrun) != 0ull) {
          const float mnew = fmaxf(mrun, mx);
          const float alpha = __builtin_amdgcn_exp2f(mrun - mnew);
          mrun = mnew;
          lrun *= alpha;
#pragma unroll
          for (int d = 0; d < 4; ++d)
#pragma unroll
            for (int r = 0; r < 16; ++r) o[d][r] *= alpha;
        }
        union { bf16x8 v[2]; unsigned u[8]; } pfu;
        float ps = 0.f;
#pragma unroll
        for (int r = 0; r < 16; r += 2) {
          float p0 = __builtin_amdgcn_exp2f(s[r] - mrun);
          float p1 = __builtin_amdgcn_exp2f(s[r + 1] - mrun);
          ps += p0 + p1;
          pfu.u[r >> 1] = pk2bf(p0, p1);
        }
        lrun += ps;
#pragma unroll
        for (int oc = 0; oc < 2; ++oc)
#pragma unroll
          for (int d = 0; d < 4; ++d) o[d] = __builtin_amdgcn_mfma_f32_32x32x16_bf16(vf[oc * 4 + d], pfu.v[oc], o[d], 0, 0, 0);
      }
    }
  }
  const float ltot = lrun + __shfl_xor(lrun, 32, 64);
  const float inv = 1.0f / ltot;
#pragma unroll
  for (int d = 0; d < 4; ++d)
#pragma unroll
    for (int g = 0; g < 4; ++g) {
      uint2 ov;
      ov.x = pk2bf(o[d][g * 4 + 0] * inv, o[d][g * 4 + 1] * inv);
      ov.y = pk2bf(o[d][g * 4 + 2] * inv, o[d][g * 4 + 3] * inv);
      *(uint2*)(orow + d * 32 + g * 8 + hh * 4) = ov;
    }
  __syncthreads();
}

DEV void lru_item(const Params& p, int l, int sb, int nbk, int half, unsigned char* smem) {
  const int tid = TIDX(), lane = tid & 63, w = tid >> 6, hh = lane >> 5, l31 = lane & 31;
  const bool samp = sb >= 16;
  const int S = samp ? 16 : 4096;
  const int row0 = samp ? MP + (sb - 16) * 16 : sb * 4096;
  const int kc0 = nbk * 128, oc0 = nbk * 128 + half * 64;
  const u16* XA = (const u16*)(p.ws + OFF_R1);
  u16* YL = (u16*)(p.ws + OFF_R2);
  const u16* WL = (const u16*)(p.ws + OFF_W) + (size_t)l * W_LAYER;
  u16* sXC = (u16*)smem;
  float* sA = (float*)(smem + 17408);
  float* sB = sA + 4096;
  float* segA = sB + 4096;
  float* segB = segA + 256;
  float* hc = segB + 256;
  float* cw = hc + 64;
  float* cb = cw + 512;
  const int tm = w >> 1, tn = w & 1;
  __syncthreads();
  for (int e = tid; e < 512; e += NT) cw[e] = p.conv_w[(size_t)l * 4096 + (e >> 7) * 1024 + kc0 + (e & 127)];
  if (tid < 128) cb[tid] = p.conv_b[l * 1024 + kc0 + tid];
  if (tid < 64) hc[tid] = samp ? p.state_lru[((size_t)l * 32 + (sb - 16)) * 1024 + oc0 + tid] : 0.f;
  bf16x8 waf[8], wxf[8];
  {
    const u16* wa = WL + WO_LA + (size_t)nbk * 16384 + (size_t)(half * 64 + tn * 32 + l31) * 128 + hh * 8;
    const u16* wx = WL + WO_LX + (size_t)nbk * 16384 + (size_t)(half * 64 + tn * 32 + l31) * 128 + hh * 8;
#pragma unroll
    for (int ks = 0; ks < 8; ++ks) {
      waf[ks] = *(const bf16x8*)(wa + ks * 16);
      wxf[ks] = *(const bf16x8*)(wx + ks * 16);
    }
  }
  const int och = oc0 + tn * 32 + l31;
  const float ba = p.lru_ba[l * 1024 + och], bx = p.lru_bx[l * 1024 + och];
  const float lam = p.lru_lambda[l * 1024 + och];
  const float ex_ = __expf(-lam);
  const float sp = (-lam > 20.f) ? -lam
                   : (ex_ < 0.01f ? ex_ * (1.0f - ex_ * (0.5f - ex_ * (0.33333334f - 0.25f * ex_))) : __logf(1.0f + ex_));
  __syncthreads();
  for (int t0 = 0; t0 < S; t0 += 64) {
    {
      const int cc = (tid & 15) * 8, tq = tid >> 4;
      bf16x8 xr[7];
#pragma unroll
      for (int j = 0; j < 7; ++j) {
        int ts = t0 + tq * 4 - 3 + j;
        ts = ts < 0 ? 0 : (ts > S - 1 ? S - 1 : ts);
        xr[j] = *(const bf16x8*)(XA + (size_t)(row0 + ts) * 1024 + kc0 + cc);
      }
      float xf[7][8];
#pragma unroll
      for (int j = 0; j < 7; ++j) {
        const int ts = t0 + tq * 4 - 3 + j;
        const bool ok = ts >= 0;
#pragma unroll
        for (int c = 0; c < 8; ++c) xf[j][c] = ok ? bf2f((u16)xr[j][c]) : 0.f;
      }
      if (samp && t0 == 0 && tq == 0) {
#pragma unroll
        for (int j = 0; j < 3; ++j) {
          const float* st = p.state_conv + (((size_t)l * 32 + (sb - 16)) * 3 + j) * 1024 + kc0 + cc;
#pragma unroll
          for (int c = 0; c < 8; ++c) xf[j][c] = st[c];
        }
      }
#pragma unroll
      for (int i = 0; i < 4; ++i) {
        const int tl = tq * 4 + i;
        bf16x8 o;
#pragma unroll
        for (int c = 0; c < 8; ++c) {
          float v = cb[cc + c];
#pragma unroll
          for (int k = 0; k < 4; ++k) v += xf[i + k][c] * cw[k * 128 + cc + c];
          o[c] = (short)f2bf(v);
        }
        *(bf16x8*)(sXC + tl * 136 + cc) = o;
      }
    }
    __syncthreads();
    f32x16 aR, aI;
#pragma unroll
    for (int r = 0; r < 16; ++r) { aR[r] = 0.f; aI[r] = 0.f; }
#pragma unroll
    for (int ks = 0; ks < 8; ++ks) {
      bf16x8 a = *(const bf16x8*)(sXC + (tm * 32 + l31) * 136 + ks * 16 + hh * 8);
      aR = __builtin_amdgcn_mfma_f32_32x32x16_bf16(a, waf[ks], aR, 0, 0, 0);
      aI = __builtin_amdgcn_mfma_f32_32x32x16_bf16(a, wxf[ks], aI, 0, 0, 0);
    }
#pragma unroll
    for (int r = 0; r < 16; ++r) {
      const int tl = tm * 32 + (r & 3) + 8 * (r >> 2) + 4 * hh;
      const int cl = tn * 32 + l31;
      float av, bv;
      {
        const float rg = __builtin_amdgcn_rcpf(1.0f + __expf(-(aR[r] + ba)));
        const float ig = __builtin_amdgcn_rcpf(1.0f + __expf(-(aI[r] + bx)));
        const float la = -8.0f * rg * sp;
        const float a_ = __expf(la);
        const float x2 = 2.0f * la;
        const float ser = -x2 * (1.0f + x2 * (0.5f + x2 * (0.16666667f + x2 * (0.041666668f + x2 * 0.0083333338f))));
        const float em = (x2 > -0.25f) ? ser : 1.0f - __expf(x2);
        const float mult = __builtin_amdgcn_sqrtf(em);
        const float xcv = bf2f(sXC[tl * 136 + half * 64 + cl]);
        const bool valid = (t0 + tl < S);
        av = valid ? a_ : 1.f;
        bv = valid ? mult * ig * xcv : 0.f;
      }
      sA[tl * 64 + cl] = av;
      sB[tl * 64 + cl] = bv;
    }
    __syncthreads();
    {
      const int c = lane, sg = w;
      float A_ = 1.f, B_ = 0.f;
#pragma unroll
      for (int i = 0; i < 16; ++i) {
        const float a = sA[(sg * 16 + i) * 64 + c], b = sB[(sg * 16 + i) * 64 + c];
        B_ = a * B_ + b;
        A_ *= a;
      }
      segA[sg * 64 + c] = A_;
      segB[sg * 64 + c] = B_;
      __syncthreads();
      float h = hc[c];
      for (int s2 = 0; s2 < sg; ++s2) h = segA[s2 * 64 + c] * h + segB[s2 * 64 + c];
      __syncthreads();
#pragma unroll
      for (int i = 0; i < 16; ++i) {
        const int tl = sg * 16 + i;
        const float a = sA[tl * 64 + c], b = sB[tl * 64 + c];
        h = a * h + b;
        if (t0 + tl < S) YL[(size_t)(row0 + t0 + tl) * 1024 + oc0 + c] = f2bf(h);
      }
      if (sg == 3) hc[c] = h;
    }
    __syncthreads();
  }
  if (tid < 64) {
    const float h = hc[tid];
    if (samp) p.out[OUT_LRUS + ((size_t)l * 32 + (sb - 16)) * 1024 + oc0 + tid] = h;
    else p.out[OUT_LRUP + ((size_t)l * 16 + sb) * 1024 + oc0 + tid] = h;
  }
  __syncthreads();
}

DEV void phase_p3(const Params& p, int l, unsigned char* smem) {
  __shared__ int s_item;
  const int tid = TIDX(), lane = tid & 63, w = tid >> 6;
#pragma unroll 1
  for (int it = blockIdx.x; it < 256; it += gridDim.x) lru_item(p, l, it >> 4, (it >> 1) & 7, it & 1, smem);
#pragma unroll 1
  for (int it0 = blockIdx.x; it0 < 320; it0 += gridDim.x) {
    if (it0 < 256) continue;
    const int it = it0 - 256;
    const int b = it >> 1, dvh = it & 1;
    const int r = w * 32 + (lane & 31), h = r >> 4, t = r & 15;
    const u16* qrow = (const u16*)(p.ws + OFF_QS) + ((size_t)b * 16 + t) * 2560 + h * 320;
    const u16* ka = (const u16*)(p.ws + OFF_SKV) + (size_t)b * 2112 * 320;
    const u16* vt = (const u16*)(p.ws + OFF_SVT) + ((size_t)b * 256 + dvh * 128) * 2112;
    u16* orow = (u16*)(p.ws + OFF_OLAT) + ((size_t)b * 16 + t) * 2048 + h * 256 + dvh * 128;
    attn_item<320, false>(qrow, ka, 320, ka + 256, 320, vt, 2112, 33, 33, 2064, orow, smem);
  }
  const int xcd = blockIdx.x & 7;
#pragma unroll 1
  for (int qi = 0; qi < 8; ++qi) {
    const int q = (xcd + qi) & 7;
    unsigned* qc = (unsigned*)(p.ws + OFF_CNT) + 8 + l * 8 + q;
#pragma unroll 1
    for (;;) {
      __syncthreads();
      if (tid == 0) s_item = (int)atomicAdd(qc, 1u);
      __syncthreads();
      const int it = s_item;
      if (it >= 512) break;
      const int qt = 31 - (it & 31), bh = (it >> 5) * 8 + q, b = bh >> 3, h = bh & 7;
      u16* Q = (u16*)(p.ws + OFF_R3);
      const int r = w * 32 + (lane & 31);
      u16* qrow = Q + ((size_t)b * 4096 + qt * 128 + r) * 1536 + h * 192;
      const u16* ka = (const u16*)(p.ws + OFF_R4) + (size_t)b * 4096 * 1024 + h * 128;
      const u16* kb = (const u16*)(p.ws + OFF_KPE) + (size_t)b * 4096 * 64;
      const u16* vt = (const u16*)(p.ws + OFF_VT) + ((size_t)b * 1024 + h * 128) * 4096;
      attn_item<192, ATT_PF>(qrow, ka, 1024, kb, 64, vt, 4096, 2 * (qt + 1), 2 * qt + 1 + (w >> 1), 1 << 30, qrow, smem);
    }
  }
#pragma unroll 1
  for (int it = blockIdx.x; it < 512; it += gridDim.x) lru_item(p, l, 16 + (it >> 4), (it >> 1) & 7, it & 1, smem);
}

template <int MI>
DEV void p4_tile(const Params& p, int l, int m0, int nt, unsigned char* smem) {
  const u16* WL = (const u16*)(p.ws + OFF_W) + (size_t)l * W_LAYER;
  const u16* H = (const u16*)(p.ws + OFF_H);
  const u16* Q = (const u16*)(p.ws + OFF_R3);
  const u16* OLAT = (const u16*)(p.ws + OFF_OLAT);
  u16* YB = (u16*)(p.ws + OFF_R1);
  u16* YA = (u16*)(p.ws + OFF_R2);
  u16* sC = (u16*)smem;
  f32x16 acc[MI][2];
  if (nt < 8) {
    if constexpr (MI == 2) {
      if (m0 >= MP) {
        f32x16 att[MI][2];
        zero_acc_t<MI>(att);
        gemm_mm<MI>(att, OLAT + (size_t)(m0 - MP) * 2048 + nt * 256, 2048, WL + WO_UVP + (size_t)nt * 128 * 256, 256, 256, smem);
        zero_acc_t<MI>(acc);
        gemm_mm<MI>(acc, H + (size_t)m0 * 1024, 1024, WL + WO_G + (size_t)(1024 + nt * 128) * 1024, 1024, 1024, smem);
        acc_foreach_t<MI>([&](int mi, int ni, int r, int row, int col) __attribute__((always_inline)) {
          sC[row * LDC + col] = f2bf(att[mi][ni][r] * siluf_(acc[mi][ni][r]));
        });
        tile_store_t<MI>(smem, YB + (size_t)m0 * 1024 + nt * 128, 1024);
        return;
      }
    }
    zero_acc_t<MI>(acc);
    gemm_mm<MI>(acc, H + (size_t)m0 * 1024, 1024, WL + WO_G + (size_t)(1024 + nt * 128) * 1024, 1024, 1024, smem);
    const u16* at = Q + (size_t)m0 * 1536 + nt * 192;
    acc_foreach_t<MI>([&](int mi, int ni, int r, int row, int col) __attribute__((always_inline)) {
      sC[row * LDC + col] = f2bf(bf2f(at[(size_t)row * 1536 + col]) * siluf_(acc[mi][ni][r]));
    });
    tile_store_t<MI>(smem, YB + (size_t)m0 * 1024 + nt * 128, 1024);
  } else {
    const int n0 = (nt - 8) * 128;
    zero_acc_t<MI>(acc);
    gemm_mm<MI>(acc, H + (size_t)m0 * 1024, 1024, WL + WO_G + (size_t)n0 * 1024, 1024, 1024, smem);
    const u16* ya = YA + (size_t)m0 * 1024 + n0;
    acc_foreach_t<MI>([&](int mi, int ni, int r, int row, int col) __attribute__((always_inline)) {
      sC[row * LDC + col] = f2bf(bf2f(ya[(size_t)row * 1024 + col]) * siluf_(acc[mi][ni][r]));
    });
    tile_store_t<MI>(smem, YA + (size_t)m0 * 1024 + n0, 1024);
  }
}
DEV void phase_p4(const Params& p, int l, unsigned char* smem) {
  const int nb = gridDim.x;
  int idx = vbid(), base = 0;
#pragma unroll 1
  for (; idx < base + 256 * 16; idx += nb) {
    const int t = idx - base;
    p4_tile<4>(p, l, (t >> 4) * 256, t & 15, smem);
  }
  base += 256 * 16;
#pragma unroll 1
  for (; idx < base + 4 * 16; idx += nb) {
    const int t = idx - base;
    p4_tile<2>(p, l, MP + (t >> 4) * 128, t & 15, smem);
  }
}

constexpr int SM_GATE = 2 * 128 * LDT * 2 + 1024;
DEV void gemm_gates(f32x16 (&acc)[2][4], const u16* __restrict__ A, const u16* __restrict__ B0, const u16* __restrict__ B1,
                    unsigned char* smem) {
  u16* sA = (u16*)smem;
  u16* sB = sA + 128 * LDT;
  const int tid = TIDX(), lane = tid & 63, w = tid >> 6, wm = w >> 1, wn = w & 1;
  const int srow = tid >> 3, scol = (tid & 7) * 8;
  const u16* ap = A + (size_t)srow * 1024 + scol;
  const u16* b0p = B0 + (size_t)srow * 1024 + scol;
  const u16* b1p = B1 + (size_t)srow * 1024 + scol;
  bf16x8 ra[4], rb[8];
#pragma unroll
  for (int i = 0; i < 4; ++i) {
    ra[i] = *(const bf16x8*)(ap + (size_t)(32 * i) * 1024);
    rb[i] = *(const bf16x8*)(b0p + (size_t)(32 * i) * 1024);
    rb[4 + i] = *(const bf16x8*)(b1p + (size_t)(32 * i) * 1024);
  }
  const int fro = (lane & 31) * LDT + (lane >> 5) * 8;
#pragma unroll 1
  for (int kt = 0; kt < 16; ++kt) {
    __syncthreads();
#pragma unroll
    for (int i = 0; i < 4; ++i) *(bf16x8*)(sA + (srow + 32 * i) * LDT + scol) = ra[i];
#pragma unroll
    for (int i = 0; i < 8; ++i) *(bf16x8*)(sB + (srow + 32 * i) * LDT + scol) = rb[i];
    __syncthreads();
    if (kt + 1 < 16) {
      ap += 64;
      b0p += 64;
      b1p += 64;
#pragma unroll
      for (int i = 0; i < 4; ++i) {
        ra[i] = *(const bf16x8*)(ap + (size_t)(32 * i) * 1024);
        rb[i] = *(const bf16x8*)(b0p + (size_t)(32 * i) * 1024);
        rb[4 + i] = *(const bf16x8*)(b1p + (size_t)(32 * i) * 1024);
      }
    }
#pragma unroll 2
    for (int ks = 0; ks < 4; ++ks) {
      bf16x8 af[2], bfr[4];
#pragma unroll
      for (int i = 0; i < 2; ++i) af[i] = *(const bf16x8*)(sA + (wm * 64 + i * 32) * LDT + fro + ks * 16);
#pragma unroll
      for (int i = 0; i < 4; ++i)
        bfr[i] = *(const bf16x8*)(sB + ((i >> 1) * 128 + wn * 64 + (i & 1) * 32) * LDT + fro + ks * 16);
      __builtin_amdgcn_s_setprio(1);
#pragma unroll
      for (int mi = 0; mi < 2; ++mi)
#pragma unroll
        for (int ni = 0; ni < 4; ++ni)
          acc[mi][ni] = __builtin_amdgcn_mfma_f32_32x32x16_bf16(af[mi], bfr[ni], acc[mi][ni], 0, 0, 0);
      __builtin_amdgcn_s_setprio(0);
    }
  }
  __syncthreads();
}
DEV void phase_p5(const Params& p, int l, unsigned char* smem) {
  const u16* WL = (const u16*)(p.ws + OFF_W) + (size_t)l * W_LAYER;
  const u16* H = (const u16*)(p.ws + OFF_H);
  const u16* YB = (const u16*)(p.ws + OFF_R1);
  const u16* YA = (const u16*)(p.ws + OFF_R2);
  u16* MRG = (u16*)(p.ws + OFF_R3);
  u16* sC = (u16*)smem;
  const int ntiles = 516 * 8;
  for (int t = vbid(); t < ntiles; t += gridDim.x) {
    const int mt = t >> 3, nt = t & 7;
    unsigned ga[2][2][8];
    unsigned* sG = (unsigned*)(smem + SM_GATE);
    const int tid = TIDX();
    {
      f32x16 g[2][4];
#pragma unroll
      for (int a_ = 0; a_ < 2; ++a_)
#pragma unroll
        for (int b_ = 0; b_ < 4; ++b_)
#pragma unroll
          for (int r = 0; r < 16; ++r) g[a_][b_][r] = 0.f;
      gemm_gates(g, H + (size_t)mt * 128 * 1024, WL + WO_G + (size_t)(2048 + nt * 128) * 1024,
                 WL + WO_G + (size_t)(3072 + nt * 128) * 1024, smem);
#pragma unroll
      for (int a_ = 0; a_ < 2; ++a_)
#pragma unroll
        for (int b_ = 0; b_ < 2; ++b_) {
#pragma unroll
          for (int r = 0; r < 8; ++r)
            sG[((a_ * 2 + b_) * 8 + r) * 256 + tid] = pk2bf(sigmoidf_(g[a_][2 + b_][2 * r]), sigmoidf_(g[a_][2 + b_][2 * r + 1]));
          __builtin_amdgcn_sched_barrier(0);
        }
#pragma unroll
      for (int a_ = 0; a_ < 2; ++a_)
#pragma unroll
        for (int b_ = 0; b_ < 2; ++b_) {
#pragma unroll
          for (int r = 0; r < 8; ++r) ga[a_][b_][r] = pk2bf(sigmoidf_(g[a_][b_][2 * r]), sigmoidf_(g[a_][b_][2 * r + 1]));
          __builtin_amdgcn_sched_barrier(0);
        }
    }
    auto gate_a = [&](int mi, int ni, int r) __attribute__((always_inline)) -> float {
      const unsigned gq = ga[mi][ni][r >> 1];
      return __uint_as_float((r & 1) ? (gq & 0xffff0000u) : (gq << 16));
    };
    auto gate_b = [&](int mi, int ni, int r) __attribute__((always_inline)) -> float {
      const unsigned gq = sG[((mi * 2 + ni) * 8 + (r >> 1)) * 256 + tid];
      return __uint_as_float((r & 1) ? (gq & 0xffff0000u) : (gq << 16));
    };
    f32x16 acc[2][2];
    unsigned res[2][2][8];
    zero_acc(acc);
    gemm_main<0, 1, true>(acc, YA + (size_t)mt * 128 * 1024, 1024, WL + WO_BA + (size_t)nt * 128 * 1024, 1024, 1024, smem);
#pragma unroll
    for (int mi = 0; mi < 2; ++mi)
#pragma unroll
      for (int ni = 0; ni < 2; ++ni)
#pragma unroll
        for (int r = 0; r < 8; ++r)
          res[mi][ni][r] = pk2bf(acc[mi][ni][2 * r] * gate_a(mi, ni, 2 * r), acc[mi][ni][2 * r + 1] * gate_a(mi, ni, 2 * r + 1));
    zero_acc(acc);
    gemm_main<0>(acc, YB + (size_t)mt * 128 * 1024, 1024, WL + WO_BB + (size_t)nt * 128 * 1024, 1024, 1024, smem);
    __syncthreads();
    acc_foreach([&](int mi, int ni, int r, int row, int col) __attribute__((always_inline)) {
      const unsigned rq = res[mi][ni][r >> 1];
      const float rv = __uint_as_float((r & 1) ? (rq & 0xffff0000u) : (rq << 16));
      sC[row * LDC + col] = f2bf(rv + acc[mi][ni][r] * gate_b(mi, ni, r));
    });
    tile_store(smem, MRG + (size_t)mt * 128 * 1024 + nt * 128, 1024);
  }
}

template <int MI>
DEV void p6_tile(const Params& p, int l, int m0, int nt, unsigned char* smem) {
  const u16* WL = (const u16*)(p.ws + OFF_W) + (size_t)l * W_LAYER;
  const u16* MRG = (const u16*)(p.ws + OFF_R3);
  u16* O = (u16*)(p.ws + OFF_R4);
  u16* sC = (u16*)smem;
  f32x16 acc[MI][2];
  zero_acc_t<MI>(acc);
  gemm_mm<MI>(acc, MRG + (size_t)m0 * 1024, 1024, WL + WO_OUT + (size_t)nt * 128 * 1024, 1024, 1024, smem);
  acc_foreach_t<MI>([&](int mi, int ni, int r, int row, int col) __attribute__((always_inline)) {
    sC[row * LDC + col] = f2bf(acc[mi][ni][r]);
  });
  tile_store_t<MI>(smem, O + (size_t)m0 * 1024 + nt * 128, 1024);
}
DEV void phase_p6(const Params& p, int l, unsigned char* smem) {
  const int nb = gridDim.x;
  int idx = vbid(), base = 0;
#pragma unroll 1
  for (; idx < base + 256 * 8; idx += nb) {
    const int t = idx - base;
    p6_tile<4>(p, l, (t >> 3) * 256, t & 7, smem);
  }
  base += 256 * 8;
#pragma unroll 1
  for (; idx < base + 4 * 8; idx += nb) {
    const int t = idx - base;
    p6_tile<2>(p, l, MP + (t >> 3) * 128, t & 7, smem);
  }
}

constexpr int SM_TOTAL = SM_GATE + 32768;
__global__ void __launch_bounds__(NT, 2) mega(Params p) {
  __shared__ __attribute__((aligned(16))) unsigned char smem[SM_TOTAL];
  cg::grid_group grid = cg::this_grid();
  __shared__ uint4 xb_words;
  if (threadIdx.x == 0) xb_words = make_uint4(0u, 0u, 0u, 0u);
#define PH(call)                                             \
  {                                                          \
    Params q = p;                                            \
    asm volatile("" : "+s"(q.ws), "+s"(q.out));              \
    call;                                                    \
  }
  PH(phase_prep(q, smem));
  grid.sync();
  (void)xcd_barrier_post((unsigned*)(p.ws + OFF_BAR), (volatile LAS unsigned*)&xb_words);
#define XBAR() xcd_barrier((unsigned*)(p.ws + OFF_BAR), (volatile LAS unsigned*)&xb_words)
  PH(phase_norm0(q));
  XBAR();
#pragma unroll 1
  for (int l = 0; l < 2; ++l) {
    PH(phase_gemm1(q, l, smem));
    XBAR();
    PH(phase_p2(q, l, smem));
    XBAR();
    PH(phase_p3(q, l, smem));
    XBAR();
    PH(phase_p4(q, l, smem));
    XBAR();
    PH(phase_p5(q, l, smem));
    XBAR();
    PH(phase_p6(q, l, smem));
    XBAR();
    PH(phase_final(q, l));
    if (l == 0) XBAR();
  }
}

extern "C" void kernel_launch(void* const* d_in, const int* in_sizes, int n_in, void* d_out, int out_size, void* d_ws,
                              size_t ws_size, hipStream_t stream) {
  static int grid_blocks = 0;
  if (!grid_blocks) {
    int dev = 0, cus = 0, per_cu = 0;
    hipGetDevice(&dev);
    hipDeviceGetAttribute(&cus, hipDeviceAttributeMultiprocessorCount, dev);
    hipOccupancyMaxActiveBlocksPerMultiprocessor(&per_cu, mega, NT, 0);
    if (per_cu > 2) per_cu = 2;
    grid_blocks = cus * per_cu;
  }
  if (ws_size < WS_NEED) {
    fprintf(stderr, "workspace too small: %zu < %zu\n", ws_size, (size_t)WS_NEED);
    return;
  }
  Params p{};
  const float** pp = (const float**)&p;
  for (int i = 0; i < 28; ++i) pp[i] = (const float*)d_in[i];
  p.out = (float*)d_out;
  p.ws = (unsigned char*)d_ws;
  void* args[] = {&p};
  hipError_t e = hipLaunchCooperativeKernel((void*)mega, dim3(grid_blocks), dim3(NT), args, 0, stream);
  if (e != hipSuccess) fprintf(stderr, "cooperative launch failed: %s (grid %d)\n", hipGetErrorString(e), grid_blocks);
}
```

```cpp
#include <hip/hip_runtime.h>
#include <hip/hip_cooperative_groups.h>
#include <cstdio>
namespace cg = cooperative_groups;

typedef unsigned short u16;
typedef __attribute__((ext_vector_type(8))) short bf16x8;
typedef __attribute__((ext_vector_type(16))) float f32x16;

#define DEV __device__ __forceinline__
#define NT 256

constexpr int MP = 65536, MS = 512, MT = 66048;
constexpr int IN_DIM = 6208;
constexpr float EPS = 1e-6f;
constexpr float QSCALE = 0.07216878364870322f * 1.4426950408889634f;

constexpr size_t SZ_ACT = (size_t)MT * 1024 * 2;
constexpr size_t OFF_H = 0;
constexpr size_t OFF_R1 = OFF_H + SZ_ACT;
constexpr size_t OFF_R2 = OFF_R1 + SZ_ACT;
constexpr size_t OFF_R3 = OFF_R2 + SZ_ACT;
constexpr size_t OFF_R4 = OFF_R3 + (size_t)MP * 1536 * 2;
constexpr size_t OFF_KPE = OFF_R4 + SZ_ACT;
constexpr size_t OFF_VT = OFF_KPE + (size_t)MT * 64 * 2;
constexpr size_t OFF_SKV = OFF_VT + (size_t)16 * 1024 * 4096 * 2;
constexpr size_t OFF_SVT = OFF_SKV + (size_t)32 * 2112 * 320 * 2;
constexpr size_t OFF_QS = OFF_SVT + (size_t)32 * 256 * 2112 * 2;
constexpr size_t OFF_OLAT = OFF_QS + (size_t)MS * 2560 * 2;
constexpr size_t OFF_MOD = OFF_OLAT + (size_t)MS * 2048 * 2;
constexpr size_t OFF_ROPE = OFF_MOD + (size_t)2 * 48 * 3072 * 4;
constexpr size_t OFF_CNT = OFF_ROPE + (size_t)4096 * 32 * 2 * 4;
constexpr size_t OFF_W = OFF_CNT + 256;
constexpr size_t WO_W1 = 0;
constexpr size_t WO_G = WO_W1 + (size_t)2176 * 1024;
constexpr size_t WO_QP = WO_G + (size_t)4096 * 1024;
constexpr size_t WO_QS = WO_QP + (size_t)1536 * 768;
constexpr size_t WO_UK = WO_QS + (size_t)2560 * 768;
constexpr size_t WO_UVS = WO_UK + 262144;
constexpr size_t WO_UVP = WO_UVS + 262144;
constexpr size_t WO_BA = WO_UVP + 262144;
constexpr size_t WO_BB = WO_BA + 1048576;
constexpr size_t WO_OUT = WO_BB + 1048576;
constexpr size_t WO_LA = WO_OUT + 1048576;
constexpr size_t WO_LX = WO_LA + 131072;
constexpr size_t W_LAYER = WO_LX + 131072;
constexpr size_t OFF_BAR = OFF_W + 2 * W_LAYER * 2;
constexpr size_t WS_NEED = OFF_BAR + 16384;

constexpr size_t OUT_YP = 0;
constexpr size_t OUT_YS = 67108864;
constexpr size_t OUT_CKVP = 67633152;
constexpr size_t OUT_KPEP = 101187584;
constexpr size_t OUT_CONVP = 109576192;
constexpr size_t OUT_LRUP = 109674496;
constexpr size_t OUT_CKVS = 109707264;
constexpr size_t OUT_KPES = 109969408;
constexpr size_t OUT_CONVS = 110034944;
constexpr size_t OUT_LRUS = 110231552;

struct Params {
  const float *x_p, *x_s, *c_p, *c_s, *cache_ckv, *cache_kpe, *state_conv, *state_lru;
  const float *ada_w, *ada_b, *pre_norm, *post_norm, *w_in, *conv_w, *conv_b, *lru_wa, *lru_ba, *lru_wx, *lru_bx;
  const float *lru_lambda, *q_norm, *w_q_up, *kv_norm, *w_uk, *w_uv, *w_ba, *w_bb, *w_out;
  float* out;
  unsigned char* ws;
};

DEV int TIDX() {
  int t = threadIdx.x;
  asm volatile("" : "+v"(t));
  return t;
}
typedef __attribute__((ext_vector_type(2))) float f32x2_t;
typedef __attribute__((ext_vector_type(2))) __bf16 bf16x2_t;
DEV unsigned pk2bf(float a, float b) {
  f32x2_t v = {a, b};
  bf16x2_t r = __builtin_convertvector(v, bf16x2_t);
  return __builtin_bit_cast(unsigned, r);
}
DEV u16 f2bf(float f) { return (u16)(pk2bf(f, 0.f) & 0xffffu); }
DEV float bf2f(u16 h) { return __uint_as_float(((unsigned)h) << 16); }
DEV float sigmoidf_(float x) { return 1.0f / (1.0f + __expf(-x)); }
DEV float siluf_(float x) { return x / (1.0f + __expf(-x)); }
DEV float wave_sum(float v) {
#pragma unroll
  for (int o = 32; o > 0; o >>= 1) v += __shfl_xor(v, o, 64);
  return v;
}
DEV int vbid() {
  const int b = blockIdx.x, n = gridDim.x;
  return ((n & 7) == 0) ? (b & 7) * (n >> 3) + (b >> 3) : b;
}
DEV int mod_row(int m) { return m < MP ? (m >> 12) : 16 + ((m - MP) >> 4); }
DEV int pos_of(int m) { return m < MP ? (m & 4095) : 2048 + ((m - MP) & 15); }

constexpr int LDT = 72;
#ifndef P5_DEPTH
#define P5_DEPTH 1
#endif
template <int SS, int DEPTH = 1>
DEV void gemm_main(f32x16 (&acc)[2][2], const u16* __restrict__ A, int lda, const u16* __restrict__ B, int ldb,
                   int K, unsigned char* smem) {
  u16* sA = (u16*)smem;
  u16* sB = sA + 128 * LDT;
  float* ss = (float*)(sB + 128 * LDT);
  const int tid = TIDX(), lane = tid & 63, w = tid >> 6, wm = w >> 1, wn = w & 1;
  const int srow = tid >> 3, scol = (tid & 7) * 8;
  const u16* ap = A + (size_t)srow * lda + scol;
  const u16* bp = B + (size_t)srow * ldb + scol;
  bf16x8 ra[DEPTH][4], rb[DEPTH][4];
  float ssq[4] = {0.f, 0.f, 0.f, 0.f};
  const int nk = K >> 6;
#pragma unroll
  for (int d = 0; d < DEPTH; ++d)
#pragma unroll
    for (int i = 0; i < 4; ++i) {
      ra[d][i] = *(const bf16x8*)(ap + d * 64 + (size_t)(32 * i) * lda);
      rb[d][i] = *(const bf16x8*)(bp + d * 64 + (size_t)(32 * i) * ldb);
    }
  ap += DEPTH * 64;
  bp += DEPTH * 64;
  const int fro = (lane & 31) * LDT + (lane >> 5) * 8;
#pragma unroll 1
  for (int kt = 0; kt < nk; kt += DEPTH) {
#pragma unroll
    for (int d = 0; d < DEPTH; ++d) {
      __syncthreads();
#pragma unroll
      for (int i = 0; i < 4; ++i) {
        *(bf16x8*)(sA + (srow + 32 * i) * LDT + scol) = ra[d][i];
        *(bf16x8*)(sB + (srow + 32 * i) * LDT + scol) = rb[d][i];
        if (SS) {
          bf16x8 v = (SS == 1) ? ra[d][i] : rb[d][i];
#pragma unroll
          for (int j = 0; j < 8; ++j) {
            float f = bf2f((u16)v[j]);
            ssq[i] += f * f;
          }
        }
      }
      __syncthreads();
      if (kt + d + DEPTH < nk) {
#pragma unroll
        for (int i = 0; i < 4; ++i) {
          ra[d][i] = *(const bf16x8*)(ap + (size_t)(32 * i) * lda);
          rb[d][i] = *(const bf16x8*)(bp + (size_t)(32 * i) * ldb);
        }
        ap += 64;
        bp += 64;
      }
#pragma unroll
      for (int ks = 0; ks < 4; ++ks) {
        bf16x8 af[2], bfr[2];
#pragma unroll
        for (int i = 0; i < 2; ++i) {
          af[i] = *(const bf16x8*)(sA + (wm * 64 + i * 32) * LDT + fro + ks * 16);
          bfr[i] = *(const bf16x8*)(sB + (wn * 64 + i * 32) * LDT + fro + ks * 16);
        }
        __builtin_amdgcn_s_setprio(1);
#pragma unroll
        for (int mi = 0; mi < 2; ++mi)
#pragma unroll
          for (int ni = 0; ni < 2; ++ni)
            acc[mi][ni] = __builtin_amdgcn_mfma_f32_32x32x16_bf16(af[mi], bfr[ni], acc[mi][ni], 0, 0, 0);
        __builtin_amdgcn_s_setprio(0);
      }
    }
  }
  if (SS) {
#pragma unroll
    for (int i = 0; i < 4; ++i) {
      float v = ssq[i];
      v += __shfl_xor(v, 1, 64);
      v += __shfl_xor(v, 2, 64);
      v += __shfl_xor(v, 4, 64);
      if ((tid & 7) == 0) ss[srow + 32 * i] = v;
    }
    __syncthreads();
  }
}
DEV void zero_acc(f32x16 (&acc)[2][2]) {
#pragma unroll
  for (int a = 0; a < 2; ++a)
#pragma unroll
    for (int b = 0; b < 2; ++b)
#pragma unroll
      for (int r = 0; r < 16; ++r) acc[a][b][r] = 0.f;
}
DEV float* gemm_ss(unsigned char* smem) { return (float*)(smem + 2 * 128 * LDT * 2); }

template <class F>
DEV void acc_foreach(F f) {
  const int tid_ = TIDX();
  const int lane = tid_ & 63, w = tid_ >> 6;
#pragma unroll
  for (int mi = 0; mi < 2; ++mi)
#pragma unroll
    for (int ni = 0; ni < 2; ++ni)
#pragma unroll
      for (int r = 0; r < 16; ++r)
        f(mi, ni, r, (w >> 1) * 64 + mi * 32 + (r & 3) + 8 * (r >> 2) + 4 * (lane >> 5), (w & 1) * 64 + ni * 32 + (lane & 31));
}
constexpr int LDC = 136;
DEV void tile_store(unsigned char* smem, u16* dst, size_t ldd) {
  const u16* sC = (const u16*)smem;
  __syncthreads();
  const int tid_ = TIDX();
#pragma unroll
  for (int i = 0; i < 8; ++i) {
    const int c = tid_ + 256 * i, row = c >> 4, cc = (c & 15) * 8;
    *(bf16x8*)(dst + (size_t)row * ldd + cc) = *(const bf16x8*)(sC + row * LDC + cc);
  }
}


template <int MI>
DEV void gemm_mm(f32x16 (&acc)[MI][2], const u16* __restrict__ A, int lda, const u16* __restrict__ B, int ldb, int K,
                 unsigned char* smem) {
  constexpr int BM = MI * 64;
  u16* sA = (u16*)smem;
  u16* sB = sA + BM * LDT;
  const int tid = TIDX(), lane = tid & 63, w = tid >> 6, wm = w >> 1, wn = w & 1;
  const int srow = tid >> 3, scol = (tid & 7) * 8;
  const u16* ap = A + (size_t)srow * lda + scol;
  const u16* bp = B + (size_t)srow * ldb + scol;
  bf16x8 ra[MI * 2], rb[4];
#pragma unroll
  for (int i = 0; i < MI * 2; ++i) ra[i] = *(const bf16x8*)(ap + (size_t)(32 * i) * lda);
#pragma unroll
  for (int i = 0; i < 4; ++i) rb[i] = *(const bf16x8*)(bp + (size_t)(32 * i) * ldb);
  const int nk = K >> 6;
  const int fro = (lane & 31) * LDT + (lane >> 5) * 8;
#pragma unroll 1
  for (int kt = 0; kt < nk; ++kt) {
    __syncthreads();
#pragma unroll
    for (int i = 0; i < MI * 2; ++i) *(bf16x8*)(sA + (srow + 32 * i) * LDT + scol) = ra[i];
#pragma unroll
    for (int i = 0; i < 4; ++i) *(bf16x8*)(sB + (srow + 32 * i) * LDT + scol) = rb[i];
    __syncthreads();
    if (kt + 1 < nk) {
      ap += 64;
      bp += 64;
#pragma unroll
      for (int i = 0; i < MI * 2; ++i) ra[i] = *(const bf16x8*)(ap + (size_t)(32 * i) * lda);
#pragma unroll
      for (int i = 0; i < 4; ++i) rb[i] = *(const bf16x8*)(bp + (size_t)(32 * i) * ldb);
    }
#pragma unroll
    for (int ks = 0; ks < 4; ++ks) {
      bf16x8 af[MI], bfr[2];
#pragma unroll
      for (int i = 0; i < MI; ++i) af[i] = *(const bf16x8*)(sA + (wm * (MI * 32) + i * 32) * LDT + fro + ks * 16);
#pragma unroll
      for (int i = 0; i < 2; ++i) bfr[i] = *(const bf16x8*)(sB + (wn * 64 + i * 32) * LDT + fro + ks * 16);
      __builtin_amdgcn_s_setprio(1);
#pragma unroll
      for (int mi = 0; mi < MI; ++mi)
#pragma unroll
        for (int ni = 0; ni < 2; ++ni)
          acc[mi][ni] = __builtin_amdgcn_mfma_f32_32x32x16_bf16(af[mi], bfr[ni], acc[mi][ni], 0, 0, 0);
      __builtin_amdgcn_s_setprio(0);
    }
  }
  __syncthreads();
}
template <int MI>
DEV void zero_acc_t(f32x16 (&acc)[MI][2]) {
#pragma unroll
  for (int a = 0; a < MI; ++a)
#pragma unroll
    for (int b = 0; b < 2; ++b)
#pragma unroll
      for (int r = 0; r < 16; ++r) acc[a][b][r] = 0.f;
}
template <int MI, class F>
DEV void acc_foreach_t(F f) {
  const int tid_ = TIDX();
  const int lane = tid_ & 63, w = tid_ >> 6;
#pragma unroll
  for (int mi = 0; mi < MI; ++mi)
#pragma unroll
    for (int ni = 0; ni < 2; ++ni)
#pragma unroll
      for (int r = 0; r < 16; ++r)
        f(mi, ni, r, (w >> 1) * (MI * 32) + mi * 32 + (r & 3) + 8 * (r >> 2) + 4 * (lane >> 5), (w & 1) * 64 + ni * 32 + (lane & 31));
}
template <int MI>
DEV void tile_load_t(unsigned char* smem, const u16* src, size_t lds_) {
  u16* sC = (u16*)smem;
  const int tid_ = TIDX();
#pragma unroll
  for (int i = 0; i < MI * 4; ++i) {
    const int c = tid_ + 256 * i, row = c >> 4, cc = (c & 15) * 8;
    *(bf16x8*)(sC + row * LDC + cc) = *(const bf16x8*)(src + (size_t)row * lds_ + cc);
  }
  __syncthreads();
}
template <int MI>
DEV void tile_store_t(unsigned char* smem, u16* dst, size_t ldd) {
  const u16* sC = (const u16*)smem;
  __syncthreads();
  const int tid_ = TIDX();
#pragma unroll
  for (int i = 0; i < MI * 4; ++i) {
    const int c = tid_ + 256 * i, row = c >> 4, cc = (c & 15) * 8;
    *(bf16x8*)(dst + (size_t)row * ldd + cc) = *(const bf16x8*)(sC + row * LDC + cc);
  }
}

#define XB_TMO      128
#define XB_XCNT(j)  (256  + 64 * (j))
#define XB_XSUB(j)  (1280 + 64 * (j))
#define XB_XGEN(j)  (2304 + 64 * (j))
#define XB_TOP      3328
#define XB_TOPGEN   3392
#define XCD_BAR_WORDS 3456
#define XB_SPIN_CAP (1u << 20)
#define LAS __attribute__((address_space(3)))
DEV unsigned xb_ld(unsigned* p) { return __hip_atomic_load(p, __ATOMIC_RELAXED, __HIP_MEMORY_SCOPE_AGENT); }
DEV unsigned xb_add(unsigned* p, unsigned v) { return __hip_atomic_fetch_add(p, v, __ATOMIC_RELAXED, __HIP_MEMORY_SCOPE_AGENT); }
DEV unsigned xb_xcc_id() { return (unsigned)__builtin_amdgcn_s_getreg((3 << 11) | 20) & 0xFu; }
#define XB_SPIN(cond, bar) do { unsigned _sp = 0; while (cond) { __builtin_amdgcn_s_sleep(1); \
    if ((++_sp & 255u) == 0u) { if (xb_ld(&(bar)[XB_TMO])) break; if (_sp > XB_SPIN_CAP) { atomicAdd(&(bar)[XB_TMO], 1u); break; } } } } while (0)
struct XcdBarrier {
  unsigned* bar;
  unsigned x;
  volatile LAS unsigned* st;
};
DEV XcdBarrier xcd_barrier_post(unsigned* bar, volatile LAS unsigned* st) {
  XcdBarrier b;
  b.bar = bar;
  b.x = xb_xcc_id();
  b.st = st;
  if (threadIdx.x == 0) (void)xb_add(&bar[XB_XCNT(b.x)], 1u);
  return b;
}
DEV void xcd_barrier_complete(unsigned* bar, unsigned x, unsigned& nloc, unsigned& nx) {
  const unsigned G = gridDim.x * gridDim.y * gridDim.z;
  unsigned sum, cnt, mine, sp = 0u;
  for (;;) {
    sum = 0u; cnt = 0u; mine = 0u;
#pragma unroll
    for (unsigned j = 0; j < 16; ++j) {
      const unsigned c = xb_ld(&bar[XB_XCNT(j)]);
      sum += c;
      cnt += (c > 0u) ? 1u : 0u;
      mine = (j == x) ? c : mine;
    }
    if (sum == G) break;
    __builtin_amdgcn_s_sleep(1);
    if ((++sp & 255u) == 0u) {
      if (xb_ld(&bar[XB_TMO])) break;
      if (sp > XB_SPIN_CAP) { atomicAdd(&bar[XB_TMO], 1u); break; }
    }
  }
  nloc = mine > 0u ? mine : 1u;
  nx = cnt > 0u ? cnt : 1u;
}
DEV void xcd_barrier(unsigned* bar_, volatile LAS unsigned* st_) {
  asm volatile("s_waitcnt vmcnt(0)" ::: "memory");
  __syncthreads();
  if (threadIdx.x == 0) {
    XcdBarrier b;
    b.bar = bar_;
    b.x = xb_xcc_id();
    b.st = st_;
    unsigned* bar = b.bar;
    __builtin_amdgcn_s_waitcnt(0);
    unsigned nloc = b.st[0], nx = b.st[1];
    if (nloc == 0u) {
      xcd_barrier_complete(bar, b.x, nloc, nx);
      b.st[0] = nloc;
      b.st[1] = nx;
    }
    const unsigned old = xb_add(&bar[XB_XSUB(b.x)], 1u);
    const unsigned gen = old / nloc;
    if (old + 1u == (gen + 1u) * nloc) {
      __builtin_amdgcn_fence(__ATOMIC_RELEASE, "agent");
      asm volatile("s_waitcnt vmcnt(0)" ::: "memory");
      const unsigned og = xb_add(&bar[XB_TOP], 1u);
      const unsigned tg = og / nx;
      if (og + 1u == (tg + 1u) * nx) xb_add(&bar[XB_TOPGEN], 1u);
      else XB_SPIN(xb_ld(&bar[XB_TOPGEN]) == tg, bar);
      __builtin_amdgcn_fence(__ATOMIC_ACQUIRE, "agent");
      xb_add(&bar[XB_XGEN(b.x)], 1u);
      asm volatile("s_waitcnt vmcnt(0)" ::: "memory");
    } else {
      XB_SPIN(xb_ld(&bar[XB_XGEN(b.x)]) == gen, bar);
      __builtin_amdgcn_fence(__ATOMIC_ACQUIRE, "agent");
      asm volatile("s_waitcnt vmcnt(0)" ::: "memory");
    }
  }
  __syncthreads();
}

DEV void transpose_tile(const float* __restrict__ src, int lds_, u16* __restrict__ dst, int ldd, const float* scale,
                        int k0, int n0, unsigned char* smem) {
  float* s = (float*)smem;
  const int tid = TIDX();
  __syncthreads();
  {
    const int n = tid & 63, kq = tid >> 6;
#pragma unroll 4
    for (int i = 0; i < 16; ++i) {
      int kk = kq * 16 + i;
      s[kk * 65 + n] = src[(size_t)(k0 + kk) * lds_ + n0 + n];
    }
  }
  __syncthreads();
  {
    const int k = tid & 63, nq = tid >> 6;
    const float sc = scale ? scale[k0 + k] : 1.0f;
#pragma unroll 4
    for (int i = 0; i < 16; ++i) {
      int n = nq * 16 + i;
      dst[(size_t)(n0 + n) * ldd + k0 + k] = f2bf(s[k * 65 + n] * sc);
    }
  }
}

DEV void qlat_tile(const float* __restrict__ wq, const float* __restrict__ wuk, const float* __restrict__ g,
                   u16* __restrict__ dst, int h, int r0, int k0, unsigned char* smem) {
  float* sQ = (float*)smem;
  float* sU = sQ + 64 * 65;
  const int tid = TIDX();
  float acc[16];
#pragma unroll
  for (int i = 0; i < 16; ++i) acc[i] = 0.f;
  for (int nh = 0; nh < 2; ++nh) {
    __syncthreads();
    {
      const int n = tid & 63, q = tid >> 6;
      for (int i = 0; i < 16; ++i) {
        int rr = q * 16 + i;
        sQ[rr * 65 + n] = wq[(size_t)(k0 + rr) * 1536 + h * 192 + nh * 64 + n];
        sU[rr * 65 + n] = wuk[(size_t)(r0 + rr) * 1024 + h * 128 + nh * 64 + n];
      }
    }
    __syncthreads();
    const int k = tid & 63, rq = tid >> 6;
    for (int n = 0; n < 64; ++n) {
      float qv = sQ[k * 65 + n];
#pragma unroll
      for (int i = 0; i < 16; ++i) acc[i] += qv * sU[(rq * 16 + i) * 65 + n];
    }
  }
  const int k = tid & 63, rq = tid >> 6;
  const float sc = g[k0 + k];
#pragma unroll
  for (int i = 0; i < 16; ++i) dst[(size_t)(h * 320 + r0 + rq * 16 + i) * 768 + k0 + k] = f2bf(acc[i] * sc);
}

DEV void mod_item(const Params& p, int item, unsigned char* smem) {
  const int l = item / 48, cg_ = item % 48;
  float* sc = (float*)smem;
  float* red = sc + 48 * 256;
  (void)red;
  const int tid = TIDX(), col = tid & 63, kq = tid >> 6;
  const float* W = p.ada_w + (size_t)l * 1024 * 3072 + cg_ * 64 + col;
  float acc[48];
#pragma unroll
  for (int b = 0; b < 48; ++b) acc[b] = 0.f;
  for (int kc = 0; kc < 4; ++kc) {
    __syncthreads();
    for (int e = tid; e < 48 * 256; e += NT) {
      int b = e >> 8, k = e & 255;
      float c = b < 16 ? p.c_p[b * 1024 + kc * 256 + k] : p.c_s[(b - 16) * 1024 + kc * 256 + k];
      sc[e] = siluf_(c);
    }
    __syncthreads();
#pragma unroll 1
    for (int i0 = 0; i0 < 64; i0 += 8) {
      float wv[8];
#pragma unroll
      for (int i = 0; i < 8; ++i) wv[i] = W[(size_t)(kc * 256 + kq * 64 + i0 + i) * 3072];
#pragma unroll
      for (int i = 0; i < 8; ++i) {
        const int k = kq * 64 + i0 + i;
#pragma unroll
        for (int b = 0; b < 48; ++b) acc[b] += sc[b * 256 + k] * wv[i];
      }
    }
  }
  __syncthreads();
#pragma unroll
  for (int b = 0; b < 48; ++b) sc[(kq * 48 + b) * 64 + col] = acc[b];
  __syncthreads();
  float* MOD = (float*)(p.ws + OFF_MOD);
  for (int e = tid; e < 48 * 64; e += NT) {
    int b = e >> 6, c = e & 63;
    float v = sc[(0 * 48 + b) * 64 + c] + sc[(1 * 48 + b) * 64 + c] + sc[(2 * 48 + b) * 64 + c] + sc[(3 * 48 + b) * 64 + c];
    int gc = cg_ * 64 + c;
    MOD[((size_t)l * 48 + b) * 3072 + gc] = v + p.ada_b[l * 3072 + gc];
  }
}

DEV void phase_prep(const Params& p, unsigned char* smem) {
  const int tid = TIDX();
  const int nb = gridDim.x;
  int idx = blockIdx.x, base = 0;
  if (blockIdx.x == 0) {
    if (tid < 64) ((unsigned*)(p.ws + OFF_CNT))[tid] = 0u;
    for (int e = tid; e < XCD_BAR_WORDS; e += NT) ((unsigned*)(p.ws + OFF_BAR))[e] = 0u;
  }
  for (; idx < base + 96; idx += nb) mod_item(p, idx - base, smem);
  base += 96;
  for (int l = 0; l < 2; ++l) {
    u16* WL = (u16*)(p.ws + OFF_W) + (size_t)l * W_LAYER;
    const float* win = p.w_in + (size_t)l * 1024 * IN_DIM;
#define TJOB(SRC, LDS_, KK, NN, DST, LDD, SCALE)                                     \
  {                                                                                  \
    const int nkt = (KK) / 64, ntl = nkt * ((NN) / 64);                              \
    for (; idx < base + ntl; idx += nb) {                                            \
      int t = idx - base;                                                            \
      transpose_tile((SRC), (LDS_), (DST), (LDD), (SCALE), (t % nkt) * 64, (t / nkt) * 64, smem); \
    }                                                                                \
    base += ntl;                                                                     \
  }
    TJOB(win, IN_DIM, 1024, 1024, WL + WO_W1, 1024, nullptr);
    TJOB(win + 2048, IN_DIM, 1024, 1088, WL + WO_W1 + (size_t)1024 * 1024, 1024, nullptr);
    TJOB(win + 1024, IN_DIM, 1024, 1024, WL + WO_G, 1024, nullptr);
    TJOB(win + 3136, IN_DIM, 1024, 3072, WL + WO_G + (size_t)1024 * 1024, 1024, nullptr);
    TJOB(p.w_q_up + (size_t)l * 768 * 1536, 1536, 768, 1536, WL + WO_QP, 768, p.q_norm + l * 768);
    for (int h = 0; h < 8; ++h)
      TJOB(p.w_q_up + (size_t)l * 768 * 1536 + h * 192 + 128, 1536, 768, 64, WL + WO_QS + (size_t)(h * 320 + 256) * 768, 768,
           p.q_norm + l * 768);
    TJOB(p.w_uk + (size_t)l * 262144, 1024, 256, 1024, WL + WO_UK, 256, p.kv_norm + l * 256);
    TJOB(p.w_uv + (size_t)l * 262144, 1024, 256, 1024, WL + WO_UVS, 256, p.kv_norm + l * 256);
    TJOB(p.w_uv + (size_t)l * 262144, 1024, 256, 1024, WL + WO_UVP, 256, nullptr);
    TJOB(p.w_ba + (size_t)l * 1048576, 1024, 1024, 1024, WL + WO_BA, 1024, nullptr);
    TJOB(p.w_bb + (size_t)l * 1048576, 1024, 1024, 1024, WL + WO_BB, 1024, nullptr);
    TJOB(p.w_out + (size_t)l * 1048576, 1024, 1024, 1024, WL + WO_OUT, 1024, nullptr);
    for (int b8 = 0; b8 < 8; ++b8) {
      TJOB(p.lru_wa + (size_t)l * 131072 + b8 * 16384, 128, 128, 128, WL + WO_LA + b8 * 16384, 128, nullptr);
      TJOB(p.lru_wx + (size_t)l * 131072 + b8 * 16384, 128, 128, 128, WL + WO_LX + b8 * 16384, 128, nullptr);
    }
    for (; idx < base + 384; idx += nb) {
      int t = idx - base;
      int h = t / 48, rt = (t % 48) / 12, kt = t % 12;
      qlat_tile(p.w_q_up + (size_t)l * 768 * 1536, p.w_uk + (size_t)l * 262144, p.q_norm + l * 768, WL + WO_QS, h,
                rt * 64, kt * 64, smem);
    }
    base += 384;
    for (; idx < base + 16; idx += nb) {
      int t = idx - base;
      u16* d = WL + WO_W1 + (size_t)2112 * 1024 + t * 4096;
      for (int e = tid; e < 4096; e += NT) d[e] = 0;
    }
    base += 16;
  }
  float* ROPE = (float*)(p.ws + OFF_ROPE);
  for (; idx < base + 512; idx += nb) {
    int e = (idx - base) * 256 + tid;
    int pos = e >> 5, j = e & 31;
    float inv = exp2f(-(float)j * (13.287712379549449f / 32.0f));
    float ang = (float)pos * inv;
    ROPE[2 * e] = cosf(ang);
    ROPE[2 * e + 1] = sinf(ang);
  }
  base += 512;
}

DEV void norm_row(const Params& p, int l, int m, const float (&xv)[16], int lane) {
  float ss = 0.f;
#pragma unroll
  for (int i = 0; i < 16; ++i) ss += xv[i] * xv[i];
  ss = wave_sum(ss);
  const float rstd = rsqrtf(ss * (1.0f / 1024.0f) + EPS);
  const float* MOD = (const float*)(p.ws + OFF_MOD) + ((size_t)l * 48 + mod_row(m)) * 3072;
  u16* H = (u16*)(p.ws + OFF_H) + (size_t)m * 1024;
#pragma unroll
  for (int i = 0; i < 4; ++i) {
    int c = i * 256 + lane * 4;
    float4 g = *(const float4*)(p.pre_norm + l * 1024 + c);
    float4 sh = *(const float4*)(MOD + c);
    float4 sc = *(const float4*)(MOD + 1024 + c);
    ushort4 o;
    o.x = f2bf(xv[i * 4 + 0] * rstd * g.x * (1.f + sc.x) + sh.x);
    o.y = f2bf(xv[i * 4 + 1] * rstd * g.y * (1.f + sc.y) + sh.y);
    o.z = f2bf(xv[i * 4 + 2] * rstd * g.z * (1.f + sc.z) + sh.z);
    o.w = f2bf(xv[i * 4 + 3] * rstd * g.w * (1.f + sc.w) + sh.w);
    *(ushort4*)(H + c) = o;
  }
}

DEV void phase_norm0(const Params& p) {
  const int tid_ = TIDX();
  const int lane = tid_ & 63, wv = tid_ >> 6;
  for (int m = blockIdx.x * 4 + wv; m < MT; m += gridDim.x * 4) {
    const float* x = m < MP ? p.x_p + (size_t)m * 1024 : p.x_s + (size_t)(m - MP) * 1024;
    float xv[16];
#pragma unroll
    for (int i = 0; i < 4; ++i) {
      float4 v = *(const float4*)(x + i * 256 + lane * 4);
      xv[i * 4] = v.x; xv[i * 4 + 1] = v.y; xv[i * 4 + 2] = v.z; xv[i * 4 + 3] = v.w;
    }
    norm_row(p, 0, m, xv, lane);
  }
}

DEV void phase_final(const Params& p, int l) {
  const int tid_ = TIDX();
  const int lane = tid_ & 63, wv = tid_ >> 6;
  const u16* O = (const u16*)(p.ws + OFF_R4);
  for (int m = blockIdx.x * 4 + wv; m < MT; m += gridDim.x * 4) {
    float* y = m < MP ? p.out + OUT_YP + (size_t)m * 1024 : p.out + OUT_YS + (size_t)(m - MP) * 1024;
    const float* x = (l == 0) ? (m < MP ? p.x_p + (size_t)m * 1024 : p.x_s + (size_t)(m - MP) * 1024) : y;
    float xv[16], ov[16];
    float ss = 0.f;
#pragma unroll
    for (int i = 0; i < 4; ++i) {
      int c = i * 256 + lane * 4;
      float4 v = *(const float4*)(x + c);
      xv[i * 4] = v.x; xv[i * 4 + 1] = v.y; xv[i * 4 + 2] = v.z; xv[i * 4 + 3] = v.w;
      ushort4 o = *(const ushort4*)(O + (size_t)m * 1024 + c);
      ov[i * 4] = bf2f(o.x); ov[i * 4 + 1] = bf2f(o.y); ov[i * 4 + 2] = bf2f(o.z); ov[i * 4 + 3] = bf2f(o.w);
    }
#pragma unroll
    for (int i = 0; i < 16; ++i) ss += ov[i] * ov[i];
    ss = wave_sum(ss);
    const float rstd = rsqrtf(ss * (1.0f / 1024.0f) + EPS);
    const float* MOD = (const float*)(p.ws + OFF_MOD) + ((size_t)l * 48 + mod_row(m)) * 3072 + 2048;
#pragma unroll
    for (int i = 0; i < 4; ++i) {
      int c = i * 256 + lane * 4;
      float4 g = *(const float4*)(p.post_norm + l * 1024 + c);
      float4 gt = *(const float4*)(MOD + c);
      xv[i * 4 + 0] += gt.x * ov[i * 4 + 0] * rstd * g.x;
      xv[i * 4 + 1] += gt.y * ov[i * 4 + 1] * rstd * g.y;
      xv[i * 4 + 2] += gt.z * ov[i * 4 + 2] * rstd * g.z;
      xv[i * 4 + 3] += gt.w * ov[i * 4 + 3] * rstd * g.w;
      *(float4*)(y + c) = make_float4(xv[i * 4], xv[i * 4 + 1], xv[i * 4 + 2], xv[i * 4 + 3]);
    }
    if (l == 0) norm_row(p, 1, m, xv, lane);
  }
}

template <int MI>
DEV void gemm1_tile(const Params& p, int l, int m0, int nt, unsigned char* smem) {
  constexpr int BM = MI * 64;
  const u16* H = (const u16*)(p.ws + OFF_H);
  const u16* W1 = (const u16*)(p.ws + OFF_W) + (size_t)l * W_LAYER + WO_W1;
  u16* XA = (u16*)(p.ws + OFF_R1);
  u16* CQ = (u16*)(p.ws + OFF_R2);
  u16* CKVR = CQ + (size_t)MT * 768;
  u16* sC = (u16*)smem;
  f32x16 acc[MI][2];
  zero_acc_t<MI>(acc);
  gemm_mm<MI>(acc, H + (size_t)m0 * 1024, 1024, W1 + (size_t)nt * 128 * 1024, 1024, 1024, smem);
  if (nt < 14) {
    acc_foreach_t<MI>([&](int mi, int ni, int r, int row, int col) __attribute__((always_inline)) {
      sC[row * LDC + col] = f2bf(acc[mi][ni][r]);
    });
    if (nt < 8) tile_store_t<MI>(smem, XA + (size_t)m0 * 1024 + nt * 128, 1024);
    else tile_store_t<MI>(smem, CQ + (size_t)m0 * 768 + (nt - 8) * 128, 768);
    if (nt < 8 && (m0 >= MP || ((m0 + BM) & 4095) == 0)) {
      acc_foreach_t<MI>([&](int mi, int ni, int r, int row, int col) __attribute__((always_inline)) {
        const int m = m0 + row, n = nt * 128 + col;
        const float v = acc[mi][ni][r];
        if (m < MP) {
          int j = (m & 4095) - 4093;
          if (j >= 0) p.out[OUT_CONVP + ((size_t)(l * 16 + (m >> 12)) * 3 + j) * 1024 + n] = v;
        } else {
          int j = ((m - MP) & 15) - 13;
          if (j >= 0) p.out[OUT_CONVS + ((size_t)(l * 32 + ((m - MP) >> 4)) * 3 + j) * 1024 + n] = v;
        }
      });
    }
  } else if (nt < 16) {
    float* ob = m0 < MP ? p.out + OUT_CKVP + ((size_t)l * MP + m0) * 256 + (nt - 14) * 128
                        : p.out + OUT_CKVS + ((size_t)l * MS + (m0 - MP)) * 256 + (nt - 14) * 128;
    acc_foreach_t<MI>([&](int mi, int ni, int r, int row, int col) __attribute__((always_inline)) {
      const float v = acc[mi][ni][r];
      sC[row * LDC + col] = f2bf(v);
      ob[(size_t)row * 256 + col] = v;
    });
    tile_store_t<MI>(smem, CKVR + (size_t)m0 * 256 + (nt - 14) * 128, 256);
  } else {
    float* ob = m0 < MP ? p.out + OUT_KPEP + ((size_t)l * MP + m0) * 64 : p.out + OUT_KPES + ((size_t)l * MS + (m0 - MP)) * 64;
    acc_foreach_t<MI>([&](int mi, int ni, int r, int row, int col) __attribute__((always_inline)) {
      if (col < 64) ob[(size_t)row * 64 + col] = acc[mi][ni][r];
    });
  }
}
DEV void phase_gemm1(const Params& p, int l, unsigned char* smem) {
  const int nb = gridDim.x;
  int idx = vbid(), base = 0;
#pragma unroll 1
  for (; idx < base + 256 * 17; idx += nb) {
    const int t = idx - base;
    gemm1_tile<4>(p, l, (t / 17) * 256, t % 17, smem);
  }
  base += 256 * 17;
#pragma unroll 1
  for (; idx < base + 4 * 17; idx += nb) {
    const int t = idx - base;
    gemm1_tile<2>(p, l, MP + (t / 17) * 128, t % 17, smem);
  }
}

DEV void post1_rows(const Params& p, int l, int item) {
  const int tid_ = TIDX();
  const int lane = tid_ & 63, wv = tid_ >> 6;
  const float* ROPE = (const float*)(p.ws + OFF_ROPE);
  float4 v[2];
  float kx[2];
  float2 cs[2];
  float* ckvp[2];
  float* kpep[2];
#pragma unroll
  for (int u = 0; u < 2; ++u) {
    const int m = item * 8 + wv * 2 + u;
    ckvp[u] = m < MP ? p.out + OUT_CKVP + ((size_t)l * MP + m) * 256 : p.out + OUT_CKVS + ((size_t)l * MS + (m - MP)) * 256;
    kpep[u] = m < MP ? p.out + OUT_KPEP + ((size_t)l * MP + m) * 64 : p.out + OUT_KPES + ((size_t)l * MS + (m - MP)) * 64;
    v[u] = *(const float4*)(ckvp[u] + lane * 4);
    kx[u] = kpep[u][lane];
    cs[u] = *(const float2*)(ROPE + ((size_t)pos_of(m) * 32 + (lane & 31)) * 2);
  }
  const float4 g = *(const float4*)(p.kv_norm + l * 256 + lane * 4);
#pragma unroll
  for (int u = 0; u < 2; ++u) {
    const int m = item * 8 + wv * 2 + u;
    const float ss = wave_sum(v[u].x * v[u].x + v[u].y * v[u].y + v[u].z * v[u].z + v[u].w * v[u].w);
    const float rstd = rsqrtf(ss * (1.0f / 256.0f) + EPS);
    float4 o4 = v[u];
    o4.x *= rstd * g.x; o4.y *= rstd * g.y; o4.z *= rstd * g.z; o4.w *= rstd * g.w;
    *(float4*)(ckvp[u] + lane * 4) = o4;
    const float other = __shfl_xor(kx[u], 32, 64);
    const float c = cs[u].x, sn = cs[u].y;
    const float ro = (lane < 32) ? (kx[u] * c - other * sn) : (other * sn + kx[u] * c);
    kpep[u][lane] = ro;
    if (m < MP) {
      u16* KPE = (u16*)(p.ws + OFF_KPE) + (size_t)m * 64;
      KPE[lane] = f2bf(ro);
    } else {
      const int b = (m - MP) >> 4, t = (m - MP) & 15;
      u16* SKV = (u16*)(p.ws + OFF_SKV) + ((size_t)b * 2112 + 2048 + t) * 320;
      u16* SVT = (u16*)(p.ws + OFF_SVT) + (size_t)b * 256 * 2112 + 2048 + t;
      ushort4 o;
      o.x = f2bf(o4.x); o.y = f2bf(o4.y); o.z = f2bf(o4.z); o.w = f2bf(o4.w);
      *(ushort4*)(SKV + lane * 4) = o;
      SVT[(size_t)(lane * 4 + 0) * 2112] = o.x;
      SVT[(size_t)(lane * 4 + 1) * 2112] = o.y;
      SVT[(size_t)(lane * 4 + 2) * 2112] = o.z;
      SVT[(size_t)(lane * 4 + 3) * 2112] = o.w;
      SKV[256 + lane] = f2bf(ro);
    }
  }
}

DEV void cache_item(const Params& p, int l, int item, unsigned char* smem) {
  const int tid = TIDX();
  const int b = item / 33, kt = item % 33;
  u16* SKV = (u16*)(p.ws + OFF_SKV) + (size_t)b * 2112 * 320;
  u16* SVT = (u16*)(p.ws + OFF_SVT) + (size_t)b * 256 * 2112;
  if (kt == 32) {
    for (int e = tid; e < 48 * 320; e += NT) SKV[(size_t)2064 * 320 + e] = 0;
    for (int e = tid; e < 256 * 48; e += NT) SVT[(size_t)(e / 48) * 2112 + 2064 + (e % 48)] = 0;
    return;
  }
  float* s = (float*)smem;
  const float* src = p.cache_ckv + (((size_t)l * 32 + b) * 2048 + kt * 64) * 256;
  const float* srck = p.cache_kpe + (((size_t)l * 32 + b) * 2048 + kt * 64) * 64;
  for (int dh = 0; dh < 2; ++dh) {
    __syncthreads();
    for (int e = tid; e < 64 * 128; e += NT) {
      int key = e >> 7, d = e & 127;
      float v = src[(size_t)key * 256 + dh * 128 + d];
      s[key * 129 + d] = v;
      SKV[(size_t)(kt * 64 + key) * 320 + dh * 128 + d] = f2bf(v);
    }
    __syncthreads();
    const int k = tid & 63, dq = tid >> 6;
    for (int i = 0; i < 32; ++i) {
      int d = dq * 32 + i;
      SVT[(size_t)(dh * 128 + d) * 2112 + kt * 64 + k] = f2bf(s[k * 129 + d]);
    }
  }
  for (int e = tid; e < 64 * 64; e += NT) {
    int key = e >> 6, d = e & 63;
    SKV[(size_t)(kt * 64 + key) * 320 + 256 + d] = f2bf(srck[(size_t)key * 64 + d]);
  }
}

DEV void phase_p2(const Params& p, int l, unsigned char* smem) {
  const int tid = TIDX(), lane = tid & 63, w = tid >> 6;
  const int nb = gridDim.x;
  const u16* WL = (const u16*)(p.ws + OFF_W) + (size_t)l * W_LAYER;
  const u16* CQ = (const u16*)(p.ws + OFF_R2);
  const u16* CKVR = CQ + (size_t)MT * 768;
  u16* Q = (u16*)(p.ws + OFF_R3);
  u16* QS = (u16*)(p.ws + OFF_QS);
  u16* Kb = (u16*)(p.ws + OFF_R4);
  u16* VT = (u16*)(p.ws + OFF_VT);
  const float* ROPE = (const float*)(p.ws + OFF_ROPE);
  float* ss = gemm_ss(smem);
  int idx = vbid(), base = 0;
  const int nq = 512 * 12 + 4 * 20;
  for (; idx < base + nq; idx += nb) {
    int t = idx - base;
    int mt, nt;
    const u16* Wt;
    bool samp = t >= 512 * 12;
    if (!samp) { mt = t / 12; nt = t % 12; Wt = WL + WO_QP; }
    else { t -= 512 * 12; mt = 512 + t / 20; nt = t % 20; Wt = WL + WO_QS; }
    f32x16 acc[2][2];
    zero_acc(acc);
    gemm_main<1>(acc, CQ + (size_t)mt * 128 * 768, 768, Wt + (size_t)nt * 128 * 768, 768, 768, smem);
    const int g = nt * 2 + (w & 1);
    const bool rope = samp ? (g % 5 == 4) : (g % 3 == 2);
    u16* sC = (u16*)smem;
#pragma unroll
    for (int mi = 0; mi < 2; ++mi)
#pragma unroll
      for (int r = 0; r < 16; ++r) {
        const int row = (w >> 1) * 64 + mi * 32 + (r & 3) + 8 * (r >> 2) + 4 * (lane >> 5);
        const int m = mt * 128 + row;
        const float rs = rsqrtf(ss[row] * (1.0f / 768.0f) + EPS) * QSCALE;
        float v0 = acc[mi][0][r] * rs, v1 = acc[mi][1][r] * rs;
        if (rope) {
          const int pos = pos_of(m);
          const float c = ROPE[(pos * 32 + (lane & 31)) * 2], s = ROPE[(pos * 32 + (lane & 31)) * 2 + 1];
          const float a = v0 * c - v1 * s, b = v0 * s + v1 * c;
          v0 = a; v1 = b;
        }
        const int col = (w & 1) * 64 + (lane & 31);
        sC[row * LDC + col] = f2bf(v0);
        sC[row * LDC + col + 32] = f2bf(v1);
      }
    if (!samp) tile_store(smem, Q + (size_t)mt * 128 * 1536 + nt * 128, 1536);
    else tile_store(smem, QS + (size_t)(mt - 512) * 128 * 2560 + nt * 128, 2560);
  }
  base += nq;
  for (; idx < base + 4096; idx += nb) {
    int t = idx - base;
    int mt = t >> 3, nt = t & 7;
    f32x16 acc[2][2];
    zero_acc(acc);
    gemm_main<1, 2>(acc, CKVR + (size_t)mt * 128 * 256, 256, WL + WO_UK + (size_t)nt * 128 * 256, 256, 256, smem);
    {
      u16* sC = (u16*)smem;
      acc_foreach([&](int mi, int ni, int r, int row, int col) __attribute__((always_inline)) {
        const float rs = rsqrtf(ss[row] * (1.0f / 256.0f) + EPS);
        sC[row * LDC + col] = f2bf(acc[mi][ni][r] * rs);
      });
      tile_store(smem, Kb + (size_t)mt * 128 * 1024 + nt * 128, 1024);
    }
  }
  base += 4096;
  for (; idx < base + 4096; idx += nb) {
    int t = idx - base;
    int b = t >> 8, mt = (t >> 5) & 7, nt = t & 31;
    f32x16 acc[2][2];
    zero_acc(acc);
    gemm_main<2, 2>(acc, WL + WO_UVS + (size_t)mt * 128 * 256, 256, CKVR + ((size_t)b * 4096 + nt * 128) * 256, 256, 256, smem);
    {
      u16* sC = (u16*)smem;
      acc_foreach([&](int mi, int ni, int r, int row, int col) __attribute__((always_inline)) {
        const float rs = rsqrtf(ss[col] * (1.0f / 256.0f) + EPS);
        sC[row * LDC + col] = f2bf(acc[mi][ni][r] * rs);
      });
      tile_store(smem, VT + ((size_t)b * 1024 + mt * 128) * 4096 + nt * 128, 4096);
    }
  }
  base += 4096;
  for (; idx < base + MT / 8; idx += nb) post1_rows(p, l, idx - base);
  base += MT / 8;
  for (; idx < base + 32 * 33; idx += nb) cache_item(p, l, idx - base, smem);
  base += 32 * 33;
}

#ifndef ATT_PF
#define ATT_PF true
#endif
template <int DK, bool PF>
DEV void attn_item(const u16* __restrict__ qrow, const u16* __restrict__ ka, int ldka, const u16* __restrict__ kb, int ldkb,
                   const u16* __restrict__ vt, int ldvt, int ntiles, int my_tiles, int kvlen, u16* orow,
                   unsigned char* smem) {
  constexpr int DKA = DK - 64, KST = DK + 8, VST = 68;
  u16* sK = (u16*)smem;
  u16* sV = sK + 64 * KST;
  const int tid = TIDX(), lane = tid & 63, hh = lane >> 5, l31 = lane & 31;
  constexpr bool QREG = (DK <= 192);
  bf16x8 qf[DK / 16];
  if (QREG) {
#pragma unroll
    for (int ks = 0; ks < DK / 16; ++ks) qf[ks] = *(const bf16x8*)(qrow + ks * 16 + hh * 8);
  }
  f32x16 o[4];
#pragma unroll
  for (int d = 0; d < 4; ++d)
#pragma unroll
    for (int r = 0; r < 16; ++r) o[d][r] = 0.f;
  float mrun = -1e30f, lrun = 0.f;
  constexpr int CA = DKA / 32;
  bf16x8 rk[CA + 2], rv[4];
  const int skey = tid >> 2, sq = tid & 3;
  const u16* gka = ka + (size_t)skey * ldka + sq * CA * 8;
  const u16* gkb = kb + (size_t)skey * ldkb + sq * 16;
  const u16* gv = vt + (size_t)(tid >> 1) * ldvt + (tid & 1) * 32;
  u16* lka = sK + skey * KST + sq * CA * 8;
  u16* lkb = sK + skey * KST + DKA + sq * 16;
  u16* lv = sV + (tid >> 1) * VST + (tid & 1) * 32;
  auto load_tile = [&](int t) __attribute__((always_inline)) {
    const size_t ko = (size_t)t * 64;
#pragma unroll
    for (int i = 0; i < CA; ++i) rk[i] = *(const bf16x8*)(gka + ko * ldka + i * 8);
#pragma unroll
    for (int i = 0; i < 2; ++i) rk[CA + i] = *(const bf16x8*)(gkb + ko * ldkb + i * 8);
#pragma unroll
    for (int i = 0; i < 4; ++i) rv[i] = *(const bf16x8*)(gv + ko + i * 8);
  };
  auto store_tile = [&]() __attribute__((always_inline)) {
#pragma unroll
    for (int i = 0; i < CA; ++i) *(bf16x8*)(lka + i * 8) = rk[i];
#pragma unroll
    for (int i = 0; i < 2; ++i) *(bf16x8*)(lkb + i * 8) = rk[CA + i];
#pragma unroll
    for (int i = 0; i < 4; ++i) {
      union { bf16x8 v; uint2 u[2]; } cv;
      cv.v = rv[i];
      *(uint2*)(lv + i * 8) = cv.u[0];
      *(uint2*)(lv + i * 8 + 4) = cv.u[1];
    }
  };
  if (PF) load_tile(0);
#pragma unroll 1
  for (int t = 0; t < ntiles; ++t) {
    __syncthreads();
    if (!PF) load_tile(t);
    store_tile();
    __syncthreads();
    if (PF && t + 1 < ntiles) load_tile(t + 1);
    if (t < my_tiles) {
      const u16* qp = qrow + hh * 8;
      if (!QREG) asm volatile("" : "+v"(qp));
      const int key0 = t * 64;
#pragma unroll 1
      for (int mi = 0; mi < 2; ++mi) {
        f32x16 s;
#pragma unroll
        for (int r = 0; r < 16; ++r) s[r] = 0.f;
        const u16* kp = sK + (mi * 32 + l31) * KST + hh * 8;
        constexpr int KB = QREG ? 6 : 4;
#pragma unroll
        for (int k0 = 0; k0 < DK / 16; k0 += KB) {
          bf16x8 kf[KB];
#pragma unroll
          for (int i = 0; i < KB; ++i) kf[i] = *(const bf16x8*)(kp + (k0 + i) * 16);
          __builtin_amdgcn_sched_barrier(0);
#pragma unroll
          for (int i = 0; i < KB; ++i) {
            bf16x8 qv;
            if (QREG) qv = qf[k0 + i];
            else qv = *(const bf16x8*)(qp + (k0 + i) * 16);
            s = __builtin_amdgcn_mfma_f32_32x32x16_bf16(kf[i], qv, s, 0, 0, 0);
          }
        }
        bf16x8 vf[8];
        {
          const u16* vp = sV + l31 * VST + mi * 32 + 4 * hh;
#pragma unroll
          for (int oc = 0; oc < 2; ++oc)
#pragma unroll
            for (int d = 0; d < 4; ++d) {
              union { bf16x8 v; uint2 u[2]; } cv;
              cv.u[0] = *(const uint2*)(vp + d * 32 * VST + oc * 16);
              cv.u[1] = *(const uint2*)(vp + d * 32 * VST + oc * 16 + 8);
              vf[oc * 4 + d] = cv.v;
            }
          __builtin_amdgcn_sched_barrier(0);
        }
        if (key0 + 64 > kvlen) {
#pragma unroll
          for (int r = 0; r < 16; ++r) {
            int key = key0 + mi * 32 + (r & 3) + 8 * (r >> 2) + 4 * hh;
            if (key >= kvlen) s[r] = -1e30f;
          }
        }
        float mx = -1e30f;
#pragma unroll
        for (int r = 0; r < 16; ++r) mx = fmaxf(mx, s[r]);
        mx = fmaxf(mx, __shfl_xor(mx, 32, 64));
        if (__builtin_amdgcn_ballot_w64(mx > mrun) != 0ull) {
          const float mnew = fmaxf(mrun, mx);
          const float alpha = __builtin_amdgcn_exp2f(mrun - mnew);
          mrun = mnew;
          lrun *= alpha;
#pragma unroll
          for (int d = 0; d < 4; ++d)
#pragma unroll
            for (int r = 0; r < 16; ++r) o[d][r] *= alpha;
        }
        union { bf16x8 v[2]; unsigned u[8]; } pfu;
        float ps = 0.f;
#pragma unroll
        for (int r = 0; r < 16; r += 2) {
          float p0 = __builtin_amdgcn_exp2f(s[r] - mrun);
          float p1 = __builtin_amdgcn_exp2f(s[r + 1] - mrun);
          ps += p0 + p1;
          pfu.u[r >> 1] = pk2bf(p0, p1);
        }
        lrun += ps;
#pragma unroll
        for (int oc = 0; oc < 2; ++oc)
#pragma unroll
          for (int d = 0; d < 4; ++d) o[d] = __builtin_amdgcn_mfma_f32_32x32x16_bf16(vf[oc * 4 + d], pfu.v[oc], o[d], 0, 0, 0);
      }
    }
  }
  const float ltot = lrun + __shfl_xor(lrun, 32, 64);
  const float inv = 1.0f / ltot;
#pragma unroll
  for (int d = 0; d < 4; ++d)
#pragma unroll
    for (int g = 0; g < 4; ++g) {
      uint2 ov;
      ov.x = pk2bf(o[d][g * 4 + 0] * inv, o[d][g * 4 + 1] * inv);
      ov.y = pk2bf(o[d][g * 4 + 2] * inv, o[d][g * 4 + 3] * inv);
      *(uint2*)(orow + d * 32 + g * 8 + hh * 4) = ov;
    }
  __syncthreads();
}

DEV void lru_item(const Params& p, int l, int sb, int nbk, int half, unsigned char* smem) {
  const int tid = TIDX(), lane = tid & 63, w = tid >> 6, hh = lane >> 5, l31 = lane & 31;
  const bool samp = sb >= 16;
  const int S = samp ? 16 : 4096;
  const int row0 = samp ? MP + (sb - 16) * 16 : sb * 4096;
  const int kc0 = nbk * 128, oc0 = nbk * 128 + half * 64;
  const u16* XA = (const u16*)(p.ws + OFF_R1);
  u16* YL = (u16*)(p.ws + OFF_R2);
  const u16* WL = (const u16*)(p.ws + OFF_W) + (size_t)l * W_LAYER;
  u16* sXC = (u16*)smem;
  float* sA = (float*)(smem + 17408);
  float* sB = sA + 4096;
  float* segA = sB + 4096;
  float* segB = segA + 256;
  float* hc = segB + 256;
  float* cw = hc + 64;
  float* cb = cw + 512;
  const int tm = w >> 1, tn = w & 1;
  __syncthreads();
  for (int e = tid; e < 512; e += NT) cw[e] = p.conv_w[(size_t)l * 4096 + (e >> 7) * 1024 + kc0 + (e & 127)];
  if (tid < 128) cb[tid] = p.conv_b[l * 1024 + kc0 + tid];
  if (tid < 64) hc[tid] = samp ? p.state_lru[((size_t)l * 32 + (sb - 16)) * 1024 + oc0 + tid] : 0.f;
  bf16x8 waf[8], wxf[8];
  {
    const u16* wa = WL + WO_LA + (size_t)nbk * 16384 + (size_t)(half * 64 + tn * 32 + l31) * 128 + hh * 8;
    const u16* wx = WL + WO_LX + (size_t)nbk * 16384 + (size_t)(half * 64 + tn * 32 + l31) * 128 + hh * 8;
#pragma unroll
    for (int ks = 0; ks < 8; ++ks) {
      waf[ks] = *(const bf16x8*)(wa + ks * 16);
      wxf[ks] = *(const bf16x8*)(wx + ks * 16);
    }
  }
  const int och = oc0 + tn * 32 + l31;
  const float ba = p.lru_ba[l * 1024 + och], bx = p.lru_bx[l * 1024 + och];
  const float lam = p.lru_lambda[l * 1024 + och];
  const float ex_ = __expf(-lam);
  const float sp = (-lam > 20.f) ? -lam
                   : (ex_ < 0.01f ? ex_ * (1.0f - ex_ * (0.5f - ex_ * (0.33333334f - 0.25f * ex_))) : __logf(1.0f + ex_));
  __syncthreads();
  for (int t0 = 0; t0 < S; t0 += 64) {
    {
      const int cc = (tid & 15) * 8, tq = tid >> 4;
      bf16x8 xr[7];
#pragma unroll
      for (int j = 0; j < 7; ++j) {
        int ts = t0 + tq * 4 - 3 + j;
        ts = ts < 0 ? 0 : (ts > S - 1 ? S - 1 : ts);
        xr[j] = *(const bf16x8*)(XA + (size_t)(row0 + ts) * 1024 + kc0 + cc);
      }
      float xf[7][8];
#pragma unroll
      for (int j = 0; j < 7; ++j) {
        const int ts = t0 + tq * 4 - 3 + j;
        const bool ok = ts >= 0;
#pragma unroll
        for (int c = 0; c < 8; ++c) xf[j][c] = ok ? bf2f((u16)xr[j][c]) : 0.f;
      }
      if (samp && t0 == 0 && tq == 0) {
#pragma unroll
        for (int j = 0; j < 3; ++j) {
          const float* st = p.state_conv + (((size_t)l * 32 + (sb - 16)) * 3 + j) * 1024 + kc0 + cc;
#pragma unroll
          for (int c = 0; c < 8; ++c) xf[j][c] = st[c];
        }
      }
#pragma unroll
      for (int i = 0; i < 4; ++i) {
        const int tl = tq * 4 + i;
        bf16x8 o;
#pragma unroll
        for (int c = 0; c < 8; ++c) {
          float v = cb[cc + c];
#pragma unroll
          for (int k = 0; k < 4; ++k) v += xf[i + k][c] * cw[k * 128 + cc + c];
          o[c] = (short)f2bf(v);
        }
        *(bf16x8*)(sXC + tl * 136 + cc) = o;
      }
    }
    __syncthreads();
    f32x16 aR, aI;
#pragma unroll
    for (int r = 0; r < 16; ++r) { aR[r] = 0.f; aI[r] = 0.f; }
#pragma unroll
    for (int ks = 0; ks < 8; ++ks) {
      bf16x8 a = *(const bf16x8*)(sXC + (tm * 32 + l31) * 136 + ks * 16 + hh * 8);
      aR = __builtin_amdgcn_mfma_f32_32x32x16_bf16(a, waf[ks], aR, 0, 0, 0);
      aI = __builtin_amdgcn_mfma_f32_32x32x16_bf16(a, wxf[ks], aI, 0, 0, 0);
    }
#pragma unroll
    for (int r = 0; r < 16; ++r) {
      const int tl = tm * 32 + (r & 3) + 8 * (r >> 2) + 4 * hh;
      const int cl = tn * 32 + l31;
      float av, bv;
      {
        const float rg = __builtin_amdgcn_rcpf(1.0f + __expf(-(aR[r] + ba)));
        const float ig = __builtin_amdgcn_rcpf(1.0f + __expf(-(aI[r] + bx)));
        const float la = -8.0f * rg * sp;
        const float a_ = __expf(la);
        const float x2 = 2.0f * la;
        const float ser = -x2 * (1.0f + x2 * (0.5f + x2 * (0.16666667f + x2 * (0.041666668f + x2 * 0.0083333338f))));
        const float em = (x2 > -0.25f) ? ser : 1.0f - __expf(x2);
        const float mult = __builtin_amdgcn_sqrtf(em);
        const float xcv = bf2f(sXC[tl * 136 + half * 64 + cl]);
        const bool valid = (t0 + tl < S);
        av = valid ? a_ : 1.f;
        bv = valid ? mult * ig * xcv : 0.f;
      }
      sA[tl * 64 + cl] = av;
      sB[tl * 64 + cl] = bv;
    }
    __syncthreads();
    {
      const int c = lane, sg = w;
      float A_ = 1.f, B_ = 0.f;
#pragma unroll
      for (int i = 0; i < 16; ++i) {
        const float a = sA[(sg * 16 + i) * 64 + c], b = sB[(sg * 16 + i) * 64 + c];
        B_ = a * B_ + b;
        A_ *= a;
      }
      segA[sg * 64 + c] = A_;
      segB[sg * 64 + c] = B_;
      __syncthreads();
      float h = hc[c];
      for (int s2 = 0; s2 < sg; ++s2) h = segA[s2 * 64 + c] * h + segB[s2 * 64 + c];
      __syncthreads();
#pragma unroll
      for (int i = 0; i < 16; ++i) {
        const int tl = sg * 16 + i;
        const float a = sA[tl * 64 + c], b = sB[tl * 64 + c];
        h = a * h + b;
        if (t0 + tl < S) YL[(size_t)(row0 + t0 + tl) * 1024 + oc0 + c] = f2bf(h);
      }
      if (sg == 3) hc[c] = h;
    }
    __syncthreads();
  }
  if (tid < 64) {
    const float h = hc[tid];
    if (samp) p.out[OUT_LRUS + ((size_t)l * 32 + (sb - 16)) * 1024 + oc0 + tid] = h;
    else p.out[OUT_LRUP + ((size_t)l * 16 + sb) * 1024 + oc0 + tid] = h;
  }
  __syncthreads();
}

DEV void phase_p3(const Params& p, int l, unsigned char* smem) {
  __shared__ int s_item;
  const int tid = TIDX(), lane = tid & 63, w = tid >> 6;
#pragma unroll 1
  for (int it = blockIdx.x; it < 256; it += gridDim.x) lru_item(p, l, it >> 4, (it >> 1) & 7, it & 1, smem);
#pragma unroll 1
  for (int it0 = blockIdx.x; it0 < 320; it0 += gridDim.x) {
    if (it0 < 256) continue;
    const int it = it0 - 256;
    const int b = it >> 1, dvh = it & 1;
    const int r = w * 32 + (lane & 31), h = r >> 4, t = r & 15;
    const u16* qrow = (const u16*)(p.ws + OFF_QS) + ((size_t)b * 16 + t) * 2560 + h * 320;
    const u16* ka = (const u16*)(p.ws + OFF_SKV) + (size_t)b * 2112 * 320;
    const u16* vt = (const u16*)(p.ws + OFF_SVT) + ((size_t)b * 256 + dvh * 128) * 2112;
    u16* orow = (u16*)(p.ws + OFF_OLAT) + ((size_t)b * 16 + t) * 2048 + h * 256 + dvh * 128;
    attn_item<320, false>(qrow, ka, 320, ka + 256, 320, vt, 2112, 33, 33, 2064, orow, smem);
  }
  const int xcd = blockIdx.x & 7;
#pragma unroll 1
  for (int qi = 0; qi < 8; ++qi) {
    const int q = (xcd + qi) & 7;
    unsigned* qc = (unsigned*)(p.ws + OFF_CNT) + 8 + l * 8 + q;
#pragma unroll 1
    for (;;) {
      __syncthreads();
      if (tid == 0) s_item = (int)atomicAdd(qc, 1u);
      __syncthreads();
      const int it = s_item;
      if (it >= 512) break;
      const int qt = 31 - (it & 31), bh = (it >> 5) * 8 + q, b = bh >> 3, h = bh & 7;
      u16* Q = (u16*)(p.ws + OFF_R3);
      const int r = w * 32 + (lane & 31);
      u16* qrow = Q + ((size_t)b * 4096 + qt * 128 + r) * 1536 + h * 192;
      const u16* ka = (const u16*)(p.ws + OFF_R4) + (size_t)b * 4096 * 1024 + h * 128;
      const u16* kb = (const u16*)(p.ws + OFF_KPE) + (size_t)b * 4096 * 64;
      const u16* vt = (const u16*)(p.ws + OFF_VT) + ((size_t)b * 1024 + h * 128) * 4096;
      attn_item<192, ATT_PF>(qrow, ka, 1024, kb, 64, vt, 4096, 2 * (qt + 1), 2 * qt + 1 + (w >> 1), 1 << 30, qrow, smem);
    }
  }
#pragma unroll 1
  for (int it = blockIdx.x; it < 512; it += gridDim.x) lru_item(p, l, 16 + (it >> 4), (it >> 1) & 7, it & 1, smem);
}

template <int MI>
DEV void p4_tile(const Params& p, int l, int m0, int nt, unsigned char* smem) {
  const u16* WL = (const u16*)(p.ws + OFF_W) + (size_t)l * W_LAYER;
  const u16* H = (const u16*)(p.ws + OFF_H);
  const u16* Q = (const u16*)(p.ws + OFF_R3);
  const u16* OLAT = (const u16*)(p.ws + OFF_OLAT);
  u16* YB = (u16*)(p.ws + OFF_R1);
  u16* YA = (u16*)(p.ws + OFF_R2);
  u16* sC = (u16*)smem;
  f32x16 acc[MI][2];
  if (nt < 8) {
    if constexpr (MI == 2) {
      if (m0 >= MP) {
        f32x16 att[MI][2];
        zero_acc_t<MI>(att);
        gemm_mm<MI>(att, OLAT + (size_t)(m0 - MP) * 2048 + nt * 256, 2048, WL + WO_UVP + (size_t)nt * 128 * 256, 256, 256, smem);
        zero_acc_t<MI>(acc);
        gemm_mm<MI>(acc, H + (size_t)m0 * 1024, 1024, WL + WO_G + (size_t)(1024 + nt * 128) * 1024, 1024, 1024, smem);
        acc_foreach_t<MI>([&](int mi, int ni, int r, int row, int col) __attribute__((always_inline)) {
          sC[row * LDC + col] = f2bf(att[mi][ni][r] * siluf_(acc[mi][ni][r]));
        });
        tile_store_t<MI>(smem, YB + (size_t)m0 * 1024 + nt * 128, 1024);
        return;
      }
    }
    zero_acc_t<MI>(acc);
    gemm_mm<MI>(acc, H + (size_t)m0 * 1024, 1024, WL + WO_G + (size_t)(1024 + nt * 128) * 1024, 1024, 1024, smem);
    tile_load_t<MI>(smem, Q + (size_t)m0 * 1536 + nt * 192, 1536);
    acc_foreach_t<MI>([&](int mi, int ni, int r, int row, int col) __attribute__((always_inline)) {
      sC[row * LDC + col] = f2bf(bf2f(sC[row * LDC + col]) * siluf_(acc[mi][ni][r]));
    });
    tile_store_t<MI>(smem, YB + (size_t)m0 * 1024 + nt * 128, 1024);
  } else {
    const int n0 = (nt - 8) * 128;
    zero_acc_t<MI>(acc);
    gemm_mm<MI>(acc, H + (size_t)m0 * 1024, 1024, WL + WO_G + (size_t)n0 * 1024, 1024, 1024, smem);
    tile_load_t<MI>(smem, YA + (size_t)m0 * 1024 + n0, 1024);
    acc_foreach_t<MI>([&](int mi, int ni, int r, int row, int col) __attribute__((always_inline)) {
      sC[row * LDC + col] = f2bf(bf2f(sC[row * LDC + col]) * siluf_(acc[mi][ni][r]));
    });
    tile_store_t<MI>(smem, YA + (size_t)m0 * 1024 + n0, 1024);
  }
}
DEV void phase_p4(const Params& p, int l, unsigned char* smem) {
  const int nb = gridDim.x;
  int idx = vbid(), base = 0;
#pragma unroll 1
  for (; idx < base + 256 * 16; idx += nb) {
    const int t = idx - base;
    p4_tile<4>(p, l, (t >> 4) * 256, t & 15, smem);
  }
  base += 256 * 16;
#pragma unroll 1
  for (; idx < base + 4 * 16; idx += nb) {
    const int t = idx - base;
    p4_tile<2>(p, l, MP + (t >> 4) * 128, t & 15, smem);
  }
}

constexpr int SM_GATE = 2 * 128 * LDT * 2 + 1024;
DEV void gemm_gates(f32x16 (&acc)[2][4], const u16* __restrict__ A, const u16* __restrict__ B0, const u16* __restrict__ B1,
                    unsigned char* smem) {
  u16* sA = (u16*)smem;
  u16* sB = sA + 128 * LDT;
  const int tid = TIDX(), lane = tid & 63, w = tid >> 6, wm = w >> 1, wn = w & 1;
  const int srow = tid >> 3, scol = (tid & 7) * 8;
  const u16* ap = A + (size_t)srow * 1024 + scol;
  const u16* b0p = B0 + (size_t)srow * 1024 + scol;
  const u16* b1p = B1 + (size_t)srow * 1024 + scol;
  bf16x8 ra[4], rb[8];
#pragma unroll
  for (int i = 0; i < 4; ++i) {
    ra[i] = *(const bf16x8*)(ap + (size_t)(32 * i) * 1024);
    rb[i] = *(const bf16x8*)(b0p + (size_t)(32 * i) * 1024);
    rb[4 + i] = *(const bf16x8*)(b1p + (size_t)(32 * i) * 1024);
  }
  const int fro = (lane & 31) * LDT + (lane >> 5) * 8;
#pragma unroll 1
  for (int kt = 0; kt < 16; ++kt) {
    __syncthreads();
#pragma unroll
    for (int i = 0; i < 4; ++i) *(bf16x8*)(sA + (srow + 32 * i) * LDT + scol) = ra[i];
#pragma unroll
    for (int i = 0; i < 8; ++i) *(bf16x8*)(sB + (srow + 32 * i) * LDT + scol) = rb[i];
    __syncthreads();
    if (kt + 1 < 16) {
      ap += 64;
      b0p += 64;
      b1p += 64;
#pragma unroll
      for (int i = 0; i < 4; ++i) {
        ra[i] = *(const bf16x8*)(ap + (size_t)(32 * i) * 1024);
        rb[i] = *(const bf16x8*)(b0p + (size_t)(32 * i) * 1024);
        rb[4 + i] = *(const bf16x8*)(b1p + (size_t)(32 * i) * 1024);
      }
    }
#pragma unroll 2
    for (int ks = 0; ks < 4; ++ks) {
      bf16x8 af[2], bfr[4];
#pragma unroll
      for (int i = 0; i < 2; ++i) af[i] = *(const bf16x8*)(sA + (wm * 64 + i * 32) * LDT + fro + ks * 16);
#pragma unroll
      for (int i = 0; i < 4; ++i)
        bfr[i] = *(const bf16x8*)(sB + ((i >> 1) * 128 + wn * 64 + (i & 1) * 32) * LDT + fro + ks * 16);
      __builtin_amdgcn_s_setprio(1);
#pragma unroll
      for (int mi = 0; mi < 2; ++mi)
#pragma unroll
        for (int ni = 0; ni < 4; ++ni)
          acc[mi][ni] = __builtin_amdgcn_mfma_f32_32x32x16_bf16(af[mi], bfr[ni], acc[mi][ni], 0, 0, 0);
      __builtin_amdgcn_s_setprio(0);
    }
  }
  __syncthreads();
}
DEV void phase_p5(const Params& p, int l, unsigned char* smem) {
  const u16* WL = (const u16*)(p.ws + OFF_W) + (size_t)l * W_LAYER;
  const u16* H = (const u16*)(p.ws + OFF_H);
  const u16* YB = (const u16*)(p.ws + OFF_R1);
  const u16* YA = (const u16*)(p.ws + OFF_R2);
  u16* MRG = (u16*)(p.ws + OFF_R3);
  u16* sC = (u16*)smem;
  const int ntiles = 516 * 8;
  for (int t = vbid(); t < ntiles; t += gridDim.x) {
    const int mt = t >> 3, nt = t & 7;
    unsigned ga[2][2][8];
    unsigned* sG = (unsigned*)(smem + SM_GATE);
    const int tid = TIDX();
    {
      f32x16 g[2][4];
#pragma unroll
      for (int a_ = 0; a_ < 2; ++a_)
#pragma unroll
        for (int b_ = 0; b_ < 4; ++b_)
#pragma unroll
          for (int r = 0; r < 16; ++r) g[a_][b_][r] = 0.f;
      gemm_gates(g, H + (size_t)mt * 128 * 1024, WL + WO_G + (size_t)(2048 + nt * 128) * 1024,
                 WL + WO_G + (size_t)(3072 + nt * 128) * 1024, smem);
#pragma unroll
      for (int a_ = 0; a_ < 2; ++a_)
#pragma unroll
        for (int b_ = 0; b_ < 2; ++b_) {
#pragma unroll
          for (int r = 0; r < 8; ++r)
            sG[((a_ * 2 + b_) * 8 + r) * 256 + tid] = pk2bf(sigmoidf_(g[a_][2 + b_][2 * r]), sigmoidf_(g[a_][2 + b_][2 * r + 1]));
          __builtin_amdgcn_sched_barrier(0);
        }
#pragma unroll
      for (int a_ = 0; a_ < 2; ++a_)
#pragma unroll
        for (int b_ = 0; b_ < 2; ++b_) {
#pragma unroll
          for (int r = 0; r < 8; ++r) ga[a_][b_][r] = pk2bf(sigmoidf_(g[a_][b_][2 * r]), sigmoidf_(g[a_][b_][2 * r + 1]));
          __builtin_amdgcn_sched_barrier(0);
        }
    }
    auto gate_a = [&](int mi, int ni, int r) __attribute__((always_inline)) -> float {
      const unsigned gq = ga[mi][ni][r >> 1];
      return __uint_as_float((r & 1) ? (gq & 0xffff0000u) : (gq << 16));
    };
    auto gate_b = [&](int mi, int ni, int r) __attribute__((always_inline)) -> float {
      const unsigned gq = sG[((mi * 2 + ni) * 8 + (r >> 1)) * 256 + tid];
      return __uint_as_float((r & 1) ? (gq & 0xffff0000u) : (gq << 16));
    };
    f32x16 acc[2][2];
    unsigned res[2][2][8];
    zero_acc(acc);
    gemm_main<0>(acc, YA + (size_t)mt * 128 * 1024, 1024, WL + WO_BA + (size_t)nt * 128 * 1024, 1024, 1024, smem);
#pragma unroll
    for (int mi = 0; mi < 2; ++mi)
#pragma unroll
      for (int ni = 0; ni < 2; ++ni)
#pragma unroll
        for (int r = 0; r < 8; ++r)
          res[mi][ni][r] = pk2bf(acc[mi][ni][2 * r] * gate_a(mi, ni, 2 * r), acc[mi][ni][2 * r + 1] * gate_a(mi, ni, 2 * r + 1));
    zero_acc(acc);
    gemm_main<0>(acc, YB + (size_t)mt * 128 * 1024, 1024, WL + WO_BB + (size_t)nt * 128 * 1024, 1024, 1024, smem);
    __syncthreads();
    acc_foreach([&](int mi, int ni, int r, int row, int col) __attribute__((always_inline)) {
      const unsigned rq = res[mi][ni][r >> 1];
      const float rv = __uint_as_float((r & 1) ? (rq & 0xffff0000u) : (rq << 16));
      sC[row * LDC + col] = f2bf(rv + acc[mi][ni][r] * gate_b(mi, ni, r));
    });
    tile_store(smem, MRG + (size_t)mt * 128 * 1024 + nt * 128, 1024);
  }
}

template <int MI>
DEV void p6_tile(const Params& p, int l, int m0, int nt, unsigned char* smem) {
  const u16* WL = (const u16*)(p.ws + OFF_W) + (size_t)l * W_LAYER;
  const u16* MRG = (const u16*)(p.ws + OFF_R3);
  u16* O = (u16*)(p.ws + OFF_R4);
  u16* sC = (u16*)smem;
  f32x16 acc[MI][2];
  zero_acc_t<MI>(acc);
  gemm_mm<MI>(acc, MRG + (size_t)m0 * 1024, 1024, WL + WO_OUT + (size_t)nt * 128 * 1024, 1024, 1024, smem);
  acc_foreach_t<MI>([&](int mi, int ni, int r, int row, int col) __attribute__((always_inline)) {
    sC[row * LDC + col] = f2bf(acc[mi][ni][r]);
  });
  tile_store_t<MI>(smem, O + (size_t)m0 * 1024 + nt * 128, 1024);
}
DEV void phase_p6(const Params& p, int l, unsigned char* smem) {
  const int nb = gridDim.x;
  int idx = vbid(), base = 0;
#pragma unroll 1
  for (; idx < base + 256 * 8; idx += nb) {
    const int t = idx - base;
    p6_tile<4>(p, l, (t >> 3) * 256, t & 7, smem);
  }
  base += 256 * 8;
#pragma unroll 1
  for (; idx < base + 4 * 8; idx += nb) {
    const int t = idx - base;
    p6_tile<2>(p, l, MP + (t >> 3) * 128, t & 7, smem);
  }
}

constexpr int SM_TOTAL = SM_GATE + 32768;
__global__ void __launch_bounds__(NT, 2) mega(Params p) {
  __shared__ __attribute__((aligned(16))) unsigned char smem[SM_TOTAL];
  cg::grid_group grid = cg::this_grid();
  __shared__ uint4 xb_words;
  if (threadIdx.x == 0) xb_words = make_uint4(0u, 0u, 0u, 0u);
#define PH(call)                                             \
  {                                                          \
    Params q = p;                                            \
    asm volatile("" : "+s"(q.ws), "+s"(q.out));              \
    call;                                                    \
  }
  PH(phase_prep(q, smem));
  grid.sync();
  (void)xcd_barrier_post((unsigned*)(p.ws + OFF_BAR), (volatile LAS unsigned*)&xb_words);
#define XBAR() xcd_barrier((unsigned*)(p.ws + OFF_BAR), (volatile LAS unsigned*)&xb_words)
  PH(phase_norm0(q));
  XBAR();
#pragma unroll 1
  for (int l = 0; l < 2; ++l) {
    PH(phase_gemm1(q, l, smem));
    XBAR();
    PH(phase_p2(q, l, smem));
    XBAR();
    PH(phase_p3(q, l, smem));
    XBAR();
    PH(phase_p4(q, l, smem));
    XBAR();
    PH(phase_p5(q, l, smem));
    XBAR();
    PH(phase_p6(q, l, smem));
    XBAR();
    PH(phase_final(q, l));
    if (l == 0) XBAR();
  }
}

extern "C" void kernel_launch(void* const* d_in, const int* in_sizes, int n_in, void* d_out, int out_size, void* d_ws,
                              size_t ws_size, hipStream_t stream) {
  static int grid_blocks = 0;
  if (!grid_blocks) {
    int dev = 0, cus = 0, per_cu = 0;
    hipGetDevice(&dev);
    hipDeviceGetAttribute(&cus, hipDeviceAttributeMultiprocessorCount, dev);
    hipOccupancyMaxActiveBlocksPerMultiprocessor(&per_cu, mega, NT, 0);
    if (per_cu > 2) per_cu = 2;
    grid_blocks = cus * per_cu;
  }
  if (ws_size < WS_NEED) {
    fprintf(stderr, "workspace too small: %zu < %zu\n", ws_size, (size_t)WS_NEED);
    return;
  }
  Params p{};
  const float** pp = (const float**)&p;
  for (int i = 0; i < 28; ++i) pp[i] = (const float*)d_in[i];
  p.out = (float*)d_out;
  p.ws = (unsigned char*)d_ws;
  void* args[] = {&p};
  hipError_t e = hipLaunchCooperativeKernel((void*)mega, dim3(grid_blocks), dim3(NT), args, 0, stream);
  if (e != hipSuccess) fprintf(stderr, "cooperative launch failed: %s (grid %d)\n", hipGetErrorString(e), grid_blocks);
}
```

```cpp
#include <hip/hip_runtime.h>
#include <hip/hip_cooperative_groups.h>
#include <cstdio>
namespace cg = cooperative_groups;

typedef unsigned short u16;
typedef __attribute__((ext_vector_type(8))) short bf16x8;
typedef __attribute__((ext_vector_type(16))) float f32x16;

#define DEV __device__ __forceinline__
#define NT 256

constexpr int MP = 65536, MS = 512, MT = 66048;
constexpr int IN_DIM = 6208;
constexpr float EPS = 1e-6f;
constexpr float QSCALE = 0.07216878364870322f * 1.4426950408889634f;

constexpr size_t SZ_ACT = (size_t)MT * 1024 * 2;
constexpr size_t OFF_H = 0;
constexpr size_t OFF_R1 = OFF_H + SZ_ACT;
constexpr size_t OFF_R2 = OFF_R1 + SZ_ACT;
constexpr size_t OFF_R3 = OFF_R2 + SZ_ACT;
constexpr size_t OFF_R4 = OFF_R3 + (size_t)MP * 1536 * 2;
constexpr size_t OFF_KPE = OFF_R4 + SZ_ACT;
constexpr size_t OFF_VT = OFF_KPE + (size_t)MT * 64 * 2;
constexpr size_t OFF_SKV = OFF_VT + (size_t)16 * 1024 * 4096 * 2;
constexpr size_t OFF_SVT = OFF_SKV + (size_t)32 * 2112 * 320 * 2;
constexpr size_t OFF_QS = OFF_SVT + (size_t)32 * 256 * 2112 * 2;
constexpr size_t OFF_OLAT = OFF_QS + (size_t)MS * 2560 * 2;
constexpr size_t OFF_MOD = OFF_OLAT + (size_t)MS * 2048 * 2;
constexpr size_t OFF_ROPE = OFF_MOD + (size_t)2 * 48 * 3072 * 4;
constexpr size_t OFF_CNT = OFF_ROPE + (size_t)4096 * 32 * 2 * 4;
constexpr size_t OFF_W = OFF_CNT + 256;
constexpr size_t WO_W1 = 0;
constexpr size_t WO_G = WO_W1 + (size_t)2176 * 1024;
constexpr size_t WO_QP = WO_G + (size_t)4096 * 1024;
constexpr size_t WO_QS = WO_QP + (size_t)1536 * 768;
constexpr size_t WO_UK = WO_QS + (size_t)2560 * 768;
constexpr size_t WO_UVS = WO_UK + 262144;
constexpr size_t WO_UVP = WO_UVS + 262144;
constexpr size_t WO_BA = WO_UVP + 262144;
constexpr size_t WO_BB = WO_BA + 1048576;
constexpr size_t WO_OUT = WO_BB + 1048576;
constexpr size_t WO_LA = WO_OUT + 1048576;
constexpr size_t WO_LX = WO_LA + 131072;
constexpr size_t W_LAYER = WO_LX + 131072;
constexpr size_t OFF_BAR = OFF_W + 2 * W_LAYER * 2;
constexpr size_t WS_NEED = OFF_BAR + 16384;

constexpr size_t OUT_YP = 0;
constexpr size_t OUT_YS = 67108864;
constexpr size_t OUT_CKVP = 67633152;
constexpr size_t OUT_KPEP = 101187584;
constexpr size_t OUT_CONVP = 109576192;
constexpr size_t OUT_LRUP = 109674496;
constexpr size_t OUT_CKVS = 109707264;
constexpr size_t OUT_KPES = 109969408;
constexpr size_t OUT_CONVS = 110034944;
constexpr size_t OUT_LRUS = 110231552;

struct Params {
  const float *x_p, *x_s, *c_p, *c_s, *cache_ckv, *cache_kpe, *state_conv, *state_lru;
  const float *ada_w, *ada_b, *pre_norm, *post_norm, *w_in, *conv_w, *conv_b, *lru_wa, *lru_ba, *lru_wx, *lru_bx;
  const float *lru_lambda, *q_norm, *w_q_up, *kv_norm, *w_uk, *w_uv, *w_ba, *w_bb, *w_out;
  float* out;
  unsigned char* ws;
};

DEV int TIDX() {
  int t = threadIdx.x;
  asm volatile("" : "+v"(t));
  return t;
}
typedef __attribute__((ext_vector_type(2))) float f32x2_t;
typedef __attribute__((ext_vector_type(2))) __bf16 bf16x2_t;
DEV unsigned pk2bf(float a, float b) {
  f32x2_t v = {a, b};
  bf16x2_t r = __builtin_convertvector(v, bf16x2_t);
  return __builtin_bit_cast(unsigned, r);
}
DEV u16 f2bf(float f) { return (u16)(pk2bf(f, 0.f) & 0xffffu); }
DEV float bf2f(u16 h) { return __uint_as_float(((unsigned)h) << 16); }
DEV float sigmoidf_(float x) { return 1.0f / (1.0f + __expf(-x)); }
DEV float siluf_(float x) { return x / (1.0f + __expf(-x)); }
DEV float wave_sum(float v) {
#pragma unroll
  for (int o = 32; o > 0; o >>= 1) v += __shfl_xor(v, o, 64);
  return v;
}
DEV int vbid() {
  const int b = blockIdx.x, n = gridDim.x;
  return ((n & 7) == 0) ? (b & 7) * (n >> 3) + (b >> 3) : b;
}
DEV int mod_row(int m) { return m < MP ? (m >> 12) : 16 + ((m - MP) >> 4); }
DEV int pos_of(int m) { return m < MP ? (m & 4095) : 2048 + ((m - MP) & 15); }

constexpr int LDT = 72;
#ifndef P5_DEPTH
#define P5_DEPTH 1
#endif
template <int SS, int DEPTH = 1>
DEV void gemm_main(f32x16 (&acc)[2][2], const u16* __restrict__ A, int lda, const u16* __restrict__ B, int ldb,
                   int K, unsigned char* smem) {
  u16* sA = (u16*)smem;
  u16* sB = sA + 128 * LDT;
  float* ss = (float*)(sB + 128 * LDT);
  const int tid = TIDX(), lane = tid & 63, w = tid >> 6, wm = w >> 1, wn = w & 1;
  const int srow = tid >> 3, scol = (tid & 7) * 8;
  const u16* ap = A + (size_t)srow * lda + scol;
  const u16* bp = B + (size_t)srow * ldb + scol;
  bf16x8 ra[DEPTH][4], rb[DEPTH][4];
  float ssq[4] = {0.f, 0.f, 0.f, 0.f};
  const int nk = K >> 6;
#pragma unroll
  for (int d = 0; d < DEPTH; ++d)
#pragma unroll
    for (int i = 0; i < 4; ++i) {
      ra[d][i] = *(const bf16x8*)(ap + d * 64 + (size_t)(32 * i) * lda);
      rb[d][i] = *(const bf16x8*)(bp + d * 64 + (size_t)(32 * i) * ldb);
    }
  ap += DEPTH * 64;
  bp += DEPTH * 64;
  const int fro = (lane & 31) * LDT + (lane >> 5) * 8;
#pragma unroll 1
  for (int kt = 0; kt < nk; kt += DEPTH) {
#pragma unroll
    for (int d = 0; d < DEPTH; ++d) {
      __syncthreads();
#pragma unroll
      for (int i = 0; i < 4; ++i) {
        *(bf16x8*)(sA + (srow + 32 * i) * LDT + scol) = ra[d][i];
        *(bf16x8*)(sB + (srow + 32 * i) * LDT + scol) = rb[d][i];
        if (SS) {
          bf16x8 v = (SS == 1) ? ra[d][i] : rb[d][i];
#pragma unroll
          for (int j = 0; j < 8; ++j) {
            float f = bf2f((u16)v[j]);
            ssq[i] += f * f;
          }
        }
      }
      __syncthreads();
      if (kt + d + DEPTH < nk) {
#pragma unroll
        for (int i = 0; i < 4; ++i) {
          ra[d][i] = *(const bf16x8*)(ap + (size_t)(32 * i) * lda);
          rb[d][i] = *(const bf16x8*)(bp + (size_t)(32 * i) * ldb);
        }
        ap += 64;
        bp += 64;
      }
#pragma unroll
      for (int ks = 0; ks < 4; ++ks) {
        bf16x8 af[2], bfr[2];
#pragma unroll
        for (int i = 0; i < 2; ++i) {
          af[i] = *(const bf16x8*)(sA + (wm * 64 + i * 32) * LDT + fro + ks * 16);
          bfr[i] = *(const bf16x8*)(sB + (wn * 64 + i * 32) * LDT + fro + ks * 16);
        }
        __builtin_amdgcn_s_setprio(1);
#pragma unroll
        for (int mi = 0; mi < 2; ++mi)
#pragma unroll
          for (int ni = 0; ni < 2; ++ni)
            acc[mi][ni] = __builtin_amdgcn_mfma_f32_32x32x16_bf16(af[mi], bfr[ni], acc[mi][ni], 0, 0, 0);
        __builtin_amdgcn_s_setprio(0);
      }
    }
  }
  if (SS) {
#pragma unroll
    for (int i = 0; i < 4; ++i) {
      float v = ssq[i];
      v += __shfl_xor(v, 1, 64);
      v += __shfl_xor(v, 2, 64);
      v += __shfl_xor(v, 4, 64);
      if ((tid & 7) == 0) ss[srow + 32 * i] = v;
    }
    __syncthreads();
  }
}
DEV void zero_acc(f32x16 (&acc)[2][2]) {
#pragma unroll
  for (int a = 0; a < 2; ++a)
#pragma unroll
    for (int b = 0; b < 2; ++b)
#pragma unroll
      for (int r = 0; r < 16; ++r) acc[a][b][r] = 0.f;
}
DEV float* gemm_ss(unsigned char* smem) { return (float*)(smem + 2 * 128 * LDT * 2); }

template <class F>
DEV void acc_foreach(F f) {
  const int tid_ = TIDX();
  const int lane = tid_ & 63, w = tid_ >> 6;
#pragma unroll
  for (int mi = 0; mi < 2; ++mi)
#pragma unroll
    for (int ni = 0; ni < 2; ++ni)
#pragma unroll
      for (int r = 0; r < 16; ++r)
        f(mi, ni, r, (w >> 1) * 64 + mi * 32 + (r & 3) + 8 * (r >> 2) + 4 * (lane >> 5), (w & 1) * 64 + ni * 32 + (lane & 31));
}
constexpr int LDC = 136;
DEV void tile_store(unsigned char* smem, u16* dst, size_t ldd) {
  const u16* sC = (const u16*)smem;
  __syncthreads();
  const int tid_ = TIDX();
#pragma unroll
  for (int i = 0; i < 8; ++i) {
    const int c = tid_ + 256 * i, row = c >> 4, cc = (c & 15) * 8;
    *(bf16x8*)(dst + (size_t)row * ldd + cc) = *(const bf16x8*)(sC + row * LDC + cc);
  }
}


template <int MI>
DEV void gemm_mm(f32x16 (&acc)[MI][2], const u16* __restrict__ A, int lda, const u16* __restrict__ B, int ldb, int K,
                 unsigned char* smem) {
  constexpr int BM = MI * 64;
  u16* sA = (u16*)smem;
  u16* sB = sA + BM * LDT;
  const int tid = TIDX(), lane = tid & 63, w = tid >> 6, wm = w >> 1, wn = w & 1;
  const int srow = tid >> 3, scol = (tid & 7) * 8;
  const u16* ap = A + (size_t)srow * lda + scol;
  const u16* bp = B + (size_t)srow * ldb + scol;
  bf16x8 ra[MI * 2], rb[4];
#pragma unroll
  for (int i = 0; i < MI * 2; ++i) ra[i] = *(const bf16x8*)(ap + (size_t)(32 * i) * lda);
#pragma unroll
  for (int i = 0; i < 4; ++i) rb[i] = *(const bf16x8*)(bp + (size_t)(32 * i) * ldb);
  const int nk = K >> 6;
  const int fro = (lane & 31) * LDT + (lane >> 5) * 8;
#pragma unroll 1
  for (int kt = 0; kt < nk; ++kt) {
    __syncthreads();
#pragma unroll
    for (int i = 0; i < MI * 2; ++i) *(bf16x8*)(sA + (srow + 32 * i) * LDT + scol) = ra[i];
#pragma unroll
    for (int i = 0; i < 4; ++i) *(bf16x8*)(sB + (srow + 32 * i) * LDT + scol) = rb[i];
    __syncthreads();
    if (kt + 1 < nk) {
      ap += 64;
      bp += 64;
#pragma unroll
      for (int i = 0; i < MI * 2; ++i) ra[i] = *(const bf16x8*)(ap + (size_t)(32 * i) * lda);
#pragma unroll
      for (int i = 0; i < 4; ++i) rb[i] = *(const bf16x8*)(bp + (size_t)(32 * i) * ldb);
    }
#pragma unroll
    for (int ks = 0; ks < 4; ++ks) {
      bf16x8 af[MI], bfr[2];
#pragma unroll
      for (int i = 0; i < MI; ++i) af[i] = *(const bf16x8*)(sA + (wm * (MI * 32) + i * 32) * LDT + fro + ks * 16);
#pragma unroll
      for (int i = 0; i < 2; ++i) bfr[i] = *(const bf16x8*)(sB + (wn * 64 + i * 32) * LDT + fro + ks * 16);
      __builtin_amdgcn_s_setprio(1);
#pragma unroll
      for (int mi = 0; mi < MI; ++mi)
#pragma unroll
        for (int ni = 0; ni < 2; ++ni)
          acc[mi][ni] = __builtin_amdgcn_mfma_f32_32x32x16_bf16(af[mi], bfr[ni], acc[mi][ni], 0, 0, 0);
      __builtin_amdgcn_s_setprio(0);
    }
  }
  __syncthreads();
}
template <int MI>
DEV void zero_acc_t(f32x16 (&acc)[MI][2]) {
#pragma unroll
  for (int a = 0; a < MI; ++a)
#pragma unroll
    for (int b = 0; b < 2; ++b)
#pragma unroll
      for (int r = 0; r < 16; ++r) acc[a][b][r] = 0.f;
}
template <int MI, class F>
DEV void acc_foreach_t(F f) {
  const int tid_ = TIDX();
  const int lane = tid_ & 63, w = tid_ >> 6;
#pragma unroll
  for (int mi = 0; mi < MI; ++mi)
#pragma unroll
    for (int ni = 0; ni < 2; ++ni)
#pragma unroll
      for (int r = 0; r < 16; ++r)
        f(mi, ni, r, (w >> 1) * (MI * 32) + mi * 32 + (r & 3) + 8 * (r >> 2) + 4 * (lane >> 5), (w & 1) * 64 + ni * 32 + (lane & 31));
}
template <int MI>
DEV void tile_load_t(unsigned char* smem, const u16* src, size_t lds_) {
  u16* sC = (u16*)smem;
  const int tid_ = TIDX();
#pragma unroll
  for (int i = 0; i < MI * 4; ++i) {
    const int c = tid_ + 256 * i, row = c >> 4, cc = (c & 15) * 8;
    *(bf16x8*)(sC + row * LDC + cc) = *(const bf16x8*)(src + (size_t)row * lds_ + cc);
  }
  __syncthreads();
}
template <int MI>
DEV void tile_store_t(unsigned char* smem, u16* dst, size_t ldd) {
  const u16* sC = (const u16*)smem;
  __syncthreads();
  const int tid_ = TIDX();
#pragma unroll
  for (int i = 0; i < MI * 4; ++i) {
    const int c = tid_ + 256 * i, row = c >> 4, cc = (c & 15) * 8;
    *(bf16x8*)(dst + (size_t)row * ldd + cc) = *(const bf16x8*)(sC + row * LDC + cc);
  }
}

#define XB_TMO      128
#define XB_XCNT(j)  (256  + 64 * (j))
#define XB_XSUB(j)  (1280 + 64 * (j))
#define XB_XGEN(j)  (2304 + 64 * (j))
#define XB_TOP      3328
#define XB_TOPGEN   3392
#define XCD_BAR_WORDS 3456
#define XB_SPIN_CAP (1u << 20)
#define LAS __attribute__((address_space(3)))
DEV unsigned xb_ld(unsigned* p) { return __hip_atomic_load(p, __ATOMIC_RELAXED, __HIP_MEMORY_SCOPE_AGENT); }
DEV unsigned xb_add(unsigned* p, unsigned v) { return __hip_atomic_fetch_add(p, v, __ATOMIC_RELAXED, __HIP_MEMORY_SCOPE_AGENT); }
DEV unsigned xb_xcc_id() { return (unsigned)__builtin_amdgcn_s_getreg((3 << 11) | 20) & 0xFu; }
#define XB_SPIN(cond, bar) do { unsigned _sp = 0; while (cond) { __builtin_amdgcn_s_sleep(1); \
    if ((++_sp & 255u) == 0u) { if (xb_ld(&(bar)[XB_TMO])) break; if (_sp > XB_SPIN_CAP) { atomicAdd(&(bar)[XB_TMO], 1u); break; } } } } while (0)
struct XcdBarrier {
  unsigned* bar;
  unsigned x;
  volatile LAS unsigned* st;
};
DEV XcdBarrier xcd_barrier_post(unsigned* bar, volatile LAS unsigned* st) {
  XcdBarrier b;
  b.bar = bar;
  b.x = xb_xcc_id();
  b.st = st;
  if (threadIdx.x == 0) (void)xb_add(&bar[XB_XCNT(b.x)], 1u);
  return b;
}
DEV void xcd_barrier_complete(unsigned* bar, unsigned x, unsigned& nloc, unsigned& nx) {
  const unsigned G = gridDim.x * gridDim.y * gridDim.z;
  unsigned sum, cnt, mine, sp = 0u;
  for (;;) {
    sum = 0u; cnt = 0u; mine = 0u;
#pragma unroll
    for (unsigned j = 0; j < 16; ++j) {
      const unsigned c = xb_ld(&bar[XB_XCNT(j)]);
      sum += c;
      cnt += (c > 0u) ? 1u : 0u;
      mine = (j == x) ? c : mine;
    }
    if (sum == G) break;
    __builtin_amdgcn_s_sleep(1);
    if ((++sp & 255u) == 0u) {
      if (xb_ld(&bar[XB_TMO])) break;
      if (sp > XB_SPIN_CAP) { atomicAdd(&bar[XB_TMO], 1u); break; }
    }
  }
  nloc = mine > 0u ? mine : 1u;
  nx = cnt > 0u ? cnt : 1u;
}
DEV void xcd_barrier(unsigned* bar_, volatile LAS unsigned* st_) {
  asm volatile("s_waitcnt vmcnt(0)" ::: "memory");
  __syncthreads();
  if (threadIdx.x == 0) {
    XcdBarrier b;
    b.bar = bar_;
    b.x = xb_xcc_id();
    b.st = st_;
    unsigned* bar = b.bar;
    __builtin_amdgcn_s_waitcnt(0);
    unsigned nloc = b.st[0], nx = b.st[1];
    if (nloc == 0u) {
      xcd_barrier_complete(bar, b.x, nloc, nx);
      b.st[0] = nloc;
      b.st[1] = nx;
    }
    const unsigned old = xb_add(&bar[XB_XSUB(b.x)], 1u);
    const unsigned gen = old / nloc;
    if (old + 1u == (gen + 1u) * nloc) {
      __builtin_amdgcn_fence(__ATOMIC_RELEASE, "agent");
      asm volatile("s_waitcnt vmcnt(0)" ::: "memory");
      const unsigned og = xb_add(&bar[XB_TOP], 1u);
      const unsigned tg = og / nx;
      if (og + 1u == (tg + 1u) * nx) xb_add(&bar[XB_TOPGEN], 1u);
      else XB_SPIN(xb_ld(&bar[XB_TOPGEN]) == tg, bar);
      __builtin_amdgcn_fence(__ATOMIC_ACQUIRE, "agent");
      xb_add(&bar[XB_XGEN(b.x)], 1u);
      asm volatile("s_waitcnt vmcnt(0)" ::: "memory");
    } else {
      XB_SPIN(xb_ld(&bar[XB_XGEN(b.x)]) == gen, bar);
      __builtin_amdgcn_fence(__ATOMIC_ACQUIRE, "agent");
      asm volatile("s_waitcnt vmcnt(0)" ::: "memory");
    }
  }
  __syncthreads();
}

DEV void transpose_tile(const float* __restrict__ src, int lds_, u16* __restrict__ dst, int ldd, const float* scale,
                        int k0, int n0, unsigned char* smem) {
  float* s = (float*)smem;
  const int tid = TIDX();
  __syncthreads();
  {
    const int n = tid & 63, kq = tid >> 6;
#pragma unroll 4
    for (int i = 0; i < 16; ++i) {
      int kk = kq * 16 + i;
      s[kk * 65 + n] = src[(size_t)(k0 + kk) * lds_ + n0 + n];
    }
  }
  __syncthreads();
  {
    const int k = tid & 63, nq = tid >> 6;
    const float sc = scale ? scale[k0 + k] : 1.0f;
#pragma unroll 4
    for (int i = 0; i < 16; ++i) {
      int n = nq * 16 + i;
      dst[(size_t)(n0 + n) * ldd + k0 + k] = f2bf(s[k * 65 + n] * sc);
    }
  }
}

DEV void qlat_tile(const float* __restrict__ wq, const float* __restrict__ wuk, const float* __restrict__ g,
                   u16* __restrict__ dst, int h, int r0, int k0, unsigned char* smem) {
  float* sQ = (float*)smem;
  float* sU = sQ + 64 * 65;
  const int tid = TIDX();
  float acc[16];
#pragma unroll
  for (int i = 0; i < 16; ++i) acc[i] = 0.f;
  for (int nh = 0; nh < 2; ++nh) {
    __syncthreads();
    {
      const int n = tid & 63, q = tid >> 6;
      for (int i = 0; i < 16; ++i) {
        int rr = q * 16 + i;
        sQ[rr * 65 + n] = wq[(size_t)(k0 + rr) * 1536 + h * 192 + nh * 64 + n];
        sU[rr * 65 + n] = wuk[(size_t)(r0 + rr) * 1024 + h * 128 + nh * 64 + n];
      }
    }
    __syncthreads();
    const int k = tid & 63, rq = tid >> 6;
    for (int n = 0; n < 64; ++n) {
      float qv = sQ[k * 65 + n];
#pragma unroll
      for (int i = 0; i < 16; ++i) acc[i] += qv * sU[(rq * 16 + i) * 65 + n];
    }
  }
  const int k = tid & 63, rq = tid >> 6;
  const float sc = g[k0 + k];
#pragma unroll
  for (int i = 0; i < 16; ++i) dst[(size_t)(h * 320 + r0 + rq * 16 + i) * 768 + k0 + k] = f2bf(acc[i] * sc);
}

DEV void mod_item(const Params& p, int item, unsigned char* smem) {
  const int l = item / 48, cg_ = item % 48;
  float* sc = (float*)smem;
  float* red = sc + 48 * 256;
  (void)red;
  const int tid = TIDX(), col = tid & 63, kq = tid >> 6;
  const float* W = p.ada_w + (size_t)l * 1024 * 3072 + cg_ * 64 + col;
  float acc[48];
#pragma unroll
  for (int b = 0; b < 48; ++b) acc[b] = 0.f;
  for (int kc = 0; kc < 4; ++kc) {
    __syncthreads();
    for (int e = tid; e < 48 * 256; e += NT) {
      int b = e >> 8, k = e & 255;
      float c = b < 16 ? p.c_p[b * 1024 + kc * 256 + k] : p.c_s[(b - 16) * 1024 + kc * 256 + k];
      sc[e] = siluf_(c);
    }
    __syncthreads();
#pragma unroll 1
    for (int i0 = 0; i0 < 64; i0 += 8) {
      float wv[8];
#pragma unroll
      for (int i = 0; i < 8; ++i) wv[i] = W[(size_t)(kc * 256 + kq * 64 + i0 + i) * 3072];
#pragma unroll
      for (int i = 0; i < 8; ++i) {
        const int k = kq * 64 + i0 + i;
#pragma unroll
        for (int b = 0; b < 48; ++b) acc[b] += sc[b * 256 + k] * wv[i];
      }
    }
  }
  __syncthreads();
#pragma unroll
  for (int b = 0; b < 48; ++b) sc[(kq * 48 + b) * 64 + col] = acc[b];
  __syncthreads();
  float* MOD = (float*)(p.ws + OFF_MOD);
  for (int e = tid; e < 48 * 64; e += NT) {
    int b = e >> 6, c = e & 63;
    float v = sc[(0 * 48 + b) * 64 + c] + sc[(1 * 48 + b) * 64 + c] + sc[(2 * 48 + b) * 64 + c] + sc[(3 * 48 + b) * 64 + c];
    int gc = cg_ * 64 + c;
    MOD[((size_t)l * 48 + b) * 3072 + gc] = v + p.ada_b[l * 3072 + gc];
  }
}

DEV void phase_prep(const Params& p, unsigned char* smem) {
  const int tid = TIDX();
  const int nb = gridDim.x;
  int idx = blockIdx.x, base = 0;
  if (blockIdx.x == 0) {
    if (tid < 64) ((unsigned*)(p.ws + OFF_CNT))[tid] = 0u;
    for (int e = tid; e < XCD_BAR_WORDS; e += NT) ((unsigned*)(p.ws + OFF_BAR))[e] = 0u;
  }
  for (; idx < base + 96; idx += nb) mod_item(p, idx - base, smem);
  base += 96;
  for (int l = 0; l < 2; ++l) {
    u16* WL = (u16*)(p.ws + OFF_W) + (size_t)l * W_LAYER;
    const float* win = p.w_in + (size_t)l * 1024 * IN_DIM;
#define TJOB(SRC, LDS_, KK, NN, DST, LDD, SCALE)                                     \
  {                                                                                  \
    const int nkt = (KK) / 64, ntl = nkt * ((NN) / 64);                              \
    for (; idx < base + ntl; idx += nb) {                                            \
      int t = idx - base;                                                            \
      transpose_tile((SRC), (LDS_), (DST), (LDD), (SCALE), (t % nkt) * 64, (t / nkt) * 64, smem); \
    }                                                                                \
    base += ntl;                                                                     \
  }
    TJOB(win, IN_DIM, 1024, 1024, WL + WO_W1, 1024, nullptr);
    TJOB(win + 2048, IN_DIM, 1024, 1088, WL + WO_W1 + (size_t)1024 * 1024, 1024, nullptr);
    TJOB(win + 1024, IN_DIM, 1024, 1024, WL + WO_G, 1024, nullptr);
    TJOB(win + 3136, IN_DIM, 1024, 3072, WL + WO_G + (size_t)1024 * 1024, 1024, nullptr);
    TJOB(p.w_q_up + (size_t)l * 768 * 1536, 1536, 768, 1536, WL + WO_QP, 768, p.q_norm + l * 768);
    for (int h = 0; h < 8; ++h)
      TJOB(p.w_q_up + (size_t)l * 768 * 1536 + h * 192 + 128, 1536, 768, 64, WL + WO_QS + (size_t)(h * 320 + 256) * 768, 768,
           p.q_norm + l * 768);
    TJOB(p.w_uk + (size_t)l * 262144, 1024, 256, 1024, WL + WO_UK, 256, p.kv_norm + l * 256);
    TJOB(p.w_uv + (size_t)l * 262144, 1024, 256, 1024, WL + WO_UVS, 256, p.kv_norm + l * 256);
    TJOB(p.w_uv + (size_t)l * 262144, 1024, 256, 1024, WL + WO_UVP, 256, nullptr);
    TJOB(p.w_ba + (size_t)l * 1048576, 1024, 1024, 1024, WL + WO_BA, 1024, nullptr);
    TJOB(p.w_bb + (size_t)l * 1048576, 1024, 1024, 1024, WL + WO_BB, 1024, nullptr);
    TJOB(p.w_out + (size_t)l * 1048576, 1024, 1024, 1024, WL + WO_OUT, 1024, nullptr);
    for (int b8 = 0; b8 < 8; ++b8) {
      TJOB(p.lru_wa + (size_t)l * 131072 + b8 * 16384, 128, 128, 128, WL + WO_LA + b8 * 16384, 128, nullptr);
      TJOB(p.lru_wx + (size_t)l * 131072 + b8 * 16384, 128, 128, 128, WL + WO_LX + b8 * 16384, 128, nullptr);
    }
    for (; idx < base + 384; idx += nb) {
      int t = idx - base;
      int h = t / 48, rt = (t % 48) / 12, kt = t % 12;
      qlat_tile(p.w_q_up + (size_t)l * 768 * 1536, p.w_uk + (size_t)l * 262144, p.q_norm + l * 768, WL + WO_QS, h,
                rt * 64, kt * 64, smem);
    }
    base += 384;
    for (; idx < base + 16; idx += nb) {
      int t = idx - base;
      u16* d = WL + WO_W1 + (size_t)2112 * 1024 + t * 4096;
      for (int e = tid; e < 4096; e += NT) d[e] = 0;
    }
    base += 16;
  }
  float* ROPE = (float*)(p.ws + OFF_ROPE);
  for (; idx < base + 512; idx += nb) {
    int e = (idx - base) * 256 + tid;
    int pos = e >> 5, j = e & 31;
    float inv = exp2f(-(float)j * (13.287712379549449f / 32.0f));
    float ang = (float)pos * inv;
    ROPE[2 * e] = cosf(ang);
    ROPE[2 * e + 1] = sinf(ang);
  }
  base += 512;
}

DEV void norm_row(const Params& p, int l, int m, const float (&xv)[16], int lane) {
  float ss = 0.f;
#pragma unroll
  for (int i = 0; i < 16; ++i) ss += xv[i] * xv[i];
  ss = wave_sum(ss);
  const float rstd = rsqrtf(ss * (1.0f / 1024.0f) + EPS);
  const float* MOD = (const float*)(p.ws + OFF_MOD) + ((size_t)l * 48 + mod_row(m)) * 3072;
  u16* H = (u16*)(p.ws + OFF_H) + (size_t)m * 1024;
#pragma unroll
  for (int i = 0; i < 4; ++i) {
    int c = i * 256 + lane * 4;
    float4 g = *(const float4*)(p.pre_norm + l * 1024 + c);
    float4 sh = *(const float4*)(MOD + c);
    float4 sc = *(const float4*)(MOD + 1024 + c);
    ushort4 o;
    o.x = f2bf(xv[i * 4 + 0] * rstd * g.x * (1.f + sc.x) + sh.x);
    o.y = f2bf(xv[i * 4 + 1] * rstd * g.y * (1.f + sc.y) + sh.y);
    o.z = f2bf(xv[i * 4 + 2] * rstd * g.z * (1.f + sc.z) + sh.z);
    o.w = f2bf(xv[i * 4 + 3] * rstd * g.w * (1.f + sc.w) + sh.w);
    *(ushort4*)(H + c) = o;
  }
}

DEV void phase_norm0(const Params& p) {
  const int tid_ = TIDX();
  const int lane = tid_ & 63, wv = tid_ >> 6;
  for (int m = blockIdx.x * 4 + wv; m < MT; m += gridDim.x * 4) {
    const float* x = m < MP ? p.x_p + (size_t)m * 1024 : p.x_s + (size_t)(m - MP) * 1024;
    float xv[16];
#pragma unroll
    for (int i = 0; i < 4; ++i) {
      float4 v = *(const float4*)(x + i * 256 + lane * 4);
      xv[i * 4] = v.x; xv[i * 4 + 1] = v.y; xv[i * 4 + 2] = v.z; xv[i * 4 + 3] = v.w;
    }
    norm_row(p, 0, m, xv, lane);
  }
}

DEV void phase_final(const Params& p, int l) {
  const int tid_ = TIDX();
  const int lane = tid_ & 63, wv = tid_ >> 6;
  const u16* O = (const u16*)(p.ws + OFF_R4);
  for (int m = blockIdx.x * 4 + wv; m < MT; m += gridDim.x * 4) {
    float* y = m < MP ? p.out + OUT_YP + (size_t)m * 1024 : p.out + OUT_YS + (size_t)(m - MP) * 1024;
    const float* x = (l == 0) ? (m < MP ? p.x_p + (size_t)m * 1024 : p.x_s + (size_t)(m - MP) * 1024) : y;
    float xv[16], ov[16];
    float ss = 0.f;
#pragma unroll
    for (int i = 0; i < 4; ++i) {
      int c = i * 256 + lane * 4;
      float4 v = *(const float4*)(x + c);
      xv[i * 4] = v.x; xv[i * 4 + 1] = v.y; xv[i * 4 + 2] = v.z; xv[i * 4 + 3] = v.w;
      ushort4 o = *(const ushort4*)(O + (size_t)m * 1024 + c);
      ov[i * 4] = bf2f(o.x); ov[i * 4 + 1] = bf2f(o.y); ov[i * 4 + 2] = bf2f(o.z); ov[i * 4 + 3] = bf2f(o.w);
    }
#pragma unroll
    for (int i = 0; i < 16; ++i) ss += ov[i] * ov[i];
    ss = wave_sum(ss);
    const float rstd = rsqrtf(ss * (1.0f / 1024.0f) + EPS);
    const float* MOD = (const float*)(p.ws + OFF_MOD) + ((size_t)l * 48 + mod_row(m)) * 3072 + 2048;
#pragma unroll
    for (int i = 0; i < 4; ++i) {
      int c = i * 256 + lane * 4;
      float4 g = *(const float4*)(p.post_norm + l * 1024 + c);
      float4 gt = *(const float4*)(MOD + c);
      xv[i * 4 + 0] += gt.x * ov[i * 4 + 0] * rstd * g.x;
      xv[i * 4 + 1] += gt.y * ov[i * 4 + 1] * rstd * g.y;
      xv[i * 4 + 2] += gt.z * ov[i * 4 + 2] * rstd * g.z;
      xv[i * 4 + 3] += gt.w * ov[i * 4 + 3] * rstd * g.w;
      *(float4*)(y + c) = make_float4(xv[i * 4], xv[i * 4 + 1], xv[i * 4 + 2], xv[i * 4 + 3]);
    }
    if (l == 0) norm_row(p, 1, m, xv, lane);
  }
}

template <int MI>
DEV void gemm1_tile(const Params& p, int l, int m0, int nt, unsigned char* smem) {
  constexpr int BM = MI * 64;
  const u16* H = (const u16*)(p.ws + OFF_H);
  const u16* W1 = (const u16*)(p.ws + OFF_W) + (size_t)l * W_LAYER + WO_W1;
  u16* XA = (u16*)(p.ws + OFF_R1);
  u16* CQ = (u16*)(p.ws + OFF_R2);
  u16* CKVR = CQ + (size_t)MT * 768;
  u16* sC = (u16*)smem;
  f32x16 acc[MI][2];
  zero_acc_t<MI>(acc);
  gemm_mm<MI>(acc, H + (size_t)m0 * 1024, 1024, W1 + (size_t)nt * 128 * 1024, 1024, 1024, smem);
  if (nt < 14) {
    acc_foreach_t<MI>([&](int mi, int ni, int r, int row, int col) __attribute__((always_inline)) {
      sC[row * LDC + col] = f2bf(acc[mi][ni][r]);
    });
    if (nt < 8) tile_store_t<MI>(smem, XA + (size_t)m0 * 1024 + nt * 128, 1024);
    else tile_store_t<MI>(smem, CQ + (size_t)m0 * 768 + (nt - 8) * 128, 768);
    if (nt < 8 && (m0 >= MP || ((m0 + BM) & 4095) == 0)) {
      acc_foreach_t<MI>([&](int mi, int ni, int r, int row, int col) __attribute__((always_inline)) {
        const int m = m0 + row, n = nt * 128 + col;
        const float v = acc[mi][ni][r];
        if (m < MP) {
          int j = (m & 4095) - 4093;
          if (j >= 0) p.out[OUT_CONVP + ((size_t)(l * 16 + (m >> 12)) * 3 + j) * 1024 + n] = v;
        } else {
          int j = ((m - MP) & 15) - 13;
          if (j >= 0) p.out[OUT_CONVS + ((size_t)(l * 32 + ((m - MP) >> 4)) * 3 + j) * 1024 + n] = v;
        }
      });
    }
  } else if (nt < 16) {
    float* ob = m0 < MP ? p.out + OUT_CKVP + ((size_t)l * MP + m0) * 256 + (nt - 14) * 128
                        : p.out + OUT_CKVS + ((size_t)l * MS + (m0 - MP)) * 256 + (nt - 14) * 128;
    acc_foreach_t<MI>([&](int mi, int ni, int r, int row, int col) __attribute__((always_inline)) {
      const float v = acc[mi][ni][r];
      sC[row * LDC + col] = f2bf(v);
      ob[(size_t)row * 256 + col] = v;
    });
    tile_store_t<MI>(smem, CKVR + (size_t)m0 * 256 + (nt - 14) * 128, 256);
  } else {
    float* ob = m0 < MP ? p.out + OUT_KPEP + ((size_t)l * MP + m0) * 64 : p.out + OUT_KPES + ((size_t)l * MS + (m0 - MP)) * 64;
    acc_foreach_t<MI>([&](int mi, int ni, int r, int row, int col) __attribute__((always_inline)) {
      if (col < 64) ob[(size_t)row * 64 + col] = acc[mi][ni][r];
    });
  }
}
DEV void phase_gemm1(const Params& p, int l, unsigned char* smem) {
  const int nb = gridDim.x;
  int idx = vbid(), base = 0;
#pragma unroll 1
  for (; idx < base + 256 * 17; idx += nb) {
    const int t = idx - base;
    gemm1_tile<4>(p, l, (t / 17) * 256, t % 17, smem);
  }
  base += 256 * 17;
#pragma unroll 1
  for (; idx < base + 4 * 17; idx += nb) {
    const int t = idx - base;
    gemm1_tile<2>(p, l, MP + (t / 17) * 128, t % 17, smem);
  }
}

DEV void post1_rows(const Params& p, int l, int item) {
  const int tid_ = TIDX();
  const int lane = tid_ & 63, wv = tid_ >> 6;
  const float* ROPE = (const float*)(p.ws + OFF_ROPE);
  float4 v[2];
  float kx[2];
  float2 cs[2];
  float* ckvp[2];
  float* kpep[2];
#pragma unroll
  for (int u = 0; u < 2; ++u) {
    const int m = item * 8 + wv * 2 + u;
    ckvp[u] = m < MP ? p.out + OUT_CKVP + ((size_t)l * MP + m) * 256 : p.out + OUT_CKVS + ((size_t)l * MS + (m - MP)) * 256;
    kpep[u] = m < MP ? p.out + OUT_KPEP + ((size_t)l * MP + m) * 64 : p.out + OUT_KPES + ((size_t)l * MS + (m - MP)) * 64;
    v[u] = *(const float4*)(ckvp[u] + lane * 4);
    kx[u] = kpep[u][lane];
    cs[u] = *(const float2*)(ROPE + ((size_t)pos_of(m) * 32 + (lane & 31)) * 2);
  }
  const float4 g = *(const float4*)(p.kv_norm + l * 256 + lane * 4);
#pragma unroll
  for (int u = 0; u < 2; ++u) {
    const int m = item * 8 + wv * 2 + u;
    const float ss = wave_sum(v[u].x * v[u].x + v[u].y * v[u].y + v[u].z * v[u].z + v[u].w * v[u].w);
    const float rstd = rsqrtf(ss * (1.0f / 256.0f) + EPS);
    float4 o4 = v[u];
    o4.x *= rstd * g.x; o4.y *= rstd * g.y; o4.z *= rstd * g.z; o4.w *= rstd * g.w;
    *(float4*)(ckvp[u] + lane * 4) = o4;
    const float other = __shfl_xor(kx[u], 32, 64);
    const float c = cs[u].x, sn = cs[u].y;
    const float ro = (lane < 32) ? (kx[u] * c - other * sn) : (other * sn + kx[u] * c);
    kpep[u][lane] = ro;
    if (m < MP) {
      u16* KPE = (u16*)(p.ws + OFF_KPE) + (size_t)m * 64;
      KPE[lane] = f2bf(ro);
    } else {
      const int b = (m - MP) >> 4, t = (m - MP) & 15;
      u16* SKV = (u16*)(p.ws + OFF_SKV) + ((size_t)b * 2112 + 2048 + t) * 320;
      u16* SVT = (u16*)(p.ws + OFF_SVT) + (size_t)b * 256 * 2112 + 2048 + t;
      ushort4 o;
      o.x = f2bf(o4.x); o.y = f2bf(o4.y); o.z = f2bf(o4.z); o.w = f2bf(o4.w);
      *(ushort4*)(SKV + lane * 4) = o;
      SVT[(size_t)(lane * 4 + 0) * 2112] = o.x;
      SVT[(size_t)(lane * 4 + 1) * 2112] = o.y;
      SVT[(size_t)(lane * 4 + 2) * 2112] = o.z;
      SVT[(size_t)(lane * 4 + 3) * 2112] = o.w;
      SKV[256 + lane] = f2bf(ro);
    }
  }
}

DEV void cache_item(const Params& p, int l, int item, unsigned char* smem) {
  const int tid = TIDX();
  const int b = item / 33, kt = item % 33;
  u16* SKV = (u16*)(p.ws + OFF_SKV) + (size_t)b * 2112 * 320;
  u16* SVT = (u16*)(p.ws + OFF_SVT) + (size_t)b * 256 * 2112;
  if (kt == 32) {
    for (int e = tid; e < 48 * 320; e += NT) SKV[(size_t)2064 * 320 + e] = 0;
    for (int e = tid; e < 256 * 48; e += NT) SVT[(size_t)(e / 48) * 2112 + 2064 + (e % 48)] = 0;
    return;
  }
  float* s = (float*)smem;
  const float* src = p.cache_ckv + (((size_t)l * 32 + b) * 2048 + kt * 64) * 256;
  const float* srck = p.cache_kpe + (((size_t)l * 32 + b) * 2048 + kt * 64) * 64;
  for (int dh = 0; dh < 2; ++dh) {
    __syncthreads();
    for (int e = tid; e < 64 * 128; e += NT) {
      int key = e >> 7, d = e & 127;
      float v = src[(size_t)key * 256 + dh * 128 + d];
      s[key * 129 + d] = v;
      SKV[(size_t)(kt * 64 + key) * 320 + dh * 128 + d] = f2bf(v);
    }
    __syncthreads();
    const int k = tid & 63, dq = tid >> 6;
    for (int i = 0; i < 32; ++i) {
      int d = dq * 32 + i;
      SVT[(size_t)(dh * 128 + d) * 2112 + kt * 64 + k] = f2bf(s[k * 129 + d]);
    }
  }
  for (int e = tid; e < 64 * 64; e += NT) {
    int key = e >> 6, d = e & 63;
    SKV[(size_t)(kt * 64 + key) * 320 + 256 + d] = f2bf(srck[(size_t)key * 64 + d]);
  }
}

DEV void phase_p2(const Params& p, int l, unsigned char* smem) {
  const int tid = TIDX(), lane = tid & 63, w = tid >> 6;
  const int nb = gridDim.x;
  const u16* WL = (const u16*)(p.ws + OFF_W) + (size_t)l * W_LAYER;
  const u16* CQ = (const u16*)(p.ws + OFF_R2);
  const u16* CKVR = CQ + (size_t)MT * 768;
  u16* Q = (u16*)(p.ws + OFF_R3);
  u16* QS = (u16*)(p.ws + OFF_QS);
  u16* Kb = (u16*)(p.ws + OFF_R4);
  u16* VT = (u16*)(p.ws + OFF_VT);
  const float* ROPE = (const float*)(p.ws + OFF_ROPE);
  float* ss = gemm_ss(smem);
  int idx = vbid(), base = 0;
  const int nq = 512 * 12 + 4 * 20;
  for (; idx < base + nq; idx += nb) {
    int t = idx - base;
    int mt, nt;
    const u16* Wt;
    bool samp = t >= 512 * 12;
    if (!samp) { mt = t / 12; nt = t % 12; Wt = WL + WO_QP; }
    else { t -= 512 * 12; mt = 512 + t / 20; nt = t % 20; Wt = WL + WO_QS; }
    f32x16 acc[2][2];
    zero_acc(acc);
    gemm_main<1>(acc, CQ + (size_t)mt * 128 * 768, 768, Wt + (size_t)nt * 128 * 768, 768, 768, smem);
    const int g = nt * 2 + (w & 1);
    const bool rope = samp ? (g % 5 == 4) : (g % 3 == 2);
    u16* sC = (u16*)smem;
#pragma unroll
    for (int mi = 0; mi < 2; ++mi)
#pragma unroll
      for (int r = 0; r < 16; ++r) {
        const int row = (w >> 1) * 64 + mi * 32 + (r & 3) + 8 * (r >> 2) + 4 * (lane >> 5);
        const int m = mt * 128 + row;
        const float rs = rsqrtf(ss[row] * (1.0f / 768.0f) + EPS) * QSCALE;
        float v0 = acc[mi][0][r] * rs, v1 = acc[mi][1][r] * rs;
        if (rope) {
          const int pos = pos_of(m);
          const float c = ROPE[(pos * 32 + (lane & 31)) * 2], s = ROPE[(pos * 32 + (lane & 31)) * 2 + 1];
          const float a = v0 * c - v1 * s, b = v0 * s + v1 * c;
          v0 = a; v1 = b;
        }
        const int col = (w & 1) * 64 + (lane & 31);
        sC[row * LDC + col] = f2bf(v0);
        sC[row * LDC + col + 32] = f2bf(v1);
      }
    if (!samp) tile_store(smem, Q + (size_t)mt * 128 * 1536 + nt * 128, 1536);
    else tile_store(smem, QS + (size_t)(mt - 512) * 128 * 2560 + nt * 128, 2560);
  }
  base += nq;
  for (; idx < base + 4096; idx += nb) {
    int t = idx - base;
    int mt = t >> 3, nt = t & 7;
    f32x16 acc[2][2];
    zero_acc(acc);
    gemm_main<1, 2>(acc, CKVR + (size_t)mt * 128 * 256, 256, WL + WO_UK + (size_t)nt * 128 * 256, 256, 256, smem);
    {
      u16* sC = (u16*)smem;
      acc_foreach([&](int mi, int ni, int r, int row, int col) __attribute__((always_inline)) {
        const float rs = rsqrtf(ss[row] * (1.0f / 256.0f) + EPS);
        sC[row * LDC + col] = f2bf(acc[mi][ni][r] * rs);
      });
      tile_store(smem, Kb + (size_t)mt * 128 * 1024 + nt * 128, 1024);
    }
  }
  base += 4096;
  for (; idx < base + 4096; idx += nb) {
    int t = idx - base;
    int b = t >> 8, mt = (t >> 5) & 7, nt = t & 31;
    f32x16 acc[2][2];
    zero_acc(acc);
    gemm_main<2, 2>(acc, WL + WO_UVS + (size_t)mt * 128 * 256, 256, CKVR + ((size_t)b * 4096 + nt * 128) * 256, 256, 256, smem);
    {
      u16* sC = (u16*)smem;
      acc_foreach([&](int mi, int ni, int r, int row, int col) __attribute__((always_inline)) {
        const float rs = rsqrtf(ss[col] * (1.0f / 256.0f) + EPS);
        sC[row * LDC + col] = f2bf(acc[mi][ni][r] * rs);
      });
      tile_store(smem, VT + ((size_t)b * 1024 + mt * 128) * 4096 + nt * 128, 4096);
    }
  }
  base += 4096;
  for (; idx < base + MT / 8; idx += nb) post1_rows(p, l, idx - base);
  base += MT / 8;
  for (; idx < base + 32 * 33; idx += nb) cache_item(p, l, idx - base, smem);
  base += 32 * 33;
}

#ifndef ATT_PF
#define ATT_PF true
#endif
template <int DK, bool PF>
DEV void attn_item(const u16* __restrict__ qrow, const u16* __restrict__ ka, int ldka, const u16* __restrict__ kb, int ldkb,
                   const u16* __restrict__ vt, int ldvt, int ntiles, int my_tiles, int kvlen, u16* orow,
                   unsigned char* smem) {
  constexpr int DKA = DK - 64, KST = DK + 8, VST = 68;
  u16* sK = (u16*)smem;
  u16* sV = sK + 64 * KST;
  const int tid = TIDX(), lane = tid & 63, hh = lane >> 5, l31 = lane & 31;
  constexpr bool QREG = (DK <= 192);
  bf16x8 qf[DK / 16];
  if (QREG) {
#pragma unroll
    for (int ks = 0; ks < DK / 16; ++ks) qf[ks] = *(const bf16x8*)(qrow + ks * 16 + hh * 8);
  }
  f32x16 o[4];
#pragma unroll
  for (int d = 0; d < 4; ++d)
#pragma unroll
    for (int r = 0; r < 16; ++r) o[d][r] = 0.f;
  float mrun = -1e30f, lrun = 0.f;
  constexpr int CA = DKA / 32;
  bf16x8 rk[CA + 2], rv[4];
  const int skey = tid >> 2, sq = tid & 3;
  const u16* gka = ka + (size_t)skey * ldka + sq * CA * 8;
  const u16* gkb = kb + (size_t)skey * ldkb + sq * 16;
  const u16* gv = vt + (size_t)(tid >> 1) * ldvt + (tid & 1) * 32;
  u16* lka = sK + skey * KST + sq * CA * 8;
  u16* lkb = sK + skey * KST + DKA + sq * 16;
  u16* lv = sV + (tid >> 1) * VST + (tid & 1) * 32;
  auto load_tile = [&](int t) __attribute__((always_inline)) {
    const size_t ko = (size_t)t * 64;
#pragma unroll
    for (int i = 0; i < CA; ++i) rk[i] = *(const bf16x8*)(gka + ko * ldka + i * 8);
#pragma unroll
    for (int i = 0; i < 2; ++i) rk[CA + i] = *(const bf16x8*)(gkb + ko * ldkb + i * 8);
#pragma unroll
    for (int i = 0; i < 4; ++i) rv[i] = *(const bf16x8*)(gv + ko + i * 8);
  };
  auto store_tile = [&]() __attribute__((always_inline)) {
#pragma unroll
    for (int i = 0; i < CA; ++i) *(bf16x8*)(lka + i * 8) = rk[i];
#pragma unroll
    for (int i = 0; i < 2; ++i) *(bf16x8*)(lkb + i * 8) = rk[CA + i];
#pragma unroll
    for (int i = 0; i < 4; ++i) {
      union { bf16x8 v; uint2 u[2]; } cv;
      cv.v = rv[i];
      *(uint2*)(lv + i * 8) = cv.u[0];
      *(uint2*)(lv + i * 8 + 4) = cv.u[1];
    }
  };
  if (PF) load_tile(0);
#pragma unroll 1
  for (int t = 0; t < ntiles; ++t) {
    __syncthreads();
    if (!PF) load_tile(t);
    store_tile();
    __syncthreads();
    if (PF && t + 1 < ntiles) load_tile(t + 1);
    if (t < my_tiles) {
      const u16* qp = qrow + hh * 8;
      if (!QREG) asm volatile("" : "+v"(qp));
      const int key0 = t * 64;
#pragma unroll 1
      for (int mi = 0; mi < 2; ++mi) {
        f32x16 s;
#pragma unroll
        for (int r = 0; r < 16; ++r) s[r] = 0.f;
        const u16* kp = sK + (mi * 32 + l31) * KST + hh * 8;
        constexpr int KB = QREG ? 12 : 4;
#pragma unroll
        for (int k0 = 0; k0 < DK / 16; k0 += KB) {
          bf16x8 kf[KB];
#pragma unroll
          for (int i = 0; i < KB; ++i) kf[i] = *(const bf16x8*)(kp + (k0 + i) * 16);
          __builtin_amdgcn_sched_barrier(0);
#pragma unroll
          for (int i = 0; i < KB; ++i) {
            bf16x8 qv;
            if (QREG) qv = qf[k0 + i];
            else qv = *(const bf16x8*)(qp + (k0 + i) * 16);
            s = __builtin_amdgcn_mfma_f32_32x32x16_bf16(kf[i], qv, s, 0, 0, 0);
          }
        }
        bf16x8 vf[8];
        {
          const u16* vp = sV + l31 * VST + mi * 32 + 4 * hh;
#pragma unroll
          for (int oc = 0; oc < 2; ++oc)
#pragma unroll
            for (int d = 0; d < 4; ++d) {
              union { bf16x8 v; uint2 u[2]; } cv;
              cv.u[0] = *(const uint2*)(vp + d * 32 * VST + oc * 16);
              cv.u[1] = *(const uint2*)(vp + d * 32 * VST + oc * 16 + 8);
              vf[oc * 4 + d] = cv.v;
            }
          __builtin_amdgcn_sched_barrier(0);
        }
        if (key0 + 64 > kvlen) {
#pragma unroll
          for (int r = 0; r < 16; ++r) {
            int key = key0 + mi * 32 + (r & 3) + 8 * (r >> 2) + 4 * hh;
            if (key >= kvlen) s[r] = -1e30f;
          }
        }
        float mx = -1e30f;
#pragma unroll
        for (int r = 0; r < 16; ++r) mx = fmaxf(mx, s[r]);
        mx = fmaxf(mx, __shfl_xor(mx, 32, 64));
        if (__builtin_amdgcn_ballot_w64(mx > mrun) != 0ull) {
          const float mnew = fmaxf(mrun, mx);
          const float alpha = __builtin_amdgcn_exp2f(mrun - mnew);
          mrun = mnew;
          lrun *= alpha;
#pragma unroll
          for (int d = 0; d < 4; ++d)
#pragma unroll
            for (int r = 0; r < 16; ++r) o[d][r] *= alpha;
        }
        union { bf16x8 v[2]; unsigned u[8]; } pfu;
        float ps = 0.f;
#pragma unroll
        for (int r = 0; r < 16; r += 2) {
          float p0 = __builtin_amdgcn_exp2f(s[r] - mrun);
          float p1 = __builtin_amdgcn_exp2f(s[r + 1] - mrun);
          ps += p0 + p1;
          pfu.u[r >> 1] = pk2bf(p0, p1);
        }
        lrun += ps;
#pragma unroll
        for (int oc = 0; oc < 2; ++oc)
#pragma unroll
          for (int d = 0; d < 4; ++d) o[d] = __builtin_amdgcn_mfma_f32_32x32x16_bf16(vf[oc * 4 + d], pfu.v[oc], o[d], 0, 0, 0);
      }
    }
  }
  const float ltot = lrun + __shfl_xor(lrun, 32, 64);
  const float inv = 1.0f / ltot;
#pragma unroll
  for (int d = 0; d < 4; ++d)
#pragma unroll
    for (int g = 0; g < 4; ++g) {
      uint2 ov;
      ov.x = pk2bf(o[d][g * 4 + 0] * inv, o[d][g * 4 + 1] * inv);
      ov.y = pk2bf(o[d][g * 4 + 2] * inv, o[d][g * 4 + 3] * inv);
      *(uint2*)(orow + d * 32 + g * 8 + hh * 4) = ov;
    }
  __syncthreads();
}

DEV void lru_item(const Params& p, int l, int sb, int nbk, int half, unsigned char* smem) {
  const int tid = TIDX(), lane = tid & 63, w = tid >> 6, hh = lane >> 5, l31 = lane & 31;
  const bool samp = sb >= 16;
  const int S = samp ? 16 : 4096;
  const int row0 = samp ? MP + (sb - 16) * 16 : sb * 4096;
  const int kc0 = nbk * 128, oc0 = nbk * 128 + half * 64;
  const u16* XA = (const u16*)(p.ws + OFF_R1);
  u16* YL = (u16*)(p.ws + OFF_R2);
  const u16* WL = (const u16*)(p.ws + OFF_W) + (size_t)l * W_LAYER;
  u16* sXC = (u16*)smem;
  float* sA = (float*)(smem + 17408);
  float* sB = sA + 4096;
  float* segA = sB + 4096;
  float* segB = segA + 256;
  float* hc = segB + 256;
  float* cw = hc + 64;
  float* cb = cw + 512;
  const int tm = w >> 1, tn = w & 1;
  __syncthreads();
  for (int e = tid; e < 512; e += NT) cw[e] = p.conv_w[(size_t)l * 4096 + (e >> 7) * 1024 + kc0 + (e & 127)];
  if (tid < 128) cb[tid] = p.conv_b[l * 1024 + kc0 + tid];
  if (tid < 64) hc[tid] = samp ? p.state_lru[((size_t)l * 32 + (sb - 16)) * 1024 + oc0 + tid] : 0.f;
  bf16x8 waf[8], wxf[8];
  {
    const u16* wa = WL + WO_LA + (size_t)nbk * 16384 + (size_t)(half * 64 + tn * 32 + l31) * 128 + hh * 8;
    const u16* wx = WL + WO_LX + (size_t)nbk * 16384 + (size_t)(half * 64 + tn * 32 + l31) * 128 + hh * 8;
#pragma unroll
    for (int ks = 0; ks < 8; ++ks) {
      waf[ks] = *(const bf16x8*)(wa + ks * 16);
      wxf[ks] = *(const bf16x8*)(wx + ks * 16);
    }
  }
  const int och = oc0 + tn * 32 + l31;
  const float ba = p.lru_ba[l * 1024 + och], bx = p.lru_bx[l * 1024 + och];
  const float lam = p.lru_lambda[l * 1024 + och];
  const float ex_ = __expf(-lam);
  const float sp = (-lam > 20.f) ? -lam
                   : (ex_ < 0.01f ? ex_ * (1.0f - ex_ * (0.5f - ex_ * (0.33333334f - 0.25f * ex_))) : __logf(1.0f + ex_));
  __syncthreads();
  for (int t0 = 0; t0 < S; t0 += 64) {
    {
      const int cc = (tid & 15) * 8, tq = tid >> 4;
      bf16x8 xr[7];
#pragma unroll
      for (int j = 0; j < 7; ++j) {
        int ts = t0 + tq * 4 - 3 + j;
        ts = ts < 0 ? 0 : (ts > S - 1 ? S - 1 : ts);
        xr[j] = *(const bf16x8*)(XA + (size_t)(row0 + ts) * 1024 + kc0 + cc);
      }
      float xf[7][8];
#pragma unroll
      for (int j = 0; j < 7; ++j) {
        const int ts = t0 + tq * 4 - 3 + j;
        const bool ok = ts >= 0;
#pragma unroll
        for (int c = 0; c < 8; ++c) xf[j][c] = ok ? bf2f((u16)xr[j][c]) : 0.f;
      }
      if (samp && t0 == 0 && tq == 0) {
#pragma unroll
        for (int j = 0; j < 3; ++j) {
          const float* st = p.state_conv + (((size_t)l * 32 + (sb - 16)) * 3 + j) * 1024 + kc0 + cc;
#pragma unroll
          for (int c = 0; c < 8; ++c) xf[j][c] = st[c];
        }
      }
#pragma unroll
      for (int i = 0; i < 4; ++i) {
        const int tl = tq * 4 + i;
        bf16x8 o;
#pragma unroll
        for (int c = 0; c < 8; ++c) {
          float v = cb[cc + c];
#pragma unroll
          for (int k = 0; k < 4; ++k) v += xf[i + k][c] * cw[k * 128 + cc + c];
          o[c] = (short)f2bf(v);
        }
        *(bf16x8*)(sXC + tl * 136 + cc) = o;
      }
    }
    __syncthreads();
    f32x16 aR, aI;
#pragma unroll
    for (int r = 0; r < 16; ++r) { aR[r] = 0.f; aI[r] = 0.f; }
#pragma unroll
    for (int ks = 0; ks < 8; ++ks) {
      bf16x8 a = *(const bf16x8*)(sXC + (tm * 32 + l31) * 136 + ks * 16 + hh * 8);
      aR = __builtin_amdgcn_mfma_f32_32x32x16_bf16(a, waf[ks], aR, 0, 0, 0);
      aI = __builtin_amdgcn_mfma_f32_32x32x16_bf16(a, wxf[ks], aI, 0, 0, 0);
    }
#pragma unroll
    for (int r = 0; r < 16; ++r) {
      const int tl = tm * 32 + (r & 3) + 8 * (r >> 2) + 4 * hh;
      const int cl = tn * 32 + l31;
      float av, bv;
      {
        const float rg = __builtin_amdgcn_rcpf(1.0f + __expf(-(aR[r] + ba)));
        const float ig = __builtin_amdgcn_rcpf(1.0f + __expf(-(aI[r] + bx)));
        const float la = -8.0f * rg * sp;
        const float a_ = __expf(la);
        const float x2 = 2.0f * la;
        const float ser = -x2 * (1.0f + x2 * (0.5f + x2 * (0.16666667f + x2 * (0.041666668f + x2 * 0.0083333338f))));
        const float em = (x2 > -0.25f) ? ser : 1.0f - __expf(x2);
        const float mult = __builtin_amdgcn_sqrtf(em);
        const float xcv = bf2f(sXC[tl * 136 + half * 64 + cl]);
        const bool valid = (t0 + tl < S);
        av = valid ? a_ : 1.f;
        bv = valid ? mult * ig * xcv : 0.f;
      }
      sA[tl * 64 + cl] = av;
      sB[tl * 64 + cl] = bv;
    }
    __syncthreads();
    {
      const int c = lane, sg = w;
      float A_ = 1.f, B_ = 0.f;
#pragma unroll
      for (int i = 0; i < 16; ++i) {
        const float a = sA[(sg * 16 + i) * 64 + c], b = sB[(sg * 16 + i) * 64 + c];
        B_ = a * B_ + b;
        A_ *= a;
      }
      segA[sg * 64 + c] = A_;
      segB[sg * 64 + c] = B_;
      __syncthreads();
      float h = hc[c];
      for (int s2 = 0; s2 < sg; ++s2) h = segA[s2 * 64 + c] * h + segB[s2 * 64 + c];
      __syncthreads();
#pragma unroll
      for (int i = 0; i < 16; ++i) {
        const int tl = sg * 16 + i;
        const float a = sA[tl * 64 + c], b = sB[tl * 64 + c];
        h = a * h + b;
        if (t0 + tl < S) YL[(size_t)(row0 + t0 + tl) * 1024 + oc0 + c] = f2bf(h);
      }
      if (sg == 3) hc[c] = h;
    }
    __syncthreads();
  }
  if (tid < 64) {
    const float h = hc[tid];
    if (samp) p.out[OUT_LRUS + ((size_t)l * 32 + (sb - 16)) * 1024 + oc0 + tid] = h;
    else p.out[OUT_LRUP + ((size_t)l * 16 + sb) * 1024 + oc0 + tid] = h;
  }
  __syncthreads();
}

DEV void phase_p3(const Params& p, int l, unsigned char* smem) {
  __shared__ int s_item;
  const int tid = TIDX(), lane = tid & 63, w = tid >> 6;
#pragma unroll 1
  for (int it = blockIdx.x; it < 256; it += gridDim.x) lru_item(p, l, it >> 4, (it >> 1) & 7, it & 1, smem);
#pragma unroll 1
  for (int it0 = blockIdx.x; it0 < 320; it0 += gridDim.x) {
    if (it0 < 256) continue;
    const int it = it0 - 256;
    const int b = it >> 1, dvh = it & 1;
    const int r = w * 32 + (lane & 31), h = r >> 4, t = r & 15;
    const u16* qrow = (const u16*)(p.ws + OFF_QS) + ((size_t)b * 16 + t) * 2560 + h * 320;
    const u16* ka = (const u16*)(p.ws + OFF_SKV) + (size_t)b * 2112 * 320;
    const u16* vt = (const u16*)(p.ws + OFF_SVT) + ((size_t)b * 256 + dvh * 128) * 2112;
    u16* orow = (u16*)(p.ws + OFF_OLAT) + ((size_t)b * 16 + t) * 2048 + h * 256 + dvh * 128;
    attn_item<320, false>(qrow, ka, 320, ka + 256, 320, vt, 2112, 33, 33, 2064, orow, smem);
  }
  const int xcd = blockIdx.x & 7;
#pragma unroll 1
  for (int qi = 0; qi < 8; ++qi) {
    const int q = (xcd + qi) & 7;
    unsigned* qc = (unsigned*)(p.ws + OFF_CNT) + 8 + l * 8 + q;
#pragma unroll 1
    for (;;) {
      __syncthreads();
      if (tid == 0) s_item = (int)atomicAdd(qc, 1u);
      __syncthreads();
      const int it = s_item;
      if (it >= 512) break;
      const int qt = 31 - (it & 31), bh = (it >> 5) * 8 + q, b = bh >> 3, h = bh & 7;
      u16* Q = (u16*)(p.ws + OFF_R3);
      const int r = w * 32 + (lane & 31);
      u16* qrow = Q + ((size_t)b * 4096 + qt * 128 + r) * 1536 + h * 192;
      const u16* ka = (const u16*)(p.ws + OFF_R4) + (size_t)b * 4096 * 1024 + h * 128;
      const u16* kb = (const u16*)(p.ws + OFF_KPE) + (size_t)b * 4096 * 64;
      const u16* vt = (const u16*)(p.ws + OFF_VT) + ((size_t)b * 1024 + h * 128) * 4096;
      attn_item<192, ATT_PF>(qrow, ka, 1024, kb, 64, vt, 4096, 2 * (qt + 1), 2 * qt + 1 + (w >> 1), 1 << 30, qrow, smem);
    }
  }
#pragma unroll 1
  for (int it = blockIdx.x; it < 512; it += gridDim.x) lru_item(p, l, 16 + (it >> 4), (it >> 1) & 7, it & 1, smem);
}

template <int MI>
DEV void p4_tile(const Params& p, int l, int m0, int nt, unsigned char* smem) {
  const u16* WL = (const u16*)(p.ws + OFF_W) + (size_t)l * W_LAYER;
  const u16* H = (const u16*)(p.ws + OFF_H);
  const u16* Q = (const u16*)(p.ws + OFF_R3);
  const u16* OLAT = (const u16*)(p.ws + OFF_OLAT);
  u16* YB = (u16*)(p.ws + OFF_R1);
  u16* YA = (u16*)(p.ws + OFF_R2);
  u16* sC = (u16*)smem;
  f32x16 acc[MI][2];
  if (nt < 8) {
    if constexpr (MI == 2) {
      if (m0 >= MP) {
        f32x16 att[MI][2];
        zero_acc_t<MI>(att);
        gemm_mm<MI>(att, OLAT + (size_t)(m0 - MP) * 2048 + nt * 256, 2048, WL + WO_UVP + (size_t)nt * 128 * 256, 256, 256, smem);
        zero_acc_t<MI>(acc);
        gemm_mm<MI>(acc, H + (size_t)m0 * 1024, 1024, WL + WO_G + (size_t)(1024 + nt * 128) * 1024, 1024, 1024, smem);
        acc_foreach_t<MI>([&](int mi, int ni, int r, int row, int col) __attribute__((always_inline)) {
          sC[row * LDC + col] = f2bf(att[mi][ni][r] * siluf_(acc[mi][ni][r]));
        });
        tile_store_t<MI>(smem, YB + (size_t)m0 * 1024 + nt * 128, 1024);
        return;
      }
    }
    zero_acc_t<MI>(acc);
    gemm_mm<MI>(acc, H + (size_t)m0 * 1024, 1024, WL + WO_G + (size_t)(1024 + nt * 128) * 1024, 1024, 1024, smem);
    tile_load_t<MI>(smem, Q + (size_t)m0 * 1536 + nt * 192, 1536);
    acc_foreach_t<MI>([&](int mi, int ni, int r, int row, int col) __attribute__((always_inline)) {
      sC[row * LDC + col] = f2bf(bf2f(sC[row * LDC + col]) * siluf_(acc[mi][ni][r]));
    });
    tile_store_t<MI>(smem, YB + (size_t)m0 * 1024 + nt * 128, 1024);
  } else {
    const int n0 = (nt - 8) * 128;
    zero_acc_t<MI>(acc);
    gemm_mm<MI>(acc, H + (size_t)m0 * 1024, 1024, WL + WO_G + (size_t)n0 * 1024, 1024, 1024, smem);
    tile_load_t<MI>(smem, YA + (size_t)m0 * 1024 + n0, 1024);
    acc_foreach_t<MI>([&](int mi, int ni, int r, int row, int col) __attribute__((always_inline)) {
      sC[row * LDC + col] = f2bf(bf2f(sC[row * LDC + col]) * siluf_(acc[mi][ni][r]));
    });
    tile_store_t<MI>(smem, YA + (size_t)m0 * 1024 + n0, 1024);
  }
}
DEV void phase_p4(const Params& p, int l, unsigned char* smem) {
  const int nb = gridDim.x;
  int idx = vbid(), base = 0;
#pragma unroll 1
  for (; idx < base + 256 * 16; idx += nb) {
    const int t = idx - base;
    p4_tile<4>(p, l, (t >> 4) * 256, t & 15, smem);
  }
  base += 256 * 16;
#pragma unroll 1
  for (; idx < base + 4 * 16; idx += nb) {
    const int t = idx - base;
    p4_tile<2>(p, l, MP + (t >> 4) * 128, t & 15, smem);
  }
}

constexpr int SM_GATE = 2 * 128 * LDT * 2 + 1024;
DEV void gemm_gates(f32x16 (&acc)[2][4], const u16* __restrict__ A, const u16* __restrict__ B0, const u16* __restrict__ B1,
                    unsigned char* smem) {
  u16* sA = (u16*)smem;
  u16* sB = sA + 128 * LDT;
  const int tid = TIDX(), lane = tid & 63, w = tid >> 6, wm = w >> 1, wn = w & 1;
  const int srow = tid >> 3, scol = (tid & 7) * 8;
  const u16* ap = A + (size_t)srow * 1024 + scol;
  const u16* b0p = B0 + (size_t)srow * 1024 + scol;
  const u16* b1p = B1 + (size_t)srow * 1024 + scol;
  bf16x8 ra[4], rb[8];
#pragma unroll
  for (int i = 0; i < 4; ++i) {
    ra[i] = *(const bf16x8*)(ap + (size_t)(32 * i) * 1024);
    rb[i] = *(const bf16x8*)(b0p + (size_t)(32 * i) * 1024);
    rb[4 + i] = *(const bf16x8*)(b1p + (size_t)(32 * i) * 1024);
  }
  const int fro = (lane & 31) * LDT + (lane >> 5) * 8;
#pragma unroll 1
  for (int kt = 0; kt < 16; ++kt) {
    __syncthreads();
#pragma unroll
    for (int i = 0; i < 4; ++i) *(bf16x8*)(sA + (srow + 32 * i) * LDT + scol) = ra[i];
#pragma unroll
    for (int i = 0; i < 8; ++i) *(bf16x8*)(sB + (srow + 32 * i) * LDT + scol) = rb[i];
    __syncthreads();
    if (kt + 1 < 16) {
      ap += 64;
      b0p += 64;
      b1p += 64;
#pragma unroll
      for (int i = 0; i < 4; ++i) {
        ra[i] = *(const bf16x8*)(ap + (size_t)(32 * i) * 1024);
        rb[i] = *(const bf16x8*)(b0p + (size_t)(32 * i) * 1024);
        rb[4 + i] = *(const bf16x8*)(b1p + (size_t)(32 * i) * 1024);
      }
    }
#pragma unroll 2
    for (int ks = 0; ks < 4; ++ks) {
      bf16x8 af[2], bfr[4];
#pragma unroll
      for (int i = 0; i < 2; ++i) af[i] = *(const bf16x8*)(sA + (wm * 64 + i * 32) * LDT + fro + ks * 16);
#pragma unroll
      for (int i = 0; i < 4; ++i)
        bfr[i] = *(const bf16x8*)(sB + ((i >> 1) * 128 + wn * 64 + (i & 1) * 32) * LDT + fro + ks * 16);
      __builtin_amdgcn_s_setprio(1);
#pragma unroll
      for (int mi = 0; mi < 2; ++mi)
#pragma unroll
        for (int ni = 0; ni < 4; ++ni)
          acc[mi][ni] = __builtin_amdgcn_mfma_f32_32x32x16_bf16(af[mi], bfr[ni], acc[mi][ni], 0, 0, 0);
      __builtin_amdgcn_s_setprio(0);
    }
  }
  __syncthreads();
}
DEV void phase_p5(const Params& p, int l, unsigned char* smem) {
  const u16* WL = (const u16*)(p.ws + OFF_W) + (size_t)l * W_LAYER;
  const u16* H = (const u16*)(p.ws + OFF_H);
  const u16* YB = (const u16*)(p.ws + OFF_R1);
  const u16* YA = (const u16*)(p.ws + OFF_R2);
  u16* MRG = (u16*)(p.ws + OFF_R3);
  u16* sC = (u16*)smem;
  const int ntiles = 516 * 8;
  for (int t = vbid(); t < ntiles; t += gridDim.x) {
    const int mt = t >> 3, nt = t & 7;
    unsigned ga[2][2][8];
    unsigned* sG = (unsigned*)(smem + SM_GATE);
    const int tid = TIDX();
    {
      f32x16 g[2][4];
#pragma unroll
      for (int a_ = 0; a_ < 2; ++a_)
#pragma unroll
        for (int b_ = 0; b_ < 4; ++b_)
#pragma unroll
          for (int r = 0; r < 16; ++r) g[a_][b_][r] = 0.f;
      gemm_gates(g, H + (size_t)mt * 128 * 1024, WL + WO_G + (size_t)(2048 + nt * 128) * 1024,
                 WL + WO_G + (size_t)(3072 + nt * 128) * 1024, smem);
#pragma unroll
      for (int a_ = 0; a_ < 2; ++a_)
#pragma unroll
        for (int b_ = 0; b_ < 2; ++b_) {
#pragma unroll
          for (int r = 0; r < 8; ++r)
            sG[((a_ * 2 + b_) * 8 + r) * 256 + tid] = pk2bf(sigmoidf_(g[a_][2 + b_][2 * r]), sigmoidf_(g[a_][2 + b_][2 * r + 1]));
          __builtin_amdgcn_sched_barrier(0);
        }
#pragma unroll
      for (int a_ = 0; a_ < 2; ++a_)
#pragma unroll
        for (int b_ = 0; b_ < 2; ++b_) {
#pragma unroll
          for (int r = 0; r < 8; ++r) ga[a_][b_][r] = pk2bf(sigmoidf_(g[a_][b_][2 * r]), sigmoidf_(g[a_][b_][2 * r + 1]));
          __builtin_amdgcn_sched_barrier(0);
        }
    }
    auto gate_a = [&](int mi, int ni, int r) __attribute__((always_inline)) -> float {
      const unsigned gq = ga[mi][ni][r >> 1];
      return __uint_as_float((r & 1) ? (gq & 0xffff0000u) : (gq << 16));
    };
    auto gate_b = [&](int mi, int ni, int r) __attribute__((always_inline)) -> float {
      const unsigned gq = sG[((mi * 2 + ni) * 8 + (r >> 1)) * 256 + tid];
      return __uint_as_float((r & 1) ? (gq & 0xffff0000u) : (gq << 16));
    };
    f32x16 acc[2][2];
    unsigned res[2][2][8];
    zero_acc(acc);
    gemm_main<0>(acc, YA + (size_t)mt * 128 * 1024, 1024, WL + WO_BA + (size_t)nt * 128 * 1024, 1024, 1024, smem);
#pragma unroll
    for (int mi = 0; mi < 2; ++mi)
#pragma unroll
      for (int ni = 0; ni < 2; ++ni)
#pragma unroll
        for (int r = 0; r < 8; ++r)
          res[mi][ni][r] = pk2bf(acc[mi][ni][2 * r] * gate_a(mi, ni, 2 * r), acc[mi][ni][2 * r + 1] * gate_a(mi, ni, 2 * r + 1));
    zero_acc(acc);
    gemm_main<0>(acc, YB + (size_t)mt * 128 * 1024, 1024, WL + WO_BB + (size_t)nt * 128 * 1024, 1024, 1024, smem);
    __syncthreads();
    acc_foreach([&](int mi, int ni, int r, int row, int col) __attribute__((always_inline)) {
      const unsigned rq = res[mi][ni][r >> 1];
      const float rv = __uint_as_float((r & 1) ? (rq & 0xffff0000u) : (rq << 16));
      sC[row * LDC + col] = f2bf(rv + acc[mi][ni][r] * gate_b(mi, ni, r));
    });
    tile_store(smem, MRG + (size_t)mt * 128 * 1024 + nt * 128, 1024);
  }
}

template <int MI>
DEV void p6_tile(const Params& p, int l, int m0, int nt, unsigned char* smem) {
  const u16* WL = (const u16*)(p.ws + OFF_W) + (size_t)l * W_LAYER;
  const u16* MRG = (const u16*)(p.ws + OFF_R3);
  u16* O = (u16*)(p.ws + OFF_R4);
  u16* sC = (u16*)smem;
  f32x16 acc[MI][2];
  zero_acc_t<MI>(acc);
  gemm_mm<MI>(acc, MRG + (size_t)m0 * 1024, 1024, WL + WO_OUT + (size_t)nt * 128 * 1024, 1024, 1024, smem);
  acc_foreach_t<MI>([&](int mi, int ni, int r, int row, int col) __attribute__((always_inline)) {
    sC[row * LDC + col] = f2bf(acc[mi][ni][r]);
  });
  tile_store_t<MI>(smem, O + (size_t)m0 * 1024 + nt * 128, 1024);
}
DEV void phase_p6(const Params& p, int l, unsigned char* smem) {
  const int nb = gridDim.x;
  int idx = vbid(), base = 0;
#pragma unroll 1
  for (; idx < base + 256 * 8; idx += nb) {
    const int t = idx - base;
    p6_tile<4>(p, l, (t >> 3) * 256, t & 7, smem);
  }
  base += 256 * 8;
#pragma unroll 1
  for (; idx < base + 4 * 8; idx += nb) {
    const int t = idx - base;
    p6_tile<2>(p, l, MP + (t >> 3) * 128, t & 7, smem);
  }
}

constexpr int SM_TOTAL = SM_GATE + 32768;
__global__ void __launch_bounds__(NT, 2) mega(Params p) {
  __shared__ __attribute__((aligned(16))) unsigned char smem[SM_TOTAL];
  cg::grid_group grid = cg::this_grid();
  __shared__ uint4 xb_words;
  if (threadIdx.x == 0) xb_words = make_uint4(0u, 0u, 0u, 0u);
#define PH(call)                                             \
  {                                                          \
    Params q = p;                                            \
    asm volatile("" : "+s"(q.ws), "+s"(q.out));              \
    call;                                                    \
  }
  PH(phase_prep(q, smem));
  grid.sync();
  (void)xcd_barrier_post((unsigned*)(p.ws + OFF_BAR), (volatile LAS unsigned*)&xb_words);
#define XBAR() xcd_barrier((unsigned*)(p.ws + OFF_BAR), (volatile LAS unsigned*)&xb_words)
  PH(phase_norm0(q));
  XBAR();
#pragma unroll 1
  for (int l = 0; l < 2; ++l) {
    PH(phase_gemm1(q, l, smem));
    XBAR();
    PH(phase_p2(q, l, smem));
    XBAR();
    PH(phase_p3(q, l, smem));
    XBAR();
    PH(phase_p4(q, l, smem));
    XBAR();
    PH(phase_p5(q, l, smem));
    XBAR();
    PH(phase_p6(q, l, smem));
    XBAR();
    PH(phase_final(q, l));
    if (l == 0) XBAR();
  }
}

extern "C" void kernel_launch(void* const* d_in, const int* in_sizes, int n_in, void* d_out, int out_size, void* d_ws,
                              size_t ws_size, hipStream_t stream) {
  static int grid_blocks = 0;
  if (!grid_blocks) {
    int dev = 0, cus = 0, per_cu = 0;
    hipGetDevice(&dev);
    hipDeviceGetAttribute(&cus, hipDeviceAttributeMultiprocessorCount, dev);
    hipOccupancyMaxActiveBlocksPerMultiprocessor(&per_cu, mega, NT, 0);
    if (per_cu > 2) per_cu = 2;
    grid_blocks = cus * per_cu;
  }
  if (ws_size < WS_NEED) {
    fprintf(stderr, "workspace too small: %zu < %zu\n", ws_size, (size_t)WS_NEED);
    return;
  }
  Params p{};
  const float** pp = (const float**)&p;
  for (int i = 0; i < 28; ++i) pp[i] = (const float*)d_in[i];
  p.out = (float*)d_out;
  p.ws = (unsigned char*)d_ws;
  void* args[] = {&p};
  hipError_t e = hipLaunchCooperativeKernel((void*)mega, dim3(grid_blocks), dim3(NT), args, 0, stream);
  if (e != hipSuccess) fprintf(stderr, "cooperative launch failed: %s (grid %d)\n", hipGetErrorString(e), grid_blocks);
}
```

```cpp
#include <hip/hip_runtime.h>
#include <hip/hip_cooperative_groups.h>
#include <cstdio>
namespace cg = cooperative_groups;

typedef unsigned short u16;
typedef __attribute__((ext_vector_type(8))) short bf16x8;
typedef __attribute__((ext_vector_type(16))) float f32x16;

#define DEV __device__ __forceinline__
#define NT 256

constexpr int MP = 65536, MS = 512, MT = 66048;
constexpr int IN_DIM = 6208;
constexpr float EPS = 1e-6f;
constexpr float QSCALE = 0.07216878364870322f * 1.4426950408889634f;

constexpr size_t SZ_ACT = (size_t)MT * 1024 * 2;
constexpr size_t OFF_H = 0;
constexpr size_t OFF_R1 = OFF_H + SZ_ACT;
constexpr size_t OFF_R2 = OFF_R1 + SZ_ACT;
constexpr size_t OFF_R3 = OFF_R2 + SZ_ACT;
constexpr size_t OFF_R4 = OFF_R3 + (size_t)MP * 1536 * 2;
constexpr size_t OFF_KPE = OFF_R4 + SZ_ACT;
constexpr size_t OFF_VT = OFF_KPE + (size_t)MT * 64 * 2;
constexpr size_t OFF_SKV = OFF_VT + (size_t)16 * 1024 * 4096 * 2;
constexpr size_t OFF_SVT = OFF_SKV + (size_t)32 * 2112 * 320 * 2;
constexpr size_t OFF_QS = OFF_SVT + (size_t)32 * 256 * 2112 * 2;
constexpr size_t OFF_OLAT = OFF_QS + (size_t)MS * 2560 * 2;
constexpr size_t OFF_MOD = OFF_OLAT + (size_t)MS * 2048 * 2;
constexpr size_t OFF_ROPE = OFF_MOD + (size_t)2 * 48 * 3072 * 4;
constexpr size_t OFF_CNT = OFF_ROPE + (size_t)4096 * 32 * 2 * 4;
constexpr size_t OFF_W = OFF_CNT + 256;
constexpr size_t WO_W1 = 0;
constexpr size_t WO_G = WO_W1 + (size_t)2176 * 1024;
constexpr size_t WO_QP = WO_G + (size_t)4096 * 1024;
constexpr size_t WO_QS = WO_QP + (size_t)1536 * 768;
constexpr size_t WO_UK = WO_QS + (size_t)2560 * 768;
constexpr size_t WO_UVS = WO_UK + 262144;
constexpr size_t WO_UVP = WO_UVS + 262144;
constexpr size_t WO_BA = WO_UVP + 262144;
constexpr size_t WO_BB = WO_BA + 1048576;
constexpr size_t WO_OUT = WO_BB + 1048576;
constexpr size_t WO_LA = WO_OUT + 1048576;
constexpr size_t WO_LX = WO_LA + 131072;
constexpr size_t W_LAYER = WO_LX + 131072;
constexpr size_t OFF_BAR = OFF_W + 2 * W_LAYER * 2;
constexpr size_t WS_NEED = OFF_BAR + 16384;

constexpr size_t OUT_YP = 0;
constexpr size_t OUT_YS = 67108864;
constexpr size_t OUT_CKVP = 67633152;
constexpr size_t OUT_KPEP = 101187584;
constexpr size_t OUT_CONVP = 109576192;
constexpr size_t OUT_LRUP = 109674496;
constexpr size_t OUT_CKVS = 109707264;
constexpr size_t OUT_KPES = 109969408;
constexpr size_t OUT_CONVS = 110034944;
constexpr size_t OUT_LRUS = 110231552;

struct Params {
  const float *x_p, *x_s, *c_p, *c_s, *cache_ckv, *cache_kpe, *state_conv, *state_lru;
  const float *ada_w, *ada_b, *pre_norm, *post_norm, *w_in, *conv_w, *conv_b, *lru_wa, *lru_ba, *lru_wx, *lru_bx;
  const float *lru_lambda, *q_norm, *w_q_up, *kv_norm, *w_uk, *w_uv, *w_ba, *w_bb, *w_out;
  float* out;
  unsigned char* ws;
};

DEV int TIDX() {
  int t = threadIdx.x;
  asm volatile("" : "+v"(t));
  return t;
}
typedef __attribute__((ext_vector_type(2))) float f32x2_t;
typedef __attribute__((ext_vector_type(2))) __bf16 bf16x2_t;
DEV unsigned pk2bf(float a, float b) {
  f32x2_t v = {a, b};
  bf16x2_t r = __builtin_convertvector(v, bf16x2_t);
  return __builtin_bit_cast(unsigned, r);
}
DEV u16 f2bf(float f) { return (u16)(pk2bf(f, 0.f) & 0xffffu); }
DEV float bf2f(u16 h) { return __uint_as_float(((unsigned)h) << 16); }
DEV float sigmoidf_(float x) { return 1.0f / (1.0f + __expf(-x)); }
DEV float siluf_(float x) { return x / (1.0f + __expf(-x)); }
DEV float wave_sum(float v) {
#pragma unroll
  for (int o = 32; o > 0; o >>= 1) v += __shfl_xor(v, o, 64);
  return v;
}
DEV int vbid() {
  const int b = blockIdx.x, n = gridDim.x;
  return ((n & 7) == 0) ? (b & 7) * (n >> 3) + (b >> 3) : b;
}
DEV int mod_row(int m) { return m < MP ? (m >> 12) : 16 + ((m - MP) >> 4); }
DEV int pos_of(int m) { return m < MP ? (m & 4095) : 2048 + ((m - MP) & 15); }

constexpr int LDT = 72;
#ifndef P5_DEPTH
#define P5_DEPTH 1
#endif
template <int SS, int DEPTH = 1>
DEV void gemm_main(f32x16 (&acc)[2][2], const u16* __restrict__ A, int lda, const u16* __restrict__ B, int ldb,
                   int K, unsigned char* smem) {
  u16* sA = (u16*)smem;
  u16* sB = sA + 128 * LDT;
  float* ss = (float*)(sB + 128 * LDT);
  const int tid = TIDX(), lane = tid & 63, w = tid >> 6, wm = w >> 1, wn = w & 1;
  const int srow = tid >> 3, scol = (tid & 7) * 8;
  const u16* ap = A + (size_t)srow * lda + scol;
  const u16* bp = B + (size_t)srow * ldb + scol;
  bf16x8 ra[DEPTH][4], rb[DEPTH][4];
  float ssq[4] = {0.f, 0.f, 0.f, 0.f};
  const int nk = K >> 6;
#pragma unroll
  for (int d = 0; d < DEPTH; ++d)
#pragma unroll
    for (int i = 0; i < 4; ++i) {
      ra[d][i] = *(const bf16x8*)(ap + d * 64 + (size_t)(32 * i) * lda);
      rb[d][i] = *(const bf16x8*)(bp + d * 64 + (size_t)(32 * i) * ldb);
    }
  ap += DEPTH * 64;
  bp += DEPTH * 64;
  const int fro = (lane & 31) * LDT + (lane >> 5) * 8;
#pragma unroll 1
  for (int kt = 0; kt < nk; kt += DEPTH) {
#pragma unroll
    for (int d = 0; d < DEPTH; ++d) {
      __syncthreads();
#pragma unroll
      for (int i = 0; i < 4; ++i) {
        *(bf16x8*)(sA + (srow + 32 * i) * LDT + scol) = ra[d][i];
        *(bf16x8*)(sB + (srow + 32 * i) * LDT + scol) = rb[d][i];
        if (SS) {
          bf16x8 v = (SS == 1) ? ra[d][i] : rb[d][i];
#pragma unroll
          for (int j = 0; j < 8; ++j) {
            float f = bf2f((u16)v[j]);
            ssq[i] += f * f;
          }
        }
      }
      __syncthreads();
      if (kt + d + DEPTH < nk) {
#pragma unroll
        for (int i = 0; i < 4; ++i) {
          ra[d][i] = *(const bf16x8*)(ap + (size_t)(32 * i) * lda);
          rb[d][i] = *(const bf16x8*)(bp + (size_t)(32 * i) * ldb);
        }
        ap += 64;
        bp += 64;
      }
#pragma unroll
      for (int ks = 0; ks < 4; ++ks) {
        bf16x8 af[2], bfr[2];
#pragma unroll
        for (int i = 0; i < 2; ++i) {
          af[i] = *(const bf16x8*)(sA + (wm * 64 + i * 32) * LDT + fro + ks * 16);
          bfr[i] = *(const bf16x8*)(sB + (wn * 64 + i * 32) * LDT + fro + ks * 16);
        }
        __builtin_amdgcn_s_setprio(1);
#pragma unroll
        for (int mi = 0; mi < 2; ++mi)
#pragma unroll
          for (int ni = 0; ni < 2; ++ni)
            acc[mi][ni] = __builtin_amdgcn_mfma_f32_32x32x16_bf16(af[mi], bfr[ni], acc[mi][ni], 0, 0, 0);
        __builtin_amdgcn_s_setprio(0);
      }
    }
  }
  if (SS) {
#pragma unroll
    for (int i = 0; i < 4; ++i) {
      float v = ssq[i];
      v += __shfl_xor(v, 1, 64);
      v += __shfl_xor(v, 2, 64);
      v += __shfl_xor(v, 4, 64);
      if ((tid & 7) == 0) ss[srow + 32 * i] = v;
    }
    __syncthreads();
  }
}
DEV void zero_acc(f32x16 (&acc)[2][2]) {
#pragma unroll
  for (int a = 0; a < 2; ++a)
#pragma unroll
    for (int b = 0; b < 2; ++b)
#pragma unroll
      for (int r = 0; r < 16; ++r) acc[a][b][r] = 0.f;
}
DEV float* gemm_ss(unsigned char* smem) { return (float*)(smem + 2 * 128 * LDT * 2); }

template <class F>
DEV void acc_foreach(F f) {
  const int tid_ = TIDX();
  const int lane = tid_ & 63, w = tid_ >> 6;
#pragma unroll
  for (int mi = 0; mi < 2; ++mi)
#pragma unroll
    for (int ni = 0; ni < 2; ++ni)
#pragma unroll
      for (int r = 0; r < 16; ++r)
        f(mi, ni, r, (w >> 1) * 64 + mi * 32 + (r & 3) + 8 * (r >> 2) + 4 * (lane >> 5), (w & 1) * 64 + ni * 32 + (lane & 31));
}
constexpr int LDC = 136;
DEV void tile_store(unsigned char* smem, u16* dst, size_t ldd) {
  const u16* sC = (const u16*)smem;
  __syncthreads();
  const int tid_ = TIDX();
#pragma unroll
  for (int i = 0; i < 8; ++i) {
    const int c = tid_ + 256 * i, row = c >> 4, cc = (c & 15) * 8;
    *(bf16x8*)(dst + (size_t)row * ldd + cc) = *(const bf16x8*)(sC + row * LDC + cc);
  }
}


template <int MI>
DEV void gemm_mm(f32x16 (&acc)[MI][2], const u16* __restrict__ A, int lda, const u16* __restrict__ B, int ldb, int K,
                 unsigned char* smem) {
  constexpr int BM = MI * 64;
  u16* sA = (u16*)smem;
  u16* sB = sA + BM * LDT;
  const int tid = TIDX(), lane = tid & 63, w = tid >> 6, wm = w >> 1, wn = w & 1;
  const int srow = tid >> 3, scol = (tid & 7) * 8;
  const u16* ap = A + (size_t)srow * lda + scol;
  const u16* bp = B + (size_t)srow * ldb + scol;
  bf16x8 ra[MI * 2], rb[4];
#pragma unroll
  for (int i = 0; i < MI * 2; ++i) ra[i] = *(const bf16x8*)(ap + (size_t)(32 * i) * lda);
#pragma unroll
  for (int i = 0; i < 4; ++i) rb[i] = *(const bf16x8*)(bp + (size_t)(32 * i) * ldb);
  const int nk = K >> 6;
  const int fro = (lane & 31) * LDT + (lane >> 5) * 8;
#pragma unroll 1
  for (int kt = 0; kt < nk; ++kt) {
    __syncthreads();
#pragma unroll
    for (int i = 0; i < MI * 2; ++i) *(bf16x8*)(sA + (srow + 32 * i) * LDT + scol) = ra[i];
#pragma unroll
    for (int i = 0; i < 4; ++i) *(bf16x8*)(sB + (srow + 32 * i) * LDT + scol) = rb[i];
    __syncthreads();
    if (kt + 1 < nk) {
      ap += 64;
      bp += 64;
#pragma unroll
      for (int i = 0; i < MI * 2; ++i) ra[i] = *(const bf16x8*)(ap + (size_t)(32 * i) * lda);
#pragma unroll
      for (int i = 0; i < 4; ++i) rb[i] = *(const bf16x8*)(bp + (size_t)(32 * i) * ldb);
    }
#pragma unroll
    for (int ks = 0; ks < 4; ++ks) {
      bf16x8 af[MI], bfr[2];
#pragma unroll
      for (int i = 0; i < MI; ++i) af[i] = *(const bf16x8*)(sA + (wm * (MI * 32) + i * 32) * LDT + fro + ks * 16);
#pragma unroll
      for (int i = 0; i < 2; ++i) bfr[i] = *(const bf16x8*)(sB + (wn * 64 + i * 32) * LDT + fro + ks * 16);
      __builtin_amdgcn_s_setprio(1);
#pragma unroll
      for (int mi = 0; mi < MI; ++mi)
#pragma unroll
        for (int ni = 0; ni < 2; ++ni)
          acc[mi][ni] = __builtin_amdgcn_mfma_f32_32x32x16_bf16(af[mi], bfr[ni], acc[mi][ni], 0, 0, 0);
      __builtin_amdgcn_s_setprio(0);
    }
  }
  __syncthreads();
}
template <int MI>
DEV void zero_acc_t(f32x16 (&acc)[MI][2]) {
#pragma unroll
  for (int a = 0; a < MI; ++a)
#pragma unroll
    for (int b = 0; b < 2; ++b)
#pragma unroll
      for (int r = 0; r < 16; ++r) acc[a][b][r] = 0.f;
}
template <int MI, class F>
DEV void acc_foreach_t(F f) {
  const int tid_ = TIDX();
  const int lane = tid_ & 63, w = tid_ >> 6;
#pragma unroll
  for (int mi = 0; mi < MI; ++mi)
#pragma unroll
    for (int ni = 0; ni < 2; ++ni)
#pragma unroll
      for (int r = 0; r < 16; ++r)
        f(mi, ni, r, (w >> 1) * (MI * 32) + mi * 32 + (r & 3) + 8 * (r >> 2) + 4 * (lane >> 5), (w & 1) * 64 + ni * 32 + (lane & 31));
}
template <int MI>
DEV void tile_load_t(unsigned char* smem, const u16* src, size_t lds_) {
  u16* sC = (u16*)smem;
  const int tid_ = TIDX();
#pragma unroll
  for (int i = 0; i < MI * 4; ++i) {
    const int c = tid_ + 256 * i, row = c >> 4, cc = (c & 15) * 8;
    *(bf16x8*)(sC + row * LDC + cc) = *(const bf16x8*)(src + (size_t)row * lds_ + cc);
  }
  __syncthreads();
}
template <int MI>
DEV void tile_store_t(unsigned char* smem, u16* dst, size_t ldd) {
  const u16* sC = (const u16*)smem;
  __syncthreads();
  const int tid_ = TIDX();
#pragma unroll
  for (int i = 0; i < MI * 4; ++i) {
    const int c = tid_ + 256 * i, row = c >> 4, cc = (c & 15) * 8;
    *(bf16x8*)(dst + (size_t)row * ldd + cc) = *(const bf16x8*)(sC + row * LDC + cc);
  }
}

#define XB_TMO      128
#define XB_XCNT(j)  (256  + 64 * (j))
#define XB_XSUB(j)  (1280 + 64 * (j))
#define XB_XGEN(j)  (2304 + 64 * (j))
#define XB_TOP      3328
#define XB_TOPGEN   3392
#define XCD_BAR_WORDS 3456
#define XB_SPIN_CAP (1u << 20)
#define LAS __attribute__((address_space(3)))
DEV unsigned xb_ld(unsigned* p) { return __hip_atomic_load(p, __ATOMIC_RELAXED, __HIP_MEMORY_SCOPE_AGENT); }
DEV unsigned xb_add(unsigned* p, unsigned v) { return __hip_atomic_fetch_add(p, v, __ATOMIC_RELAXED, __HIP_MEMORY_SCOPE_AGENT); }
DEV unsigned xb_xcc_id() { return (unsigned)__builtin_amdgcn_s_getreg((3 << 11) | 20) & 0xFu; }
#define XB_SPIN(cond, bar) do { unsigned _sp = 0; while (cond) { __builtin_amdgcn_s_sleep(1); \
    if ((++_sp & 255u) == 0u) { if (xb_ld(&(bar)[XB_TMO])) break; if (_sp > XB_SPIN_CAP) { atomicAdd(&(bar)[XB_TMO], 1u); break; } } } } while (0)
struct XcdBarrier {
  unsigned* bar;
  unsigned x;
  volatile LAS unsigned* st;
};
DEV XcdBarrier xcd_barrier_post(unsigned* bar, volatile LAS unsigned* st) {
  XcdBarrier b;
  b.bar = bar;
  b.x = xb_xcc_id();
  b.st = st;
  if (threadIdx.x == 0) (void)xb_add(&bar[XB_XCNT(b.x)], 1u);
  return b;
}
DEV void xcd_barrier_complete(unsigned* bar, unsigned x, unsigned& nloc, unsigned& nx) {
  const unsigned G = gridDim.x * gridDim.y * gridDim.z;
  unsigned sum, cnt, mine, sp = 0u;
  for (;;) {
    sum = 0u; cnt = 0u; mine = 0u;
#pragma unroll
    for (unsigned j = 0; j < 16; ++j) {
      const unsigned c = xb_ld(&bar[XB_XCNT(j)]);
      sum += c;
      cnt += (c > 0u) ? 1u : 0u;
      mine = (j == x) ? c : mine;
    }
    if (sum == G) break;
    __builtin_amdgcn_s_sleep(1);
    if ((++sp & 255u) == 0u) {
      if (xb_ld(&bar[XB_TMO])) break;
      if (sp > XB_SPIN_CAP) { atomicAdd(&bar[XB_TMO], 1u); break; }
    }
  }
  nloc = mine > 0u ? mine : 1u;
  nx = cnt > 0u ? cnt : 1u;
}
DEV void xcd_barrier(unsigned* bar_, volatile LAS unsigned* st_) {
  asm volatile("s_waitcnt vmcnt(0)" ::: "memory");
  __syncthreads();
  if (threadIdx.x == 0) {
    XcdBarrier b;
    b.bar = bar_;
    b.x = xb_xcc_id();
    b.st = st_;
    unsigned* bar = b.bar;
    __builtin_amdgcn_s_waitcnt(0);
    unsigned nloc = b.st[0], nx = b.st[1];
    if (nloc == 0u) {
      xcd_barrier_complete(bar, b.x, nloc, nx);
      b.st[0] = nloc;
      b.st[1] = nx;
    }
    const unsigned old = xb_add(&bar[XB_XSUB(b.x)], 1u);
    const unsigned gen = old / nloc;
    if (old + 1u == (gen + 1u) * nloc) {
      __builtin_amdgcn_fence(__ATOMIC_RELEASE, "agent");
      asm volatile("s_waitcnt vmcnt(0)" ::: "memory");
      const unsigned og = xb_add(&bar[XB_TOP], 1u);
      const unsigned tg = og / nx;
      if (og + 1u == (tg + 1u) * nx) xb_add(&bar[XB_TOPGEN], 1u);
      else XB_SPIN(xb_ld(&bar[XB_TOPGEN]) == tg, bar);
      __builtin_amdgcn_fence(__ATOMIC_ACQUIRE, "agent");
      xb_add(&bar[XB_XGEN(b.x)], 1u);
      asm volatile("s_waitcnt vmcnt(0)" ::: "memory");
    } else {
      XB_SPIN(xb_ld(&bar[XB_XGEN(b.x)]) == gen, bar);
      __builtin_amdgcn_fence(__ATOMIC_ACQUIRE, "agent");
      asm volatile("s_waitcnt vmcnt(0)" ::: "memory");
    }
  }
  __syncthreads();
}

DEV void transpose_tile(const float* __restrict__ src, int lds_, u16* __restrict__ dst, int ldd, const float* scale,
                        int k0, int n0, unsigned char* smem) {
  float* s = (float*)smem;
  const int tid = TIDX();
  __syncthreads();
  {
    const int n = tid & 63, kq = tid >> 6;
#pragma unroll 4
    for (int i = 0; i < 16; ++i) {
      int kk = kq * 16 + i;
      s[kk * 65 + n] = src[(size_t)(k0 + kk) * lds_ + n0 + n];
    }
  }
  __syncthreads();
  {
    const int k = tid & 63, nq = tid >> 6;
    const float sc = scale ? scale[k0 + k] : 1.0f;
#pragma unroll 4
    for (int i = 0; i < 16; ++i) {
      int n = nq * 16 + i;
      dst[(size_t)(n0 + n) * ldd + k0 + k] = f2bf(s[k * 65 + n] * sc);
    }
  }
}

DEV void qlat_tile(const float* __restrict__ wq, const float* __restrict__ wuk, const float* __restrict__ g,
                   u16* __restrict__ dst, int h, int r0, int k0, unsigned char* smem) {
  float* sQ = (float*)smem;
  float* sU = sQ + 64 * 65;
  const int tid = TIDX();
  float acc[16];
#pragma unroll
  for (int i = 0; i < 16; ++i) acc[i] = 0.f;
  for (int nh = 0; nh < 2; ++nh) {
    __syncthreads();
    {
      const int n = tid & 63, q = tid >> 6;
      for (int i = 0; i < 16; ++i) {
        int rr = q * 16 + i;
        sQ[rr * 65 + n] = wq[(size_t)(k0 + rr) * 1536 + h * 192 + nh * 64 + n];
        sU[rr * 65 + n] = wuk[(size_t)(r0 + rr) * 1024 + h * 128 + nh * 64 + n];
      }
    }
    __syncthreads();
    const int k = tid & 63, rq = tid >> 6;
    for (int n = 0; n < 64; ++n) {
      float qv = sQ[k * 65 + n];
#pragma unroll
      for (int i = 0; i < 16; ++i) acc[i] += qv * sU[(rq * 16 + i) * 65 + n];
    }
  }
  const int k = tid & 63, rq = tid >> 6;
  const float sc = g[k0 + k];
#pragma unroll
  for (int i = 0; i < 16; ++i) dst[(size_t)(h * 320 + r0 + rq * 16 + i) * 768 + k0 + k] = f2bf(acc[i] * sc);
}

DEV void mod_item(const Params& p, int item, unsigned char* smem) {
  const int l = item / 48, cg_ = item % 48;
  float* sc = (float*)smem;
  float* red = sc + 48 * 256;
  (void)red;
  const int tid = TIDX(), col = tid & 63, kq = tid >> 6;
  const float* W = p.ada_w + (size_t)l * 1024 * 3072 + cg_ * 64 + col;
  float acc[48];
#pragma unroll
  for (int b = 0; b < 48; ++b) acc[b] = 0.f;
  for (int kc = 0; kc < 4; ++kc) {
    __syncthreads();
    for (int e = tid; e < 48 * 256; e += NT) {
      int b = e >> 8, k = e & 255;
      float c = b < 16 ? p.c_p[b * 1024 + kc * 256 + k] : p.c_s[(b - 16) * 1024 + kc * 256 + k];
      sc[e] = siluf_(c);
    }
    __syncthreads();
#pragma unroll 1
    for (int i0 = 0; i0 < 64; i0 += 8) {
      float wv[8];
#pragma unroll
      for (int i = 0; i < 8; ++i) wv[i] = W[(size_t)(kc * 256 + kq * 64 + i0 + i) * 3072];
#pragma unroll
      for (int i = 0; i < 8; ++i) {
        const int k = kq * 64 + i0 + i;
#pragma unroll
        for (int b = 0; b < 48; ++b) acc[b] += sc[b * 256 + k] * wv[i];
      }
    }
  }
  __syncthreads();
#pragma unroll
  for (int b = 0; b < 48; ++b) sc[(kq * 48 + b) * 64 + col] = acc[b];
  __syncthreads();
  float* MOD = (float*)(p.ws + OFF_MOD);
  for (int e = tid; e < 48 * 64; e += NT) {
    int b = e >> 6, c = e & 63;
    float v = sc[(0 * 48 + b) * 64 + c] + sc[(1 * 48 + b) * 64 + c] + sc[(2 * 48 + b) * 64 + c] + sc[(3 * 48 + b) * 64 + c];
    int gc = cg_ * 64 + c;
    MOD[((size_t)l * 48 + b) * 3072 + gc] = v + p.ada_b[l * 3072 + gc];
  }
}

DEV void phase_prep(const Params& p, unsigned char* smem) {
  const int tid = TIDX();
  if (blockIdx.x == 0) {
    if (tid < 64) ((unsigned*)(p.ws + OFF_CNT))[tid] = 0u;
    for (int e = tid; e < XCD_BAR_WORDS; e += NT) ((unsigned*)(p.ws + OFF_BAR))[e] = 0u;
  }
  const bool split = gridDim.x >= 192;
  if (split && blockIdx.x < 96) {
    mod_item(p, blockIdx.x, smem);
    return;
  }
  const int nb = split ? (int)gridDim.x - 96 : (int)gridDim.x;
  int idx = split ? (int)blockIdx.x - 96 : (int)blockIdx.x, base = 0;
  if (!split) {
    for (; idx < base + 96; idx += nb) mod_item(p, idx - base, smem);
    base += 96;
  }
  for (int l = 0; l < 2; ++l) {
    u16* WL = (u16*)(p.ws + OFF_W) + (size_t)l * W_LAYER;
    const float* win = p.w_in + (size_t)l * 1024 * IN_DIM;
#define TJOB(SRC, LDS_, KK, NN, DST, LDD, SCALE)                                     \
  {                                                                                  \
    const int nkt = (KK) / 64, ntl = nkt * ((NN) / 64);                              \
    for (; idx < base + ntl; idx += nb) {                                            \
      int t = idx - base;                                                            \
      transpose_tile((SRC), (LDS_), (DST), (LDD), (SCALE), (t % nkt) * 64, (t / nkt) * 64, smem); \
    }                                                                                \
    base += ntl;                                                                     \
  }
    TJOB(win, IN_DIM, 1024, 1024, WL + WO_W1, 1024, nullptr);
    TJOB(win + 2048, IN_DIM, 1024, 1088, WL + WO_W1 + (size_t)1024 * 1024, 1024, nullptr);
    TJOB(win + 1024, IN_DIM, 1024, 1024, WL + WO_G, 1024, nullptr);
    TJOB(win + 3136, IN_DIM, 1024, 3072, WL + WO_G + (size_t)1024 * 1024, 1024, nullptr);
    TJOB(p.w_q_up + (size_t)l * 768 * 1536, 1536, 768, 1536, WL + WO_QP, 768, p.q_norm + l * 768);
    for (int h = 0; h < 8; ++h)
      TJOB(p.w_q_up + (size_t)l * 768 * 1536 + h * 192 + 128, 1536, 768, 64, WL + WO_QS + (size_t)(h * 320 + 256) * 768, 768,
           p.q_norm + l * 768);
    TJOB(p.w_uk + (size_t)l * 262144, 1024, 256, 1024, WL + WO_UK, 256, p.kv_norm + l * 256);
    TJOB(p.w_uv + (size_t)l * 262144, 1024, 256, 1024, WL + WO_UVS, 256, p.kv_norm + l * 256);
    TJOB(p.w_uv + (size_t)l * 262144, 1024, 256, 1024, WL + WO_UVP, 256, nullptr);
    TJOB(p.w_ba + (size_t)l * 1048576, 1024, 1024, 1024, WL + WO_BA, 1024, nullptr);
    TJOB(p.w_bb + (size_t)l * 1048576, 1024, 1024, 1024, WL + WO_BB, 1024, nullptr);
    TJOB(p.w_out + (size_t)l * 1048576, 1024, 1024, 1024, WL + WO_OUT, 1024, nullptr);
    for (int b8 = 0; b8 < 8; ++b8) {
      TJOB(p.lru_wa + (size_t)l * 131072 + b8 * 16384, 128, 128, 128, WL + WO_LA + b8 * 16384, 128, nullptr);
      TJOB(p.lru_wx + (size_t)l * 131072 + b8 * 16384, 128, 128, 128, WL + WO_LX + b8 * 16384, 128, nullptr);
    }
    for (; idx < base + 384; idx += nb) {
      int t = idx - base;
      int h = t / 48, rt = (t % 48) / 12, kt = t % 12;
      qlat_tile(p.w_q_up + (size_t)l * 768 * 1536, p.w_uk + (size_t)l * 262144, p.q_norm + l * 768, WL + WO_QS, h,
                rt * 64, kt * 64, smem);
    }
    base += 384;
    for (; idx < base + 16; idx += nb) {
      int t = idx - base;
      u16* d = WL + WO_W1 + (size_t)2112 * 1024 + t * 4096;
      for (int e = tid; e < 4096; e += NT) d[e] = 0;
    }
    base += 16;
  }
  float* ROPE = (float*)(p.ws + OFF_ROPE);
  for (; idx < base + 512; idx += nb) {
    int e = (idx - base) * 256 + tid;
    int pos = e >> 5, j = e & 31;
    float inv = exp2f(-(float)j * (13.287712379549449f / 32.0f));
    float ang = (float)pos * inv;
    ROPE[2 * e] = cosf(ang);
    ROPE[2 * e + 1] = sinf(ang);
  }
  base += 512;
}

DEV void norm_row(const Params& p, int l, int m, const float (&xv)[16], int lane) {
  float ss = 0.f;
#pragma unroll
  for (int i = 0; i < 16; ++i) ss += xv[i] * xv[i];
  ss = wave_sum(ss);
  const float rstd = rsqrtf(ss * (1.0f / 1024.0f) + EPS);
  const float* MOD = (const float*)(p.ws + OFF_MOD) + ((size_t)l * 48 + mod_row(m)) * 3072;
  u16* H = (u16*)(p.ws + OFF_H) + (size_t)m * 1024;
#pragma unroll
  for (int i = 0; i < 4; ++i) {
    int c = i * 256 + lane * 4;
    float4 g = *(const float4*)(p.pre_norm + l * 1024 + c);
    float4 sh = *(const float4*)(MOD + c);
    float4 sc = *(const float4*)(MOD + 1024 + c);
    ushort4 o;
    o.x = f2bf(xv[i * 4 + 0] * rstd * g.x * (1.f + sc.x) + sh.x);
    o.y = f2bf(xv[i * 4 + 1] * rstd * g.y * (1.f + sc.y) + sh.y);
    o.z = f2bf(xv[i * 4 + 2] * rstd * g.z * (1.f + sc.z) + sh.z);
    o.w = f2bf(xv[i * 4 + 3] * rstd * g.w * (1.f + sc.w) + sh.w);
    *(ushort4*)(H + c) = o;
  }
}

DEV void phase_norm0(const Params& p) {
  const int tid_ = TIDX();
  const int lane = tid_ & 63, wv = tid_ >> 6;
  for (int m = blockIdx.x * 4 + wv; m < MT; m += gridDim.x * 4) {
    const float* x = m < MP ? p.x_p + (size_t)m * 1024 : p.x_s + (size_t)(m - MP) * 1024;
    float xv[16];
#pragma unroll
    for (int i = 0; i < 4; ++i) {
      float4 v = *(const float4*)(x + i * 256 + lane * 4);
      xv[i * 4] = v.x; xv[i * 4 + 1] = v.y; xv[i * 4 + 2] = v.z; xv[i * 4 + 3] = v.w;
    }
    norm_row(p, 0, m, xv, lane);
  }
}

DEV void phase_final(const Params& p, int l) {
  const int tid_ = TIDX();
  const int lane = tid_ & 63, wv = tid_ >> 6;
  const u16* O = (const u16*)(p.ws + OFF_R4);
  for (int m = blockIdx.x * 4 + wv; m < MT; m += gridDim.x * 4) {
    float* y = m < MP ? p.out + OUT_YP + (size_t)m * 1024 : p.out + OUT_YS + (size_t)(m - MP) * 1024;
    const float* x = (l == 0) ? (m < MP ? p.x_p + (size_t)m * 1024 : p.x_s + (size_t)(m - MP) * 1024) : y;
    float xv[16], ov[16];
    float ss = 0.f;
#pragma unroll
    for (int i = 0; i < 4; ++i) {
      int c = i * 256 + lane * 4;
      float4 v = *(const float4*)(x + c);
      xv[i * 4] = v.x; xv[i * 4 + 1] = v.y; xv[i * 4 + 2] = v.z; xv[i * 4 + 3] = v.w;
      ushort4 o = *(const ushort4*)(O + (size_t)m * 1024 + c);
      ov[i * 4] = bf2f(o.x); ov[i * 4 + 1] = bf2f(o.y); ov[i * 4 + 2] = bf2f(o.z); ov[i * 4 + 3] = bf2f(o.w);
    }
#pragma unroll
    for (int i = 0; i < 16; ++i) ss += ov[i] * ov[i];
    ss = wave_sum(ss);
    const float rstd = rsqrtf(ss * (1.0f / 1024.0f) + EPS);
    const float* MOD = (const float*)(p.ws + OFF_MOD) + ((size_t)l * 48 + mod_row(m)) * 3072 + 2048;
#pragma unroll
    for (int i = 0; i < 4; ++i) {
      int c = i * 256 + lane * 4;
      float4 g = *(const float4*)(p.post_norm + l * 1024 + c);
      float4 gt = *(const float4*)(MOD + c);
      xv[i * 4 + 0] += gt.x * ov[i * 4 + 0] * rstd * g.x;
      xv[i * 4 + 1] += gt.y * ov[i * 4 + 1] * rstd * g.y;
      xv[i * 4 + 2] += gt.z * ov[i * 4 + 2] * rstd * g.z;
      xv[i * 4 + 3] += gt.w * ov[i * 4 + 3] * rstd * g.w;
      *(float4*)(y + c) = make_float4(xv[i * 4], xv[i * 4 + 1], xv[i * 4 + 2], xv[i * 4 + 3]);
    }
    if (l == 0) norm_row(p, 1, m, xv, lane);
  }
}

template <int MI>
DEV void gemm1_tile(const Params& p, int l, int m0, int nt, unsigned char* smem) {
  constexpr int BM = MI * 64;
  const u16* H = (const u16*)(p.ws + OFF_H);
  const u16* W1 = (const u16*)(p.ws + OFF_W) + (size_t)l * W_LAYER + WO_W1;
  u16* XA = (u16*)(p.ws + OFF_R1);
  u16* CQ = (u16*)(p.ws + OFF_R2);
  u16* CKVR = CQ + (size_t)MT * 768;
  u16* sC = (u16*)smem;
  f32x16 acc[MI][2];
  zero_acc_t<MI>(acc);
  gemm_mm<MI>(acc, H + (size_t)m0 * 1024, 1024, W1 + (size_t)nt * 128 * 1024, 1024, 1024, smem);
  if (nt < 14) {
    acc_foreach_t<MI>([&](int mi, int ni, int r, int row, int col) __attribute__((always_inline)) {
      sC[row * LDC + col] = f2bf(acc[mi][ni][r]);
    });
    if (nt < 8) tile_store_t<MI>(smem, XA + (size_t)m0 * 1024 + nt * 128, 1024);
    else tile_store_t<MI>(smem, CQ + (size_t)m0 * 768 + (nt - 8) * 128, 768);
    if (nt < 8 && (m0 >= MP || ((m0 + BM) & 4095) == 0)) {
      acc_foreach_t<MI>([&](int mi, int ni, int r, int row, int col) __attribute__((always_inline)) {
        const int m = m0 + row, n = nt * 128 + col;
        const float v = acc[mi][ni][r];
        if (m < MP) {
          int j = (m & 4095) - 4093;
          if (j >= 0) p.out[OUT_CONVP + ((size_t)(l * 16 + (m >> 12)) * 3 + j) * 1024 + n] = v;
        } else {
          int j = ((m - MP) & 15) - 13;
          if (j >= 0) p.out[OUT_CONVS + ((size_t)(l * 32 + ((m - MP) >> 4)) * 3 + j) * 1024 + n] = v;
        }
      });
    }
  } else if (nt < 16) {
    float* ob = m0 < MP ? p.out + OUT_CKVP + ((size_t)l * MP + m0) * 256 + (nt - 14) * 128
                        : p.out + OUT_CKVS + ((size_t)l * MS + (m0 - MP)) * 256 + (nt - 14) * 128;
    acc_foreach_t<MI>([&](int mi, int ni, int r, int row, int col) __attribute__((always_inline)) {
      const float v = acc[mi][ni][r];
      sC[row * LDC + col] = f2bf(v);
      ob[(size_t)row * 256 + col] = v;
    });
    tile_store_t<MI>(smem, CKVR + (size_t)m0 * 256 + (nt - 14) * 128, 256);
  } else {
    float* ob = m0 < MP ? p.out + OUT_KPEP + ((size_t)l * MP + m0) * 64 : p.out + OUT_KPES + ((size_t)l * MS + (m0 - MP)) * 64;
    acc_foreach_t<MI>([&](int mi, int ni, int r, int row, int col) __attribute__((always_inline)) {
      if (col < 64) ob[(size_t)row * 64 + col] = acc[mi][ni][r];
    });
  }
}
DEV void phase_gemm1(const Params& p, int l, unsigned char* smem) {
  const int nb = gridDim.x;
  int idx = vbid(), base = 0;
#pragma unroll 1
  for (; idx < base + 256 * 17; idx += nb) {
    const int t = idx - base;
    gemm1_tile<4>(p, l, (t / 17) * 256, t % 17, smem);
  }
  base += 256 * 17;
#pragma unroll 1
  for (; idx < base + 4 * 17; idx += nb) {
    const int t = idx - base;
    gemm1_tile<2>(p, l, MP + (t / 17) * 128, t % 17, smem);
  }
}

DEV void post1_rows(const Params& p, int l, int item) {
  const int tid_ = TIDX();
  const int lane = tid_ & 63, wv = tid_ >> 6;
  const float* ROPE = (const float*)(p.ws + OFF_ROPE);
  float4 v[2];
  float kx[2];
  float2 cs[2];
  float* ckvp[2];
  float* kpep[2];
#pragma unroll
  for (int u = 0; u < 2; ++u) {
    const int m = item * 8 + wv * 2 + u;
    ckvp[u] = m < MP ? p.out + OUT_CKVP + ((size_t)l * MP + m) * 256 : p.out + OUT_CKVS + ((size_t)l * MS + (m - MP)) * 256;
    kpep[u] = m < MP ? p.out + OUT_KPEP + ((size_t)l * MP + m) * 64 : p.out + OUT_KPES + ((size_t)l * MS + (m - MP)) * 64;
    v[u] = *(const float4*)(ckvp[u] + lane * 4);
    kx[u] = kpep[u][lane];
    cs[u] = *(const float2*)(ROPE + ((size_t)pos_of(m) * 32 + (lane & 31)) * 2);
  }
  const float4 g = *(const float4*)(p.kv_norm + l * 256 + lane * 4);
#pragma unroll
  for (int u = 0; u < 2; ++u) {
    const int m = item * 8 + wv * 2 + u;
    const float ss = wave_sum(v[u].x * v[u].x + v[u].y * v[u].y + v[u].z * v[u].z + v[u].w * v[u].w);
    const float rstd = rsqrtf(ss * (1.0f / 256.0f) + EPS);
    float4 o4 = v[u];
    o4.x *= rstd * g.x; o4.y *= rstd * g.y; o4.z *= rstd * g.z; o4.w *= rstd * g.w;
    *(float4*)(ckvp[u] + lane * 4) = o4;
    const float other = __shfl_xor(kx[u], 32, 64);
    const float c = cs[u].x, sn = cs[u].y;
    const float ro = (lane < 32) ? (kx[u] * c - other * sn) : (other * sn + kx[u] * c);
    kpep[u][lane] = ro;
    if (m < MP) {
      u16* KPE = (u16*)(p.ws + OFF_KPE) + (size_t)m * 64;
      KPE[lane] = f2bf(ro);
    } else {
      const int b = (m - MP) >> 4, t = (m - MP) & 15;
      u16* SKV = (u16*)(p.ws + OFF_SKV) + ((size_t)b * 2112 + 2048 + t) * 320;
      u16* SVT = (u16*)(p.ws + OFF_SVT) + (size_t)b * 256 * 2112 + 2048 + t;
      ushort4 o;
      o.x = f2bf(o4.x); o.y = f2bf(o4.y); o.z = f2bf(o4.z); o.w = f2bf(o4.w);
      *(ushort4*)(SKV + lane * 4) = o;
      SVT[(size_t)(lane * 4 + 0) * 2112] = o.x;
      SVT[(size_t)(lane * 4 + 1) * 2112] = o.y;
      SVT[(size_t)(lane * 4 + 2) * 2112] = o.z;
      SVT[(size_t)(lane * 4 + 3) * 2112] = o.w;
      SKV[256 + lane] = f2bf(ro);
    }
  }
}

DEV void cache_item(const Params& p, int l, int item, unsigned char* smem) {
  const int tid = TIDX();
  const int b = item / 33, kt = item % 33;
  u16* SKV = (u16*)(p.ws + OFF_SKV) + (size_t)b * 2112 * 320;
  u16* SVT = (u16*)(p.ws + OFF_SVT) + (size_t)b * 256 * 2112;
  if (kt == 32) {
    for (int e = tid; e < 48 * 320; e += NT) SKV[(size_t)2064 * 320 + e] = 0;
    for (int e = tid; e < 256 * 48; e += NT) SVT[(size_t)(e / 48) * 2112 + 2064 + (e % 48)] = 0;
    return;
  }
  float* s = (float*)smem;
  const float* src = p.cache_ckv + (((size_t)l * 32 + b) * 2048 + kt * 64) * 256;
  const float* srck = p.cache_kpe + (((size_t)l * 32 + b) * 2048 + kt * 64) * 64;
  for (int dh = 0; dh < 2; ++dh) {
    __syncthreads();
    for (int e = tid; e < 64 * 128; e += NT) {
      int key = e >> 7, d = e & 127;
      float v = src[(size_t)key * 256 + dh * 128 + d];
      s[key * 129 + d] = v;
      SKV[(size_t)(kt * 64 + key) * 320 + dh * 128 + d] = f2bf(v);
    }
    __syncthreads();
    const int k = tid & 63, dq = tid >> 6;
    for (int i = 0; i < 32; ++i) {
      int d = dq * 32 + i;
      SVT[(size_t)(dh * 128 + d) * 2112 + kt * 64 + k] = f2bf(s[k * 129 + d]);
    }
  }
  for (int e = tid; e < 64 * 64; e += NT) {
    int key = e >> 6, d = e & 63;
    SKV[(size_t)(kt * 64 + key) * 320 + 256 + d] = f2bf(srck[(size_t)key * 64 + d]);
  }
}

DEV void phase_p2(const Params& p, int l, unsigned char* smem) {
  const int tid = TIDX(), lane = tid & 63, w = tid >> 6;
  const int nb = gridDim.x;
  const u16* WL = (const u16*)(p.ws + OFF_W) + (size_t)l * W_LAYER;
  const u16* CQ = (const u16*)(p.ws + OFF_R2);
  const u16* CKVR = CQ + (size_t)MT * 768;
  u16* Q = (u16*)(p.ws + OFF_R3);
  u16* QS = (u16*)(p.ws + OFF_QS);
  u16* Kb = (u16*)(p.ws + OFF_R4);
  u16* VT = (u16*)(p.ws + OFF_VT);
  const float* ROPE = (const float*)(p.ws + OFF_ROPE);
  float* ss = gemm_ss(smem);
  int idx = vbid(), base = 0;
  const int nq = 512 * 12 + 4 * 20;
  for (; idx < base + nq; idx += nb) {
    int t = idx - base;
    int mt, nt;
    const u16* Wt;
    bool samp = t >= 512 * 12;
    if (!samp) { mt = t / 12; nt = t % 12; Wt = WL + WO_QP; }
    else { t -= 512 * 12; mt = 512 + t / 20; nt = t % 20; Wt = WL + WO_QS; }
    f32x16 acc[2][2];
    zero_acc(acc);
    gemm_main<1>(acc, CQ + (size_t)mt * 128 * 768, 768, Wt + (size_t)nt * 128 * 768, 768, 768, smem);
    const int g = nt * 2 + (w & 1);
    const bool rope = samp ? (g % 5 == 4) : (g % 3 == 2);
    u16* sC = (u16*)smem;
#pragma unroll
    for (int mi = 0; mi < 2; ++mi)
#pragma unroll
      for (int r = 0; r < 16; ++r) {
        const int row = (w >> 1) * 64 + mi * 32 + (r & 3) + 8 * (r >> 2) + 4 * (lane >> 5);
        const int m = mt * 128 + row;
        const float rs = rsqrtf(ss[row] * (1.0f / 768.0f) + EPS) * QSCALE;
        float v0 = acc[mi][0][r] * rs, v1 = acc[mi][1][r] * rs;
        if (rope) {
          const int pos = pos_of(m);
          const float c = ROPE[(pos * 32 + (lane & 31)) * 2], s = ROPE[(pos * 32 + (lane & 31)) * 2 + 1];
          const float a = v0 * c - v1 * s, b = v0 * s + v1 * c;
          v0 = a; v1 = b;
        }
        const int col = (w & 1) * 64 + (lane & 31);
        sC[row * LDC + col] = f2bf(v0);
        sC[row * LDC + col + 32] = f2bf(v1);
      }
    if (!samp) tile_store(smem, Q + (size_t)mt * 128 * 1536 + nt * 128, 1536);
    else tile_store(smem, QS + (size_t)(mt - 512) * 128 * 2560 + nt * 128, 2560);
  }
  base += nq;
  for (; idx < base + 4096; idx += nb) {
    int t = idx - base;
    int mt = t >> 3, nt = t & 7;
    f32x16 acc[2][2];
    zero_acc(acc);
    gemm_main<1, 2>(acc, CKVR + (size_t)mt * 128 * 256, 256, WL + WO_UK + (size_t)nt * 128 * 256, 256, 256, smem);
    {
      u16* sC = (u16*)smem;
      acc_foreach([&](int mi, int ni, int r, int row, int col) __attribute__((always_inline)) {
        const float rs = rsqrtf(ss[row] * (1.0f / 256.0f) + EPS);
        sC[row * LDC + col] = f2bf(acc[mi][ni][r] * rs);
      });
      tile_store(smem, Kb + (size_t)mt * 128 * 1024 + nt * 128, 1024);
    }
  }
  base += 4096;
  for (; idx < base + 4096; idx += nb) {
    int t = idx - base;
    int b = t >> 8, mt = (t >> 5) & 7, nt = t & 31;
    f32x16 acc[2][2];
    zero_acc(acc);
    gemm_main<2, 2>(acc, WL + WO_UVS + (size_t)mt * 128 * 256, 256, CKVR + ((size_t)b * 4096 + nt * 128) * 256, 256, 256, smem);
    {
      u16* sC = (u16*)smem;
      acc_foreach([&](int mi, int ni, int r, int row, int col) __attribute__((always_inline)) {
        const float rs = rsqrtf(ss[col] * (1.0f / 256.0f) + EPS);
        sC[row * LDC + col] = f2bf(acc[mi][ni][r] * rs);
      });
      tile_store(smem, VT + ((size_t)b * 1024 + mt * 128) * 4096 + nt * 128, 4096);
    }
  }
  base += 4096;
  for (; idx < base + MT / 8; idx += nb) post1_rows(p, l, idx - base);
  base += MT / 8;
  for (; idx < base + 32 * 33; idx += nb) cache_item(p, l, idx - base, smem);
  base += 32 * 33;
}

#ifndef ATT_PF
#define ATT_PF true
#endif
template <int DK, bool PF>
DEV void attn_item(const u16* __restrict__ qrow, const u16* __restrict__ ka, int ldka, const u16* __restrict__ kb, int ldkb,
                   const u16* __restrict__ vt, int ldvt, int ntiles, int my_tiles, int kvlen, u16* orow,
                   unsigned char* smem) {
  constexpr int DKA = DK - 64, KST = DK + 8, VST = 68;
  u16* sK = (u16*)smem;
  u16* sV = sK + 64 * KST;
  const int tid = TIDX(), lane = tid & 63, hh = lane >> 5, l31 = lane & 31;
  constexpr bool QREG = (DK <= 192);
  bf16x8 qf[DK / 16];
  if (QREG) {
#pragma unroll
    for (int ks = 0; ks < DK / 16; ++ks) qf[ks] = *(const bf16x8*)(qrow + ks * 16 + hh * 8);
  }
  f32x16 o[4];
#pragma unroll
  for (int d = 0; d < 4; ++d)
#pragma unroll
    for (int r = 0; r < 16; ++r) o[d][r] = 0.f;
  float mrun = -1e30f, lrun = 0.f;
  constexpr int CA = DKA / 32;
  bf16x8 rk[CA + 2], rv[4];
  const int skey = tid >> 2, sq = tid & 3;
  const u16* gka = ka + (size_t)skey * ldka + sq * CA * 8;
  const u16* gkb = kb + (size_t)skey * ldkb + sq * 16;
  const u16* gv = vt + (size_t)(tid >> 1) * ldvt + (tid & 1) * 32;
  u16* lka = sK + skey * KST + sq * CA * 8;
  u16* lkb = sK + skey * KST + DKA + sq * 16;
  u16* lv = sV + (tid >> 1) * VST + (tid & 1) * 32;
  auto load_tile = [&](int t) __attribute__((always_inline)) {
    const size_t ko = (size_t)t * 64;
#pragma unroll
    for (int i = 0; i < CA; ++i) rk[i] = *(const bf16x8*)(gka + ko * ldka + i * 8);
#pragma unroll
    for (int i = 0; i < 2; ++i) rk[CA + i] = *(const bf16x8*)(gkb + ko * ldkb + i * 8);
#pragma unroll
    for (int i = 0; i < 4; ++i) rv[i] = *(const bf16x8*)(gv + ko + i * 8);
  };
  auto store_tile = [&]() __attribute__((always_inline)) {
#pragma unroll
    for (int i = 0; i < CA; ++i) *(bf16x8*)(lka + i * 8) = rk[i];
#pragma unroll
    for (int i = 0; i < 2; ++i) *(bf16x8*)(lkb + i * 8) = rk[CA + i];
#pragma unroll
    for (int i = 0; i < 4; ++i) {
      union { bf16x8 v; uint2 u[2]; } cv;
      cv.v = rv[i];
      *(uint2*)(lv + i * 8) = cv.u[0];
      *(uint2*)(lv + i * 8 + 4) = cv.u[1];
    }
  };
  if (PF) load_tile(0);
#pragma unroll 1
  for (int t = 0; t < ntiles; ++t) {
    __syncthreads();
    if (!PF) load_tile(t);
    store_tile();
    __syncthreads();
    if (PF && t + 1 < ntiles) load_tile(t + 1);
    if (t < my_tiles) {
      const u16* qp = qrow + hh * 8;
      if (!QREG) asm volatile("" : "+v"(qp));
      const int key0 = t * 64;
#pragma unroll 1
      for (int mi = 0; mi < 2; ++mi) {
        f32x16 s;
#pragma unroll
        for (int r = 0; r < 16; ++r) s[r] = 0.f;
        const u16* kp = sK + (mi * 32 + l31) * KST + hh * 8;
        constexpr int KB = QREG ? 12 : 4;
#pragma unroll
        for (int k0 = 0; k0 < DK / 16; k0 += KB) {
          bf16x8 kf[KB];
#pragma unroll
          for (int i = 0; i < KB; ++i) kf[i] = *(const bf16x8*)(kp + (k0 + i) * 16);
          __builtin_amdgcn_sched_barrier(0);
#pragma unroll
          for (int i = 0; i < KB; ++i) {
            bf16x8 qv;
            if (QREG) qv = qf[k0 + i];
            else qv = *(const bf16x8*)(qp + (k0 + i) * 16);
            s = __builtin_amdgcn_mfma_f32_32x32x16_bf16(kf[i], qv, s, 0, 0, 0);
          }
        }
        bf16x8 vf[8];
        {
          const u16* vp = sV + l31 * VST + mi * 32 + 4 * hh;
#pragma unroll
          for (int oc = 0; oc < 2; ++oc)
#pragma unroll
            for (int d = 0; d < 4; ++d) {
              union { bf16x8 v; uint2 u[2]; } cv;
              cv.u[0] = *(const uint2*)(vp + d * 32 * VST + oc * 16);
              cv.u[1] = *(const uint2*)(vp + d * 32 * VST + oc * 16 + 8);
              vf[oc * 4 + d] = cv.v;
            }
          __builtin_amdgcn_sched_barrier(0);
        }
        if (key0 + 64 > kvlen) {
#pragma unroll
          for (int r = 0; r < 16; ++r) {
            int key = key0 + mi * 32 + (r & 3) + 8 * (r >> 2) + 4 * hh;
            if (key >= kvlen) s[r] = -1e30f;
          }
        }
        float mx = -1e30f;
#pragma unroll
        for (int r = 0; r < 16; ++r) mx = fmaxf(mx, s[r]);
        mx = fmaxf(mx, __shfl_xor(mx, 32, 64));
        if (__builtin_amdgcn_ballot_w64(mx > mrun) != 0ull) {
          const float mnew = fmaxf(mrun, mx);
          const float alpha = __builtin_amdgcn_exp2f(mrun - mnew);
          mrun = mnew;
          lrun *= alpha;
#pragma unroll
          for (int d = 0; d < 4; ++d)
#pragma unroll
            for (int r = 0; r < 16; ++r) o[d][r] *= alpha;
        }
        union { bf16x8 v[2]; unsigned u[8]; } pfu;
        float ps = 0.f;
#pragma unroll
        for (int r = 0; r < 16; r += 2) {
          float p0 = __builtin_amdgcn_exp2f(s[r] - mrun);
          float p1 = __builtin_amdgcn_exp2f(s[r + 1] - mrun);
          ps += p0 + p1;
          pfu.u[r >> 1] = pk2bf(p0, p1);
        }
        lrun += ps;
#pragma unroll
        for (int oc = 0; oc < 2; ++oc)
#pragma unroll
          for (int d = 0; d < 4; ++d) o[d] = __builtin_amdgcn_mfma_f32_32x32x16_bf16(vf[oc * 4 + d], pfu.v[oc], o[d], 0, 0, 0);
      }
    }
  }
  const float ltot = lrun + __shfl_xor(lrun, 32, 64);
  const float inv = 1.0f / ltot;
#pragma unroll
  for (int d = 0; d < 4; ++d)
#pragma unroll
    for (int g = 0; g < 4; ++g) {
      uint2 ov;
      ov.x = pk2bf(o[d][g * 4 + 0] * inv, o[d][g * 4 + 1] * inv);
      ov.y = pk2bf(o[d][g * 4 + 2] * inv, o[d][g * 4 + 3] * inv);
      *(uint2*)(orow + d * 32 + g * 8 + hh * 4) = ov;
    }
  __syncthreads();
}

DEV void lru_item(const Params& p, int l, int sb, int nbk, int half, unsigned char* smem) {
  const int tid = TIDX(), lane = tid & 63, w = tid >> 6, hh = lane >> 5, l31 = lane & 31;
  const bool samp = sb >= 16;
  const int S = samp ? 16 : 4096;
  const int row0 = samp ? MP + (sb - 16) * 16 : sb * 4096;
  const int kc0 = nbk * 128, oc0 = nbk * 128 + half * 64;
  const u16* XA = (const u16*)(p.ws + OFF_R1);
  u16* YL = (u16*)(p.ws + OFF_R2);
  const u16* WL = (const u16*)(p.ws + OFF_W) + (size_t)l * W_LAYER;
  u16* sXC = (u16*)smem;
  float* sA = (float*)(smem + 17408);
  float* sB = sA + 4096;
  float* segA = sB + 4096;
  float* segB = segA + 256;
  float* hc = segB + 256;
  float* cw = hc + 64;
  float* cb = cw + 512;
  const int tm = w >> 1, tn = w & 1;
  __syncthreads();
  for (int e = tid; e < 512; e += NT) cw[e] = p.conv_w[(size_t)l * 4096 + (e >> 7) * 1024 + kc0 + (e & 127)];
  if (tid < 128) cb[tid] = p.conv_b[l * 1024 + kc0 + tid];
  if (tid < 64) hc[tid] = samp ? p.state_lru[((size_t)l * 32 + (sb - 16)) * 1024 + oc0 + tid] : 0.f;
  bf16x8 waf[8], wxf[8];
  {
    const u16* wa = WL + WO_LA + (size_t)nbk * 16384 + (size_t)(half * 64 + tn * 32 + l31) * 128 + hh * 8;
    const u16* wx = WL + WO_LX + (size_t)nbk * 16384 + (size_t)(half * 64 + tn * 32 + l31) * 128 + hh * 8;
#pragma unroll
    for (int ks = 0; ks < 8; ++ks) {
      waf[ks] = *(const bf16x8*)(wa + ks * 16);
      wxf[ks] = *(const bf16x8*)(wx + ks * 16);
    }
  }
  const int och = oc0 + tn * 32 + l31;
  const float ba = p.lru_ba[l * 1024 + och], bx = p.lru_bx[l * 1024 + och];
  const float lam = p.lru_lambda[l * 1024 + och];
  const float ex_ = __expf(-lam);
  const float sp = (-lam > 20.f) ? -lam
                   : (ex_ < 0.01f ? ex_ * (1.0f - ex_ * (0.5f - ex_ * (0.33333334f - 0.25f * ex_))) : __logf(1.0f + ex_));
  __syncthreads();
  for (int t0 = 0; t0 < S; t0 += 64) {
    {
      const int cc = (tid & 15) * 8, tq = tid >> 4;
      bf16x8 xr[7];
#pragma unroll
      for (int j = 0; j < 7; ++j) {
        int ts = t0 + tq * 4 - 3 + j;
        ts = ts < 0 ? 0 : (ts > S - 1 ? S - 1 : ts);
        xr[j] = *(const bf16x8*)(XA + (size_t)(row0 + ts) * 1024 + kc0 + cc);
      }
      float xf[7][8];
#pragma unroll
      for (int j = 0; j < 7; ++j) {
        const int ts = t0 + tq * 4 - 3 + j;
        const bool ok = ts >= 0;
#pragma unroll
        for (int c = 0; c < 8; ++c) xf[j][c] = ok ? bf2f((u16)xr[j][c]) : 0.f;
      }
      if (samp && t0 == 0 && tq == 0) {
#pragma unroll
        for (int j = 0; j < 3; ++j) {
          const float* st = p.state_conv + (((size_t)l * 32 + (sb - 16)) * 3 + j) * 1024 + kc0 + cc;
#pragma unroll
          for (int c = 0; c < 8; ++c) xf[j][c] = st[c];
        }
      }
#pragma unroll
      for (int i = 0; i < 4; ++i) {
        const int tl = tq * 4 + i;
        bf16x8 o;
#pragma unroll
        for (int c = 0; c < 8; ++c) {
          float v = cb[cc + c];
#pragma unroll
          for (int k = 0; k < 4; ++k) v += xf[i + k][c] * cw[k * 128 + cc + c];
          o[c] = (short)f2bf(v);
        }
        *(bf16x8*)(sXC + tl * 136 + cc) = o;
      }
    }
    __syncthreads();
    f32x16 aR, aI;
#pragma unroll
    for (int r = 0; r < 16; ++r) { aR[r] = 0.f; aI[r] = 0.f; }
#pragma unroll
    for (int ks = 0; ks < 8; ++ks) {
      bf16x8 a = *(const bf16x8*)(sXC + (tm * 32 + l31) * 136 + ks * 16 + hh * 8);
      aR = __builtin_amdgcn_mfma_f32_32x32x16_bf16(a, waf[ks], aR, 0, 0, 0);
      aI = __builtin_amdgcn_mfma_f32_32x32x16_bf16(a, wxf[ks], aI, 0, 0, 0);
    }
#pragma unroll
    for (int r = 0; r < 16; ++r) {
      const int tl = tm * 32 + (r & 3) + 8 * (r >> 2) + 4 * hh;
      const int cl = tn * 32 + l31;
      float av, bv;
      {
        const float rg = __builtin_amdgcn_rcpf(1.0f + __expf(-(aR[r] + ba)));
        const float ig = __builtin_amdgcn_rcpf(1.0f + __expf(-(aI[r] + bx)));
        const float la = -8.0f * rg * sp;
        const float a_ = __expf(la);
        const float x2 = 2.0f * la;
        const float ser = -x2 * (1.0f + x2 * (0.5f + x2 * (0.16666667f + x2 * (0.041666668f + x2 * 0.0083333338f))));
        const float em = (x2 > -0.25f) ? ser : 1.0f - __expf(x2);
        const float mult = __builtin_amdgcn_sqrtf(em);
        const float xcv = bf2f(sXC[tl * 136 + half * 64 + cl]);
        const bool valid = (t0 + tl < S);
        av = valid ? a_ : 1.f;
        bv = valid ? mult * ig * xcv : 0.f;
      }
      sA[tl * 64 + cl] = av;
      sB[tl * 64 + cl] = bv;
    }
    __syncthreads();
    {
      const int c = lane, sg = w;
      float A_ = 1.f, B_ = 0.f;
#pragma unroll
      for (int i = 0; i < 16; ++i) {
        const float a = sA[(sg * 16 + i) * 64 + c], b = sB[(sg * 16 + i) * 64 + c];
        B_ = a * B_ + b;
        A_ *= a;
      }
      segA[sg * 64 + c] = A_;
      segB[sg * 64 + c] = B_;
      __syncthreads();
      float h = hc[c];
      for (int s2 = 0; s2 < sg; ++s2) h = segA[s2 * 64 + c] * h + segB[s2 * 64 + c];
      __syncthreads();
#pragma unroll
      for (int i = 0; i < 16; ++i) {
        const int tl = sg * 16 + i;
        const float a = sA[tl * 64 + c], b = sB[tl * 64 + c];
        h = a * h + b;
        if (t0 + tl < S) YL[(size_t)(row0 + t0 + tl) * 1024 + oc0 + c] = f2bf(h);
      }
      if (sg == 3) hc[c] = h;
    }
    __syncthreads();
  }
  if (tid < 64) {
    const float h = hc[tid];
    if (samp) p.out[OUT_LRUS + ((size_t)l * 32 + (sb - 16)) * 1024 + oc0 + tid] = h;
    else p.out[OUT_LRUP + ((size_t)l * 16 + sb) * 1024 + oc0 + tid] = h;
  }
  __syncthreads();
}

DEV void phase_p3(const Params& p, int l, unsigned char* smem) {
  __shared__ int s_item;
  const int tid = TIDX(), lane = tid & 63, w = tid >> 6;
#pragma unroll 1
  for (int it = blockIdx.x; it < 256; it += gridDim.x) lru_item(p, l, it >> 4, (it >> 1) & 7, it & 1, smem);
#pragma unroll 1
  for (int it0 = blockIdx.x; it0 < 320; it0 += gridDim.x) {
    if (it0 < 256) continue;
    const int it = it0 - 256;
    const int b = it >> 1, dvh = it & 1;
    const int r = w * 32 + (lane & 31), h = r >> 4, t = r & 15;
    const u16* qrow = (const u16*)(p.ws + OFF_QS) + ((size_t)b * 16 + t) * 2560 + h * 320;
    const u16* ka = (const u16*)(p.ws + OFF_SKV) + (size_t)b * 2112 * 320;
    const u16* vt = (const u16*)(p.ws + OFF_SVT) + ((size_t)b * 256 + dvh * 128) * 2112;
    u16* orow = (u16*)(p.ws + OFF_OLAT) + ((size_t)b * 16 + t) * 2048 + h * 256 + dvh * 128;
    attn_item<320, false>(qrow, ka, 320, ka + 256, 320, vt, 2112, 33, 33, 2064, orow, smem);
  }
  const int xcd = blockIdx.x & 7;
#pragma unroll 1
  for (int qi = 0; qi < 8; ++qi) {
    const int q = (xcd + qi) & 7;
    unsigned* qc = (unsigned*)(p.ws + OFF_CNT) + 8 + l * 8 + q;
#pragma unroll 1
    for (;;) {
      __syncthreads();
      if (tid == 0) s_item = (int)atomicAdd(qc, 1u);
      __syncthreads();
      const int it = s_item;
      if (it >= 512) break;
      const int qt = 31 - (it & 31), bh = (it >> 5) * 8 + q, b = bh >> 3, h = bh & 7;
      u16* Q = (u16*)(p.ws + OFF_R3);
      const int r = w * 32 + (lane & 31);
      u16* qrow = Q + ((size_t)b * 4096 + qt * 128 + r) * 1536 + h * 192;
      const u16* ka = (const u16*)(p.ws + OFF_R4) + (size_t)b * 4096 * 1024 + h * 128;
      const u16* kb = (const u16*)(p.ws + OFF_KPE) + (size_t)b * 4096 * 64;
      const u16* vt = (const u16*)(p.ws + OFF_VT) + ((size_t)b * 1024 + h * 128) * 4096;
      attn_item<192, ATT_PF>(qrow, ka, 1024, kb, 64, vt, 4096, 2 * (qt + 1), 2 * qt + 1 + (w >> 1), 1 << 30, qrow, smem);
    }
  }
#pragma unroll 1
  for (int it = blockIdx.x; it < 512; it += gridDim.x) lru_item(p, l, 16 + (it >> 4), (it >> 1) & 7, it & 1, smem);
}

template <int MI>
DEV void p4_tile(const Params& p, int l, int m0, int nt, unsigned char* smem) {
  const u16* WL = (const u16*)(p.ws + OFF_W) + (size_t)l * W_LAYER;
  const u16* H = (const u16*)(p.ws + OFF_H);
  const u16* Q = (const u16*)(p.ws + OFF_R3);
  const u16* OLAT = (const u16*)(p.ws + OFF_OLAT);
  u16* YB = (u16*)(p.ws + OFF_R1);
  u16* YA = (u16*)(p.ws + OFF_R2);
  u16* sC = (u16*)smem;
  f32x16 acc[MI][2];
  if (nt < 8) {
    if constexpr (MI == 2) {
      if (m0 >= MP) {
        f32x16 att[MI][2];
        zero_acc_t<MI>(att);
        gemm_mm<MI>(att, OLAT + (size_t)(m0 - MP) * 2048 + nt * 256, 2048, WL + WO_UVP + (size_t)nt * 128 * 256, 256, 256, smem);
        zero_acc_t<MI>(acc);
        gemm_mm<MI>(acc, H + (size_t)m0 * 1024, 1024, WL + WO_G + (size_t)(1024 + nt * 128) * 1024, 1024, 1024, smem);
        acc_foreach_t<MI>([&](int mi, int ni, int r, int row, int col) __attribute__((always_inline)) {
          sC[row * LDC + col] = f2bf(att[mi][ni][r] * siluf_(acc[mi][ni][r]));
        });
        tile_store_t<MI>(smem, YB + (size_t)m0 * 1024 + nt * 128, 1024);
        return;
      }
    }
    zero_acc_t<MI>(acc);
    gemm_mm<MI>(acc, H + (size_t)m0 * 1024, 1024, WL + WO_G + (size_t)(1024 + nt * 128) * 1024, 1024, 1024, smem);
    tile_load_t<MI>(smem, Q + (size_t)m0 * 1536 + nt * 192, 1536);
    acc_foreach_t<MI>([&](int mi, int ni, int r, int row, int col) __attribute__((always_inline)) {
      sC[row * LDC + col] = f2bf(bf2f(sC[row * LDC + col]) * siluf_(acc[mi][ni][r]));
    });
    tile_store_t<MI>(smem, YB + (size_t)m0 * 1024 + nt * 128, 1024);
  } else {
    const int n0 = (nt - 8) * 128;
    zero_acc_t<MI>(acc);
    gemm_mm<MI>(acc, H + (size_t)m0 * 1024, 1024, WL + WO_G + (size_t)n0 * 1024, 1024, 1024, smem);
    tile_load_t<MI>(smem, YA + (size_t)m0 * 1024 + n0, 1024);
    acc_foreach_t<MI>([&](int mi, int ni, int r, int row, int col) __attribute__((always_inline)) {
      sC[row * LDC + col] = f2bf(bf2f(sC[row * LDC + col]) * siluf_(acc[mi][ni][r]));
    });
    tile_store_t<MI>(smem, YA + (size_t)m0 * 1024 + n0, 1024);
  }
}
DEV void phase_p4(const Params& p, int l, unsigned char* smem) {
  const int nb = gridDim.x;
  int idx = vbid(), base = 0;
#pragma unroll 1
  for (; idx < base + 256 * 16; idx += nb) {
    const int t = idx - base;
    p4_tile<4>(p, l, (t >> 4) * 256, t & 15, smem);
  }
  base += 256 * 16;
#pragma unroll 1
  for (; idx < base + 4 * 16; idx += nb) {
    const int t = idx - base;
    p4_tile<2>(p, l, MP + (t >> 4) * 128, t & 15, smem);
  }
}

constexpr int SM_GATE = 2 * 128 * LDT * 2 + 1024;
DEV void gemm_gates(f32x16 (&acc)[2][4], const u16* __restrict__ A, const u16* __restrict__ B0, const u16* __restrict__ B1,
                    unsigned char* smem) {
  u16* sA = (u16*)smem;
  u16* sB = sA + 128 * LDT;
  const int tid = TIDX(), lane = tid & 63, w = tid >> 6, wm = w >> 1, wn = w & 1;
  const int srow = tid >> 3, scol = (tid & 7) * 8;
  const u16* ap = A + (size_t)srow * 1024 + scol;
  const u16* b0p = B0 + (size_t)srow * 1024 + scol;
  const u16* b1p = B1 + (size_t)srow * 1024 + scol;
  bf16x8 ra[4], rb[8];
#pragma unroll
  for (int i = 0; i < 4; ++i) {
    ra[i] = *(const bf16x8*)(ap + (size_t)(32 * i) * 1024);
    rb[i] = *(const bf16x8*)(b0p + (size_t)(32 * i) * 1024);
    rb[4 + i] = *(const bf16x8*)(b1p + (size_t)(32 * i) * 1024);
  }
  const int fro = (lane & 31) * LDT + (lane >> 5) * 8;
#pragma unroll 1
  for (int kt = 0; kt < 16; ++kt) {
    __syncthreads();
#pragma unroll
    for (int i = 0; i < 4; ++i) *(bf16x8*)(sA + (srow + 32 * i) * LDT + scol) = ra[i];
#pragma unroll
    for (int i = 0; i < 8; ++i) *(bf16x8*)(sB + (srow + 32 * i) * LDT + scol) = rb[i];
    __syncthreads();
    if (kt + 1 < 16) {
      ap += 64;
      b0p += 64;
      b1p += 64;
#pragma unroll
      for (int i = 0; i < 4; ++i) {
        ra[i] = *(const bf16x8*)(ap + (size_t)(32 * i) * 1024);
        rb[i] = *(const bf16x8*)(b0p + (size_t)(32 * i) * 1024);
        rb[4 + i] = *(const bf16x8*)(b1p + (size_t)(32 * i) * 1024);
      }
    }
#pragma unroll 2
    for (int ks = 0; ks < 4; ++ks) {
      bf16x8 af[2], bfr[4];
#pragma unroll
      for (int i = 0; i < 2; ++i) af[i] = *(const bf16x8*)(sA + (wm * 64 + i * 32) * LDT + fro + ks * 16);
#pragma unroll
      for (int i = 0; i < 4; ++i)
        bfr[i] = *(const bf16x8*)(sB + ((i >> 1) * 128 + wn * 64 + (i & 1) * 32) * LDT + fro + ks * 16);
      __builtin_amdgcn_s_setprio(1);
#pragma unroll
      for (int mi = 0; mi < 2; ++mi)
#pragma unroll
        for (int ni = 0; ni < 4; ++ni)
          acc[mi][ni] = __builtin_amdgcn_mfma_f32_32x32x16_bf16(af[mi], bfr[ni], acc[mi][ni], 0, 0, 0);
      __builtin_amdgcn_s_setprio(0);
    }
  }
  __syncthreads();
}
DEV void phase_p5(const Params& p, int l, unsigned char* smem) {
  const u16* WL = (const u16*)(p.ws + OFF_W) + (size_t)l * W_LAYER;
  const u16* H = (const u16*)(p.ws + OFF_H);
  const u16* YB = (const u16*)(p.ws + OFF_R1);
  const u16* YA = (const u16*)(p.ws + OFF_R2);
  u16* MRG = (u16*)(p.ws + OFF_R3);
  u16* sC = (u16*)smem;
  const int ntiles = 516 * 8;
  for (int t = vbid(); t < ntiles; t += gridDim.x) {
    const int mt = t >> 3, nt = t & 7;
    unsigned ga[2][2][8];
    unsigned* sG = (unsigned*)(smem + SM_GATE);
    const int tid = TIDX();
    {
      f32x16 g[2][4];
#pragma unroll
      for (int a_ = 0; a_ < 2; ++a_)
#pragma unroll
        for (int b_ = 0; b_ < 4; ++b_)
#pragma unroll
          for (int r = 0; r < 16; ++r) g[a_][b_][r] = 0.f;
      gemm_gates(g, H + (size_t)mt * 128 * 1024, WL + WO_G + (size_t)(2048 + nt * 128) * 1024,
                 WL + WO_G + (size_t)(3072 + nt * 128) * 1024, smem);
#pragma unroll
      for (int a_ = 0; a_ < 2; ++a_)
#pragma unroll
        for (int b_ = 0; b_ < 2; ++b_) {
#pragma unroll
          for (int r = 0; r < 8; ++r)
            sG[((a_ * 2 + b_) * 8 + r) * 256 + tid] = pk2bf(sigmoidf_(g[a_][2 + b_][2 * r]), sigmoidf_(g[a_][2 + b_][2 * r + 1]));
          __builtin_amdgcn_sched_barrier(0);
        }
#pragma unroll
      for (int a_ = 0; a_ < 2; ++a_)
#pragma unroll
        for (int b_ = 0; b_ < 2; ++b_) {
#pragma unroll
          for (int r = 0; r < 8; ++r) ga[a_][b_][r] = pk2bf(sigmoidf_(g[a_][b_][2 * r]), sigmoidf_(g[a_][b_][2 * r + 1]));
          __builtin_amdgcn_sched_barrier(0);
        }
    }
    auto gate_a = [&](int mi, int ni, int r) __attribute__((always_inline)) -> float {
      const unsigned gq = ga[mi][ni][r >> 1];
      return __uint_as_float((r & 1) ? (gq & 0xffff0000u) : (gq << 16));
    };
    auto gate_b = [&](int mi, int ni, int r) __attribute__((always_inline)) -> float {
      const unsigned gq = sG[((mi * 2 + ni) * 8 + (r >> 1)) * 256 + tid];
      return __uint_as_float((r & 1) ? (gq & 0xffff0000u) : (gq << 16));
    };
    f32x16 acc[2][2];
    unsigned res[2][2][8];
    zero_acc(acc);
    gemm_main<0>(acc, YA + (size_t)mt * 128 * 1024, 1024, WL + WO_BA + (size_t)nt * 128 * 1024, 1024, 1024, smem);
#pragma unroll
    for (int mi = 0; mi < 2; ++mi)
#pragma unroll
      for (int ni = 0; ni < 2; ++ni)
#pragma unroll
        for (int r = 0; r < 8; ++r)
          res[mi][ni][r] = pk2bf(acc[mi][ni][2 * r] * gate_a(mi, ni, 2 * r), acc[mi][ni][2 * r + 1] * gate_a(mi, ni, 2 * r + 1));
    zero_acc(acc);
    gemm_main<0>(acc, YB + (size_t)mt * 128 * 1024, 1024, WL + WO_BB + (size_t)nt * 128 * 1024, 1024, 1024, smem);
    __syncthreads();
    acc_foreach([&](int mi, int ni, int r, int row, int col) __attribute__((always_inline)) {
      const unsigned rq = res[mi][ni][r >> 1];
      const float rv = __uint_as_float((r & 1) ? (rq & 0xffff0000u) : (rq << 16));
      sC[row * LDC + col] = f2bf(rv + acc[mi][ni][r] * gate_b(mi, ni, r));
    });
    tile_store(smem, MRG + (size_t)mt * 128 * 1024 + nt * 128, 1024);
  }
}

template <int MI>
DEV void p6_tile(const Params& p, int l, int m0, int nt, unsigned char* smem) {
  const u16* WL = (const u16*)(p.ws + OFF_W) + (size_t)l * W_LAYER;
  const u16* MRG = (const u16*)(p.ws + OFF_R3);
  u16* O = (u16*)(p.ws + OFF_R4);
  u16* sC = (u16*)smem;
  f32x16 acc[MI][2];
  zero_acc_t<MI>(acc);
  gemm_mm<MI>(acc, MRG + (size_t)m0 * 1024, 1024, WL + WO_OUT + (size_t)nt * 128 * 1024, 1024, 1024, smem);
  acc_foreach_t<MI>([&](int mi, int ni, int r, int row, int col) __attribute__((always_inline)) {
    sC[row * LDC + col] = f2bf(acc[mi][ni][r]);
  });
  tile_store_t<MI>(smem, O + (size_t)m0 * 1024 + nt * 128, 1024);
}
DEV void phase_p6(const Params& p, int l, unsigned char* smem) {
  const int nb = gridDim.x;
  int idx = vbid(), base = 0;
#pragma unroll 1
  for (; idx < base + 256 * 8; idx += nb) {
    const int t = idx - base;
    p6_tile<4>(p, l, (t >> 3) * 256, t & 7, smem);
  }
  base += 256 * 8;
#pragma unroll 1
  for (; idx < base + 4 * 8; idx += nb) {
    const int t = idx - base;
    p6_tile<2>(p, l, MP + (t >> 3) * 128, t & 7, smem);
  }
}

constexpr int SM_TOTAL = SM_GATE + 32768;
__global__ void __launch_bounds__(NT, 2) mega(Params p) {
  __shared__ __attribute__((aligned(16))) unsigned char smem[SM_TOTAL];
  cg::grid_group grid = cg::this_grid();
  __shared__ uint4 xb_words;
  if (threadIdx.x == 0) xb_words = make_uint4(0u, 0u, 0u, 0u);
#define PH(call)                                             \
  {                                                          \
    Params q = p;                                            \
    asm volatile("" : "+s"(q.ws), "+s"(q.out));              \
    call;                                                    \
  }
  PH(phase_prep(q, smem));
  grid.sync();
  (void)xcd_barrier_post((unsigned*)(p.ws + OFF_BAR), (volatile LAS unsigned*)&xb_words);
#define XBAR() xcd_barrier((unsigned*)(p.ws + OFF_BAR), (volatile LAS unsigned*)&xb_words)
  PH(phase_norm0(q));
  XBAR();
#pragma unroll 1
  for (int l = 0; l < 2; ++l) {
    PH(phase_gemm1(q, l, smem));
    XBAR();
    PH(phase_p2(q, l, smem));
    XBAR();
    PH(phase_p3(q, l, smem));
    XBAR();
    PH(phase_p4(q, l, smem));
    XBAR();
    PH(phase_p5(q, l, smem));
    XBAR();
    PH(phase_p6(q, l, smem));
    XBAR();
    PH(phase_final(q, l));
    if (l == 0) XBAR();
  }
}

extern "C" void kernel_launch(void* const* d_in, const int* in_sizes, int n_in, void* d_out, int out_size, void* d_ws,
                              size_t ws_size, hipStream_t stream) {
  static int grid_blocks = 0;
  if (!grid_blocks) {
    int dev = 0, cus = 0, per_cu = 0;
    hipGetDevice(&dev);
    hipDeviceGetAttribute(&cus, hipDeviceAttributeMultiprocessorCount, dev);
    hipOccupancyMaxActiveBlocksPerMultiprocessor(&per_cu, mega, NT, 0);
    if (per_cu > 2) per_cu = 2;
    grid_blocks = cus * per_cu;
  }
  if (ws_size < WS_NEED) {
    fprintf(stderr, "workspace too small: %zu < %zu\n", ws_size, (size_t)WS_NEED);
    return;
  }
  Params p{};
  const float** pp = (const float**)&p;
  for (int i = 0; i < 28; ++i) pp[i] = (const float*)d_in[i];
  p.out = (float*)d_out;
  p.ws = (unsigned char*)d_ws;
  void* args[] = {&p};
  hipError_t e = hipLaunchCooperativeKernel((void*)mega, dim3(grid_blocks), dim3(NT), args, 0, stream);
  if (e != hipSuccess) fprintf(stderr, "cooperative launch failed: %s (grid %d)\n", hipGetErrorString(e), grid_blocks);
}
```

```cpp
#include <hip/hip_runtime.h>
#include <hip/hip_cooperative_groups.h>
#include <cstdio>
namespace cg = cooperative_groups;

typedef unsigned short u16;
typedef __attribute__((ext_vector_type(8))) short bf16x8;
typedef __attribute__((ext_vector_type(16))) float f32x16;

#define DEV __device__ __forceinline__
#define NT 256

constexpr int MP = 65536, MS = 512, MT = 66048;
constexpr int IN_DIM = 6208;
constexpr float EPS = 1e-6f;
constexpr float QSCALE = 0.07216878364870322f * 1.4426950408889634f;

constexpr size_t SZ_ACT = (size_t)MT * 1024 * 2;
constexpr size_t OFF_H = 0;
constexpr size_t OFF_R1 = OFF_H + SZ_ACT;
constexpr size_t OFF_R2 = OFF_R1 + SZ_ACT;
constexpr size_t OFF_R3 = OFF_R2 + SZ_ACT;
constexpr size_t OFF_R4 = OFF_R3 + (size_t)MP * 1536 * 2;
constexpr size_t OFF_KPE = OFF_R4 + SZ_ACT;
constexpr size_t OFF_VT = OFF_KPE + (size_t)MT * 64 * 2;
constexpr size_t OFF_SKV = OFF_VT + (size_t)16 * 1024 * 4096 * 2;
constexpr size_t OFF_SVT = OFF_SKV + (size_t)32 * 2112 * 320 * 2;
constexpr size_t OFF_QS = OFF_SVT + (size_t)32 * 256 * 2112 * 2;
constexpr size_t OFF_OLAT = OFF_QS + (size_t)MS * 2560 * 2;
constexpr size_t OFF_MOD = OFF_OLAT + (size_t)MS * 2048 * 2;
constexpr size_t OFF_ROPE = OFF_MOD + (size_t)2 * 48 * 3072 * 4;
constexpr size_t OFF_CNT = OFF_ROPE + (size_t)4096 * 32 * 2 * 4;
constexpr size_t OFF_W = OFF_CNT + 256;
constexpr size_t WO_W1 = 0;
constexpr size_t WO_G = WO_W1 + (size_t)2176 * 1024;
constexpr size_t WO_QP = WO_G + (size_t)4096 * 1024;
constexpr size_t WO_QS = WO_QP + (size_t)1536 * 768;
constexpr size_t WO_UK = WO_QS + (size_t)2560 * 768;
constexpr size_t WO_UVS = WO_UK + 262144;
constexpr size_t WO_UVP = WO_UVS + 262144;
constexpr size_t WO_BA = WO_UVP + 262144;
constexpr size_t WO_BB = WO_BA + 1048576;
constexpr size_t WO_OUT = WO_BB + 1048576;
constexpr size_t WO_LA = WO_OUT + 1048576;
constexpr size_t WO_LX = WO_LA + 131072;
constexpr size_t W_LAYER = WO_LX + 131072;
constexpr size_t OFF_BAR = OFF_W + 2 * W_LAYER * 2;
constexpr size_t WS_NEED = OFF_BAR + 16384;

constexpr size_t OUT_YP = 0;
constexpr size_t OUT_YS = 67108864;
constexpr size_t OUT_CKVP = 67633152;
constexpr size_t OUT_KPEP = 101187584;
constexpr size_t OUT_CONVP = 109576192;
constexpr size_t OUT_LRUP = 109674496;
constexpr size_t OUT_CKVS = 109707264;
constexpr size_t OUT_KPES = 109969408;
constexpr size_t OUT_CONVS = 110034944;
constexpr size_t OUT_LRUS = 110231552;

struct Params {
  const float *x_p, *x_s, *c_p, *c_s, *cache_ckv, *cache_kpe, *state_conv, *state_lru;
  const float *ada_w, *ada_b, *pre_norm, *post_norm, *w_in, *conv_w, *conv_b, *lru_wa, *lru_ba, *lru_wx, *lru_bx;
  const float *lru_lambda, *q_norm, *w_q_up, *kv_norm, *w_uk, *w_uv, *w_ba, *w_bb, *w_out;
  float* out;
  unsigned char* ws;
};

DEV int TIDX() {
  int t = threadIdx.x;
  asm volatile("" : "+v"(t));
  return t;
}
typedef __attribute__((ext_vector_type(2))) float f32x2_t;
typedef __attribute__((ext_vector_type(2))) __bf16 bf16x2_t;
DEV unsigned pk2bf(float a, float b) {
  f32x2_t v = {a, b};
  bf16x2_t r = __builtin_convertvector(v, bf16x2_t);
  return __builtin_bit_cast(unsigned, r);
}
DEV u16 f2bf(float f) { return (u16)(pk2bf(f, 0.f) & 0xffffu); }
DEV float bf2f(u16 h) { return __uint_as_float(((unsigned)h) << 16); }
DEV float sigmoidf_(float x) { return 1.0f / (1.0f + __expf(-x)); }
DEV float siluf_(float x) { return x / (1.0f + __expf(-x)); }
DEV float wave_sum(float v) {
#pragma unroll
  for (int o = 32; o > 0; o >>= 1) v += __shfl_xor(v, o, 64);
  return v;
}
DEV int vbid() {
  const int b = blockIdx.x, n = gridDim.x;
  return ((n & 7) == 0) ? (b & 7) * (n >> 3) + (b >> 3) : b;
}
DEV int mod_row(int m) { return m < MP ? (m >> 12) : 16 + ((m - MP) >> 4); }
DEV int pos_of(int m) { return m < MP ? (m & 4095) : 2048 + ((m - MP) & 15); }

constexpr int LDT = 72;
#ifndef P5_DEPTH
#define P5_DEPTH 1
#endif
template <int SS, int DEPTH = 1>
DEV void gemm_main(f32x16 (&acc)[2][2], const u16* __restrict__ A, int lda, const u16* __restrict__ B, int ldb,
                   int K, unsigned char* smem) {
  u16* sA = (u16*)smem;
  u16* sB = sA + 128 * LDT;
  float* ss = (float*)(sB + 128 * LDT);
  const int tid = TIDX(), lane = tid & 63, w = tid >> 6, wm = w >> 1, wn = w & 1;
  const int srow = tid >> 3, scol = (tid & 7) * 8;
  const u16* ap = A + (size_t)srow * lda + scol;
  const u16* bp = B + (size_t)srow * ldb + scol;
  bf16x8 ra[DEPTH][4], rb[DEPTH][4];
  float ssq[4] = {0.f, 0.f, 0.f, 0.f};
  const int nk = K >> 6;
#pragma unroll
  for (int d = 0; d < DEPTH; ++d)
#pragma unroll
    for (int i = 0; i < 4; ++i) {
      ra[d][i] = *(const bf16x8*)(ap + d * 64 + (size_t)(32 * i) * lda);
      rb[d][i] = *(const bf16x8*)(bp + d * 64 + (size_t)(32 * i) * ldb);
    }
  ap += DEPTH * 64;
  bp += DEPTH * 64;
  const int fro = (lane & 31) * LDT + (lane >> 5) * 8;
#pragma unroll 1
  for (int kt = 0; kt < nk; kt += DEPTH) {
#pragma unroll
    for (int d = 0; d < DEPTH; ++d) {
      __syncthreads();
#pragma unroll
      for (int i = 0; i < 4; ++i) {
        *(bf16x8*)(sA + (srow + 32 * i) * LDT + scol) = ra[d][i];
        *(bf16x8*)(sB + (srow + 32 * i) * LDT + scol) = rb[d][i];
        if (SS) {
          bf16x8 v = (SS == 1) ? ra[d][i] : rb[d][i];
#pragma unroll
          for (int j = 0; j < 8; ++j) {
            float f = bf2f((u16)v[j]);
            ssq[i] += f * f;
          }
        }
      }
      __syncthreads();
      if (kt + d + DEPTH < nk) {
#pragma unroll
        for (int i = 0; i < 4; ++i) {
          ra[d][i] = *(const bf16x8*)(ap + (size_t)(32 * i) * lda);
          rb[d][i] = *(const bf16x8*)(bp + (size_t)(32 * i) * ldb);
        }
        ap += 64;
        bp += 64;
      }
#pragma unroll
      for (int ks = 0; ks < 4; ++ks) {
        bf16x8 af[2], bfr[2];
#pragma unroll
        for (int i = 0; i < 2; ++i) {
          af[i] = *(const bf16x8*)(sA + (wm * 64 + i * 32) * LDT + fro + ks * 16);
          bfr[i] = *(const bf16x8*)(sB + (wn * 64 + i * 32) * LDT + fro + ks * 16);
        }
        __builtin_amdgcn_s_setprio(1);
#pragma unroll
        for (int mi = 0; mi < 2; ++mi)
#pragma unroll
          for (int ni = 0; ni < 2; ++ni)
            acc[mi][ni] = __builtin_amdgcn_mfma_f32_32x32x16_bf16(af[mi], bfr[ni], acc[mi][ni], 0, 0, 0);
        __builtin_amdgcn_s_setprio(0);
      }
    }
  }
  if (SS) {
#pragma unroll
    for (int i = 0; i < 4; ++i) {
      float v = ssq[i];
      v += __shfl_xor(v, 1, 64);
      v += __shfl_xor(v, 2, 64);
      v += __shfl_xor(v, 4, 64);
      if ((tid & 7) == 0) ss[srow + 32 * i] = v;
    }
    __syncthreads();
  }
}
DEV void zero_acc(f32x16 (&acc)[2][2]) {
#pragma unroll
  for (int a = 0; a < 2; ++a)
#pragma unroll
    for (int b = 0; b < 2; ++b)
#pragma unroll
      for (int r = 0; r < 16; ++r) acc[a][b][r] = 0.f;
}
DEV float* gemm_ss(unsigned char* smem) { return (float*)(smem + 2 * 128 * LDT * 2); }

template <class F>
DEV void acc_foreach(F f) {
  const int tid_ = TIDX();
  const int lane = tid_ & 63, w = tid_ >> 6;
#pragma unroll
  for (int mi = 0; mi < 2; ++mi)
#pragma unroll
    for (int ni = 0; ni < 2; ++ni)
#pragma unroll
      for (int r = 0; r < 16; ++r)
        f(mi, ni, r, (w >> 1) * 64 + mi * 32 + (r & 3) + 8 * (r >> 2) + 4 * (lane >> 5), (w & 1) * 64 + ni * 32 + (lane & 31));
}
constexpr int LDC = 136;
DEV void tile_store(unsigned char* smem, u16* dst, size_t ldd) {
  const u16* sC = (const u16*)smem;
  __syncthreads();
  const int tid_ = TIDX();
#pragma unroll
  for (int i = 0; i < 8; ++i) {
    const int c = tid_ + 256 * i, row = c >> 4, cc = (c & 15) * 8;
    *(bf16x8*)(dst + (size_t)row * ldd + cc) = *(const bf16x8*)(sC + row * LDC + cc);
  }
}


template <int MI>
DEV void gemm_mm(f32x16 (&acc)[MI][2], const u16* __restrict__ A, int lda, const u16* __restrict__ B, int ldb, int K,
                 unsigned char* smem) {
  constexpr int BM = MI * 64;
  u16* sA = (u16*)smem;
  u16* sB = sA + BM * LDT;
  const int tid = TIDX(), lane = tid & 63, w = tid >> 6, wm = w >> 1, wn = w & 1;
  const int srow = tid >> 3, scol = (tid & 7) * 8;
  const u16* ap = A + (size_t)srow * lda + scol;
  const u16* bp = B + (size_t)srow * ldb + scol;
  bf16x8 ra[MI * 2], rb[4];
#pragma unroll
  for (int i = 0; i < MI * 2; ++i) ra[i] = *(const bf16x8*)(ap + (size_t)(32 * i) * lda);
#pragma unroll
  for (int i = 0; i < 4; ++i) rb[i] = *(const bf16x8*)(bp + (size_t)(32 * i) * ldb);
  const int nk = K >> 6;
  const int fro = (lane & 31) * LDT + (lane >> 5) * 8;
#pragma unroll 1
  for (int kt = 0; kt < nk; ++kt) {
    __syncthreads();
#pragma unroll
    for (int i = 0; i < MI * 2; ++i) *(bf16x8*)(sA + (srow + 32 * i) * LDT + scol) = ra[i];
#pragma unroll
    for (int i = 0; i < 4; ++i) *(bf16x8*)(sB + (srow + 32 * i) * LDT + scol) = rb[i];
    __syncthreads();
    if (kt + 1 < nk) {
      ap += 64;
      bp += 64;
#pragma unroll
      for (int i = 0; i < MI * 2; ++i) ra[i] = *(const bf16x8*)(ap + (size_t)(32 * i) * lda);
#pragma unroll
      for (int i = 0; i < 4; ++i) rb[i] = *(const bf16x8*)(bp + (size_t)(32 * i) * ldb);
    }
#pragma unroll
    for (int ks = 0; ks < 4; ++ks) {
      bf16x8 af[MI], bfr[2];
#pragma unroll
      for (int i = 0; i < MI; ++i) af[i] = *(const bf16x8*)(sA + (wm * (MI * 32) + i * 32) * LDT + fro + ks * 16);
#pragma unroll
      for (int i = 0; i < 2; ++i) bfr[i] = *(const bf16x8*)(sB + (wn * 64 + i * 32) * LDT + fro + ks * 16);
      __builtin_amdgcn_s_setprio(1);
#pragma unroll
      for (int mi = 0; mi < MI; ++mi)
#pragma unroll
        for (int ni = 0; ni < 2; ++ni)
          acc[mi][ni] = __builtin_amdgcn_mfma_f32_32x32x16_bf16(af[mi], bfr[ni], acc[mi][ni], 0, 0, 0);
      __builtin_amdgcn_s_setprio(0);
    }
  }
  __syncthreads();
}
template <int MI>
DEV void zero_acc_t(f32x16 (&acc)[MI][2]) {
#pragma unroll
  for (int a = 0; a < MI; ++a)
#pragma unroll
    for (int b = 0; b < 2; ++b)
#pragma unroll
      for (int r = 0; r < 16; ++r) acc[a][b][r] = 0.f;
}
template <int MI, class F>
DEV void acc_foreach_t(F f) {
  const int tid_ = TIDX();
  const int lane = tid_ & 63, w = tid_ >> 6;
#pragma unroll
  for (int mi = 0; mi < MI; ++mi)
#pragma unroll
    for (int ni = 0; ni < 2; ++ni)
#pragma unroll
      for (int r = 0; r < 16; ++r)
        f(mi, ni, r, (w >> 1) * (MI * 32) + mi * 32 + (r & 3) + 8 * (r >> 2) + 4 * (lane >> 5), (w & 1) * 64 + ni * 32 + (lane & 31));
}
template <int MI>
DEV void tile_load_t(unsigned char* smem, const u16* src, size_t lds_) {
  u16* sC = (u16*)smem;
  const int tid_ = TIDX();
#pragma unroll
  for (int i = 0; i < MI * 4; ++i) {
    const int c = tid_ + 256 * i, row = c >> 4, cc = (c & 15) * 8;
    *(bf16x8*)(sC + row * LDC + cc) = *(const bf16x8*)(src + (size_t)row * lds_ + cc);
  }
  __syncthreads();
}
template <int MI>
DEV void tile_store_t(unsigned char* smem, u16* dst, size_t ldd) {
  const u16* sC = (const u16*)smem;
  __syncthreads();
  const int tid_ = TIDX();
#pragma unroll
  for (int i = 0; i < MI * 4; ++i) {
    const int c = tid_ + 256 * i, row = c >> 4, cc = (c & 15) * 8;
    *(bf16x8*)(dst + (size_t)row * ldd + cc) = *(const bf16x8*)(sC + row * LDC + cc);
  }
}

#define XB_TMO      128
#define XB_XCNT(j)  (256  + 64 * (j))
#define XB_XSUB(j)  (1280 + 64 * (j))
#define XB_XGEN(j)  (2304 + 64 * (j))
#define XB_TOP      3328
#define XB_TOPGEN   3392
#define XCD_BAR_WORDS 3456
#define XB_SPIN_CAP (1u << 20)
#define LAS __attribute__((address_space(3)))
DEV unsigned xb_ld(unsigned* p) { return __hip_atomic_load(p, __ATOMIC_RELAXED, __HIP_MEMORY_SCOPE_AGENT); }
DEV unsigned xb_add(unsigned* p, unsigned v) { return __hip_atomic_fetch_add(p, v, __ATOMIC_RELAXED, __HIP_MEMORY_SCOPE_AGENT); }
DEV unsigned xb_xcc_id() { return (unsigned)__builtin_amdgcn_s_getreg((3 << 11) | 20) & 0xFu; }
#define XB_SPIN(cond, bar) do { unsigned _sp = 0; while (cond) { __builtin_amdgcn_s_sleep(1); \
    if ((++_sp & 255u) == 0u) { if (xb_ld(&(bar)[XB_TMO])) break; if (_sp > XB_SPIN_CAP) { atomicAdd(&(bar)[XB_TMO], 1u); break; } } } } while (0)
struct XcdBarrier {
  unsigned* bar;
  unsigned x;
  volatile LAS unsigned* st;
};
DEV XcdBarrier xcd_barrier_post(unsigned* bar, volatile LAS unsigned* st) {
  XcdBarrier b;
  b.bar = bar;
  b.x = xb_xcc_id();
  b.st = st;
  if (threadIdx.x == 0) (void)xb_add(&bar[XB_XCNT(b.x)], 1u);
  return b;
}
DEV void xcd_barrier_complete(unsigned* bar, unsigned x, unsigned& nloc, unsigned& nx) {
  const unsigned G = gridDim.x * gridDim.y * gridDim.z;
  unsigned sum, cnt, mine, sp = 0u;
  for (;;) {
    sum = 0u; cnt = 0u; mine = 0u;
#pragma unroll
    for (unsigned j = 0; j < 16; ++j) {
      const unsigned c = xb_ld(&bar[XB_XCNT(j)]);
      sum += c;
      cnt += (c > 0u) ? 1u : 0u;
      mine = (j == x) ? c : mine;
    }
    if (sum == G) break;
    __builtin_amdgcn_s_sleep(1);
    if ((++sp & 255u) == 0u) {
      if (xb_ld(&bar[XB_TMO])) break;
      if (sp > XB_SPIN_CAP) { atomicAdd(&bar[XB_TMO], 1u); break; }
    }
  }
  nloc = mine > 0u ? mine : 1u;
  nx = cnt > 0u ? cnt : 1u;
}
DEV void xcd_barrier(unsigned* bar_, volatile LAS unsigned* st_) {
  asm volatile("s_waitcnt vmcnt(0)" ::: "memory");
  __syncthreads();
  if (threadIdx.x == 0) {
    XcdBarrier b;
    b.bar = bar_;
    b.x = xb_xcc_id();
    b.st = st_;
    unsigned* bar = b.bar;
    __builtin_amdgcn_s_waitcnt(0);
    unsigned nloc = b.st[0], nx = b.st[1];
    if (nloc == 0u) {
      xcd_barrier_complete(bar, b.x, nloc, nx);
      b.st[0] = nloc;
      b.st[1] = nx;
    }
    const unsigned old = xb_add(&bar[XB_XSUB(b.x)], 1u);
    const unsigned gen = old / nloc;
    if (old + 1u == (gen + 1u) * nloc) {
      __builtin_amdgcn_fence(__ATOMIC_RELEASE, "agent");
      asm volatile("s_waitcnt vmcnt(0)" ::: "memory");
      const unsigned og = xb_add(&bar[XB_TOP], 1u);
      const unsigned tg = og / nx;
      if (og + 1u == (tg + 1u) * nx) xb_add(&bar[XB_TOPGEN], 1u);
      else XB_SPIN(xb_ld(&bar[XB_TOPGEN]) == tg, bar);
      __builtin_amdgcn_fence(__ATOMIC_ACQUIRE, "agent");
      xb_add(&bar[XB_XGEN(b.x)], 1u);
      asm volatile("s_waitcnt vmcnt(0)" ::: "memory");
    } else {
      XB_SPIN(xb_ld(&bar[XB_XGEN(b.x)]) == gen, bar);
      __builtin_amdgcn_fence(__ATOMIC_ACQUIRE, "agent");
      asm volatile("s_waitcnt vmcnt(0)" ::: "memory");
    }
  }
  __syncthreads();
}

DEV void transpose_tile(const float* __restrict__ src, int lds_, u16* __restrict__ dst, int ldd, const float* scale,
                        int k0, int n0, unsigned char* smem) {
  float* s = (float*)smem;
  const int tid = TIDX();
  __syncthreads();
  {
    const int n = tid & 63, kq = tid >> 6;
#pragma unroll 4
    for (int i = 0; i < 16; ++i) {
      int kk = kq * 16 + i;
      s[kk * 65 + n] = src[(size_t)(k0 + kk) * lds_ + n0 + n];
    }
  }
  __syncthreads();
  {
    const int k = tid & 63, nq = tid >> 6;
    const float sc = scale ? scale[k0 + k] : 1.0f;
#pragma unroll 4
    for (int i = 0; i < 16; ++i) {
      int n = nq * 16 + i;
      dst[(size_t)(n0 + n) * ldd + k0 + k] = f2bf(s[k * 65 + n] * sc);
    }
  }
}

DEV void qlat_tile(const float* __restrict__ wq, const float* __restrict__ wuk, const float* __restrict__ g,
                   u16* __restrict__ dst, int h, int r0, int k0, unsigned char* smem) {
  float* sQ = (float*)smem;
  float* sU = sQ + 64 * 65;
  const int tid = TIDX();
  float acc[16];
#pragma unroll
  for (int i = 0; i < 16; ++i) acc[i] = 0.f;
  for (int nh = 0; nh < 2; ++nh) {
    __syncthreads();
    {
      const int n = tid & 63, q = tid >> 6;
      for (int i = 0; i < 16; ++i) {
        int rr = q * 16 + i;
        sQ[rr * 65 + n] = wq[(size_t)(k0 + rr) * 1536 + h * 192 + nh * 64 + n];
        sU[rr * 65 + n] = wuk[(size_t)(r0 + rr) * 1024 + h * 128 + nh * 64 + n];
      }
    }
    __syncthreads();
    const int k = tid & 63, rq = tid >> 6;
    for (int n = 0; n < 64; ++n) {
      float qv = sQ[k * 65 + n];
#pragma unroll
      for (int i = 0; i < 16; ++i) acc[i] += qv * sU[(rq * 16 + i) * 65 + n];
    }
  }
  const int k = tid & 63, rq = tid >> 6;
  const float sc = g[k0 + k];
#pragma unroll
  for (int i = 0; i < 16; ++i) dst[(size_t)(h * 320 + r0 + rq * 16 + i) * 768 + k0 + k] = f2bf(acc[i] * sc);
}

DEV void mod_item(const Params& p, int item, unsigned char* smem) {
  const int l = item / 48, cg_ = item % 48;
  float* sc = (float*)smem;
  float* red = sc + 48 * 256;
  (void)red;
  const int tid = TIDX(), col = tid & 63, kq = tid >> 6;
  const float* W = p.ada_w + (size_t)l * 1024 * 3072 + cg_ * 64 + col;
  float acc[48];
#pragma unroll
  for (int b = 0; b < 48; ++b) acc[b] = 0.f;
  for (int kc = 0; kc < 4; ++kc) {
    __syncthreads();
    for (int e = tid; e < 48 * 256; e += NT) {
      int b = e >> 8, k = e & 255;
      float c = b < 16 ? p.c_p[b * 1024 + kc * 256 + k] : p.c_s[(b - 16) * 1024 + kc * 256 + k];
      sc[e] = siluf_(c);
    }
    __syncthreads();
#pragma unroll 1
    for (int i0 = 0; i0 < 64; i0 += 8) {
      float wv[8];
#pragma unroll
      for (int i = 0; i < 8; ++i) wv[i] = W[(size_t)(kc * 256 + kq * 64 + i0 + i) * 3072];
#pragma unroll
      for (int i = 0; i < 8; ++i) {
        const int k = kq * 64 + i0 + i;
#pragma unroll
        for (int b = 0; b < 48; ++b) acc[b] += sc[b * 256 + k] * wv[i];
      }
    }
  }
  __syncthreads();
#pragma unroll
  for (int b = 0; b < 48; ++b) sc[(kq * 48 + b) * 64 + col] = acc[b];
  __syncthreads();
  float* MOD = (float*)(p.ws + OFF_MOD);
  for (int e = tid; e < 48 * 64; e += NT) {
    int b = e >> 6, c = e & 63;
    float v = sc[(0 * 48 + b) * 64 + c] + sc[(1 * 48 + b) * 64 + c] + sc[(2 * 48 + b) * 64 + c] + sc[(3 * 48 + b) * 64 + c];
    int gc = cg_ * 64 + c;
    MOD[((size_t)l * 48 + b) * 3072 + gc] = v + p.ada_b[l * 3072 + gc];
  }
}

DEV void phase_prep(const Params& p, unsigned char* smem) {
  const int tid = TIDX();
  if (blockIdx.x == 0) {
    if (tid < 64) ((unsigned*)(p.ws + OFF_CNT))[tid] = 0u;
    for (int e = tid; e < XCD_BAR_WORDS; e += NT) ((unsigned*)(p.ws + OFF_BAR))[e] = 0u;
  }
  const bool split = gridDim.x >= 192;
  if (split && blockIdx.x < 96) {
    mod_item(p, blockIdx.x, smem);
    return;
  }
  const int nb = split ? (int)gridDim.x - 96 : (int)gridDim.x;
  int idx = split ? (int)blockIdx.x - 96 : (int)blockIdx.x, base = 0;
  if (!split) {
    for (; idx < base + 96; idx += nb) mod_item(p, idx - base, smem);
    base += 96;
  }
  for (int l = 0; l < 2; ++l) {
    u16* WL = (u16*)(p.ws + OFF_W) + (size_t)l * W_LAYER;
    const float* win = p.w_in + (size_t)l * 1024 * IN_DIM;
#define TJOB(SRC, LDS_, KK, NN, DST, LDD, SCALE)                                     \
  {                                                                                  \
    const int nkt = (KK) / 64, ntl = nkt * ((NN) / 64);                              \
    for (; idx < base + ntl; idx += nb) {                                            \
      int t = idx - base;                                                            \
      transpose_tile((SRC), (LDS_), (DST), (LDD), (SCALE), (t % nkt) * 64, (t / nkt) * 64, smem); \
    }                                                                                \
    base += ntl;                                                                     \
  }
    TJOB(win, IN_DIM, 1024, 1024, WL + WO_W1, 1024, nullptr);
    TJOB(win + 2048, IN_DIM, 1024, 1088, WL + WO_W1 + (size_t)1024 * 1024, 1024, nullptr);
    TJOB(win + 1024, IN_DIM, 1024, 1024, WL + WO_G, 1024, nullptr);
    TJOB(win + 3136, IN_DIM, 1024, 3072, WL + WO_G + (size_t)1024 * 1024, 1024, nullptr);
    TJOB(p.w_q_up + (size_t)l * 768 * 1536, 1536, 768, 1536, WL + WO_QP, 768, p.q_norm + l * 768);
    for (int h = 0; h < 8; ++h)
      TJOB(p.w_q_up + (size_t)l * 768 * 1536 + h * 192 + 128, 1536, 768, 64, WL + WO_QS + (size_t)(h * 320 + 256) * 768, 768,
           p.q_norm + l * 768);
    TJOB(p.w_uk + (size_t)l * 262144, 1024, 256, 1024, WL + WO_UK, 256, p.kv_norm + l * 256);
    TJOB(p.w_uv + (size_t)l * 262144, 1024, 256, 1024, WL + WO_UVS, 256, p.kv_norm + l * 256);
    TJOB(p.w_uv + (size_t)l * 262144, 1024, 256, 1024, WL + WO_UVP, 256, nullptr);
    TJOB(p.w_ba + (size_t)l * 1048576, 1024, 1024, 1024, WL + WO_BA, 1024, nullptr);
    TJOB(p.w_bb + (size_t)l * 1048576, 1024, 1024, 1024, WL + WO_BB, 1024, nullptr);
    TJOB(p.w_out + (size_t)l * 1048576, 1024, 1024, 1024, WL + WO_OUT, 1024, nullptr);
    for (int b8 = 0; b8 < 8; ++b8) {
      TJOB(p.lru_wa + (size_t)l * 131072 + b8 * 16384, 128, 128, 128, WL + WO_LA + b8 * 16384, 128, nullptr);
      TJOB(p.lru_wx + (size_t)l * 131072 + b8 * 16384, 128, 128, 128, WL + WO_LX + b8 * 16384, 128, nullptr);
    }
    for (; idx < base + 384; idx += nb) {
      int t = idx - base;
      int h = t / 48, rt = (t % 48) / 12, kt = t % 12;
      qlat_tile(p.w_q_up + (size_t)l * 768 * 1536, p.w_uk + (size_t)l * 262144, p.q_norm + l * 768, WL + WO_QS, h,
                rt * 64, kt * 64, smem);
    }
    base += 384;
    for (; idx < base + 16; idx += nb) {
      int t = idx - base;
      u16* d = WL + WO_W1 + (size_t)2112 * 1024 + t * 4096;
      for (int e = tid; e < 4096; e += NT) d[e] = 0;
    }
    base += 16;
  }
  float* ROPE = (float*)(p.ws + OFF_ROPE);
  for (; idx < base + 512; idx += nb) {
    int e = (idx - base) * 256 + tid;
    int pos = e >> 5, j = e & 31;
    float inv = exp2f(-(float)j * (13.287712379549449f / 32.0f));
    float ang = (float)pos * inv;
    ROPE[2 * e] = cosf(ang);
    ROPE[2 * e + 1] = sinf(ang);
  }
  base += 512;
}

DEV void norm_row(const Params& p, int l, int m, const float (&xv)[16], int lane) {
  float ss = 0.f;
#pragma unroll
  for (int i = 0; i < 16; ++i) ss += xv[i] * xv[i];
  ss = wave_sum(ss);
  const float rstd = rsqrtf(ss * (1.0f / 1024.0f) + EPS);
  const float* MOD = (const float*)(p.ws + OFF_MOD) + ((size_t)l * 48 + mod_row(m)) * 3072;
  u16* H = (u16*)(p.ws + OFF_H) + (size_t)m * 1024;
#pragma unroll
  for (int i = 0; i < 4; ++i) {
    int c = i * 256 + lane * 4;
    float4 g = *(const float4*)(p.pre_norm + l * 1024 + c);
    float4 sh = *(const float4*)(MOD + c);
    float4 sc = *(const float4*)(MOD + 1024 + c);
    ushort4 o;
    o.x = f2bf(xv[i * 4 + 0] * rstd * g.x * (1.f + sc.x) + sh.x);
    o.y = f2bf(xv[i * 4 + 1] * rstd * g.y * (1.f + sc.y) + sh.y);
    o.z = f2bf(xv[i * 4 + 2] * rstd * g.z * (1.f + sc.z) + sh.z);
    o.w = f2bf(xv[i * 4 + 3] * rstd * g.w * (1.f + sc.w) + sh.w);
    *(ushort4*)(H + c) = o;
  }
}

DEV void phase_norm0(const Params& p) {
  const int tid_ = TIDX();
  const int lane = tid_ & 63, wv = tid_ >> 6;
  for (int m = blockIdx.x * 4 + wv; m < MT; m += gridDim.x * 4) {
    const float* x = m < MP ? p.x_p + (size_t)m * 1024 : p.x_s + (size_t)(m - MP) * 1024;
    float xv[16];
#pragma unroll
    for (int i = 0; i < 4; ++i) {
      float4 v = *(const float4*)(x + i * 256 + lane * 4);
      xv[i * 4] = v.x; xv[i * 4 + 1] = v.y; xv[i * 4 + 2] = v.z; xv[i * 4 + 3] = v.w;
    }
    norm_row(p, 0, m, xv, lane);
  }
}

DEV void phase_final(const Params& p, int l) {
  const int tid_ = TIDX();
  const int lane = tid_ & 63, wv = tid_ >> 6;
  const u16* O = (const u16*)(p.ws + OFF_R4);
  for (int m = blockIdx.x * 4 + wv; m < MT; m += gridDim.x * 4) {
    float* y = m < MP ? p.out + OUT_YP + (size_t)m * 1024 : p.out + OUT_YS + (size_t)(m - MP) * 1024;
    const float* x = (l == 0) ? (m < MP ? p.x_p + (size_t)m * 1024 : p.x_s + (size_t)(m - MP) * 1024) : y;
    float xv[16], ov[16];
    float ss = 0.f;
#pragma unroll
    for (int i = 0; i < 4; ++i) {
      int c = i * 256 + lane * 4;
      float4 v = *(const float4*)(x + c);
      xv[i * 4] = v.x; xv[i * 4 + 1] = v.y; xv[i * 4 + 2] = v.z; xv[i * 4 + 3] = v.w;
      ushort4 o = *(const ushort4*)(O + (size_t)m * 1024 + c);
      ov[i * 4] = bf2f(o.x); ov[i * 4 + 1] = bf2f(o.y); ov[i * 4 + 2] = bf2f(o.z); ov[i * 4 + 3] = bf2f(o.w);
    }
#pragma unroll
    for (int i = 0; i < 16; ++i) ss += ov[i] * ov[i];
    ss = wave_sum(ss);
    const float rstd = rsqrtf(ss * (1.0f / 1024.0f) + EPS);
    const float* MOD = (const float*)(p.ws + OFF_MOD) + ((size_t)l * 48 + mod_row(m)) * 3072 + 2048;
#pragma unroll
    for (int i = 0; i < 4; ++i) {
      int c = i * 256 + lane * 4;
      float4 g = *(const float4*)(p.post_norm + l * 1024 + c);
      float4 gt = *(const float4*)(MOD + c);
      xv[i * 4 + 0] += gt.x * ov[i * 4 + 0] * rstd * g.x;
      xv[i * 4 + 1] += gt.y * ov[i * 4 + 1] * rstd * g.y;
      xv[i * 4 + 2] += gt.z * ov[i * 4 + 2] * rstd * g.z;
      xv[i * 4 + 3] += gt.w * ov[i * 4 + 3] * rstd * g.w;
      *(float4*)(y + c) = make_float4(xv[i * 4], xv[i * 4 + 1], xv[i * 4 + 2], xv[i * 4 + 3]);
    }
    if (l == 0) norm_row(p, 1, m, xv, lane);
  }
}

template <int MI>
DEV void gemm1_tile(const Params& p, int l, int m0, int nt, unsigned char* smem) {
  constexpr int BM = MI * 64;
  const u16* H = (const u16*)(p.ws + OFF_H);
  const u16* W1 = (const u16*)(p.ws + OFF_W) + (size_t)l * W_LAYER + WO_W1;
  u16* XA = (u16*)(p.ws + OFF_R1);
  u16* CQ = (u16*)(p.ws + OFF_R2);
  u16* CKVR = CQ + (size_t)MT * 768;
  u16* sC = (u16*)smem;
  f32x16 acc[MI][2];
  zero_acc_t<MI>(acc);
  gemm_mm<MI>(acc, H + (size_t)m0 * 1024, 1024, W1 + (size_t)nt * 128 * 1024, 1024, 1024, smem);
  if (nt < 14) {
    acc_foreach_t<MI>([&](int mi, int ni, int r, int row, int col) __attribute__((always_inline)) {
      sC[row * LDC + col] = f2bf(acc[mi][ni][r]);
    });
    if (nt < 8) tile_store_t<MI>(smem, XA + (size_t)m0 * 1024 + nt * 128, 1024);
    else tile_store_t<MI>(smem, CQ + (size_t)m0 * 768 + (nt - 8) * 128, 768);
    if (nt < 8 && (m0 >= MP || ((m0 + BM) & 4095) == 0)) {
      acc_foreach_t<MI>([&](int mi, int ni, int r, int row, int col) __attribute__((always_inline)) {
        const int m = m0 + row, n = nt * 128 + col;
        const float v = acc[mi][ni][r];
        if (m < MP) {
          int j = (m & 4095) - 4093;
          if (j >= 0) p.out[OUT_CONVP + ((size_t)(l * 16 + (m >> 12)) * 3 + j) * 1024 + n] = v;
        } else {
          int j = ((m - MP) & 15) - 13;
          if (j >= 0) p.out[OUT_CONVS + ((size_t)(l * 32 + ((m - MP) >> 4)) * 3 + j) * 1024 + n] = v;
        }
      });
    }
  } else if (nt < 16) {
    float* ob = m0 < MP ? p.out + OUT_CKVP + ((size_t)l * MP + m0) * 256 + (nt - 14) * 128
                        : p.out + OUT_CKVS + ((size_t)l * MS + (m0 - MP)) * 256 + (nt - 14) * 128;
    acc_foreach_t<MI>([&](int mi, int ni, int r, int row, int col) __attribute__((always_inline)) {
      const float v = acc[mi][ni][r];
      sC[row * LDC + col] = f2bf(v);
      ob[(size_t)row * 256 + col] = v;
    });
    tile_store_t<MI>(smem, CKVR + (size_t)m0 * 256 + (nt - 14) * 128, 256);
  } else {
    float* ob = m0 < MP ? p.out + OUT_KPEP + ((size_t)l * MP + m0) * 64 : p.out + OUT_KPES + ((size_t)l * MS + (m0 - MP)) * 64;
    acc_foreach_t<MI>([&](int mi, int ni, int r, int row, int col) __attribute__((always_inline)) {
      if (col < 64) ob[(size_t)row * 64 + col] = acc[mi][ni][r];
    });
  }
}
DEV void phase_gemm1(const Params& p, int l, unsigned char* smem) {
  const int nb = gridDim.x;
  int idx = vbid(), base = 0;
#pragma unroll 1
  for (; idx < base + 256 * 17; idx += nb) {
    const int t = idx - base;
    gemm1_tile<4>(p, l, (t / 17) * 256, t % 17, smem);
  }
  base += 256 * 17;
#pragma unroll 1
  for (; idx < base + 4 * 17; idx += nb) {
    const int t = idx - base;
    gemm1_tile<2>(p, l, MP + (t / 17) * 128, t % 17, smem);
  }
}

DEV void post1_rows(const Params& p, int l, int item) {
  const int tid_ = TIDX();
  const int lane = tid_ & 63, wv = tid_ >> 6;
  const float* ROPE = (const float*)(p.ws + OFF_ROPE);
  float4 v[2];
  float kx[2];
  float2 cs[2];
  float* ckvp[2];
  float* kpep[2];
#pragma unroll
  for (int u = 0; u < 2; ++u) {
    const int m = item * 8 + wv * 2 + u;
    ckvp[u] = m < MP ? p.out + OUT_CKVP + ((size_t)l * MP + m) * 256 : p.out + OUT_CKVS + ((size_t)l * MS + (m - MP)) * 256;
    kpep[u] = m < MP ? p.out + OUT_KPEP + ((size_t)l * MP + m) * 64 : p.out + OUT_KPES + ((size_t)l * MS + (m - MP)) * 64;
    v[u] = *(const float4*)(ckvp[u] + lane * 4);
    kx[u] = kpep[u][lane];
    cs[u] = *(const float2*)(ROPE + ((size_t)pos_of(m) * 32 + (lane & 31)) * 2);
  }
  const float4 g = *(const float4*)(p.kv_norm + l * 256 + lane * 4);
#pragma unroll
  for (int u = 0; u < 2; ++u) {
    const int m = item * 8 + wv * 2 + u;
    const float ss = wave_sum(v[u].x * v[u].x + v[u].y * v[u].y + v[u].z * v[u].z + v[u].w * v[u].w);
    const float rstd = rsqrtf(ss * (1.0f / 256.0f) + EPS);
    float4 o4 = v[u];
    o4.x *= rstd * g.x; o4.y *= rstd * g.y; o4.z *= rstd * g.z; o4.w *= rstd * g.w;
    *(float4*)(ckvp[u] + lane * 4) = o4;
    const float other = __shfl_xor(kx[u], 32, 64);
    const float c = cs[u].x, sn = cs[u].y;
    const float ro = (lane < 32) ? (kx[u] * c - other * sn) : (other * sn + kx[u] * c);
    kpep[u][lane] = ro;
    if (m < MP) {
      u16* KPE = (u16*)(p.ws + OFF_KPE) + (size_t)m * 64;
      KPE[lane] = f2bf(ro);
    } else {
      const int b = (m - MP) >> 4, t = (m - MP) & 15;
      u16* SKV = (u16*)(p.ws + OFF_SKV) + ((size_t)b * 2112 + 2048 + t) * 320;
      u16* SVT = (u16*)(p.ws + OFF_SVT) + (size_t)b * 256 * 2112 + 2048 + t;
      ushort4 o;
      o.x = f2bf(o4.x); o.y = f2bf(o4.y); o.z = f2bf(o4.z); o.w = f2bf(o4.w);
      *(ushort4*)(SKV + lane * 4) = o;
      SVT[(size_t)(lane * 4 + 0) * 2112] = o.x;
      SVT[(size_t)(lane * 4 + 1) * 2112] = o.y;
      SVT[(size_t)(lane * 4 + 2) * 2112] = o.z;
      SVT[(size_t)(lane * 4 + 3) * 2112] = o.w;
      SKV[256 + lane] = f2bf(ro);
    }
  }
}

DEV void cache_item(const Params& p, int l, int item, unsigned char* smem) {
  const int tid = TIDX();
  const int b = item / 33, kt = item % 33;
  u16* SKV = (u16*)(p.ws + OFF_SKV) + (size_t)b * 2112 * 320;
  u16* SVT = (u16*)(p.ws + OFF_SVT) + (size_t)b * 256 * 2112;
  if (kt == 32) {
    for (int e = tid; e < 48 * 320; e += NT) SKV[(size_t)2064 * 320 + e] = 0;
    for (int e = tid; e < 256 * 48; e += NT) SVT[(size_t)(e / 48) * 2112 + 2064 + (e % 48)] = 0;
    return;
  }
  float* s = (float*)smem;
  const float* src = p.cache_ckv + (((size_t)l * 32 + b) * 2048 + kt * 64) * 256;
  const float* srck = p.cache_kpe + (((size_t)l * 32 + b) * 2048 + kt * 64) * 64;
  for (int dh = 0; dh < 2; ++dh) {
    __syncthreads();
    for (int e = tid; e < 64 * 128; e += NT) {
      int key = e >> 7, d = e & 127;
      float v = src[(size_t)key * 256 + dh * 128 + d];
      s[key * 129 + d] = v;
      SKV[(size_t)(kt * 64 + key) * 320 + dh * 128 + d] = f2bf(v);
    }
    __syncthreads();
    const int k = tid & 63, dq = tid >> 6;
    for (int i = 0; i < 32; ++i) {
      int d = dq * 32 + i;
      SVT[(size_t)(dh * 128 + d) * 2112 + kt * 64 + k] = f2bf(s[k * 129 + d]);
    }
  }
  for (int e = tid; e < 64 * 64; e += NT) {
    int key = e >> 6, d = e & 63;
    SKV[(size_t)(kt * 64 + key) * 320 + 256 + d] = f2bf(srck[(size_t)key * 64 + d]);
  }
}

DEV void phase_p2(const Params& p, int l, unsigned char* smem) {
  const int tid = TIDX(), lane = tid & 63, w = tid >> 6;
  const int nb = gridDim.x;
  const u16* WL = (const u16*)(p.ws + OFF_W) + (size_t)l * W_LAYER;
  const u16* CQ = (const u16*)(p.ws + OFF_R2);
  const u16* CKVR = CQ + (size_t)MT * 768;
  u16* Q = (u16*)(p.ws + OFF_R3);
  u16* QS = (u16*)(p.ws + OFF_QS);
  u16* Kb = (u16*)(p.ws + OFF_R4);
  u16* VT = (u16*)(p.ws + OFF_VT);
  const float* ROPE = (const float*)(p.ws + OFF_ROPE);
  float* ss = gemm_ss(smem);
  int idx = vbid(), base = 0;
  const int nq = 512 * 12 + 4 * 20;
  for (; idx < base + nq; idx += nb) {
    int t = idx - base;
    int mt, nt;
    const u16* Wt;
    bool samp = t >= 512 * 12;
    if (!samp) { mt = t / 12; nt = t % 12; Wt = WL + WO_QP; }
    else { t -= 512 * 12; mt = 512 + t / 20; nt = t % 20; Wt = WL + WO_QS; }
    f32x16 acc[2][2];
    zero_acc(acc);
    gemm_main<1>(acc, CQ + (size_t)mt * 128 * 768, 768, Wt + (size_t)nt * 128 * 768, 768, 768, smem);
    const int g = nt * 2 + (w & 1);
    const bool rope = samp ? (g % 5 == 4) : (g % 3 == 2);
    u16* sC = (u16*)smem;
#pragma unroll
    for (int mi = 0; mi < 2; ++mi)
#pragma unroll
      for (int r = 0; r < 16; ++r) {
        const int row = (w >> 1) * 64 + mi * 32 + (r & 3) + 8 * (r >> 2) + 4 * (lane >> 5);
        const int m = mt * 128 + row;
        const float rs = rsqrtf(ss[row] * (1.0f / 768.0f) + EPS) * QSCALE;
        float v0 = acc[mi][0][r] * rs, v1 = acc[mi][1][r] * rs;
        if (rope) {
          const int pos = pos_of(m);
          const float c = ROPE[(pos * 32 + (lane & 31)) * 2], s = ROPE[(pos * 32 + (lane & 31)) * 2 + 1];
          const float a = v0 * c - v1 * s, b = v0 * s + v1 * c;
          v0 = a; v1 = b;
        }
        const int col = (w & 1) * 64 + (lane & 31);
        sC[row * LDC + col] = f2bf(v0);
        sC[row * LDC + col + 32] = f2bf(v1);
      }
    if (!samp) tile_store(smem, Q + (size_t)mt * 128 * 1536 + nt * 128, 1536);
    else tile_store(smem, QS + (size_t)(mt - 512) * 128 * 2560 + nt * 128, 2560);
  }
  base += nq;
  for (; idx < base + 4096; idx += nb) {
    int t = idx - base;
    int mt = t >> 3, nt = t & 7;
    f32x16 acc[2][2];
    zero_acc(acc);
    gemm_main<1, 2>(acc, CKVR + (size_t)mt * 128 * 256, 256, WL + WO_UK + (size_t)nt * 128 * 256, 256, 256, smem);
    {
      u16* sC = (u16*)smem;
      acc_foreach([&](int mi, int ni, int r, int row, int col) __attribute__((always_inline)) {
        const float rs = rsqrtf(ss[row] * (1.0f / 256.0f) + EPS);
        sC[row * LDC + col] = f2bf(acc[mi][ni][r] * rs);
      });
      tile_store(smem, Kb + (size_t)mt * 128 * 1024 + nt * 128, 1024);
    }
  }
  base += 4096;
  for (; idx < base + 4096; idx += nb) {
    int t = idx - base;
    int b = t >> 8, mt = (t >> 5) & 7, nt = t & 31;
    f32x16 acc[2][2];
    zero_acc(acc);
    gemm_main<2, 2>(acc, WL + WO_UVS + (size_t)mt * 128 * 256, 256, CKVR + ((size_t)b * 4096 + nt * 128) * 256, 256, 256, smem);
    {
      u16* sC = (u16*)smem;
      acc_foreach([&](int mi, int ni, int r, int row, int col) __attribute__((always_inline)) {
        const float rs = rsqrtf(ss[col] * (1.0f / 256.0f) + EPS);
        sC[row * LDC + col] = f2bf(acc[mi][ni][r] * rs);
      });
      tile_store(smem, VT + ((size_t)b * 1024 + mt * 128) * 4096 + nt * 128, 4096);
    }
  }
  base += 4096;
  for (; idx < base + MT / 8; idx += nb) post1_rows(p, l, idx - base);
  base += MT / 8;
  for (; idx < base + 32 * 33; idx += nb) cache_item(p, l, idx - base, smem);
  base += 32 * 33;
}

#ifndef ATT_PF
#define ATT_PF true
#endif
template <int DK, bool PF>
DEV void attn_item(const u16* __restrict__ qrow, const u16* __restrict__ ka, int ldka, const u16* __restrict__ kb, int ldkb,
                   const u16* __restrict__ vt, int ldvt, int ntiles, int my_tiles, int kvlen, u16* orow,
                   unsigned char* smem) {
  constexpr int DKA = DK - 64, KST = DK + 8, VST = 68;
  u16* sK = (u16*)smem;
  u16* sV = sK + 64 * KST;
  const int tid = TIDX(), lane = tid & 63, hh = lane >> 5, l31 = lane & 31;
  constexpr bool QREG = (DK <= 192);
  bf16x8 qf[DK / 16];
  if (QREG) {
#pragma unroll
    for (int ks = 0; ks < DK / 16; ++ks) qf[ks] = *(const bf16x8*)(qrow + ks * 16 + hh * 8);
  }
  f32x16 o[4];
#pragma unroll
  for (int d = 0; d < 4; ++d)
#pragma unroll
    for (int r = 0; r < 16; ++r) o[d][r] = 0.f;
  float mrun = -1e30f, lrun = 0.f;
  constexpr int CA = DKA / 32;
  bf16x8 rk[CA + 2], rv[4];
  const int skey = tid >> 2, sq = tid & 3;
  const u16* gka = ka + (size_t)skey * ldka + sq * CA * 8;
  const u16* gkb = kb + (size_t)skey * ldkb + sq * 16;
  const u16* gv = vt + (size_t)(tid >> 1) * ldvt + (tid & 1) * 32;
  u16* lka = sK + skey * KST + sq * CA * 8;
  u16* lkb = sK + skey * KST + DKA + sq * 16;
  u16* lv = sV + (tid >> 1) * VST + (tid & 1) * 32;
  auto load_tile = [&](int t) __attribute__((always_inline)) {
    const size_t ko = (size_t)t * 64;
#pragma unroll
    for (int i = 0; i < CA; ++i) rk[i] = *(const bf16x8*)(gka + ko * ldka + i * 8);
#pragma unroll
    for (int i = 0; i < 2; ++i) rk[CA + i] = *(const bf16x8*)(gkb + ko * ldkb + i * 8);
#pragma unroll
    for (int i = 0; i < 4; ++i) rv[i] = *(const bf16x8*)(gv + ko + i * 8);
  };
  auto store_tile = [&]() __attribute__((always_inline)) {
#pragma unroll
    for (int i = 0; i < CA; ++i) *(bf16x8*)(lka + i * 8) = rk[i];
#pragma unroll
    for (int i = 0; i < 2; ++i) *(bf16x8*)(lkb + i * 8) = rk[CA + i];
#pragma unroll
    for (int i = 0; i < 4; ++i) {
      union { bf16x8 v; uint2 u[2]; } cv;
      cv.v = rv[i];
      *(uint2*)(lv + i * 8) = cv.u[0];
      *(uint2*)(lv + i * 8 + 4) = cv.u[1];
    }
  };
  if (PF) load_tile(0);
#pragma unroll 1
  for (int t = 0; t < ntiles; ++t) {
    __syncthreads();
    if (!PF) load_tile(t);
    store_tile();
    __syncthreads();
    if (PF && t + 1 < ntiles) load_tile(t + 1);
    if (t < my_tiles) {
      const u16* qp = qrow + hh * 8;
      if (!QREG) asm volatile("" : "+v"(qp));
      const int key0 = t * 64;
#pragma unroll 1
      for (int mi = 0; mi < 2; ++mi) {
        f32x16 s;
#pragma unroll
        for (int r = 0; r < 16; ++r) s[r] = 0.f;
        const u16* kp = sK + (mi * 32 + l31) * KST + hh * 8;
        constexpr int KB = QREG ? 12 : 4;
#pragma unroll
        for (int k0 = 0; k0 < DK / 16; k0 += KB) {
          bf16x8 kf[KB];
#pragma unroll
          for (int i = 0; i < KB; ++i) kf[i] = *(const bf16x8*)(kp + (k0 + i) * 16);
          __builtin_amdgcn_sched_barrier(0);
#pragma unroll
          for (int i = 0; i < KB; ++i) {
            bf16x8 qv;
            if (QREG) qv = qf[k0 + i];
            else qv = *(const bf16x8*)(qp + (k0 + i) * 16);
            s = __builtin_amdgcn_mfma_f32_32x32x16_bf16(kf[i], qv, s, 0, 0, 0);
          }
        }
        bf16x8 vf[8];
        {
          const u16* vp = sV + l31 * VST + mi * 32 + 4 * hh;
#pragma unroll
          for (int oc = 0; oc < 2; ++oc)
#pragma unroll
            for (int d = 0; d < 4; ++d) {
              union { bf16x8 v; uint2 u[2]; } cv;
              cv.u[0] = *(const uint2*)(vp + d * 32 * VST + oc * 16);
              cv.u[1] = *(const uint2*)(vp + d * 32 * VST + oc * 16 + 8);
              vf[oc * 4 + d] = cv.v;
            }
          __builtin_amdgcn_sched_barrier(0);
        }
        if (key0 + 64 > kvlen) {
#pragma unroll
          for (int r = 0; r < 16; ++r) {
            int key = key0 + mi * 32 + (r & 3) + 8 * (r >> 2) + 4 * hh;
            if (key >= kvlen) s[r] = -1e30f;
          }
        }
        float mx = -1e30f;
#pragma unroll
        for (int r = 0; r < 16; ++r) mx = fmaxf(mx, s[r]);
        mx = fmaxf(mx, __shfl_xor(mx, 32, 64));
        if (__builtin_amdgcn_ballot_w64(mx > mrun) != 0ull) {
          const float mnew = fmaxf(mrun, mx);
          const float alpha = __builtin_amdgcn_exp2f(mrun - mnew);
          mrun = mnew;
          lrun *= alpha;
#pragma unroll
          for (int d = 0; d < 4; ++d)
#pragma unroll
            for (int r = 0; r < 16; ++r) o[d][r] *= alpha;
        }
        union { bf16x8 v[2]; unsigned u[8]; } pfu;
        float ps = 0.f;
#pragma unroll
        for (int r = 0; r < 16; r += 2) {
          float p0 = __builtin_amdgcn_exp2f(s[r] - mrun);
          float p1 = __builtin_amdgcn_exp2f(s[r + 1] - mrun);
          ps += p0 + p1;
          pfu.u[r >> 1] = pk2bf(p0, p1);
        }
        lrun += ps;
#pragma unroll
        for (int oc = 0; oc < 2; ++oc)
#pragma unroll
          for (int d = 0; d < 4; ++d) o[d] = __builtin_amdgcn_mfma_f32_32x32x16_bf16(vf[oc * 4 + d], pfu.v[oc], o[d], 0, 0, 0);
      }
    }
  }
  const float ltot = lrun + __shfl_xor(lrun, 32, 64);
  const float inv = 1.0f / ltot;
#pragma unroll
  for (int d = 0; d < 4; ++d)
#pragma unroll
    for (int g = 0; g < 4; ++g) {
      uint2 ov;
      ov.x = pk2bf(o[d][g * 4 + 0] * inv, o[d][g * 4 + 1] * inv);
      ov.y = pk2bf(o[d][g * 4 + 2] * inv, o[d][g * 4 + 3] * inv);
      *(uint2*)(orow + d * 32 + g * 8 + hh * 4) = ov;
    }
  __syncthreads();
}

DEV void lru_item(const Params& p, int l, int sb, int nbk, int half, unsigned char* smem) {
  const int tid = TIDX(), lane = tid & 63, w = tid >> 6, hh = lane >> 5, l31 = lane & 31;
  const bool samp = sb >= 16;
  const int S = samp ? 16 : 4096;
  const int row0 = samp ? MP + (sb - 16) * 16 : sb * 4096;
  const int kc0 = nbk * 128, oc0 = nbk * 128 + half * 64;
  const u16* XA = (const u16*)(p.ws + OFF_R1);
  u16* YL = (u16*)(p.ws + OFF_R2);
  const u16* WL = (const u16*)(p.ws + OFF_W) + (size_t)l * W_LAYER;
  u16* sXC = (u16*)smem;
  float* sA = (float*)(smem + 17408);
  float* sB = sA + 4096;
  float* segA = sB + 4096;
  float* segB = segA + 256;
  float* hc = segB + 256;
  float* cw = hc + 64;
  float* cb = cw + 512;
  const int tm = w >> 1, tn = w & 1;
  __syncthreads();
  for (int e = tid; e < 512; e += NT) cw[e] = p.conv_w[(size_t)l * 4096 + (e >> 7) * 1024 + kc0 + (e & 127)];
  if (tid < 128) cb[tid] = p.conv_b[l * 1024 + kc0 + tid];
  if (tid < 64) hc[tid] = samp ? p.state_lru[((size_t)l * 32 + (sb - 16)) * 1024 + oc0 + tid] : 0.f;
  bf16x8 waf[8], wxf[8];
  {
    const u16* wa = WL + WO_LA + (size_t)nbk * 16384 + (size_t)(half * 64 + tn * 32 + l31) * 128 + hh * 8;
    const u16* wx = WL + WO_LX + (size_t)nbk * 16384 + (size_t)(half * 64 + tn * 32 + l31) * 128 + hh * 8;
#pragma unroll
    for (int ks = 0; ks < 8; ++ks) {
      waf[ks] = *(const bf16x8*)(wa + ks * 16);
      wxf[ks] = *(const bf16x8*)(wx + ks * 16);
    }
  }
  const int och = oc0 + tn * 32 + l31;
  const float ba = p.lru_ba[l * 1024 + och], bx = p.lru_bx[l * 1024 + och];
  const float lam = p.lru_lambda[l * 1024 + och];
  const float ex_ = __expf(-lam);
  const float sp = (-lam > 20.f) ? -lam
                   : (ex_ < 0.01f ? ex_ * (1.0f - ex_ * (0.5f - ex_ * (0.33333334f - 0.25f * ex_))) : __logf(1.0f + ex_));
  __syncthreads();
  for (int t0 = 0; t0 < S; t0 += 64) {
    {
      const int cc = (tid & 15) * 8, tq = tid >> 4;
      bf16x8 xr[7];
#pragma unroll
      for (int j = 0; j < 7; ++j) {
        int ts = t0 + tq * 4 - 3 + j;
        ts = ts < 0 ? 0 : (ts > S - 1 ? S - 1 : ts);
        xr[j] = *(const bf16x8*)(XA + (size_t)(row0 + ts) * 1024 + kc0 + cc);
      }
      float xf[7][8];
#pragma unroll
      for (int j = 0; j < 7; ++j) {
        const int ts = t0 + tq * 4 - 3 + j;
        const bool ok = ts >= 0;
#pragma unroll
        for (int c = 0; c < 8; ++c) xf[j][c] = ok ? bf2f((u16)xr[j][c]) : 0.f;
      }
      if (samp && t0 == 0 && tq == 0) {
#pragma unroll
        for (int j = 0; j < 3; ++j) {
          const float* st = p.state_conv + (((size_t)l * 32 + (sb - 16)) * 3 + j) * 1024 + kc0 + cc;
#pragma unroll
          for (int c = 0; c < 8; ++c) xf[j][c] = st[c];
        }
      }
#pragma unroll
      for (int i = 0; i < 4; ++i) {
        const int tl = tq * 4 + i;
        bf16x8 o;
#pragma unroll
        for (int c = 0; c < 8; ++c) {
          float v = cb[cc + c];
#pragma unroll
          for (int k = 0; k < 4; ++k) v += xf[i + k][c] * cw[k * 128 + cc + c];
          o[c] = (short)f2bf(v);
        }
        *(bf16x8*)(sXC + tl * 136 + cc) = o;
      }
    }
    __syncthreads();
    f32x16 aR, aI;
#pragma unroll
    for (int r = 0; r < 16; ++r) { aR[r] = 0.f; aI[r] = 0.f; }
#pragma unroll
    for (int ks = 0; ks < 8; ++ks) {
      bf16x8 a = *(const bf16x8*)(sXC + (tm * 32 + l31) * 136 + ks * 16 + hh * 8);
      aR = __builtin_amdgcn_mfma_f32_32x32x16_bf16(a, waf[ks], aR, 0, 0, 0);
      aI = __builtin_amdgcn_mfma_f32_32x32x16_bf16(a, wxf[ks], aI, 0, 0, 0);
    }
#pragma unroll
    for (int r = 0; r < 16; ++r) {
      const int tl = tm * 32 + (r & 3) + 8 * (r >> 2) + 4 * hh;
      const int cl = tn * 32 + l31;
      float av, bv;
      {
        const float rg = __builtin_amdgcn_rcpf(1.0f + __expf(-(aR[r] + ba)));
        const float ig = __builtin_amdgcn_rcpf(1.0f + __expf(-(aI[r] + bx)));
        const float la = -8.0f * rg * sp;
        const float a_ = __expf(la);
        const float x2 = 2.0f * la;
        const float ser = -x2 * (1.0f + x2 * (0.5f + x2 * (0.16666667f + x2 * (0.041666668f + x2 * 0.0083333338f))));
        const float em = (x2 > -0.25f) ? ser : 1.0f - __expf(x2);
        const float mult = __builtin_amdgcn_sqrtf(em);
        const float xcv = bf2f(sXC[tl * 136 + half * 64 + cl]);
        const bool valid = (t0 + tl < S);
        av = valid ? a_ : 1.f;
        bv = valid ? mult * ig * xcv : 0.f;
      }
      sA[tl * 64 + cl] = av;
      sB[tl * 64 + cl] = bv;
    }
    __syncthreads();
    {
      const int c = lane, sg = w;
      float A_ = 1.f, B_ = 0.f;
#pragma unroll
      for (int i = 0; i < 16; ++i) {
        const float a = sA[(sg * 16 + i) * 64 + c], b = sB[(sg * 16 + i) * 64 + c];
        B_ = a * B_ + b;
        A_ *= a;
      }
      segA[sg * 64 + c] = A_;
      segB[sg * 64 + c] = B_;
      __syncthreads();
      float h = hc[c];
      for (int s2 = 0; s2 < sg; ++s2) h = segA[s2 * 64 + c] * h + segB[s2 * 64 + c];
      __syncthreads();
#pragma unroll
      for (int i = 0; i < 16; ++i) {
        const int tl = sg * 16 + i;
        const float a = sA[tl * 64 + c], b = sB[tl * 64 + c];
        h = a * h + b;
        if (t0 + tl < S) YL[(size_t)(row0 + t0 + tl) * 1024 + oc0 + c] = f2bf(h);
      }
      if (sg == 3) hc[c] = h;
    }
    __syncthreads();
  }
  if (tid < 64) {
    const float h = hc[tid];
    if (samp) p.out[OUT_LRUS + ((size_t)l * 32 + (sb - 16)) * 1024 + oc0 + tid] = h;
    else p.out[OUT_LRUP + ((size_t)l * 16 + sb) * 1024 + oc0 + tid] = h;
  }
  __syncthreads();
}

DEV void phase_p3(const Params& p, int l, unsigned char* smem) {
  __shared__ int s_item;
  const int tid = TIDX(), lane = tid & 63, w = tid >> 6;
#pragma unroll 1
  for (int it = blockIdx.x; it < 256; it += gridDim.x) lru_item(p, l, it >> 4, (it >> 1) & 7, it & 1, smem);
#pragma unroll 1
  for (int it0 = blockIdx.x; it0 < 320; it0 += gridDim.x) {
    if (it0 < 256) continue;
    const int it = it0 - 256;
    const int b = it >> 1, dvh = it & 1;
    const int r = w * 32 + (lane & 31), h = r >> 4, t = r & 15;
    const u16* qrow = (const u16*)(p.ws + OFF_QS) + ((size_t)b * 16 + t) * 2560 + h * 320;
    const u16* ka = (const u16*)(p.ws + OFF_SKV) + (size_t)b * 2112 * 320;
    const u16* vt = (const u16*)(p.ws + OFF_SVT) + ((size_t)b * 256 + dvh * 128) * 2112;
    u16* orow = (u16*)(p.ws + OFF_OLAT) + ((size_t)b * 16 + t) * 2048 + h * 256 + dvh * 128;
    attn_item<320, false>(qrow, ka, 320, ka + 256, 320, vt, 2112, 33, 33, 2064, orow, smem);
  }
  const int xcd = blockIdx.x & 7;
#pragma unroll 1
  for (int qi = 0; qi < 8; ++qi) {
    const int q = (xcd + qi) & 7;
    unsigned* qc = (unsigned*)(p.ws + OFF_CNT) + 8 + l * 8 + q;
#pragma unroll 1
    for (;;) {
      __syncthreads();
      if (tid == 0) s_item = (int)atomicAdd(qc, 1u);
      __syncthreads();
      const int it = s_item;
      if (it >= 512) break;
      const int half_ = it >> 8, j_ = it & 255;
      const int qt = (half_ ? 15 : 31) - (j_ & 15), bh = (j_ >> 4) * 8 + q, b = bh >> 3, h = bh & 7;
      u16* Q = (u16*)(p.ws + OFF_R3);
      const int r = w * 32 + (lane & 31);
      u16* qrow = Q + ((size_t)b * 4096 + qt * 128 + r) * 1536 + h * 192;
      const u16* ka = (const u16*)(p.ws + OFF_R4) + (size_t)b * 4096 * 1024 + h * 128;
      const u16* kb = (const u16*)(p.ws + OFF_KPE) + (size_t)b * 4096 * 64;
      const u16* vt = (const u16*)(p.ws + OFF_VT) + ((size_t)b * 1024 + h * 128) * 4096;
      attn_item<192, ATT_PF>(qrow, ka, 1024, kb, 64, vt, 4096, 2 * (qt + 1), 2 * qt + 1 + (w >> 1), 1 << 30, qrow, smem);
    }
  }
#pragma unroll 1
  for (int it = blockIdx.x; it < 512; it += gridDim.x) lru_item(p, l, 16 + (it >> 4), (it >> 1) & 7, it & 1, smem);
}

template <int MI>
DEV void p4_tile(const Params& p, int l, int m0, int nt, unsigned char* smem) {
  const u16* WL = (const u16*)(p.ws + OFF_W) + (size_t)l * W_LAYER;
  const u16* H = (const u16*)(p.ws + OFF_H);
  const u16* Q = (const u16*)(p.ws + OFF_R3);
  const u16* OLAT = (const u16*)(p.ws + OFF_OLAT);
  u16* YB = (u16*)(p.ws + OFF_R1);
  u16* YA = (u16*)(p.ws + OFF_R2);
  u16* sC = (u16*)smem;
  f32x16 acc[MI][2];
  if (nt < 8) {
    if constexpr (MI == 2) {
      if (m0 >= MP) {
        f32x16 att[MI][2];
        zero_acc_t<MI>(att);
        gemm_mm<MI>(att, OLAT + (size_t)(m0 - MP) * 2048 + nt * 256, 2048, WL + WO_UVP + (size_t)nt * 128 * 256, 256, 256, smem);
        zero_acc_t<MI>(acc);
        gemm_mm<MI>(acc, H + (size_t)m0 * 1024, 1024, WL + WO_G + (size_t)(1024 + nt * 128) * 1024, 1024, 1024, smem);
        acc_foreach_t<MI>([&](int mi, int ni, int r, int row, int col) __attribute__((always_inline)) {
          sC[row * LDC + col] = f2bf(att[mi][ni][r] * siluf_(acc[mi][ni][r]));
        });
        tile_store_t<MI>(smem, YB + (size_t)m0 * 1024 + nt * 128, 1024);
        return;
      }
    }
    zero_acc_t<MI>(acc);
    gemm_mm<MI>(acc, H + (size_t)m0 * 1024, 1024, WL + WO_G + (size_t)(1024 + nt * 128) * 1024, 1024, 1024, smem);
    tile_load_t<MI>(smem, Q + (size_t)m0 * 1536 + nt * 192, 1536);
    acc_foreach_t<MI>([&](int mi, int ni, int r, int row, int col) __attribute__((always_inline)) {
      sC[row * LDC + col] = f2bf(bf2f(sC[row * LDC + col]) * siluf_(acc[mi][ni][r]));
    });
    tile_store_t<MI>(smem, YB + (size_t)m0 * 1024 + nt * 128, 1024);
  } else {
    const int n0 = (nt - 8) * 128;
    zero_acc_t<MI>(acc);
    gemm_mm<MI>(acc, H + (size_t)m0 * 1024, 1024, WL + WO_G + (size_t)n0 * 1024, 1024, 1024, smem);
    tile_load_t<MI>(smem, YA + (size_t)m0 * 1024 + n0, 1024);
    acc_foreach_t<MI>([&](int mi, int ni, int r, int row, int col) __attribute__((always_inline)) {
      sC[row * LDC + col] = f2bf(bf2f(sC[row * LDC + col]) * siluf_(acc[mi][ni][r]));
    });
    tile_store_t<MI>(smem, YA + (size_t)m0 * 1024 + n0, 1024);
  }
}
DEV void phase_p4(const Params& p, int l, unsigned char* smem) {
  const int nb = gridDim.x;
  int idx = vbid(), base = 0;
#pragma unroll 1
  for (; idx < base + 256 * 16; idx += nb) {
    const int t = idx - base;
    p4_tile<4>(p, l, (t >> 4) * 256, t & 15, smem);
  }
  base += 256 * 16;
#pragma unroll 1
  for (; idx < base + 4 * 16; idx += nb) {
    const int t = idx - base;
    p4_tile<2>(p, l, MP + (t >> 4) * 128, t & 15, smem);
  }
}

constexpr int SM_GATE = 2 * 128 * LDT * 2 + 1024;
DEV void gemm_gates(f32x16 (&acc)[2][4], const u16* __restrict__ A, const u16* __restrict__ B0, const u16* __restrict__ B1,
                    unsigned char* smem) {
  u16* sA = (u16*)smem;
  u16* sB = sA + 128 * LDT;
  const int tid = TIDX(), lane = tid & 63, w = tid >> 6, wm = w >> 1, wn = w & 1;
  const int srow = tid >> 3, scol = (tid & 7) * 8;
  const u16* ap = A + (size_t)srow * 1024 + scol;
  const u16* b0p = B0 + (size_t)srow * 1024 + scol;
  const u16* b1p = B1 + (size_t)srow * 1024 + scol;
  bf16x8 ra[4], rb[8];
#pragma unroll
  for (int i = 0; i < 4; ++i) {
    ra[i] = *(const bf16x8*)(ap + (size_t)(32 * i) * 1024);
    rb[i] = *(const bf16x8*)(b0p + (size_t)(32 * i) * 1024);
    rb[4 + i] = *(const bf16x8*)(b1p + (size_t)(32 * i) * 1024);
  }
  const int fro = (lane & 31) * LDT + (lane >> 5) * 8;
#pragma unroll 1
  for (int kt = 0; kt < 16; ++kt) {
    __syncthreads();
#pragma unroll
    for (int i = 0; i < 4; ++i) *(bf16x8*)(sA + (srow + 32 * i) * LDT + scol) = ra[i];
#pragma unroll
    for (int i = 0; i < 8; ++i) *(bf16x8*)(sB + (srow + 32 * i) * LDT + scol) = rb[i];
    __syncthreads();
    if (kt + 1 < 16) {
      ap += 64;
      b0p += 64;
      b1p += 64;
#pragma unroll
      for (int i = 0; i < 4; ++i) {
        ra[i] = *(const bf16x8*)(ap + (size_t)(32 * i) * 1024);
        rb[i] = *(const bf16x8*)(b0p + (size_t)(32 * i) * 1024);
        rb[4 + i] = *(const bf16x8*)(b1p + (size_t)(32 * i) * 1024);
      }
    }
#pragma unroll 2
    for (int ks = 0; ks < 4; ++ks) {
      bf16x8 af[2], bfr[4];
#pragma unroll
      for (int i = 0; i < 2; ++i) af[i] = *(const bf16x8*)(sA + (wm * 64 + i * 32) * LDT + fro + ks * 16);
#pragma unroll
      for (int i = 0; i < 4; ++i)
        bfr[i] = *(const bf16x8*)(sB + ((i >> 1) * 128 + wn * 64 + (i & 1) * 32) * LDT + fro + ks * 16);
      __builtin_amdgcn_s_setprio(1);
#pragma unroll
      for (int mi = 0; mi < 2; ++mi)
#pragma unroll
        for (int ni = 0; ni < 4; ++ni)
          acc[mi][ni] = __builtin_amdgcn_mfma_f32_32x32x16_bf16(af[mi], bfr[ni], acc[mi][ni], 0, 0, 0);
      __builtin_amdgcn_s_setprio(0);
    }
  }
  __syncthreads();
}
DEV void phase_p5(const Params& p, int l, unsigned char* smem) {
  const u16* WL = (const u16*)(p.ws + OFF_W) + (size_t)l * W_LAYER;
  const u16* H = (const u16*)(p.ws + OFF_H);
  const u16* YB = (const u16*)(p.ws + OFF_R1);
  const u16* YA = (const u16*)(p.ws + OFF_R2);
  u16* MRG = (u16*)(p.ws + OFF_R3);
  u16* sC = (u16*)smem;
  const int ntiles = 516 * 8;
  for (int t = vbid(); t < ntiles; t += gridDim.x) {
    const int mt = t >> 3, nt = t & 7;
    unsigned ga[2][2][8];
    unsigned* sG = (unsigned*)(smem + SM_GATE);
    const int tid = TIDX();
    {
      f32x16 g[2][4];
#pragma unroll
      for (int a_ = 0; a_ < 2; ++a_)
#pragma unroll
        for (int b_ = 0; b_ < 4; ++b_)
#pragma unroll
          for (int r = 0; r < 16; ++r) g[a_][b_][r] = 0.f;
      gemm_gates(g, H + (size_t)mt * 128 * 1024, WL + WO_G + (size_t)(2048 + nt * 128) * 1024,
                 WL + WO_G + (size_t)(3072 + nt * 128) * 1024, smem);
#pragma unroll
      for (int a_ = 0; a_ < 2; ++a_)
#pragma unroll
        for (int b_ = 0; b_ < 2; ++b_) {
#pragma unroll
          for (int r = 0; r < 8; ++r)
            sG[((a_ * 2 + b_) * 8 + r) * 256 + tid] = pk2bf(sigmoidf_(g[a_][2 + b_][2 * r]), sigmoidf_(g[a_][2 + b_][2 * r + 1]));
          __builtin_amdgcn_sched_barrier(0);
        }
#pragma unroll
      for (int a_ = 0; a_ < 2; ++a_)
#pragma unroll
        for (int b_ = 0; b_ < 2; ++b_) {
#pragma unroll
          for (int r = 0; r < 8; ++r) ga[a_][b_][r] = pk2bf(sigmoidf_(g[a_][b_][2 * r]), sigmoidf_(g[a_][b_][2 * r + 1]));
          __builtin_amdgcn_sched_barrier(0);
        }
    }
    auto gate_a = [&](int mi, int ni, int r) __attribute__((always_inline)) -> float {
      const unsigned gq = ga[mi][ni][r >> 1];
      return __uint_as_float((r & 1) ? (gq & 0xffff0000u) : (gq << 16));
    };
    auto gate_b = [&](int mi, int ni, int r) __attribute__((always_inline)) -> float {
      const unsigned gq = sG[((mi * 2 + ni) * 8 + (r >> 1)) * 256 + tid];
      return __uint_as_float((r & 1) ? (gq & 0xffff0000u) : (gq << 16));
    };
    f32x16 acc[2][2];
    unsigned res[2][2][8];
    zero_acc(acc);
    gemm_main<0>(acc, YA + (size_t)mt * 128 * 1024, 1024, WL + WO_BA + (size_t)nt * 128 * 1024, 1024, 1024, smem);
#pragma unroll
    for (int mi = 0; mi < 2; ++mi)
#pragma unroll
      for (int ni = 0; ni < 2; ++ni)
#pragma unroll
        for (int r = 0; r < 8; ++r)
          res[mi][ni][r] = pk2bf(acc[mi][ni][2 * r] * gate_a(mi, ni, 2 * r), acc[mi][ni][2 * r + 1] * gate_a(mi, ni, 2 * r + 1));
    zero_acc(acc);
    gemm_main<0>(acc, YB + (size_t)mt * 128 * 1024, 1024, WL + WO_BB + (size_t)nt * 128 * 1024, 1024, 1024, smem);
    __syncthreads();
    acc_foreach([&](int mi, int ni, int r, int row, int col) __attribute__((always_inline)) {
      const unsigned rq = res[mi][ni][r >> 1];
      const float rv = __uint_as_float((r & 1) ? (rq & 0xffff0000u) : (rq << 16));
      sC[row * LDC + col] = f2bf(rv + acc[mi][ni][r] * gate_b(mi, ni, r));
    });
    tile_store(smem, MRG + (size_t)mt * 128 * 1024 + nt * 128, 1024);
  }
}

template <int MI>
DEV void p6_tile(const Params& p, int l, int m0, int nt, unsigned char* smem) {
  const u16* WL = (const u16*)(p.ws + OFF_W) + (size_t)l * W_LAYER;
  const u16* MRG = (const u16*)(p.ws + OFF_R3);
  u16* O = (u16*)(p.ws + OFF_R4);
  u16* sC = (u16*)smem;
  f32x16 acc[MI][2];
  zero_acc_t<MI>(acc);
  gemm_mm<MI>(acc, MRG + (size_t)m0 * 1024, 1024, WL + WO_OUT + (size_t)nt * 128 * 1024, 1024, 1024, smem);
  acc_foreach_t<MI>([&](int mi, int ni, int r, int row, int col) __attribute__((always_inline)) {
    sC[row * LDC + col] = f2bf(acc[mi][ni][r]);
  });
  tile_store_t<MI>(smem, O + (size_t)m0 * 1024 + nt * 128, 1024);
}
DEV void phase_p6(const Params& p, int l, unsigned char* smem) {
  const int nb = gridDim.x;
  int idx = vbid(), base = 0;
#pragma unroll 1
  for (; idx < base + 256 * 8; idx += nb) {
    const int t = idx - base;
    p6_tile<4>(p, l, (t >> 3) * 256, t & 7, smem);
  }
  base += 256 * 8;
#pragma unroll 1
  for (; idx < base + 4 * 8; idx += nb) {
    const int t = idx - base;
    p6_tile<2>(p, l, MP + (t >> 3) * 128, t & 7, smem);
  }
}

constexpr int SM_TOTAL = SM_GATE + 32768;
__global__ void __launch_bounds__(NT, 2) mega(Params p) {
  __shared__ __attribute__((aligned(16))) unsigned char smem[SM_TOTAL];
  cg::grid_group grid = cg::this_grid();
  __shared__ uint4 xb_words;
  if (threadIdx.x == 0) xb_words = make_uint4(0u, 0u, 0u, 0u);
#define PH(call)                                             \
  {                                                          \
    Params q = p;                                            \
    asm volatile("" : "+s"(q.ws), "+s"(q.out));              \
    call;                                                    \
  }
  PH(phase_prep(q, smem));
  grid.sync();
  (void)xcd_barrier_post((unsigned*)(p.ws + OFF_BAR), (volatile LAS unsigned*)&xb_words);
#define XBAR() xcd_barrier((unsigned*)(p.ws + OFF_BAR), (volatile LAS unsigned*)&xb_words)
  PH(phase_norm0(q));
  XBAR();
#pragma unroll 1
  for (int l = 0; l < 2; ++l) {
    PH(phase_gemm1(q, l, smem));
    XBAR();
    PH(phase_p2(q, l, smem));
    XBAR();
    PH(phase_p3(q, l, smem));
    XBAR();
    PH(phase_p4(q, l, smem));
    XBAR();
    PH(phase_p5(q, l, smem));
    XBAR();
    PH(phase_p6(q, l, smem));
    XBAR();
    PH(phase_final(q, l));
    if (l == 0) XBAR();
  }
}

extern "C" void kernel_launch(void* const* d_in, const int* in_sizes, int n_in, void* d_out, int out_size, void* d_ws,
                              size_t ws_size, hipStream_t stream) {
  static int grid_blocks = 0;
  if (!grid_blocks) {
    int dev = 0, cus = 0, per_cu = 0;
    hipGetDevice(&dev);
    hipDeviceGetAttribute(&cus, hipDeviceAttributeMultiprocessorCount, dev);
    hipOccupancyMaxActiveBlocksPerMultiprocessor(&per_cu, mega, NT, 0);
    if (per_cu > 2) per_cu = 2;
    grid_blocks = cus * per_cu;
  }
  if (ws_size < WS_NEED) {
    fprintf(stderr, "workspace too small: %zu < %zu\n", ws_size, (size_t)WS_NEED);
    return;
  }
  Params p{};
  const float** pp = (const float**)&p;
  for (int i = 0; i < 28; ++i) pp[i] = (const float*)d_in[i];
  p.out = (float*)d_out;
  p.ws = (unsigned char*)d_ws;
  void* args[] = {&p};
  hipError_t e = hipLaunchCooperativeKernel((void*)mega, dim3(grid_blocks), dim3(NT), args, 0, stream);
  if (e != hipSuccess) fprintf(stderr, "cooperative launch failed: %s (grid %d)\n", hipGetErrorString(e), grid_blocks);
}
```

```cpp
#include <hip/hip_runtime.h>
#include <hip/hip_cooperative_groups.h>
#include <cstdio>
namespace cg = cooperative_groups;

typedef unsigned short u16;
typedef __attribute__((ext_vector_type(8))) short bf16x8;
typedef __attribute__((ext_vector_type(16))) float f32x16;

#define DEV __device__ __forceinline__
#define NT 256

constexpr int MP = 65536, MS = 512, MT = 66048;
constexpr int IN_DIM = 6208;
constexpr float EPS = 1e-6f;
constexpr float QSCALE = 0.07216878364870322f * 1.4426950408889634f;

constexpr size_t SZ_ACT = (size_t)MT * 1024 * 2;
constexpr size_t OFF_H = 0;
constexpr size_t OFF_R1 = OFF_H + SZ_ACT;
constexpr size_t OFF_R2 = OFF_R1 + SZ_ACT;
constexpr size_t OFF_R3 = OFF_R2 + SZ_ACT;
constexpr size_t OFF_R4 = OFF_R3 + (size_t)MP * 1536 * 2;
constexpr size_t OFF_KPE = OFF_R4 + SZ_ACT;
constexpr size_t OFF_VT = OFF_KPE + (size_t)MT * 64 * 2;
constexpr size_t OFF_SKV = OFF_VT + (size_t)16 * 1024 * 4096 * 2;
constexpr size_t OFF_SVT = OFF_SKV + (size_t)32 * 2112 * 320 * 2;
constexpr size_t OFF_QS = OFF_SVT + (size_t)32 * 256 * 2112 * 2;
constexpr size_t OFF_OLAT = OFF_QS + (size_t)MS * 2560 * 2;
constexpr size_t OFF_MOD = OFF_OLAT + (size_t)MS * 2048 * 2;
constexpr size_t OFF_ROPE = OFF_MOD + (size_t)2 * 48 * 3072 * 4;
constexpr size_t OFF_CNT = OFF_ROPE + (size_t)4096 * 32 * 2 * 4;
constexpr size_t OFF_W = OFF_CNT + 256;
constexpr size_t WO_W1 = 0;
constexpr size_t WO_G = WO_W1 + (size_t)2176 * 1024;
constexpr size_t WO_QP = WO_G + (size_t)4096 * 1024;
constexpr size_t WO_QS = WO_QP + (size_t)1536 * 768;
constexpr size_t WO_UK = WO_QS + (size_t)2560 * 768;
constexpr size_t WO_UVS = WO_UK + 262144;
constexpr size_t WO_UVP = WO_UVS + 262144;
constexpr size_t WO_BA = WO_UVP + 262144;
constexpr size_t WO_BB = WO_BA + 1048576;
constexpr size_t WO_OUT = WO_BB + 1048576;
constexpr size_t WO_LA = WO_OUT + 1048576;
constexpr size_t WO_LX = WO_LA + 131072;
constexpr size_t W_LAYER = WO_LX + 131072;
constexpr size_t OFF_BAR = OFF_W + 2 * W_LAYER * 2;
constexpr size_t WS_NEED = OFF_BAR + 16384;

constexpr size_t OUT_YP = 0;
constexpr size_t OUT_YS = 67108864;
constexpr size_t OUT_CKVP = 67633152;
constexpr size_t OUT_KPEP = 101187584;
constexpr size_t OUT_CONVP = 109576192;
constexpr size_t OUT_LRUP = 109674496;
constexpr size_t OUT_CKVS = 109707264;
constexpr size_t OUT_KPES = 109969408;
constexpr size_t OUT_CONVS = 110034944;
constexpr size_t OUT_LRUS = 110231552;

struct Params {
  const float *x_p, *x_s, *c_p, *c_s, *cache_ckv, *cache_kpe, *state_conv, *state_lru;
  const float *ada_w, *ada_b, *pre_norm, *post_norm, *w_in, *conv_w, *conv_b, *lru_wa, *lru_ba, *lru_wx, *lru_bx;
  const float *lru_lambda, *q_norm, *w_q_up, *kv_norm, *w_uk, *w_uv, *w_ba, *w_bb, *w_out;
  float* out;
  unsigned char* ws;
};

DEV int TIDX() {
  int t = threadIdx.x;
  asm volatile("" : "+v"(t));
  return t;
}
typedef __attribute__((ext_vector_type(2))) float f32x2_t;
typedef __attribute__((ext_vector_type(2))) __bf16 bf16x2_t;
DEV unsigned pk2bf(float a, float b) {
  f32x2_t v = {a, b};
  bf16x2_t r = __builtin_convertvector(v, bf16x2_t);
  return __builtin_bit_cast(unsigned, r);
}
DEV u16 f2bf(float f) { return (u16)(pk2bf(f, 0.f) & 0xffffu); }
DEV float bf2f(u16 h) { return __uint_as_float(((unsigned)h) << 16); }
DEV float sigmoidf_(float x) { return 1.0f / (1.0f + __expf(-x)); }
DEV float siluf_(float x) { return x / (1.0f + __expf(-x)); }
DEV float wave_sum(float v) {
#pragma unroll
  for (int o = 32; o > 0; o >>= 1) v += __shfl_xor(v, o, 64);
  return v;
}
DEV int vbid() {
  const int b = blockIdx.x, n = gridDim.x;
  return ((n & 7) == 0) ? (b & 7) * (n >> 3) + (b >> 3) : b;
}
DEV int mod_row(int m) { return m < MP ? (m >> 12) : 16 + ((m - MP) >> 4); }
DEV int pos_of(int m) { return m < MP ? (m & 4095) : 2048 + ((m - MP) & 15); }

constexpr int LDT = 72;
#ifndef P5_DEPTH
#define P5_DEPTH 1
#endif
template <int SS, int DEPTH = 1>
DEV void gemm_main(f32x16 (&acc)[2][2], const u16* __restrict__ A, int lda, const u16* __restrict__ B, int ldb,
                   int K, unsigned char* smem) {
  u16* sA = (u16*)smem;
  u16* sB = sA + 128 * LDT;
  float* ss = (float*)(sB + 128 * LDT);
  const int tid = TIDX(), lane = tid & 63, w = tid >> 6, wm = w >> 1, wn = w & 1;
  const int srow = tid >> 3, scol = (tid & 7) * 8;
  const u16* ap = A + (size_t)srow * lda + scol;
  const u16* bp = B + (size_t)srow * ldb + scol;
  bf16x8 ra[DEPTH][4], rb[DEPTH][4];
  float ssq[4] = {0.f, 0.f, 0.f, 0.f};
  const int nk = K >> 6;
#pragma unroll
  for (int d = 0; d < DEPTH; ++d)
#pragma unroll
    for (int i = 0; i < 4; ++i) {
      ra[d][i] = *(const bf16x8*)(ap + d * 64 + (size_t)(32 * i) * lda);
      rb[d][i] = *(const bf16x8*)(bp + d * 64 + (size_t)(32 * i) * ldb);
    }
  ap += DEPTH * 64;
  bp += DEPTH * 64;
  const int fro = (lane & 31) * LDT + (lane >> 5) * 8;
#pragma unroll 1
  for (int kt = 0; kt < nk; kt += DEPTH) {
#pragma unroll
    for (int d = 0; d < DEPTH; ++d) {
      __syncthreads();
#pragma unroll
      for (int i = 0; i < 4; ++i) {
        *(bf16x8*)(sA + (srow + 32 * i) * LDT + scol) = ra[d][i];
        *(bf16x8*)(sB + (srow + 32 * i) * LDT + scol) = rb[d][i];
        if (SS) {
          bf16x8 v = (SS == 1) ? ra[d][i] : rb[d][i];
#pragma unroll
          for (int j = 0; j < 8; ++j) {
            float f = bf2f((u16)v[j]);
            ssq[i] += f * f;
          }
        }
      }
      __syncthreads();
      if (kt + d + DEPTH < nk) {
#pragma unroll
        for (int i = 0; i < 4; ++i) {
          ra[d][i] = *(const bf16x8*)(ap + (size_t)(32 * i) * lda);
          rb[d][i] = *(const bf16x8*)(bp + (size_t)(32 * i) * ldb);
        }
        ap += 64;
        bp += 64;
      }
#pragma unroll
      for (int ks = 0; ks < 4; ++ks) {
        bf16x8 af[2], bfr[2];
#pragma unroll
        for (int i = 0; i < 2; ++i) {
          af[i] = *(const bf16x8*)(sA + (wm * 64 + i * 32) * LDT + fro + ks * 16);
          bfr[i] = *(const bf16x8*)(sB + (wn * 64 + i * 32) * LDT + fro + ks * 16);
        }
        __builtin_amdgcn_s_setprio(1);
#pragma unroll
        for (int mi = 0; mi < 2; ++mi)
#pragma unroll
          for (int ni = 0; ni < 2; ++ni)
            acc[mi][ni] = __builtin_amdgcn_mfma_f32_32x32x16_bf16(af[mi], bfr[ni], acc[mi][ni], 0, 0, 0);
        __builtin_amdgcn_s_setprio(0);
      }
    }
  }
  if (SS) {
#pragma unroll
    for (int i = 0; i < 4; ++i) {
      float v = ssq[i];
      v += __shfl_xor(v, 1, 64);
      v += __shfl_xor(v, 2, 64);
      v += __shfl_xor(v, 4, 64);
      if ((tid & 7) == 0) ss[srow + 32 * i] = v;
    }
    __syncthreads();
  }
}
DEV void zero_acc(f32x16 (&acc)[2][2]) {
#pragma unroll
  for (int a = 0; a < 2; ++a)
#pragma unroll
    for (int b = 0; b < 2; ++b)
#pragma unroll
      for (int r = 0; r < 16; ++r) acc[a][b][r] = 0.f;
}
DEV float* gemm_ss(unsigned char* smem) { return (float*)(smem + 2 * 128 * LDT * 2); }

template <class F>
DEV void acc_foreach(F f) {
  const int tid_ = TIDX();
  const int lane = tid_ & 63, w = tid_ >> 6;
#pragma unroll
  for (int mi = 0; mi < 2; ++mi)
#pragma unroll
    for (int ni = 0; ni < 2; ++ni)
#pragma unroll
      for (int r = 0; r < 16; ++r)
        f(mi, ni, r, (w >> 1) * 64 + mi * 32 + (r & 3) + 8 * (r >> 2) + 4 * (lane >> 5), (w & 1) * 64 + ni * 32 + (lane & 31));
}
constexpr int LDC = 136;
DEV void tile_store(unsigned char* smem, u16* dst, size_t ldd) {
  const u16* sC = (const u16*)smem;
  __syncthreads();
  const int tid_ = TIDX();
#pragma unroll
  for (int i = 0; i < 8; ++i) {
    const int c = tid_ + 256 * i, row = c >> 4, cc = (c & 15) * 8;
    *(bf16x8*)(dst + (size_t)row * ldd + cc) = *(const bf16x8*)(sC + row * LDC + cc);
  }
}


template <int MI>
DEV void gemm_mm(f32x16 (&acc)[MI][2], const u16* __restrict__ A, int lda, const u16* __restrict__ B, int ldb, int K,
                 unsigned char* smem) {
  constexpr int BM = MI * 64;
  u16* sA = (u16*)smem;
  u16* sB = sA + BM * LDT;
  const int tid = TIDX(), lane = tid & 63, w = tid >> 6, wm = w >> 1, wn = w & 1;
  const int srow = tid >> 3, scol = (tid & 7) * 8;
  const u16* ap = A + (size_t)srow * lda + scol;
  const u16* bp = B + (size_t)srow * ldb + scol;
  bf16x8 ra[MI * 2], rb[4];
#pragma unroll
  for (int i = 0; i < MI * 2; ++i) ra[i] = *(const bf16x8*)(ap + (size_t)(32 * i) * lda);
#pragma unroll
  for (int i = 0; i < 4; ++i) rb[i] = *(const bf16x8*)(bp + (size_t)(32 * i) * ldb);
  const int nk = K >> 6;
  const int fro = (lane & 31) * LDT + (lane >> 5) * 8;
#pragma unroll 1
  for (int kt = 0; kt < nk; ++kt) {
    __syncthreads();
#pragma unroll
    for (int i = 0; i < MI * 2; ++i) *(bf16x8*)(sA + (srow + 32 * i) * LDT + scol) = ra[i];
#pragma unroll
    for (int i = 0; i < 4; ++i) *(bf16x8*)(sB + (srow + 32 * i) * LDT + scol) = rb[i];
    __syncthreads();
    if (kt + 1 < nk) {
      ap += 64;
      bp += 64;
#pragma unroll
      for (int i = 0; i < MI * 2; ++i) ra[i] = *(const bf16x8*)(ap + (size_t)(32 * i) * lda);
#pragma unroll
      for (int i = 0; i < 4; ++i) rb[i] = *(const bf16x8*)(bp + (size_t)(32 * i) * ldb);
    }
#pragma unroll
    for (int ks = 0; ks < 4; ++ks) {
      bf16x8 af[MI], bfr[2];
#pragma unroll
      for (int i = 0; i < MI; ++i) af[i] = *(const bf16x8*)(sA + (wm * (MI * 32) + i * 32) * LDT + fro + ks * 16);
#pragma unroll
      for (int i = 0; i < 2; ++i) bfr[i] = *(const bf16x8*)(sB + (wn * 64 + i * 32) * LDT + fro + ks * 16);
      __builtin_amdgcn_s_setprio(1);
#pragma unroll
      for (int mi = 0; mi < MI; ++mi)
#pragma unroll
        for (int ni = 0; ni < 2; ++ni)
          acc[mi][ni] = __builtin_amdgcn_mfma_f32_32x32x16_bf16(af[mi], bfr[ni], acc[mi][ni], 0, 0, 0);
      __builtin_amdgcn_s_setprio(0);
    }
  }
  __syncthreads();
}
template <int MI>
DEV void zero_acc_t(f32x16 (&acc)[MI][2]) {
#pragma unroll
  for (int a = 0; a < MI; ++a)
#pragma unroll
    for (int b = 0; b < 2; ++b)
#pragma unroll
      for (int r = 0; r < 16; ++r) acc[a][b][r] = 0.f;
}
template <int MI, class F>
DEV void acc_foreach_t(F f) {
  const int tid_ = TIDX();
  const int lane = tid_ & 63, w = tid_ >> 6;
#pragma unroll
  for (int mi = 0; mi < MI; ++mi)
#pragma unroll
    for (int ni = 0; ni < 2; ++ni)
#pragma unroll
      for (int r = 0; r < 16; ++r)
        f(mi, ni, r, (w >> 1) * (MI * 32) + mi * 32 + (r & 3) + 8 * (r >> 2) + 4 * (lane >> 5), (w & 1) * 64 + ni * 32 + (lane & 31));
}
template <int MI>
DEV void tile_load_t(unsigned char* smem, const u16* src, size_t lds_) {
  u16* sC = (u16*)smem;
  const int tid_ = TIDX();
#pragma unroll
  for (int i = 0; i < MI * 4; ++i) {
    const int c = tid_ + 256 * i, row = c >> 4, cc = (c & 15) * 8;
    *(bf16x8*)(sC + row * LDC + cc) = *(const bf16x8*)(src + (size_t)row * lds_ + cc);
  }
  __syncthreads();
}
template <int MI>
DEV void tile_store_t(unsigned char* smem, u16* dst, size_t ldd) {
  const u16* sC = (const u16*)smem;
  __syncthreads();
  const int tid_ = TIDX();
#pragma unroll
  for (int i = 0; i < MI * 4; ++i) {
    const int c = tid_ + 256 * i, row = c >> 4, cc = (c & 15) * 8;
    *(bf16x8*)(dst + (size_t)row * ldd + cc) = *(const bf16x8*)(sC + row * LDC + cc);
  }
}

#define XB_TMO      128
#define XB_XCNT(j)  (256  + 64 * (j))
#define XB_XSUB(j)  (1280 + 64 * (j))
#define XB_XGEN(j)  (2304 + 64 * (j))
#define XB_TOP      3328
#define XB_TOPGEN   3392
#define XCD_BAR_WORDS 3456
#define XB_SPIN_CAP (1u << 20)
#define LAS __attribute__((address_space(3)))
DEV unsigned xb_ld(unsigned* p) { return __hip_atomic_load(p, __ATOMIC_RELAXED, __HIP_MEMORY_SCOPE_AGENT); }
DEV unsigned xb_add(unsigned* p, unsigned v) { return __hip_atomic_fetch_add(p, v, __ATOMIC_RELAXED, __HIP_MEMORY_SCOPE_AGENT); }
DEV unsigned xb_xcc_id() { return (unsigned)__builtin_amdgcn_s_getreg((3 << 11) | 20) & 0xFu; }
#define XB_SPIN(cond, bar) do { unsigned _sp = 0; while (cond) { __builtin_amdgcn_s_sleep(1); \
    if ((++_sp & 255u) == 0u) { if (xb_ld(&(bar)[XB_TMO])) break; if (_sp > XB_SPIN_CAP) { atomicAdd(&(bar)[XB_TMO], 1u); break; } } } } while (0)
struct XcdBarrier {
  unsigned* bar;
  unsigned x;
  volatile LAS unsigned* st;
};
DEV XcdBarrier xcd_barrier_post(unsigned* bar, volatile LAS unsigned* st) {
  XcdBarrier b;
  b.bar = bar;
  b.x = xb_xcc_id();
  b.st = st;
  if (threadIdx.x == 0) (void)xb_add(&bar[XB_XCNT(b.x)], 1u);
  return b;
}
DEV void xcd_barrier_complete(unsigned* bar, unsigned x, unsigned& nloc, unsigned& nx) {
  const unsigned G = gridDim.x * gridDim.y * gridDim.z;
  unsigned sum, cnt, mine, sp = 0u;
  for (;;) {
    sum = 0u; cnt = 0u; mine = 0u;
#pragma unroll
    for (unsigned j = 0; j < 16; ++j) {
      const unsigned c = xb_ld(&bar[XB_XCNT(j)]);
      sum += c;
      cnt += (c > 0u) ? 1u : 0u;
      mine = (j == x) ? c : mine;
    }
    if (sum == G) break;
    __builtin_amdgcn_s_sleep(1);
    if ((++sp & 255u) == 0u) {
      if (xb_ld(&bar[XB_TMO])) break;
      if (sp > XB_SPIN_CAP) { atomicAdd(&bar[XB_TMO], 1u); break; }
    }
  }
  nloc = mine > 0u ? mine : 1u;
  nx = cnt > 0u ? cnt : 1u;
}
DEV void xcd_barrier(unsigned* bar_, volatile LAS unsigned* st_) {
  asm volatile("s_waitcnt vmcnt(0)" ::: "memory");
  __syncthreads();
  if (threadIdx.x == 0) {
    XcdBarrier b;
    b.bar = bar_;
    b.x = xb_xcc_id();
    b.st = st_;
    unsigned* bar = b.bar;
    __builtin_amdgcn_s_waitcnt(0);
    unsigned nloc = b.st[0], nx = b.st[1];
    if (nloc == 0u) {
      xcd_barrier_complete(bar, b.x, nloc, nx);
      b.st[0] = nloc;
      b.st[1] = nx;
    }
    const unsigned old = xb_add(&bar[XB_XSUB(b.x)], 1u);
    const unsigned gen = old / nloc;
    if (old + 1u == (gen + 1u) * nloc) {
      __builtin_amdgcn_fence(__ATOMIC_RELEASE, "agent");
      asm volatile("s_waitcnt vmcnt(0)" ::: "memory");
      const unsigned og = xb_add(&bar[XB_TOP], 1u);
      const unsigned tg = og / nx;
      if (og + 1u == (tg + 1u) * nx) xb_add(&bar[XB_TOPGEN], 1u);
      else XB_SPIN(xb_ld(&bar[XB_TOPGEN]) == tg, bar);
      __builtin_amdgcn_fence(__ATOMIC_ACQUIRE, "agent");
      xb_add(&bar[XB_XGEN(b.x)], 1u);
      asm volatile("s_waitcnt vmcnt(0)" ::: "memory");
    } else {
      XB_SPIN(xb_ld(&bar[XB_XGEN(b.x)]) == gen, bar);
      __builtin_amdgcn_fence(__ATOMIC_ACQUIRE, "agent");
      asm volatile("s_waitcnt vmcnt(0)" ::: "memory");
    }
  }
  __syncthreads();
}

DEV void transpose_tile(const float* __restrict__ src, int lds_, u16* __restrict__ dst, int ldd, const float* scale,
                        int k0, int n0, unsigned char* smem) {
  float* s = (float*)smem;
  const int tid = TIDX();
  __syncthreads();
  {
    const int n = tid & 63, kq = tid >> 6;
#pragma unroll 4
    for (int i = 0; i < 16; ++i) {
      int kk = kq * 16 + i;
      s[kk * 65 + n] = src[(size_t)(k0 + kk) * lds_ + n0 + n];
    }
  }
  __syncthreads();
  {
    const int k = tid & 63, nq = tid >> 6;
    const float sc = scale ? scale[k0 + k] : 1.0f;
#pragma unroll 4
    for (int i = 0; i < 16; ++i) {
      int n = nq * 16 + i;
      dst[(size_t)(n0 + n) * ldd + k0 + k] = f2bf(s[k * 65 + n] * sc);
    }
  }
}

DEV void qlat_tile(const float* __restrict__ wq, const float* __restrict__ wuk, const float* __restrict__ g,
                   u16* __restrict__ dst, int h, int r0, int k0, unsigned char* smem) {
  float* sQ = (float*)smem;
  float* sU = sQ + 64 * 65;
  const int tid = TIDX();
  float acc[16];
#pragma unroll
  for (int i = 0; i < 16; ++i) acc[i] = 0.f;
  for (int nh = 0; nh < 2; ++nh) {
    __syncthreads();
    {
      const int n = tid & 63, q = tid >> 6;
      for (int i = 0; i < 16; ++i) {
        int rr = q * 16 + i;
        sQ[rr * 65 + n] = wq[(size_t)(k0 + rr) * 1536 + h * 192 + nh * 64 + n];
        sU[rr * 65 + n] = wuk[(size_t)(r0 + rr) * 1024 + h * 128 + nh * 64 + n];
      }
    }
    __syncthreads();
    const int k = tid & 63, rq = tid >> 6;
    for (int n = 0; n < 64; ++n) {
      float qv = sQ[k * 65 + n];
#pragma unroll
      for (int i = 0; i < 16; ++i) acc[i] += qv * sU[(rq * 16 + i) * 65 + n];
    }
  }
  const int k = tid & 63, rq = tid >> 6;
  const float sc = g[k0 + k];
#pragma unroll
  for (int i = 0; i < 16; ++i) dst[(size_t)(h * 320 + r0 + rq * 16 + i) * 768 + k0 + k] = f2bf(acc[i] * sc);
}

DEV void mod_item(const Params& p, int item, unsigned char* smem) {
  const int l = item / 48, cg_ = item % 48;
  float* sc = (float*)smem;
  float* red = sc + 48 * 256;
  (void)red;
  const int tid = TIDX(), col = tid & 63, kq = tid >> 6;
  const float* W = p.ada_w + (size_t)l * 1024 * 3072 + cg_ * 64 + col;
  float acc[48];
#pragma unroll
  for (int b = 0; b < 48; ++b) acc[b] = 0.f;
  for (int kc = 0; kc < 4; ++kc) {
    __syncthreads();
    for (int e = tid; e < 48 * 256; e += NT) {
      int b = e >> 8, k = e & 255;
      float c = b < 16 ? p.c_p[b * 1024 + kc * 256 + k] : p.c_s[(b - 16) * 1024 + kc * 256 + k];
      sc[e] = siluf_(c);
    }
    __syncthreads();
#pragma unroll 1
    for (int i0 = 0; i0 < 64; i0 += 8) {
      float wv[8];
#pragma unroll
      for (int i = 0; i < 8; ++i) wv[i] = W[(size_t)(kc * 256 + kq * 64 + i0 + i) * 3072];
#pragma unroll
      for (int i = 0; i < 8; ++i) {
        const int k = kq * 64 + i0 + i;
#pragma unroll
        for (int b = 0; b < 48; ++b) acc[b] += sc[b * 256 + k] * wv[i];
      }
    }
  }
  __syncthreads();
#pragma unroll
  for (int b = 0; b < 48; ++b) sc[(kq * 48 + b) * 64 + col] = acc[b];
  __syncthreads();
  float* MOD = (float*)(p.ws + OFF_MOD);
  for (int e = tid; e < 48 * 64; e += NT) {
    int b = e >> 6, c = e & 63;
    float v = sc[(0 * 48 + b) * 64 + c] + sc[(1 * 48 + b) * 64 + c] + sc[(2 * 48 + b) * 64 + c] + sc[(3 * 48 + b) * 64 + c];
    int gc = cg_ * 64 + c;
    MOD[((size_t)l * 48 + b) * 3072 + gc] = v + p.ada_b[l * 3072 + gc];
  }
}

DEV void phase_prep(const Params& p, unsigned char* smem) {
  const int tid = TIDX();
  if (blockIdx.x == 0) {
    if (tid < 64) ((unsigned*)(p.ws + OFF_CNT))[tid] = 0u;
    for (int e = tid; e < XCD_BAR_WORDS; e += NT) ((unsigned*)(p.ws + OFF_BAR))[e] = 0u;
  }
  const bool split = gridDim.x >= 192;
  if (split && blockIdx.x < 96) {
    mod_item(p, blockIdx.x, smem);
    return;
  }
  const int nb = split ? (int)gridDim.x - 96 : (int)gridDim.x;
  int idx = split ? (int)blockIdx.x - 96 : (int)blockIdx.x, base = 0;
  if (!split) {
    for (; idx < base + 96; idx += nb) mod_item(p, idx - base, smem);
    base += 96;
  }
  for (int l = 0; l < 2; ++l) {
    u16* WL = (u16*)(p.ws + OFF_W) + (size_t)l * W_LAYER;
    const float* win = p.w_in + (size_t)l * 1024 * IN_DIM;
#define TJOB(SRC, LDS_, KK, NN, DST, LDD, SCALE)                                     \
  {                                                                                  \
    const int nkt = (KK) / 64, ntl = nkt * ((NN) / 64);                              \
    for (; idx < base + ntl; idx += nb) {                                            \
      int t = idx - base;                                                            \
      transpose_tile((SRC), (LDS_), (DST), (LDD), (SCALE), (t % nkt) * 64, (t / nkt) * 64, smem); \
    }                                                                                \
    base += ntl;                                                                     \
  }
    TJOB(win, IN_DIM, 1024, 1024, WL + WO_W1, 1024, nullptr);
    TJOB(win + 2048, IN_DIM, 1024, 1088, WL + WO_W1 + (size_t)1024 * 1024, 1024, nullptr);
    TJOB(win + 1024, IN_DIM, 1024, 1024, WL + WO_G, 1024, nullptr);
    TJOB(win + 3136, IN_DIM, 1024, 3072, WL + WO_G + (size_t)1024 * 1024, 1024, nullptr);
    TJOB(p.w_q_up + (size_t)l * 768 * 1536, 1536, 768, 1536, WL + WO_QP, 768, p.q_norm + l * 768);
    for (int h = 0; h < 8; ++h)
      TJOB(p.w_q_up + (size_t)l * 768 * 1536 + h * 192 + 128, 1536, 768, 64, WL + WO_QS + (size_t)(h * 320 + 256) * 768, 768,
           p.q_norm + l * 768);
    TJOB(p.w_uk + (size_t)l * 262144, 1024, 256, 1024, WL + WO_UK, 256, p.kv_norm + l * 256);
    TJOB(p.w_uv + (size_t)l * 262144, 1024, 256, 1024, WL + WO_UVS, 256, p.kv_norm + l * 256);
    TJOB(p.w_uv + (size_t)l * 262144, 1024, 256, 1024, WL + WO_UVP, 256, nullptr);
    TJOB(p.w_ba + (size_t)l * 1048576, 1024, 1024, 1024, WL + WO_BA, 1024, nullptr);
    TJOB(p.w_bb + (size_t)l * 1048576, 1024, 1024, 1024, WL + WO_BB, 1024, nullptr);
    TJOB(p.w_out + (size_t)l * 1048576, 1024, 1024, 1024, WL + WO_OUT, 1024, nullptr);
    for (int b8 = 0; b8 < 8; ++b8) {
      TJOB(p.lru_wa + (size_t)l * 131072 + b8 * 16384, 128, 128, 128, WL + WO_LA + b8 * 16384, 128, nullptr);
      TJOB(p.lru_wx + (size_t)l * 131072 + b8 * 16384, 128, 128, 128, WL + WO_LX + b8 * 16384, 128, nullptr);
    }
    for (; idx < base + 384; idx += nb) {
      int t = idx - base;
      int h = t / 48, rt = (t % 48) / 12, kt = t % 12;
      qlat_tile(p.w_q_up + (size_t)l * 768 * 1536, p.w_uk + (size_t)l * 262144, p.q_norm + l * 768, WL + WO_QS, h,
                rt * 64, kt * 64, smem);
    }
    base += 384;
    for (; idx < base + 16; idx += nb) {
      int t = idx - base;
      u16* d = WL + WO_W1 + (size_t)2112 * 1024 + t * 4096;
      for (int e = tid; e < 4096; e += NT) d[e] = 0;
    }
    base += 16;
  }
  float* ROPE = (float*)(p.ws + OFF_ROPE);
  for (; idx < base + 512; idx += nb) {
    int e = (idx - base) * 256 + tid;
    int pos = e >> 5, j = e & 31;
    float inv = exp2f(-(float)j * (13.287712379549449f / 32.0f));
    float ang = (float)pos * inv;
    ROPE[2 * e] = cosf(ang);
    ROPE[2 * e + 1] = sinf(ang);
  }
  base += 512;
}

DEV void norm_row(const Params& p, int l, int m, const float (&xv)[16], int lane) {
  float ss = 0.f;
#pragma unroll
  for (int i = 0; i < 16; ++i) ss += xv[i] * xv[i];
  ss = wave_sum(ss);
  const float rstd = rsqrtf(ss * (1.0f / 1024.0f) + EPS);
  const float* MOD = (const float*)(p.ws + OFF_MOD) + ((size_t)l * 48 + mod_row(m)) * 3072;
  u16* H = (u16*)(p.ws + OFF_H) + (size_t)m * 1024;
#pragma unroll
  for (int i = 0; i < 4; ++i) {
    int c = i * 256 + lane * 4;
    float4 g = *(const float4*)(p.pre_norm + l * 1024 + c);
    float4 sh = *(const float4*)(MOD + c);
    float4 sc = *(const float4*)(MOD + 1024 + c);
    ushort4 o;
    o.x = f2bf(xv[i * 4 + 0] * rstd * g.x * (1.f + sc.x) + sh.x);
    o.y = f2bf(xv[i * 4 + 1] * rstd * g.y * (1.f + sc.y) + sh.y);
    o.z = f2bf(xv[i * 4 + 2] * rstd * g.z * (1.f + sc.z) + sh.z);
    o.w = f2bf(xv[i * 4 + 3] * rstd * g.w * (1.f + sc.w) + sh.w);
    *(ushort4*)(H + c) = o;
  }
}

DEV void phase_norm0(const Params& p) {
  const int tid_ = TIDX();
  const int lane = tid_ & 63, wv = tid_ >> 6;
  for (int m = blockIdx.x * 4 + wv; m < MT; m += gridDim.x * 4) {
    const float* x = m < MP ? p.x_p + (size_t)m * 1024 : p.x_s + (size_t)(m - MP) * 1024;
    float xv[16];
#pragma unroll
    for (int i = 0; i < 4; ++i) {
      float4 v = *(const float4*)(x + i * 256 + lane * 4);
      xv[i * 4] = v.x; xv[i * 4 + 1] = v.y; xv[i * 4 + 2] = v.z; xv[i * 4 + 3] = v.w;
    }
    norm_row(p, 0, m, xv, lane);
  }
}

DEV void phase_final(const Params& p, int l) {
  const int tid_ = TIDX();
  const int lane = tid_ & 63, wv = tid_ >> 6;
  const u16* O = (const u16*)(p.ws + OFF_R4);
  for (int m = blockIdx.x * 4 + wv; m < MT; m += gridDim.x * 4) {
    float* y = m < MP ? p.out + OUT_YP + (size_t)m * 1024 : p.out + OUT_YS + (size_t)(m - MP) * 1024;
    const float* x = (l == 0) ? (m < MP ? p.x_p + (size_t)m * 1024 : p.x_s + (size_t)(m - MP) * 1024) : y;
    float xv[16], ov[16];
    float ss = 0.f;
#pragma unroll
    for (int i = 0; i < 4; ++i) {
      int c = i * 256 + lane * 4;
      float4 v = *(const float4*)(x + c);
      xv[i * 4] = v.x; xv[i * 4 + 1] = v.y; xv[i * 4 + 2] = v.z; xv[i * 4 + 3] = v.w;
      ushort4 o = *(const ushort4*)(O + (size_t)m * 1024 + c);
      ov[i * 4] = bf2f(o.x); ov[i * 4 + 1] = bf2f(o.y); ov[i * 4 + 2] = bf2f(o.z); ov[i * 4 + 3] = bf2f(o.w);
    }
#pragma unroll
    for (int i = 0; i < 16; ++i) ss += ov[i] * ov[i];
    ss = wave_sum(ss);
    const float rstd = rsqrtf(ss * (1.0f / 1024.0f) + EPS);
    const float* MOD = (const float*)(p.ws + OFF_MOD) + ((size_t)l * 48 + mod_row(m)) * 3072 + 2048;
#pragma unroll
    for (int i = 0; i < 4; ++i) {
      int c = i * 256 + lane * 4;
      float4 g = *(const float4*)(p.post_norm + l * 1024 + c);
      float4 gt = *(const float4*)(MOD + c);
      xv[i * 4 + 0] += gt.x * ov[i * 4 + 0] * rstd * g.x;
      xv[i * 4 + 1] += gt.y * ov[i * 4 + 1] * rstd * g.y;
      xv[i * 4 + 2] += gt.z * ov[i * 4 + 2] * rstd * g.z;
      xv[i * 4 + 3] += gt.w * ov[i * 4 + 3] * rstd * g.w;
      *(float4*)(y + c) = make_float4(xv[i * 4], xv[i * 4 + 1], xv[i * 4 + 2], xv[i * 4 + 3]);
    }
    if (l == 0) norm_row(p, 1, m, xv, lane);
  }
}

template <int MI>
DEV void gemm1_tile(const Params& p, int l, int m0, int nt, unsigned char* smem) {
  constexpr int BM = MI * 64;
  const u16* H = (const u16*)(p.ws + OFF_H);
  const u16* W1 = (const u16*)(p.ws + OFF_W) + (size_t)l * W_LAYER + WO_W1;
  u16* XA = (u16*)(p.ws + OFF_R1);
  u16* CQ = (u16*)(p.ws + OFF_R2);
  u16* CKVR = CQ + (size_t)MT * 768;
  u16* sC = (u16*)smem;
  f32x16 acc[MI][2];
  zero_acc_t<MI>(acc);
  gemm_mm<MI>(acc, H + (size_t)m0 * 1024, 1024, W1 + (size_t)nt * 128 * 1024, 1024, 1024, smem);
  if (nt < 14) {
    acc_foreach_t<MI>([&](int mi, int ni, int r, int row, int col) __attribute__((always_inline)) {
      sC[row * LDC + col] = f2bf(acc[mi][ni][r]);
    });
    if (nt < 8) tile_store_t<MI>(smem, XA + (size_t)m0 * 1024 + nt * 128, 1024);
    else tile_store_t<MI>(smem, CQ + (size_t)m0 * 768 + (nt - 8) * 128, 768);
    if (nt < 8 && (m0 >= MP || ((m0 + BM) & 4095) == 0)) {
      acc_foreach_t<MI>([&](int mi, int ni, int r, int row, int col) __attribute__((always_inline)) {
        const int m = m0 + row, n = nt * 128 + col;
        const float v = acc[mi][ni][r];
        if (m < MP) {
          int j = (m & 4095) - 4093;
          if (j >= 0) p.out[OUT_CONVP + ((size_t)(l * 16 + (m >> 12)) * 3 + j) * 1024 + n] = v;
        } else {
          int j = ((m - MP) & 15) - 13;
          if (j >= 0) p.out[OUT_CONVS + ((size_t)(l * 32 + ((m - MP) >> 4)) * 3 + j) * 1024 + n] = v;
        }
      });
    }
  } else if (nt < 16) {
    float* ob = m0 < MP ? p.out + OUT_CKVP + ((size_t)l * MP + m0) * 256 + (nt - 14) * 128
                        : p.out + OUT_CKVS + ((size_t)l * MS + (m0 - MP)) * 256 + (nt - 14) * 128;
    acc_foreach_t<MI>([&](int mi, int ni, int r, int row, int col) __attribute__((always_inline)) {
      const float v = acc[mi][ni][r];
      sC[row * LDC + col] = f2bf(v);
      ob[(size_t)row * 256 + col] = v;
    });
    tile_store_t<MI>(smem, CKVR + (size_t)m0 * 256 + (nt - 14) * 128, 256);
  } else {
    float* ob = m0 < MP ? p.out + OUT_KPEP + ((size_t)l * MP + m0) * 64 : p.out + OUT_KPES + ((size_t)l * MS + (m0 - MP)) * 64;
    acc_foreach_t<MI>([&](int mi, int ni, int r, int row, int col) __attribute__((always_inline)) {
      if (col < 64) ob[(size_t)row * 64 + col] = acc[mi][ni][r];
    });
  }
}
DEV void phase_gemm1(const Params& p, int l, unsigned char* smem) {
  const int nb = gridDim.x;
  int idx = vbid(), base = 0;
#pragma unroll 1
  for (; idx < base + 256 * 17; idx += nb) {
    const int t = idx - base;
    gemm1_tile<4>(p, l, (t / 17) * 256, t % 17, smem);
  }
  base += 256 * 17;
#pragma unroll 1
  for (; idx < base + 4 * 17; idx += nb) {
    const int t = idx - base;
    gemm1_tile<2>(p, l, MP + (t / 17) * 128, t % 17, smem);
  }
}

DEV void post1_rows(const Params& p, int l, int item) {
  const int tid_ = TIDX();
  const int lane = tid_ & 63, wv = tid_ >> 6;
  const float* ROPE = (const float*)(p.ws + OFF_ROPE);
  float4 v[2];
  float kx[2];
  float2 cs[2];
  float* ckvp[2];
  float* kpep[2];
#pragma unroll
  for (int u = 0; u < 2; ++u) {
    const int m = item * 8 + wv * 2 + u;
    ckvp[u] = m < MP ? p.out + OUT_CKVP + ((size_t)l * MP + m) * 256 : p.out + OUT_CKVS + ((size_t)l * MS + (m - MP)) * 256;
    kpep[u] = m < MP ? p.out + OUT_KPEP + ((size_t)l * MP + m) * 64 : p.out + OUT_KPES + ((size_t)l * MS + (m - MP)) * 64;
    v[u] = *(const float4*)(ckvp[u] + lane * 4);
    kx[u] = kpep[u][lane];
    cs[u] = *(const float2*)(ROPE + ((size_t)pos_of(m) * 32 + (lane & 31)) * 2);
  }
  const float4 g = *(const float4*)(p.kv_norm + l * 256 + lane * 4);
#pragma unroll
  for (int u = 0; u < 2; ++u) {
    const int m = item * 8 + wv * 2 + u;
    const float ss = wave_sum(v[u].x * v[u].x + v[u].y * v[u].y + v[u].z * v[u].z + v[u].w * v[u].w);
    const float rstd = rsqrtf(ss * (1.0f / 256.0f) + EPS);
    float4 o4 = v[u];
    o4.x *= rstd * g.x; o4.y *= rstd * g.y; o4.z *= rstd * g.z; o4.w *= rstd * g.w;
    *(float4*)(ckvp[u] + lane * 4) = o4;
    const float other = __shfl_xor(kx[u], 32, 64);
    const float c = cs[u].x, sn = cs[u].y;
    const float ro = (lane < 32) ? (kx[u] * c - other * sn) : (other * sn + kx[u] * c);
    kpep[u][lane] = ro;
    if (m < MP) {
      u16* KPE = (u16*)(p.ws + OFF_KPE) + (size_t)m * 64;
      KPE[lane] = f2bf(ro);
    } else {
      const int b = (m - MP) >> 4, t = (m - MP) & 15;
      u16* SKV = (u16*)(p.ws + OFF_SKV) + ((size_t)b * 2112 + 2048 + t) * 320;
      u16* SVT = (u16*)(p.ws + OFF_SVT) + (size_t)b * 256 * 2112 + 2048 + t;
      ushort4 o;
      o.x = f2bf(o4.x); o.y = f2bf(o4.y); o.z = f2bf(o4.z); o.w = f2bf(o4.w);
      *(ushort4*)(SKV + lane * 4) = o;
      SVT[(size_t)(lane * 4 + 0) * 2112] = o.x;
      SVT[(size_t)(lane * 4 + 1) * 2112] = o.y;
      SVT[(size_t)(lane * 4 + 2) * 2112] = o.z;
      SVT[(size_t)(lane * 4 + 3) * 2112] = o.w;
      SKV[256 + lane] = f2bf(ro);
    }
  }
}

DEV void cache_item(const Params& p, int l, int item, unsigned char* smem) {
  const int tid = TIDX();
  const int b = item / 33, kt = item % 33;
  u16* SKV = (u16*)(p.ws + OFF_SKV) + (size_t)b * 2112 * 320;
  u16* SVT = (u16*)(p.ws + OFF_SVT) + (size_t)b * 256 * 2112;
  if (kt == 32) {
    for (int e = tid; e < 48 * 320; e += NT) SKV[(size_t)2064 * 320 + e] = 0;
    for (int e = tid; e < 256 * 48; e += NT) SVT[(size_t)(e / 48) * 2112 + 2064 + (e % 48)] = 0;
    return;
  }
  float* s = (float*)smem;
  const float* src = p.cache_ckv + (((size_t)l * 32 + b) * 2048 + kt * 64) * 256;
  const float* srck = p.cache_kpe + (((size_t)l * 32 + b) * 2048 + kt * 64) * 64;
  for (int dh = 0; dh < 2; ++dh) {
    __syncthreads();
    for (int e = tid; e < 64 * 128; e += NT) {
      int key = e >> 7, d = e & 127;
      float v = src[(size_t)key * 256 + dh * 128 + d];
      s[key * 129 + d] = v;
      SKV[(size_t)(kt * 64 + key) * 320 + dh * 128 + d] = f2bf(v);
    }
    __syncthreads();
    const int k = tid & 63, dq = tid >> 6;
    for (int i = 0; i < 32; ++i) {
      int d = dq * 32 + i;
      SVT[(size_t)(dh * 128 + d) * 2112 + kt * 64 + k] = f2bf(s[k * 129 + d]);
    }
  }
  for (int e = tid; e < 64 * 64; e += NT) {
    int key = e >> 6, d = e & 63;
    SKV[(size_t)(kt * 64 + key) * 320 + 256 + d] = f2bf(srck[(size_t)key * 64 + d]);
  }
}

DEV void phase_p2(const Params& p, int l, unsigned char* smem) {
  const int tid = TIDX(), lane = tid & 63, w = tid >> 6;
  const int nb = gridDim.x;
  const u16* WL = (const u16*)(p.ws + OFF_W) + (size_t)l * W_LAYER;
  const u16* CQ = (const u16*)(p.ws + OFF_R2);
  const u16* CKVR = CQ + (size_t)MT * 768;
  u16* Q = (u16*)(p.ws + OFF_R3);
  u16* QS = (u16*)(p.ws + OFF_QS);
  u16* Kb = (u16*)(p.ws + OFF_R4);
  u16* VT = (u16*)(p.ws + OFF_VT);
  const float* ROPE = (const float*)(p.ws + OFF_ROPE);
  float* ss = gemm_ss(smem);
  int idx = vbid(), base = 0;
  const int nq = 512 * 12 + 4 * 20;
  for (; idx < base + nq; idx += nb) {
    int t = idx - base;
    int mt, nt;
    const u16* Wt;
    bool samp = t >= 512 * 12;
    if (!samp) { mt = t / 12; nt = t % 12; Wt = WL + WO_QP; }
    else { t -= 512 * 12; mt = 512 + t / 20; nt = t % 20; Wt = WL + WO_QS; }
    f32x16 acc[2][2];
    zero_acc(acc);
    gemm_main<1>(acc, CQ + (size_t)mt * 128 * 768, 768, Wt + (size_t)nt * 128 * 768, 768, 768, smem);
    const int g = nt * 2 + (w & 1);
    const bool rope = samp ? (g % 5 == 4) : (g % 3 == 2);
    u16* sC = (u16*)smem;
#pragma unroll
    for (int mi = 0; mi < 2; ++mi)
#pragma unroll
      for (int r = 0; r < 16; ++r) {
        const int row = (w >> 1) * 64 + mi * 32 + (r & 3) + 8 * (r >> 2) + 4 * (lane >> 5);
        const int m = mt * 128 + row;
        const float rs = rsqrtf(ss[row] * (1.0f / 768.0f) + EPS) * QSCALE;
        float v0 = acc[mi][0][r] * rs, v1 = acc[mi][1][r] * rs;
        if (rope) {
          const int pos = pos_of(m);
          const float c = ROPE[(pos * 32 + (lane & 31)) * 2], s = ROPE[(pos * 32 + (lane & 31)) * 2 + 1];
          const float a = v0 * c - v1 * s, b = v0 * s + v1 * c;
          v0 = a; v1 = b;
        }
        const int col = (w & 1) * 64 + (lane & 31);
        sC[row * LDC + col] = f2bf(v0);
        sC[row * LDC + col + 32] = f2bf(v1);
      }
    if (!samp) tile_store(smem, Q + (size_t)mt * 128 * 1536 + nt * 128, 1536);
    else tile_store(smem, QS + (size_t)(mt - 512) * 128 * 2560 + nt * 128, 2560);
  }
  base += nq;
  for (; idx < base + 4096; idx += nb) {
    int t = idx - base;
    int mt = t >> 3, nt = t & 7;
    f32x16 acc[2][2];
    zero_acc(acc);
    gemm_main<1, 2>(acc, CKVR + (size_t)mt * 128 * 256, 256, WL + WO_UK + (size_t)nt * 128 * 256, 256, 256, smem);
    {
      u16* sC = (u16*)smem;
      acc_foreach([&](int mi, int ni, int r, int row, int col) __attribute__((always_inline)) {
        const float rs = rsqrtf(ss[row] * (1.0f / 256.0f) + EPS);
        sC[row * LDC + col] = f2bf(acc[mi][ni][r] * rs);
      });
      tile_store(smem, Kb + (size_t)mt * 128 * 1024 + nt * 128, 1024);
    }
  }
  base += 4096;
  for (; idx < base + 4096; idx += nb) {
    int t = idx - base;
    int b = t >> 8, mt = (t >> 5) & 7, nt = t & 31;
    f32x16 acc[2][2];
    zero_acc(acc);
    gemm_main<2, 2>(acc, WL + WO_UVS + (size_t)mt * 128 * 256, 256, CKVR + ((size_t)b * 4096 + nt * 128) * 256, 256, 256, smem);
    {
      u16* sC = (u16*)smem;
      acc_foreach([&](int mi, int ni, int r, int row, int col) __attribute__((always_inline)) {
        const float rs = rsqrtf(ss[col] * (1.0f / 256.0f) + EPS);
        sC[row * LDC + col] = f2bf(acc[mi][ni][r] * rs);
      });
      tile_store(smem, VT + ((size_t)b * 1024 + mt * 128) * 4096 + nt * 128, 4096);
    }
  }
  base += 4096;
  for (; idx < base + MT / 8; idx += nb) post1_rows(p, l, idx - base);
  base += MT / 8;
  for (; idx < base + 32 * 33; idx += nb) cache_item(p, l, idx - base, smem);
  base += 32 * 33;
}

#ifndef ATT_PF
#define ATT_PF true
#endif
template <int DK, bool PF>
DEV void attn_item(const u16* __restrict__ qrow, const u16* __restrict__ ka, int ldka, const u16* __restrict__ kb, int ldkb,
                   const u16* __restrict__ vt, int ldvt, int ntiles, int my_tiles, int kvlen, u16* orow,
                   unsigned char* smem) {
  constexpr int DKA = DK - 64, KST = DK + 8, VST = 68;
  u16* sK = (u16*)smem;
  u16* sV = sK + 64 * KST;
  const int tid = TIDX(), lane = tid & 63, hh = lane >> 5, l31 = lane & 31;
  constexpr bool QREG = (DK <= 192);
  bf16x8 qf[DK / 16];
  if (QREG) {
#pragma unroll
    for (int ks = 0; ks < DK / 16; ++ks) qf[ks] = *(const bf16x8*)(qrow + ks * 16 + hh * 8);
  }
  f32x16 o[4];
#pragma unroll
  for (int d = 0; d < 4; ++d)
#pragma unroll
    for (int r = 0; r < 16; ++r) o[d][r] = 0.f;
  float mrun = -1e30f, lrun = 0.f;
  constexpr int CA = DKA / 32;
  bf16x8 rk[CA + 2], rv[4];
  const int skey = tid >> 2, sq = tid & 3;
  const u16* gka = ka + (size_t)skey * ldka + sq * CA * 8;
  const u16* gkb = kb + (size_t)skey * ldkb + sq * 16;
  const u16* gv = vt + (size_t)(tid >> 1) * ldvt + (tid & 1) * 32;
  u16* lka = sK + skey * KST + sq * CA * 8;
  u16* lkb = sK + skey * KST + DKA + sq * 16;
  u16* lv = sV + (tid >> 1) * VST + (tid & 1) * 32;
  auto load_tile = [&](int t) __attribute__((always_inline)) {
    const size_t ko = (size_t)t * 64;
#pragma unroll
    for (int i = 0; i < CA; ++i) rk[i] = *(const bf16x8*)(gka + ko * ldka + i * 8);
#pragma unroll
    for (int i = 0; i < 2; ++i) rk[CA + i] = *(const bf16x8*)(gkb + ko * ldkb + i * 8);
#pragma unroll
    for (int i = 0; i < 4; ++i) rv[i] = *(const bf16x8*)(gv + ko + i * 8);
  };
  auto store_tile = [&]() __attribute__((always_inline)) {
#pragma unroll
    for (int i = 0; i < CA; ++i) *(bf16x8*)(lka + i * 8) = rk[i];
#pragma unroll
    for (int i = 0; i < 2; ++i) *(bf16x8*)(lkb + i * 8) = rk[CA + i];
#pragma unroll
    for (int i = 0; i < 4; ++i) {
      union { bf16x8 v; uint2 u[2]; } cv;
      cv.v = rv[i];
      *(uint2*)(lv + i * 8) = cv.u[0];
      *(uint2*)(lv + i * 8 + 4) = cv.u[1];
    }
  };
  if (PF) load_tile(0);
#pragma unroll 1
  for (int t = 0; t < ntiles; ++t) {
    __syncthreads();
    if (!PF) load_tile(t);
    store_tile();
    __syncthreads();
    if (PF && t + 1 < ntiles) load_tile(t + 1);
    if (t < my_tiles) {
      const u16* qp = qrow + hh * 8;
      if (!QREG) asm volatile("" : "+v"(qp));
      const int key0 = t * 64;
#pragma unroll 1
      for (int mi = 0; mi < 2; ++mi) {
        f32x16 s;
#pragma unroll
        for (int r = 0; r < 16; ++r) s[r] = 0.f;
        const u16* kp = sK + (mi * 32 + l31) * KST + hh * 8;
        constexpr int KB = QREG ? 12 : 4;
#pragma unroll
        for (int k0 = 0; k0 < DK / 16; k0 += KB) {
          bf16x8 kf[KB];
#pragma unroll
          for (int i = 0; i < KB; ++i) kf[i] = *(const bf16x8*)(kp + (k0 + i) * 16);
          __builtin_amdgcn_sched_barrier(0);
#pragma unroll
          for (int i = 0; i < KB; ++i) {
            bf16x8 qv;
            if (QREG) qv = qf[k0 + i];
            else qv = *(const bf16x8*)(qp + (k0 + i) * 16);
            s = __builtin_amdgcn_mfma_f32_32x32x16_bf16(kf[i], qv, s, 0, 0, 0);
          }
        }
        bf16x8 vf[8];
        {
          const u16* vp = sV + l31 * VST + mi * 32 + 4 * hh;
#pragma unroll
          for (int oc = 0; oc < 2; ++oc)
#pragma unroll
            for (int d = 0; d < 4; ++d) {
              union { bf16x8 v; uint2 u[2]; } cv;
              cv.u[0] = *(const uint2*)(vp + d * 32 * VST + oc * 16);
              cv.u[1] = *(const uint2*)(vp + d * 32 * VST + oc * 16 + 8);
              vf[oc * 4 + d] = cv.v;
            }
          __builtin_amdgcn_sched_barrier(0);
        }
        if (key0 + 64 > kvlen) {
#pragma unroll
          for (int r = 0; r < 16; ++r) {
            int key = key0 + mi * 32 + (r & 3) + 8 * (r >> 2) + 4 * hh;
            if (key >= kvlen) s[r] = -1e30f;
          }
        }
        float mx = -1e30f;
#pragma unroll
        for (int r = 0; r < 16; ++r) mx = fmaxf(mx, s[r]);
        mx = fmaxf(mx, __shfl_xor(mx, 32, 64));
        if (__builtin_amdgcn_ballot_w64(mx > mrun) != 0ull) {
          const float mnew = fmaxf(mrun, mx);
          const float alpha = __builtin_amdgcn_exp2f(mrun - mnew);
          mrun = mnew;
          lrun *= alpha;
#pragma unroll
          for (int d = 0; d < 4; ++d)
#pragma unroll
            for (int r = 0; r < 16; ++r) o[d][r] *= alpha;
        }
        union { bf16x8 v[2]; unsigned u[8]; } pfu;
        float ps = 0.f;
#pragma unroll
        for (int r = 0; r < 16; r += 2) {
          float p0 = __builtin_amdgcn_exp2f(s[r] - mrun);
          float p1 = __builtin_amdgcn_exp2f(s[r + 1] - mrun);
          ps += p0 + p1;
          pfu.u[r >> 1] = pk2bf(p0, p1);
        }
        lrun += ps;
#pragma unroll
        for (int oc = 0; oc < 2; ++oc)
#pragma unroll
          for (int d = 0; d < 4; ++d) o[d] = __builtin_amdgcn_mfma_f32_32x32x16_bf16(vf[oc * 4 + d], pfu.v[oc], o[d], 0, 0, 0);
      }
    }
  }
  const float ltot = lrun + __shfl_xor(lrun, 32, 64);
  const float inv = 1.0f / ltot;
#pragma unroll
  for (int d = 0; d < 4; ++d)
#pragma unroll
    for (int g = 0; g < 4; ++g) {
      uint2 ov;
      ov.x = pk2bf(o[d][g * 4 + 0] * inv, o[d][g * 4 + 1] * inv);
      ov.y = pk2bf(o[d][g * 4 + 2] * inv, o[d][g * 4 + 3] * inv);
      *(uint2*)(orow + d * 32 + g * 8 + hh * 4) = ov;
    }
  __syncthreads();
}

DEV void lru_item(const Params& p, int l, int sb, int nbk, int half, unsigned char* smem) {
  const int tid = TIDX(), lane = tid & 63, w = tid >> 6, hh = lane >> 5, l31 = lane & 31;
  const bool samp = sb >= 16;
  const int S = samp ? 16 : 4096;
  const int row0 = samp ? MP + (sb - 16) * 16 : sb * 4096;
  const int kc0 = nbk * 128, oc0 = nbk * 128 + half * 64;
  const u16* XA = (const u16*)(p.ws + OFF_R1);
  u16* YL = (u16*)(p.ws + OFF_R2);
  const u16* WL = (const u16*)(p.ws + OFF_W) + (size_t)l * W_LAYER;
  u16* sXC = (u16*)smem;
  float* sA = (float*)(smem + 17408);
  float* sB = sA + 4096;
  float* segA = sB + 4096;
  float* segB = segA + 256;
  float* hc = segB + 256;
  float* cw = hc + 64;
  float* cb = cw + 512;
  const int tm = w >> 1, tn = w & 1;
  __syncthreads();
  for (int e = tid; e < 512; e += NT) cw[e] = p.conv_w[(size_t)l * 4096 + (e >> 7) * 1024 + kc0 + (e & 127)];
  if (tid < 128) cb[tid] = p.conv_b[l * 1024 + kc0 + tid];
  if (tid < 64) hc[tid] = samp ? p.state_lru[((size_t)l * 32 + (sb - 16)) * 1024 + oc0 + tid] : 0.f;
  bf16x8 waf[8], wxf[8];
  {
    const u16* wa = WL + WO_LA + (size_t)nbk * 16384 + (size_t)(half * 64 + tn * 32 + l31) * 128 + hh * 8;
    const u16* wx = WL + WO_LX + (size_t)nbk * 16384 + (size_t)(half * 64 + tn * 32 + l31) * 128 + hh * 8;
#pragma unroll
    for (int ks = 0; ks < 8; ++ks) {
      waf[ks] = *(const bf16x8*)(wa + ks * 16);
      wxf[ks] = *(const bf16x8*)(wx + ks * 16);
    }
  }
  const int och = oc0 + tn * 32 + l31;
  const float ba = p.lru_ba[l * 1024 + och], bx = p.lru_bx[l * 1024 + och];
  const float lam = p.lru_lambda[l * 1024 + och];
  const float ex_ = __expf(-lam);
  const float sp = (-lam > 20.f) ? -lam
                   : (ex_ < 0.01f ? ex_ * (1.0f - ex_ * (0.5f - ex_ * (0.33333334f - 0.25f * ex_))) : __logf(1.0f + ex_));
  __syncthreads();
  for (int t0 = 0; t0 < S; t0 += 64) {
    {
      const int cc = (tid & 15) * 8, tq = tid >> 4;
      bf16x8 xr[7];
#pragma unroll
      for (int j = 0; j < 7; ++j) {
        int ts = t0 + tq * 4 - 3 + j;
        ts = ts < 0 ? 0 : (ts > S - 1 ? S - 1 : ts);
        xr[j] = *(const bf16x8*)(XA + (size_t)(row0 + ts) * 1024 + kc0 + cc);
      }
      float xf[7][8];
#pragma unroll
      for (int j = 0; j < 7; ++j) {
        const int ts = t0 + tq * 4 - 3 + j;
        const bool ok = ts >= 0;
#pragma unroll
        for (int c = 0; c < 8; ++c) xf[j][c] = ok ? bf2f((u16)xr[j][c]) : 0.f;
      }
      if (samp && t0 == 0 && tq == 0) {
#pragma unroll
        for (int j = 0; j < 3; ++j) {
          const float* st = p.state_conv + (((size_t)l * 32 + (sb - 16)) * 3 + j) * 1024 + kc0 + cc;
#pragma unroll
          for (int c = 0; c < 8; ++c) xf[j][c] = st[c];
        }
      }
#pragma unroll
      for (int i = 0; i < 4; ++i) {
        const int tl = tq * 4 + i;
        bf16x8 o;
#pragma unroll
        for (int c = 0; c < 8; ++c) {
          float v = cb[cc + c];
#pragma unroll
          for (int k = 0; k < 4; ++k) v += xf[i + k][c] * cw[k * 128 + cc + c];
          o[c] = (short)f2bf(v);
        }
        *(bf16x8*)(sXC + tl * 136 + cc) = o;
      }
    }
    __syncthreads();
    f32x16 aR, aI;
#pragma unroll
    for (int r = 0; r < 16; ++r) { aR[r] = 0.f; aI[r] = 0.f; }
#pragma unroll
    for (int ks = 0; ks < 8; ++ks) {
      bf16x8 a = *(const bf16x8*)(sXC + (tm * 32 + l31) * 136 + ks * 16 + hh * 8);
      aR = __builtin_amdgcn_mfma_f32_32x32x16_bf16(a, waf[ks], aR, 0, 0, 0);
      aI = __builtin_amdgcn_mfma_f32_32x32x16_bf16(a, wxf[ks], aI, 0, 0, 0);
    }
#pragma unroll
    for (int r = 0; r < 16; ++r) {
      const int tl = tm * 32 + (r & 3) + 8 * (r >> 2) + 4 * hh;
      const int cl = tn * 32 + l31;
      float av, bv;
      {
        const float rg = __builtin_amdgcn_rcpf(1.0f + __expf(-(aR[r] + ba)));
        const float ig = __builtin_amdgcn_rcpf(1.0f + __expf(-(aI[r] + bx)));
        const float la = -8.0f * rg * sp;
        const float a_ = __expf(la);
        const float x2 = 2.0f * la;
        const float ser = -x2 * (1.0f + x2 * (0.5f + x2 * (0.16666667f + x2 * (0.041666668f + x2 * 0.0083333338f))));
        const float em = (x2 > -0.25f) ? ser : 1.0f - __expf(x2);
        const float mult = __builtin_amdgcn_sqrtf(em);
        const float xcv = bf2f(sXC[tl * 136 + half * 64 + cl]);
        const bool valid = (t0 + tl < S);
        av = valid ? a_ : 1.f;
        bv = valid ? mult * ig * xcv : 0.f;
      }
      sA[tl * 64 + cl] = av;
      sB[tl * 64 + cl] = bv;
    }
    __syncthreads();
    {
      const int c = lane, sg = w;
      float A_ = 1.f, B_ = 0.f;
#pragma unroll
      for (int i = 0; i < 16; ++i) {
        const float a = sA[(sg * 16 + i) * 64 + c], b = sB[(sg * 16 + i) * 64 + c];
        B_ = a * B_ + b;
        A_ *= a;
      }
      segA[sg * 64 + c] = A_;
      segB[sg * 64 + c] = B_;
      __syncthreads();
      float h = hc[c];
      for (int s2 = 0; s2 < sg; ++s2) h = segA[s2 * 64 + c] * h + segB[s2 * 64 + c];
      __syncthreads();
#pragma unroll
      for (int i = 0; i < 16; ++i) {
        const int tl = sg * 16 + i;
        const float a = sA[tl * 64 + c], b = sB[tl * 64 + c];
        h = a * h + b;
        if (t0 + tl < S) YL[(size_t)(row0 + t0 + tl) * 1024 + oc0 + c] = f2bf(h);
      }
      if (sg == 3) hc[c] = h;
    }
    __syncthreads();
  }
  if (tid < 64) {
    const float h = hc[tid];
    if (samp) p.out[OUT_LRUS + ((size_t)l * 32 + (sb - 16)) * 1024 + oc0 + tid] = h;
    else p.out[OUT_LRUP + ((size_t)l * 16 + sb) * 1024 + oc0 + tid] = h;
  }
  __syncthreads();
}

DEV void phase_p3(const Params& p, int l, unsigned char* smem) {
  __shared__ int s_item;
  const int tid = TIDX(), lane = tid & 63, w = tid >> 6;
#pragma unroll 1
  for (int it = blockIdx.x; it < 256; it += gridDim.x) lru_item(p, l, it >> 4, (it >> 1) & 7, it & 1, smem);
#pragma unroll 1
  for (int it0 = blockIdx.x; it0 < 320; it0 += gridDim.x) {
    if (it0 < 256) continue;
    const int it = it0 - 256;
    const int b = it >> 1, dvh = it & 1;
    const int r = w * 32 + (lane & 31), h = r >> 4, t = r & 15;
    const u16* qrow = (const u16*)(p.ws + OFF_QS) + ((size_t)b * 16 + t) * 2560 + h * 320;
    const u16* ka = (const u16*)(p.ws + OFF_SKV) + (size_t)b * 2112 * 320;
    const u16* vt = (const u16*)(p.ws + OFF_SVT) + ((size_t)b * 256 + dvh * 128) * 2112;
    u16* orow = (u16*)(p.ws + OFF_OLAT) + ((size_t)b * 16 + t) * 2048 + h * 256 + dvh * 128;
    attn_item<320, false>(qrow, ka, 320, ka + 256, 320, vt, 2112, 33, 33, 2064, orow, smem);
  }
  const int xcd = blockIdx.x & 7;
#pragma unroll 1
  for (int qi = 0; qi < 8; ++qi) {
    const int q = (xcd + qi) & 7;
    unsigned* qc = (unsigned*)(p.ws + OFF_CNT) + 8 + l * 8 + q;
#pragma unroll 1
    for (;;) {
      __syncthreads();
      if (tid == 0) s_item = (int)atomicAdd(qc, 1u);
      __syncthreads();
      const int it = s_item;
      if (it >= 512) break;
      const int half_ = it >> 8, j_ = it & 255;
      const int qt = (half_ ? 15 : 31) - (j_ & 15), bh = (j_ >> 4) * 8 + q, b = bh >> 3, h = bh & 7;
      u16* Q = (u16*)(p.ws + OFF_R3);
      const int r = w * 32 + (lane & 31);
      u16* qrow = Q + ((size_t)b * 4096 + qt * 128 + r) * 1536 + h * 192;
      const u16* ka = (const u16*)(p.ws + OFF_R4) + (size_t)b * 4096 * 1024 + h * 128;
      const u16* kb = (const u16*)(p.ws + OFF_KPE) + (size_t)b * 4096 * 64;
      const u16* vt = (const u16*)(p.ws + OFF_VT) + ((size_t)b * 1024 + h * 128) * 4096;
      attn_item<192, ATT_PF>(qrow, ka, 1024, kb, 64, vt, 4096, 2 * (qt + 1), 2 * qt + 1 + (w >> 1), 1 << 30, qrow, smem);
    }
  }
#pragma unroll 1
  for (int it = blockIdx.x; it < 512; it += gridDim.x) lru_item(p, l, 16 + (it >> 4), (it >> 1) & 7, it & 1, smem);
}

template <int MI>
DEV void p4_tile(const Params& p, int l, int m0, int nt, unsigned char* smem) {
  const u16* WL = (const u16*)(p.ws + OFF_W) + (size_t)l * W_LAYER;
  const u16* H = (const u16*)(p.ws + OFF_H);
  const u16* Q = (const u16*)(p.ws + OFF_R3);
  const u16* OLAT = (const u16*)(p.ws + OFF_OLAT);
  u16* YB = (u16*)(p.ws + OFF_R1);
  u16* YA = (u16*)(p.ws + OFF_R2);
  u16* sC = (u16*)smem;
  f32x16 acc[MI][2];
  if (nt < 8) {
    if constexpr (MI == 2) {
      if (m0 >= MP) {
        f32x16 att[MI][2];
        zero_acc_t<MI>(att);
        gemm_mm<MI>(att, OLAT + (size_t)(m0 - MP) * 2048 + nt * 256, 2048, WL + WO_UVP + (size_t)nt * 128 * 256, 256, 256, smem);
        zero_acc_t<MI>(acc);
        gemm_mm<MI>(acc, H + (size_t)m0 * 1024, 1024, WL + WO_G + (size_t)(1024 + nt * 128) * 1024, 1024, 1024, smem);
        acc_foreach_t<MI>([&](int mi, int ni, int r, int row, int col) __attribute__((always_inline)) {
          sC[row * LDC + col] = f2bf(att[mi][ni][r] * siluf_(acc[mi][ni][r]));
        });
        tile_store_t<MI>(smem, YB + (size_t)m0 * 1024 + nt * 128, 1024);
        return;
      }
    }
    zero_acc_t<MI>(acc);
    gemm_mm<MI>(acc, H + (size_t)m0 * 1024, 1024, WL + WO_G + (size_t)(1024 + nt * 128) * 1024, 1024, 1024, smem);
    tile_load_t<MI>(smem, Q + (size_t)m0 * 1536 + nt * 192, 1536);
    acc_foreach_t<MI>([&](int mi, int ni, int r, int row, int col) __attribute__((always_inline)) {
      sC[row * LDC + col] = f2bf(bf2f(sC[row * LDC + col]) * siluf_(acc[mi][ni][r]));
    });
    tile_store_t<MI>(smem, YB + (size_t)m0 * 1024 + nt * 128, 1024);
  } else {
    const int n0 = (nt - 8) * 128;
    zero_acc_t<MI>(acc);
    gemm_mm<MI>(acc, H + (size_t)m0 * 1024, 1024, WL + WO_G + (size_t)n0 * 1024, 1024, 1024, smem);
    tile_load_t<MI>(smem, YA + (size_t)m0 * 1024 + n0, 1024);
    acc_foreach_t<MI>([&](int mi, int ni, int r, int row, int col) __attribute__((always_inline)) {
      sC[row * LDC + col] = f2bf(bf2f(sC[row * LDC + col]) * siluf_(acc[mi][ni][r]));
    });
    tile_store_t<MI>(smem, YA + (size_t)m0 * 1024 + n0, 1024);
  }
}
DEV void phase_p4(const Params& p, int l, unsigned char* smem) {
  const int nb = gridDim.x;
  int idx = vbid(), base = 0;
#pragma unroll 1
  for (; idx < base + 256 * 16; idx += nb) {
    const int t = idx - base;
    p4_tile<4>(p, l, (t >> 4) * 256, t & 15, smem);
  }
  base += 256 * 16;
#pragma unroll 1
  for (; idx < base + 4 * 16; idx += nb) {
    const int t = idx - base;
    p4_tile<2>(p, l, MP + (t >> 4) * 128, t & 15, smem);
  }
}

constexpr int SM_GATE = 2 * 128 * LDT * 2 + 1024;
DEV void gemm_gates(f32x16 (&acc)[2][4], const u16* __restrict__ A, const u16* __restrict__ B0, const u16* __restrict__ B1,
                    unsigned char* smem) {
  u16* sA = (u16*)smem;
  u16* sB = sA + 128 * LDT;
  const int tid = TIDX(), lane = tid & 63, w = tid >> 6, wm = w >> 1, wn = w & 1;
  const int srow = tid >> 3, scol = (tid & 7) * 8;
  const u16* ap = A + (size_t)srow * 1024 + scol;
  const u16* b0p = B0 + (size_t)srow * 1024 + scol;
  const u16* b1p = B1 + (size_t)srow * 1024 + scol;
  bf16x8 ra[4], rb[8];
#pragma unroll
  for (int i = 0; i < 4; ++i) {
    ra[i] = *(const bf16x8*)(ap + (size_t)(32 * i) * 1024);
    rb[i] = *(const bf16x8*)(b0p + (size_t)(32 * i) * 1024);
    rb[4 + i] = *(const bf16x8*)(b1p + (size_t)(32 * i) * 1024);
  }
  const int fro = (lane & 31) * LDT + (lane >> 5) * 8;
#pragma unroll 1
  for (int kt = 0; kt < 16; ++kt) {
    __syncthreads();
#pragma unroll
    for (int i = 0; i < 4; ++i) *(bf16x8*)(sA + (srow + 32 * i) * LDT + scol) = ra[i];
#pragma unroll
    for (int i = 0; i < 8; ++i) *(bf16x8*)(sB + (srow + 32 * i) * LDT + scol) = rb[i];
    __syncthreads();
    if (kt + 1 < 16) {
      ap += 64;
      b0p += 64;
      b1p += 64;
#pragma unroll
      for (int i = 0; i < 4; ++i) {
        ra[i] = *(const bf16x8*)(ap + (size_t)(32 * i) * 1024);
        rb[i] = *(const bf16x8*)(b0p + (size_t)(32 * i) * 1024);
        rb[4 + i] = *(const bf16x8*)(b1p + (size_t)(32 * i) * 1024);
      }
    }
#pragma unroll 2
    for (int ks = 0; ks < 4; ++ks) {
      bf16x8 af[2], bfr[4];
#pragma unroll
      for (int i = 0; i < 2; ++i) af[i] = *(const bf16x8*)(sA + (wm * 64 + i * 32) * LDT + fro + ks * 16);
#pragma unroll
      for (int i = 0; i < 4; ++i)
        bfr[i] = *(const bf16x8*)(sB + ((i >> 1) * 128 + wn * 64 + (i & 1) * 32) * LDT + fro + ks * 16);
      __builtin_amdgcn_s_setprio(1);
#pragma unroll
      for (int mi = 0; mi < 2; ++mi)
#pragma unroll
        for (int ni = 0; ni < 4; ++ni)
          acc[mi][ni] = __builtin_amdgcn_mfma_f32_32x32x16_bf16(af[mi], bfr[ni], acc[mi][ni], 0, 0, 0);
      __builtin_amdgcn_s_setprio(0);
    }
  }
  __syncthreads();
}
DEV void phase_p5(const Params& p, int l, unsigned char* smem) {
  const u16* WL = (const u16*)(p.ws + OFF_W) + (size_t)l * W_LAYER;
  const u16* H = (const u16*)(p.ws + OFF_H);
  const u16* YB = (const u16*)(p.ws + OFF_R1);
  const u16* YA = (const u16*)(p.ws + OFF_R2);
  u16* MRG = (u16*)(p.ws + OFF_R3);
  u16* sC = (u16*)smem;
  const int ntiles = 516 * 8;
  for (int t = vbid(); t < ntiles; t += gridDim.x) {
    const int mt = t >> 3, nt = t & 7;
    unsigned ga[2][2][8];
    unsigned* sG = (unsigned*)(smem + SM_GATE);
    const int tid = TIDX();
    {
      f32x16 g[2][4];
#pragma unroll
      for (int a_ = 0; a_ < 2; ++a_)
#pragma unroll
        for (int b_ = 0; b_ < 4; ++b_)
#pragma unroll
          for (int r = 0; r < 16; ++r) g[a_][b_][r] = 0.f;
      gemm_gates(g, H + (size_t)mt * 128 * 1024, WL + WO_G + (size_t)(2048 + nt * 128) * 1024,
                 WL + WO_G + (size_t)(3072 + nt * 128) * 1024, smem);
#pragma unroll
      for (int a_ = 0; a_ < 2; ++a_)
#pragma unroll
        for (int b_ = 0; b_ < 2; ++b_) {
#pragma unroll
          for (int r = 0; r < 8; ++r)
            sG[((a_ * 2 + b_) * 8 + r) * 256 + tid] = pk2bf(sigmoidf_(g[a_][2 + b_][2 * r]), sigmoidf_(g[a_][2 + b_][2 * r + 1]));
          __builtin_amdgcn_sched_barrier(0);
        }
#pragma unroll
      for (int a_ = 0; a_ < 2; ++a_)
#pragma unroll
        for (int b_ = 0; b_ < 2; ++b_) {
#pragma unroll
          for (int r = 0; r < 8; ++r) ga[a_][b_][r] = pk2bf(sigmoidf_(g[a_][b_][2 * r]), sigmoidf_(g[a_][b_][2 * r + 1]));
          __builtin_amdgcn_sched_barrier(0);
        }
    }
    auto gate_a = [&](int mi, int ni, int r) __attribute__((always_inline)) -> float {
      const unsigned gq = ga[mi][ni][r >> 1];
      return __uint_as_float((r & 1) ? (gq & 0xffff0000u) : (gq << 16));
    };
    auto gate_b = [&](int mi, int ni, int r) __attribute__((always_inline)) -> float {
      const unsigned gq = sG[((mi * 2 + ni) * 8 + (r >> 1)) * 256 + tid];
      return __uint_as_float((r & 1) ? (gq & 0xffff0000u) : (gq << 16));
    };
    f32x16 acc[2][2];
    unsigned res[2][2][8];
    zero_acc(acc);
    gemm_main<0>(acc, YA + (size_t)mt * 128 * 1024, 1024, WL + WO_BA + (size_t)nt * 128 * 1024, 1024, 1024, smem);
#pragma unroll
    for (int mi = 0; mi < 2; ++mi)
#pragma unroll
      for (int ni = 0; ni < 2; ++ni)
#pragma unroll
        for (int r = 0; r < 8; ++r)
          res[mi][ni][r] = pk2bf(acc[mi][ni][2 * r] * gate_a(mi, ni, 2 * r), acc[mi][ni][2 * r + 1] * gate_a(mi, ni, 2 * r + 1));
    zero_acc(acc);
    gemm_main<0>(acc, YB + (size_t)mt * 128 * 1024, 1024, WL + WO_BB + (size_t)nt * 128 * 1024, 1024, 1024, smem);
    __syncthreads();
    acc_foreach([&](int mi, int ni, int r, int row, int col) __attribute__((always_inline)) {
      const unsigned rq = res[mi][ni][r >> 1];
      const float rv = __uint_as_float((r & 1) ? (rq & 0xffff0000u) : (rq << 16));
      sC[row * LDC + col] = f2bf(rv + acc[mi][ni][r] * gate_b(mi, ni, r));
    });
    tile_store(smem, MRG + (size_t)mt * 128 * 1024 + nt * 128, 1024);
  }
}

template <int MI>
DEV void p6_tile(const Params& p, int l, int m0, int nt, unsigned char* smem) {
  const u16* WL = (const u16*)(p.ws + OFF_W) + (size_t)l * W_LAYER;
  const u16* MRG = (const u16*)(p.ws + OFF_R3);
  u16* O = (u16*)(p.ws + OFF_R4);
  u16* sC = (u16*)smem;
  f32x16 acc[MI][2];
  zero_acc_t<MI>(acc);
  gemm_mm<MI>(acc, MRG + (size_t)m0 * 1024, 1024, WL + WO_OUT + (size_t)nt * 128 * 1024, 1024, 1024, smem);
  acc_foreach_t<MI>([&](int mi, int ni, int r, int row, int col) __attribute__((always_inline)) {
    sC[row * LDC + col] = f2bf(acc[mi][ni][r]);
  });
  tile_store_t<MI>(smem, O + (size_t)m0 * 1024 + nt * 128, 1024);
}
DEV void phase_p6(const Params& p, int l, unsigned char* smem) {
  const int nb = gridDim.x;
  int idx = vbid(), base = 0;
#pragma unroll 1
  for (; idx < base + 256 * 8; idx += nb) {
    const int t = idx - base;
    p6_tile<4>(p, l, (t >> 3) * 256, t & 7, smem);
  }
  base += 256 * 8;
#pragma unroll 1
  for (; idx < base + 4 * 8; idx += nb) {
    const int t = idx - base;
    p6_tile<2>(p, l, MP + (t >> 3) * 128, t & 7, smem);
  }
}

constexpr int SM_TOTAL = SM_GATE + 32768;
__global__ void __launch_bounds__(NT, 2) mega(Params p) {
  __shared__ __attribute__((aligned(16))) unsigned char smem[SM_TOTAL];
  cg::grid_group grid = cg::this_grid();
  __shared__ uint4 xb_words;
  if (threadIdx.x == 0) xb_words = make_uint4(0u, 0u, 0u, 0u);
#define PH(call)                                             \
  {                                                          \
    Params q = p;                                            \
    size_t z_ = 0;                                           \
    asm volatile("" : "+s"(z_));                             \
    q.ws = p.ws + z_;                                        \
    q.out = p.out + z_;                                      \
    call;                                                    \
  }
  PH(phase_prep(q, smem));
  grid.sync();
  (void)xcd_barrier_post((unsigned*)(p.ws + OFF_BAR), (volatile LAS unsigned*)&xb_words);
#define XBAR() xcd_barrier((unsigned*)(p.ws + OFF_BAR), (volatile LAS unsigned*)&xb_words)
  PH(phase_norm0(q));
  XBAR();
#pragma unroll 1
  for (int l = 0; l < 2; ++l) {
    PH(phase_gemm1(q, l, smem));
    XBAR();
    PH(phase_p2(q, l, smem));
    XBAR();
    PH(phase_p3(q, l, smem));
    XBAR();
    PH(phase_p4(q, l, smem));
    XBAR();
    PH(phase_p5(q, l, smem));
    XBAR();
    PH(phase_p6(q, l, smem));
    XBAR();
    PH(phase_final(q, l));
    if (l == 0) XBAR();
  }
}

extern "C" void kernel_launch(void* const* d_in, const int* in_sizes, int n_in, void* d_out, int out_size, void* d_ws,
                              size_t ws_size, hipStream_t stream) {
  static int grid_blocks = 0;
  if (!grid_blocks) {
    int dev = 0, cus = 0, per_cu = 0;
    hipGetDevice(&dev);
    hipDeviceGetAttribute(&cus, hipDeviceAttributeMultiprocessorCount, dev);
    hipOccupancyMaxActiveBlocksPerMultiprocessor(&per_cu, mega, NT, 0);
    if (per_cu > 2) per_cu = 2;
    grid_blocks = cus * per_cu;
  }
  if (ws_size < WS_NEED) {
    fprintf(stderr, "workspace too small: %zu < %zu\n", ws_size, (size_t)WS_NEED);
    return;
  }
  Params p{};
  const float** pp = (const float**)&p;
  for (int i = 0; i < 28; ++i) pp[i] = (const float*)d_in[i];
  p.out = (float*)d_out;
  p.ws = (unsigned char*)d_ws;
  void* args[] = {&p};
  hipError_t e = hipLaunchCooperativeKernel((void*)mega, dim3(grid_blocks), dim3(NT), args, 0, stream);
  if (e != hipSuccess) fprintf(stderr, "cooperative launch failed: %s (grid %d)\n", hipGetErrorString(e), grid_blocks);
}
```

```cpp
#include <hip/hip_runtime.h>
#include <hip/hip_cooperative_groups.h>
#include <cstdio>
namespace cg = cooperative_groups;

typedef unsigned short u16;
typedef __attribute__((ext_vector_type(8))) short bf16x8;
typedef __attribute__((ext_vector_type(16))) float f32x16;

#define DEV __device__ __forceinline__
#define NT 256

constexpr int MP = 65536, MS = 512, MT = 66048;
constexpr int IN_DIM = 6208;
constexpr float EPS = 1e-6f;
constexpr float QSCALE = 0.07216878364870322f * 1.4426950408889634f;

constexpr size_t SZ_ACT = (size_t)MT * 1024 * 2;
constexpr size_t OFF_H = 0;
constexpr size_t OFF_R1 = OFF_H + SZ_ACT;
constexpr size_t OFF_R2 = OFF_R1 + SZ_ACT;
constexpr size_t OFF_R3 = OFF_R2 + SZ_ACT;
constexpr size_t OFF_R4 = OFF_R3 + (size_t)MP * 1536 * 2;
constexpr size_t OFF_KPE = OFF_R4 + SZ_ACT;
constexpr size_t OFF_VT = OFF_KPE + (size_t)MT * 64 * 2;
constexpr size_t OFF_SKV = OFF_VT + (size_t)16 * 1024 * 4096 * 2;
constexpr size_t OFF_SVT = OFF_SKV + (size_t)32 * 2112 * 320 * 2;
constexpr size_t OFF_QS = OFF_SVT + (size_t)32 * 256 * 2112 * 2;
constexpr size_t OFF_OLAT = OFF_QS + (size_t)MS * 2560 * 2;
constexpr size_t OFF_MOD = OFF_OLAT + (size_t)MS * 2048 * 2;
constexpr size_t OFF_ROPE = OFF_MOD + (size_t)2 * 48 * 3072 * 4;
constexpr size_t OFF_CNT = OFF_ROPE + (size_t)4096 * 32 * 2 * 4;
constexpr size_t OFF_W = OFF_CNT + 256;
constexpr size_t WO_W1 = 0;
constexpr size_t WO_G = WO_W1 + (size_t)2176 * 1024;
constexpr size_t WO_QP = WO_G + (size_t)4096 * 1024;
constexpr size_t WO_QS = WO_QP + (size_t)1536 * 768;
constexpr size_t WO_UK = WO_QS + (size_t)2560 * 768;
constexpr size_t WO_UVS = WO_UK + 262144;
constexpr size_t WO_UVP = WO_UVS + 262144;
constexpr size_t WO_BA = WO_UVP + 262144;
constexpr size_t WO_BB = WO_BA + 1048576;
constexpr size_t WO_OUT = WO_BB + 1048576;
constexpr size_t WO_LA = WO_OUT + 1048576;
constexpr size_t WO_LX = WO_LA + 131072;
constexpr size_t W_LAYER = WO_LX + 131072;
constexpr size_t OFF_BAR = OFF_W + 2 * W_LAYER * 2;
constexpr size_t WS_NEED = OFF_BAR + 16384;

constexpr size_t OUT_YP = 0;
constexpr size_t OUT_YS = 67108864;
constexpr size_t OUT_CKVP = 67633152;
constexpr size_t OUT_KPEP = 101187584;
constexpr size_t OUT_CONVP = 109576192;
constexpr size_t OUT_LRUP = 109674496;
constexpr size_t OUT_CKVS = 109707264;
constexpr size_t OUT_KPES = 109969408;
constexpr size_t OUT_CONVS = 110034944;
constexpr size_t OUT_LRUS = 110231552;

struct Params {
  const float *x_p, *x_s, *c_p, *c_s, *cache_ckv, *cache_kpe, *state_conv, *state_lru;
  const float *ada_w, *ada_b, *pre_norm, *post_norm, *w_in, *conv_w, *conv_b, *lru_wa, *lru_ba, *lru_wx, *lru_bx;
  const float *lru_lambda, *q_norm, *w_q_up, *kv_norm, *w_uk, *w_uv, *w_ba, *w_bb, *w_out;
  float* out;
  unsigned char* ws;
};

DEV int TIDX() {
  int t = threadIdx.x;
  asm volatile("" : "+v"(t));
  return t;
}
typedef __attribute__((ext_vector_type(2))) float f32x2_t;
typedef __attribute__((ext_vector_type(2))) __bf16 bf16x2_t;
DEV unsigned pk2bf(float a, float b) {
  f32x2_t v = {a, b};
  bf16x2_t r = __builtin_convertvector(v, bf16x2_t);
  return __builtin_bit_cast(unsigned, r);
}
DEV u16 f2bf(float f) { return (u16)(pk2bf(f, 0.f) & 0xffffu); }
DEV float bf2f(u16 h) { return __uint_as_float(((unsigned)h) << 16); }
DEV float sigmoidf_(float x) { return 1.0f / (1.0f + __expf(-x)); }
DEV float siluf_(float x) { return x / (1.0f + __expf(-x)); }
DEV float wave_sum(float v) {
#pragma unroll
  for (int o = 32; o > 0; o >>= 1) v += __shfl_xor(v, o, 64);
  return v;
}
DEV int vbid() {
  const int b = blockIdx.x, n = gridDim.x;
  return ((n & 7) == 0) ? (b & 7) * (n >> 3) + (b >> 3) : b;
}
DEV int mod_row(int m) { return m < MP ? (m >> 12) : 16 + ((m - MP) >> 4); }
DEV int pos_of(int m) { return m < MP ? (m & 4095) : 2048 + ((m - MP) & 15); }

constexpr int LDT = 72;
#ifndef P5_DEPTH
#define P5_DEPTH 1
#endif
template <int SS, int DEPTH = 1>
DEV void gemm_main(f32x16 (&acc)[2][2], const u16* __restrict__ A, int lda, const u16* __restrict__ B, int ldb,
                   int K, unsigned char* smem) {
  u16* sA = (u16*)smem;
  u16* sB = sA + 128 * LDT;
  float* ss = (float*)(sB + 128 * LDT);
  const int tid = TIDX(), lane = tid & 63, w = tid >> 6, wm = w >> 1, wn = w & 1;
  const int srow = tid >> 3, scol = (tid & 7) * 8;
  const u16* ap = A + (size_t)srow * lda + scol;
  const u16* bp = B + (size_t)srow * ldb + scol;
  bf16x8 ra[DEPTH][4], rb[DEPTH][4];
  float ssq[4] = {0.f, 0.f, 0.f, 0.f};
  const int nk = K >> 6;
#pragma unroll
  for (int d = 0; d < DEPTH; ++d)
#pragma unroll
    for (int i = 0; i < 4; ++i) {
      ra[d][i] = *(const bf16x8*)(ap + d * 64 + (size_t)(32 * i) * lda);
      rb[d][i] = *(const bf16x8*)(bp + d * 64 + (size_t)(32 * i) * ldb);
    }
  ap += DEPTH * 64;
  bp += DEPTH * 64;
  const int fro = (lane & 31) * LDT + (lane >> 5) * 8;
#pragma unroll 1
  for (int kt = 0; kt < nk; kt += DEPTH) {
#pragma unroll
    for (int d = 0; d < DEPTH; ++d) {
      __syncthreads();
#pragma unroll
      for (int i = 0; i < 4; ++i) {
        *(bf16x8*)(sA + (srow + 32 * i) * LDT + scol) = ra[d][i];
        *(bf16x8*)(sB + (srow + 32 * i) * LDT + scol) = rb[d][i];
        if (SS) {
          bf16x8 v = (SS == 1) ? ra[d][i] : rb[d][i];
#pragma unroll
          for (int j = 0; j < 8; ++j) {
            float f = bf2f((u16)v[j]);
            ssq[i] += f * f;
          }
        }
      }
      __syncthreads();
      if (kt + d + DEPTH < nk) {
#pragma unroll
        for (int i = 0; i < 4; ++i) {
          ra[d][i] = *(const bf16x8*)(ap + (size_t)(32 * i) * lda);
          rb[d][i] = *(const bf16x8*)(bp + (size_t)(32 * i) * ldb);
        }
        ap += 64;
        bp += 64;
      }
#pragma unroll
      for (int ks = 0; ks < 4; ++ks) {
        bf16x8 af[2], bfr[2];
#pragma unroll
        for (int i = 0; i < 2; ++i) {
          af[i] = *(const bf16x8*)(sA + (wm * 64 + i * 32) * LDT + fro + ks * 16);
          bfr[i] = *(const bf16x8*)(sB + (wn * 64 + i * 32) * LDT + fro + ks * 16);
        }
        __builtin_amdgcn_s_setprio(1);
#pragma unroll
        for (int mi = 0; mi < 2; ++mi)
#pragma unroll
          for (int ni = 0; ni < 2; ++ni)
            acc[mi][ni] = __builtin_amdgcn_mfma_f32_32x32x16_bf16(af[mi], bfr[ni], acc[mi][ni], 0, 0, 0);
        __builtin_amdgcn_s_setprio(0);
      }
    }
  }
  if (SS) {
#pragma unroll
    for (int i = 0; i < 4; ++i) {
      float v = ssq[i];
      v += __shfl_xor(v, 1, 64);
      v += __shfl_xor(v, 2, 64);
      v += __shfl_xor(v, 4, 64);
      if ((tid & 7) == 0) ss[srow + 32 * i] = v;
    }
    __syncthreads();
  }
}
DEV void zero_acc(f32x16 (&acc)[2][2]) {
#pragma unroll
  for (int a = 0; a < 2; ++a)
#pragma unroll
    for (int b = 0; b < 2; ++b)
#pragma unroll
      for (int r = 0; r < 16; ++r) acc[a][b][r] = 0.f;
}
DEV float* gemm_ss(unsigned char* smem) { return (float*)(smem + 2 * 128 * LDT * 2); }

template <class F>
DEV void acc_foreach(F f) {
  const int tid_ = TIDX();
  const int lane = tid_ & 63, w = tid_ >> 6;
#pragma unroll
  for (int mi = 0; mi < 2; ++mi)
#pragma unroll
    for (int ni = 0; ni < 2; ++ni)
#pragma unroll
      for (int r = 0; r < 16; ++r)
        f(mi, ni, r, (w >> 1) * 64 + mi * 32 + (r & 3) + 8 * (r >> 2) + 4 * (lane >> 5), (w & 1) * 64 + ni * 32 + (lane & 31));
}
constexpr int LDC = 136;
DEV void tile_store(unsigned char* smem, u16* dst, size_t ldd) {
  const u16* sC = (const u16*)smem;
  __syncthreads();
  const int tid_ = TIDX();
#pragma unroll
  for (int i = 0; i < 8; ++i) {
    const int c = tid_ + 256 * i, row = c >> 4, cc = (c & 15) * 8;
    __builtin_nontemporal_store(*(const bf16x8*)(sC + row * LDC + cc), (bf16x8*)(dst + (size_t)row * ldd + cc));
  }
}


template <int MI>
DEV void gemm_mm(f32x16 (&acc)[MI][2], const u16* __restrict__ A, int lda, const u16* __restrict__ B, int ldb, int K,
                 unsigned char* smem) {
  constexpr int BM = MI * 64;
  u16* sA = (u16*)smem;
  u16* sB = sA + BM * LDT;
  const int tid = TIDX(), lane = tid & 63, w = tid >> 6, wm = w >> 1, wn = w & 1;
  const int srow = tid >> 3, scol = (tid & 7) * 8;
  const u16* ap = A + (size_t)srow * lda + scol;
  const u16* bp = B + (size_t)srow * ldb + scol;
  bf16x8 ra[MI * 2], rb[4];
#pragma unroll
  for (int i = 0; i < MI * 2; ++i) ra[i] = *(const bf16x8*)(ap + (size_t)(32 * i) * lda);
#pragma unroll
  for (int i = 0; i < 4; ++i) rb[i] = *(const bf16x8*)(bp + (size_t)(32 * i) * ldb);
  const int nk = K >> 6;
  const int fro = (lane & 31) * LDT + (lane >> 5) * 8;
#pragma unroll 1
  for (int kt = 0; kt < nk; ++kt) {
    __syncthreads();
#pragma unroll
    for (int i = 0; i < MI * 2; ++i) *(bf16x8*)(sA + (srow + 32 * i) * LDT + scol) = ra[i];
#pragma unroll
    for (int i = 0; i < 4; ++i) *(bf16x8*)(sB + (srow + 32 * i) * LDT + scol) = rb[i];
    __syncthreads();
    if (kt + 1 < nk) {
      ap += 64;
      bp += 64;
#pragma unroll
      for (int i = 0; i < MI * 2; ++i) ra[i] = *(const bf16x8*)(ap + (size_t)(32 * i) * lda);
#pragma unroll
      for (int i = 0; i < 4; ++i) rb[i] = *(const bf16x8*)(bp + (size_t)(32 * i) * ldb);
    }
#pragma unroll
    for (int ks = 0; ks < 4; ++ks) {
      bf16x8 af[MI], bfr[2];
#pragma unroll
      for (int i = 0; i < MI; ++i) af[i] = *(const bf16x8*)(sA + (wm * (MI * 32) + i * 32) * LDT + fro + ks * 16);
#pragma unroll
      for (int i = 0; i < 2; ++i) bfr[i] = *(const bf16x8*)(sB + (wn * 64 + i * 32) * LDT + fro + ks * 16);
      __builtin_amdgcn_s_setprio(1);
#pragma unroll
      for (int mi = 0; mi < MI; ++mi)
#pragma unroll
        for (int ni = 0; ni < 2; ++ni)
          acc[mi][ni] = __builtin_amdgcn_mfma_f32_32x32x16_bf16(af[mi], bfr[ni], acc[mi][ni], 0, 0, 0);
      __builtin_amdgcn_s_setprio(0);
    }
  }
  __syncthreads();
}
template <int MI>
DEV void zero_acc_t(f32x16 (&acc)[MI][2]) {
#pragma unroll
  for (int a = 0; a < MI; ++a)
#pragma unroll
    for (int b = 0; b < 2; ++b)
#pragma unroll
      for (int r = 0; r < 16; ++r) acc[a][b][r] = 0.f;
}
template <int MI, class F>
DEV void acc_foreach_t(F f) {
  const int tid_ = TIDX();
  const int lane = tid_ & 63, w = tid_ >> 6;
#pragma unroll
  for (int mi = 0; mi < MI; ++mi)
#pragma unroll
    for (int ni = 0; ni < 2; ++ni)
#pragma unroll
      for (int r = 0; r < 16; ++r)
        f(mi, ni, r, (w >> 1) * (MI * 32) + mi * 32 + (r & 3) + 8 * (r >> 2) + 4 * (lane >> 5), (w & 1) * 64 + ni * 32 + (lane & 31));
}
template <int MI>
DEV void tile_load_t(unsigned char* smem, const u16* src, size_t lds_) {
  u16* sC = (u16*)smem;
  const int tid_ = TIDX();
#pragma unroll
  for (int i = 0; i < MI * 4; ++i) {
    const int c = tid_ + 256 * i, row = c >> 4, cc = (c & 15) * 8;
    *(bf16x8*)(sC + row * LDC + cc) = *(const bf16x8*)(src + (size_t)row * lds_ + cc);
  }
  __syncthreads();
}
template <int MI>
DEV void tile_store_t(unsigned char* smem, u16* dst, size_t ldd) {
  const u16* sC = (const u16*)smem;
  __syncthreads();
  const int tid_ = TIDX();
#pragma unroll
  for (int i = 0; i < MI * 4; ++i) {
    const int c = tid_ + 256 * i, row = c >> 4, cc = (c & 15) * 8;
    __builtin_nontemporal_store(*(const bf16x8*)(sC + row * LDC + cc), (bf16x8*)(dst + (size_t)row * ldd + cc));
  }
}

#define XB_TMO      128
#define XB_XCNT(j)  (256  + 64 * (j))
#define XB_XSUB(j)  (1280 + 64 * (j))
#define XB_XGEN(j)  (2304 + 64 * (j))
#define XB_TOP      3328
#define XB_TOPGEN   3392
#define XCD_BAR_WORDS 3456
#define XB_SPIN_CAP (1u << 20)
#define LAS __attribute__((address_space(3)))
DEV unsigned xb_ld(unsigned* p) { return __hip_atomic_load(p, __ATOMIC_RELAXED, __HIP_MEMORY_SCOPE_AGENT); }
DEV unsigned xb_add(unsigned* p, unsigned v) { return __hip_atomic_fetch_add(p, v, __ATOMIC_RELAXED, __HIP_MEMORY_SCOPE_AGENT); }
DEV unsigned xb_xcc_id() { return (unsigned)__builtin_amdgcn_s_getreg((3 << 11) | 20) & 0xFu; }
#define XB_SPIN(cond, bar) do { unsigned _sp = 0; while (cond) { __builtin_amdgcn_s_sleep(1); \
    if ((++_sp & 255u) == 0u) { if (xb_ld(&(bar)[XB_TMO])) break; if (_sp > XB_SPIN_CAP) { atomicAdd(&(bar)[XB_TMO], 1u); break; } } } } while (0)
struct XcdBarrier {
  unsigned* bar;
  unsigned x;
  volatile LAS unsigned* st;
};
DEV XcdBarrier xcd_barrier_post(unsigned* bar, volatile LAS unsigned* st) {
  XcdBarrier b;
  b.bar = bar;
  b.x = xb_xcc_id();
  b.st = st;
  if (threadIdx.x == 0) (void)xb_add(&bar[XB_XCNT(b.x)], 1u);
  return b;
}
DEV void xcd_barrier_complete(unsigned* bar, unsigned x, unsigned& nloc, unsigned& nx) {
  const unsigned G = gridDim.x * gridDim.y * gridDim.z;
  unsigned sum, cnt, mine, sp = 0u;
  for (;;) {
    sum = 0u; cnt = 0u; mine = 0u;
#pragma unroll
    for (unsigned j = 0; j < 16; ++j) {
      const unsigned c = xb_ld(&bar[XB_XCNT(j)]);
      sum += c;
      cnt += (c > 0u) ? 1u : 0u;
      mine = (j == x) ? c : mine;
    }
    if (sum == G) break;
    __builtin_amdgcn_s_sleep(1);
    if ((++sp & 255u) == 0u) {
      if (xb_ld(&bar[XB_TMO])) break;
      if (sp > XB_SPIN_CAP) { atomicAdd(&bar[XB_TMO], 1u); break; }
    }
  }
  nloc = mine > 0u ? mine : 1u;
  nx = cnt > 0u ? cnt : 1u;
}
DEV void xcd_barrier(unsigned* bar_, volatile LAS unsigned* st_) {
  asm volatile("s_waitcnt vmcnt(0)" ::: "memory");
  __syncthreads();
  if (threadIdx.x == 0) {
    XcdBarrier b;
    b.bar = bar_;
    b.x = xb_xcc_id();
    b.st = st_;
    unsigned* bar = b.bar;
    __builtin_amdgcn_s_waitcnt(0);
    unsigned nloc = b.st[0], nx = b.st[1];
    if (nloc == 0u) {
      xcd_barrier_complete(bar, b.x, nloc, nx);
      b.st[0] = nloc;
      b.st[1] = nx;
    }
    const unsigned old = xb_add(&bar[XB_XSUB(b.x)], 1u);
    const unsigned gen = old / nloc;
    if (old + 1u == (gen + 1u) * nloc) {
      __builtin_amdgcn_fence(__ATOMIC_RELEASE, "agent");
      asm volatile("s_waitcnt vmcnt(0)" ::: "memory");
      const unsigned og = xb_add(&bar[XB_TOP], 1u);
      const unsigned tg = og / nx;
      if (og + 1u == (tg + 1u) * nx) xb_add(&bar[XB_TOPGEN], 1u);
      else XB_SPIN(xb_ld(&bar[XB_TOPGEN]) == tg, bar);
      __builtin_amdgcn_fence(__ATOMIC_ACQUIRE, "agent");
      xb_add(&bar[XB_XGEN(b.x)], 1u);
      asm volatile("s_waitcnt vmcnt(0)" ::: "memory");
    } else {
      XB_SPIN(xb_ld(&bar[XB_XGEN(b.x)]) == gen, bar);
      __builtin_amdgcn_fence(__ATOMIC_ACQUIRE, "agent");
      asm volatile("s_waitcnt vmcnt(0)" ::: "memory");
    }
  }
  __syncthreads();
}

DEV void transpose_tile(const float* __restrict__ src, int lds_, u16* __restrict__ dst, int ldd, const float* scale,
                        int k0, int n0, unsigned char* smem) {
  float* s = (float*)smem;
  const int tid = TIDX();
  __syncthreads();
  {
    const int n = tid & 63, kq = tid >> 6;
#pragma unroll 4
    for (int i = 0; i < 16; ++i) {
      int kk = kq * 16 + i;
      s[kk * 65 + n] = src[(size_t)(k0 + kk) * lds_ + n0 + n];
    }
  }
  __syncthreads();
  {
    const int k = tid & 63, nq = tid >> 6;
    const float sc = scale ? scale[k0 + k] : 1.0f;
#pragma unroll 4
    for (int i = 0; i < 16; ++i) {
      int n = nq * 16 + i;
      dst[(size_t)(n0 + n) * ldd + k0 + k] = f2bf(s[k * 65 + n] * sc);
    }
  }
}

DEV void qlat_tile(const float* __restrict__ wq, const float* __restrict__ wuk, const float* __restrict__ g,
                   u16* __restrict__ dst, int h, int r0, int k0, unsigned char* smem) {
  float* sQ = (float*)smem;
  float* sU = sQ + 64 * 65;
  const int tid = TIDX();
  float acc[16];
#pragma unroll
  for (int i = 0; i < 16; ++i) acc[i] = 0.f;
  for (int nh = 0; nh < 2; ++nh) {
    __syncthreads();
    {
      const int n = tid & 63, q = tid >> 6;
      for (int i = 0; i < 16; ++i) {
        int rr = q * 16 + i;
        sQ[rr * 65 + n] = wq[(size_t)(k0 + rr) * 1536 + h * 192 + nh * 64 + n];
        sU[rr * 65 + n] = wuk[(size_t)(r0 + rr) * 1024 + h * 128 + nh * 64 + n];
      }
    }
    __syncthreads();
    const int k = tid & 63, rq = tid >> 6;
    for (int n = 0; n < 64; ++n) {
      float qv = sQ[k * 65 + n];
#pragma unroll
      for (int i = 0; i < 16; ++i) acc[i] += qv * sU[(rq * 16 + i) * 65 + n];
    }
  }
  const int k = tid & 63, rq = tid >> 6;
  const float sc = g[k0 + k];
#pragma unroll
  for (int i = 0; i < 16; ++i) dst[(size_t)(h * 320 + r0 + rq * 16 + i) * 768 + k0 + k] = f2bf(acc[i] * sc);
}

DEV void mod_item(const Params& p, int item, unsigned char* smem) {
  const int l = item / 48, cg_ = item % 48;
  float* sc = (float*)smem;
  float* red = sc + 48 * 256;
  (void)red;
  const int tid = TIDX(), col = tid & 63, kq = tid >> 6;
  const float* W = p.ada_w + (size_t)l * 1024 * 3072 + cg_ * 64 + col;
  float acc[48];
#pragma unroll
  for (int b = 0; b < 48; ++b) acc[b] = 0.f;
  for (int kc = 0; kc < 4; ++kc) {
    __syncthreads();
    for (int e = tid; e < 48 * 256; e += NT) {
      int b = e >> 8, k = e & 255;
      float c = b < 16 ? p.c_p[b * 1024 + kc * 256 + k] : p.c_s[(b - 16) * 1024 + kc * 256 + k];
      sc[e] = siluf_(c);
    }
    __syncthreads();
#pragma unroll 1
    for (int i0 = 0; i0 < 64; i0 += 8) {
      float wv[8];
#pragma unroll
      for (int i = 0; i < 8; ++i) wv[i] = W[(size_t)(kc * 256 + kq * 64 + i0 + i) * 3072];
#pragma unroll
      for (int i = 0; i < 8; ++i) {
        const int k = kq * 64 + i0 + i;
#pragma unroll
        for (int b = 0; b < 48; ++b) acc[b] += sc[b * 256 + k] * wv[i];
      }
    }
  }
  __syncthreads();
#pragma unroll
  for (int b = 0; b < 48; ++b) sc[(kq * 48 + b) * 64 + col] = acc[b];
  __syncthreads();
  float* MOD = (float*)(p.ws + OFF_MOD);
  for (int e = tid; e < 48 * 64; e += NT) {
    int b = e >> 6, c = e & 63;
    float v = sc[(0 * 48 + b) * 64 + c] + sc[(1 * 48 + b) * 64 + c] + sc[(2 * 48 + b) * 64 + c] + sc[(3 * 48 + b) * 64 + c];
    int gc = cg_ * 64 + c;
    MOD[((size_t)l * 48 + b) * 3072 + gc] = v + p.ada_b[l * 3072 + gc];
  }
}

DEV void phase_prep(const Params& p, unsigned char* smem) {
  const int tid = TIDX();
  if (blockIdx.x == 0) {
    if (tid < 64) ((unsigned*)(p.ws + OFF_CNT))[tid] = 0u;
    for (int e = tid; e < XCD_BAR_WORDS; e += NT) ((unsigned*)(p.ws + OFF_BAR))[e] = 0u;
  }
  const bool split = gridDim.x >= 192;
  if (split && blockIdx.x < 96) {
    mod_item(p, blockIdx.x, smem);
    return;
  }
  const int nb = split ? (int)gridDim.x - 96 : (int)gridDim.x;
  int idx = split ? (int)blockIdx.x - 96 : (int)blockIdx.x, base = 0;
  if (!split) {
    for (; idx < base + 96; idx += nb) mod_item(p, idx - base, smem);
    base += 96;
  }
  for (int l = 0; l < 2; ++l) {
    u16* WL = (u16*)(p.ws + OFF_W) + (size_t)l * W_LAYER;
    const float* win = p.w_in + (size_t)l * 1024 * IN_DIM;
#define TJOB(SRC, LDS_, KK, NN, DST, LDD, SCALE)                                     \
  {                                                                                  \
    const int nkt = (KK) / 64, ntl = nkt * ((NN) / 64);                              \
    for (; idx < base + ntl; idx += nb) {                                            \
      int t = idx - base;                                                            \
      transpose_tile((SRC), (LDS_), (DST), (LDD), (SCALE), (t % nkt) * 64, (t / nkt) * 64, smem); \
    }                                                                                \
    base += ntl;                                                                     \
  }
    TJOB(win, IN_DIM, 1024, 1024, WL + WO_W1, 1024, nullptr);
    TJOB(win + 2048, IN_DIM, 1024, 1088, WL + WO_W1 + (size_t)1024 * 1024, 1024, nullptr);
    TJOB(win + 1024, IN_DIM, 1024, 1024, WL + WO_G, 1024, nullptr);
    TJOB(win + 3136, IN_DIM, 1024, 3072, WL + WO_G + (size_t)1024 * 1024, 1024, nullptr);
    TJOB(p.w_q_up + (size_t)l * 768 * 1536, 1536, 768, 1536, WL + WO_QP, 768, p.q_norm + l * 768);
    for (int h = 0; h < 8; ++h)
      TJOB(p.w_q_up + (size_t)l * 768 * 1536 + h * 192 + 128, 1536, 768, 64, WL + WO_QS + (size_t)(h * 320 + 256) * 768, 768,
           p.q_norm + l * 768);
    TJOB(p.w_uk + (size_t)l * 262144, 1024, 256, 1024, WL + WO_UK, 256, p.kv_norm + l * 256);
    TJOB(p.w_uv + (size_t)l * 262144, 1024, 256, 1024, WL + WO_UVS, 256, p.kv_norm + l * 256);
    TJOB(p.w_uv + (size_t)l * 262144, 1024, 256, 1024, WL + WO_UVP, 256, nullptr);
    TJOB(p.w_ba + (size_t)l * 1048576, 1024, 1024, 1024, WL + WO_BA, 1024, nullptr);
    TJOB(p.w_bb + (size_t)l * 1048576, 1024, 1024, 1024, WL + WO_BB, 1024, nullptr);
    TJOB(p.w_out + (size_t)l * 1048576, 1024, 1024, 1024, WL + WO_OUT, 1024, nullptr);
    for (int b8 = 0; b8 < 8; ++b8) {
      TJOB(p.lru_wa + (size_t)l * 131072 + b8 * 16384, 128, 128, 128, WL + WO_LA + b8 * 16384, 128, nullptr);
      TJOB(p.lru_wx + (size_t)l * 131072 + b8 * 16384, 128, 128, 128, WL + WO_LX + b8 * 16384, 128, nullptr);
    }
    for (; idx < base + 384; idx += nb) {
      int t = idx - base;
      int h = t / 48, rt = (t % 48) / 12, kt = t % 12;
      qlat_tile(p.w_q_up + (size_t)l * 768 * 1536, p.w_uk + (size_t)l * 262144, p.q_norm + l * 768, WL + WO_QS, h,
                rt * 64, kt * 64, smem);
    }
    base += 384;
    for (; idx < base + 16; idx += nb) {
      int t = idx - base;
      u16* d = WL + WO_W1 + (size_t)2112 * 1024 + t * 4096;
      for (int e = tid; e < 4096; e += NT) d[e] = 0;
    }
    base += 16;
  }
  float* ROPE = (float*)(p.ws + OFF_ROPE);
  for (; idx < base + 512; idx += nb) {
    int e = (idx - base) * 256 + tid;
    int pos = e >> 5, j = e & 31;
    float inv = exp2f(-(float)j * (13.287712379549449f / 32.0f));
    float ang = (float)pos * inv;
    ROPE[2 * e] = cosf(ang);
    ROPE[2 * e + 1] = sinf(ang);
  }
  base += 512;
}

DEV void norm_row(const Params& p, int l, int m, const float (&xv)[16], int lane) {
  float ss = 0.f;
#pragma unroll
  for (int i = 0; i < 16; ++i) ss += xv[i] * xv[i];
  ss = wave_sum(ss);
  const float rstd = rsqrtf(ss * (1.0f / 1024.0f) + EPS);
  const float* MOD = (const float*)(p.ws + OFF_MOD) + ((size_t)l * 48 + mod_row(m)) * 3072;
  u16* H = (u16*)(p.ws + OFF_H) + (size_t)m * 1024;
#pragma unroll
  for (int i = 0; i < 4; ++i) {
    int c = i * 256 + lane * 4;
    float4 g = *(const float4*)(p.pre_norm + l * 1024 + c);
    float4 sh = *(const float4*)(MOD + c);
    float4 sc = *(const float4*)(MOD + 1024 + c);
    ushort4 o;
    o.x = f2bf(xv[i * 4 + 0] * rstd * g.x * (1.f + sc.x) + sh.x);
    o.y = f2bf(xv[i * 4 + 1] * rstd * g.y * (1.f + sc.y) + sh.y);
    o.z = f2bf(xv[i * 4 + 2] * rstd * g.z * (1.f + sc.z) + sh.z);
    o.w = f2bf(xv[i * 4 + 3] * rstd * g.w * (1.f + sc.w) + sh.w);
    *(ushort4*)(H + c) = o;
  }
}

DEV void phase_norm0(const Params& p) {
  const int tid_ = TIDX();
  const int lane = tid_ & 63, wv = tid_ >> 6;
  for (int m = blockIdx.x * 4 + wv; m < MT; m += gridDim.x * 4) {
    const float* x = m < MP ? p.x_p + (size_t)m * 1024 : p.x_s + (size_t)(m - MP) * 1024;
    float xv[16];
#pragma unroll
    for (int i = 0; i < 4; ++i) {
      float4 v = *(const float4*)(x + i * 256 + lane * 4);
      xv[i * 4] = v.x; xv[i * 4 + 1] = v.y; xv[i * 4 + 2] = v.z; xv[i * 4 + 3] = v.w;
    }
    norm_row(p, 0, m, xv, lane);
  }
}

DEV void phase_final(const Params& p, int l) {
  const int tid_ = TIDX();
  const int lane = tid_ & 63, wv = tid_ >> 6;
  const u16* O = (const u16*)(p.ws + OFF_R4);
  for (int m = blockIdx.x * 4 + wv; m < MT; m += gridDim.x * 4) {
    float* y = m < MP ? p.out + OUT_YP + (size_t)m * 1024 : p.out + OUT_YS + (size_t)(m - MP) * 1024;
    const float* x = (l == 0) ? (m < MP ? p.x_p + (size_t)m * 1024 : p.x_s + (size_t)(m - MP) * 1024) : y;
    float xv[16], ov[16];
    float ss = 0.f;
#pragma unroll
    for (int i = 0; i < 4; ++i) {
      int c = i * 256 + lane * 4;
      float4 v = *(const float4*)(x + c);
      xv[i * 4] = v.x; xv[i * 4 + 1] = v.y; xv[i * 4 + 2] = v.z; xv[i * 4 + 3] = v.w;
      ushort4 o = *(const ushort4*)(O + (size_t)m * 1024 + c);
      ov[i * 4] = bf2f(o.x); ov[i * 4 + 1] = bf2f(o.y); ov[i * 4 + 2] = bf2f(o.z); ov[i * 4 + 3] = bf2f(o.w);
    }
#pragma unroll
    for (int i = 0; i < 16; ++i) ss += ov[i] * ov[i];
    ss = wave_sum(ss);
    const float rstd = rsqrtf(ss * (1.0f / 1024.0f) + EPS);
    const float* MOD = (const float*)(p.ws + OFF_MOD) + ((size_t)l * 48 + mod_row(m)) * 3072 + 2048;
#pragma unroll
    for (int i = 0; i < 4; ++i) {
      int c = i * 256 + lane * 4;
      float4 g = *(const float4*)(p.post_norm + l * 1024 + c);
      float4 gt = *(const float4*)(MOD + c);
      xv[i * 4 + 0] += gt.x * ov[i * 4 + 0] * rstd * g.x;
      xv[i * 4 + 1] += gt.y * ov[i * 4 + 1] * rstd * g.y;
      xv[i * 4 + 2] += gt.z * ov[i * 4 + 2] * rstd * g.z;
      xv[i * 4 + 3] += gt.w * ov[i * 4 + 3] * rstd * g.w;
      *(float4*)(y + c) = make_float4(xv[i * 4], xv[i * 4 + 1], xv[i * 4 + 2], xv[i * 4 + 3]);
    }
    if (l == 0) norm_row(p, 1, m, xv, lane);
  }
}

template <int MI>
DEV void gemm1_tile(const Params& p, int l, int m0, int nt, unsigned char* smem) {
  constexpr int BM = MI * 64;
  const u16* H = (const u16*)(p.ws + OFF_H);
  const u16* W1 = (const u16*)(p.ws + OFF_W) + (size_t)l * W_LAYER + WO_W1;
  u16* XA = (u16*)(p.ws + OFF_R1);
  u16* CQ = (u16*)(p.ws + OFF_R2);
  u16* CKVR = CQ + (size_t)MT * 768;
  u16* sC = (u16*)smem;
  f32x16 acc[MI][2];
  zero_acc_t<MI>(acc);
  gemm_mm<MI>(acc, H + (size_t)m0 * 1024, 1024, W1 + (size_t)nt * 128 * 1024, 1024, 1024, smem);
  if (nt < 14) {
    acc_foreach_t<MI>([&](int mi, int ni, int r, int row, int col) __attribute__((always_inline)) {
      sC[row * LDC + col] = f2bf(acc[mi][ni][r]);
    });
    if (nt < 8) tile_store_t<MI>(smem, XA + (size_t)m0 * 1024 + nt * 128, 1024);
    else tile_store_t<MI>(smem, CQ + (size_t)m0 * 768 + (nt - 8) * 128, 768);
    if (nt < 8 && (m0 >= MP || ((m0 + BM) & 4095) == 0)) {
      acc_foreach_t<MI>([&](int mi, int ni, int r, int row, int col) __attribute__((always_inline)) {
        const int m = m0 + row, n = nt * 128 + col;
        const float v = acc[mi][ni][r];
        if (m < MP) {
          int j = (m & 4095) - 4093;
          if (j >= 0) p.out[OUT_CONVP + ((size_t)(l * 16 + (m >> 12)) * 3 + j) * 1024 + n] = v;
        } else {
          int j = ((m - MP) & 15) - 13;
          if (j >= 0) p.out[OUT_CONVS + ((size_t)(l * 32 + ((m - MP) >> 4)) * 3 + j) * 1024 + n] = v;
        }
      });
    }
  } else if (nt < 16) {
    float* ob = m0 < MP ? p.out + OUT_CKVP + ((size_t)l * MP + m0) * 256 + (nt - 14) * 128
                        : p.out + OUT_CKVS + ((size_t)l * MS + (m0 - MP)) * 256 + (nt - 14) * 128;
    acc_foreach_t<MI>([&](int mi, int ni, int r, int row, int col) __attribute__((always_inline)) {
      const float v = acc[mi][ni][r];
      sC[row * LDC + col] = f2bf(v);
      ob[(size_t)row * 256 + col] = v;
    });
    tile_store_t<MI>(smem, CKVR + (size_t)m0 * 256 + (nt - 14) * 128, 256);
  } else {
    float* ob = m0 < MP ? p.out + OUT_KPEP + ((size_t)l * MP + m0) * 64 : p.out + OUT_KPES + ((size_t)l * MS + (m0 - MP)) * 64;
    acc_foreach_t<MI>([&](int mi, int ni, int r, int row, int col) __attribute__((always_inline)) {
      if (col < 64) ob[(size_t)row * 64 + col] = acc[mi][ni][r];
    });
  }
}
DEV void phase_gemm1(const Params& p, int l, unsigned char* smem) {
  const int nb = gridDim.x;
  int idx = vbid(), base = 0;
#pragma unroll 1
  for (; idx < base + 256 * 17; idx += nb) {
    const int t = idx - base;
    gemm1_tile<4>(p, l, (t / 17) * 256, t % 17, smem);
  }
  base += 256 * 17;
#pragma unroll 1
  for (; idx < base + 4 * 17; idx += nb) {
    const int t = idx - base;
    gemm1_tile<2>(p, l, MP + (t / 17) * 128, t % 17, smem);
  }
}

DEV void post1_rows(const Params& p, int l, int item) {
  const int tid_ = TIDX();
  const int lane = tid_ & 63, wv = tid_ >> 6;
  const float* ROPE = (const float*)(p.ws + OFF_ROPE);
  float4 v[2];
  float kx[2];
  float2 cs[2];
  float* ckvp[2];
  float* kpep[2];
#pragma unroll
  for (int u = 0; u < 2; ++u) {
    const int m = item * 8 + wv * 2 + u;
    ckvp[u] = m < MP ? p.out + OUT_CKVP + ((size_t)l * MP + m) * 256 : p.out + OUT_CKVS + ((size_t)l * MS + (m - MP)) * 256;
    kpep[u] = m < MP ? p.out + OUT_KPEP + ((size_t)l * MP + m) * 64 : p.out + OUT_KPES + ((size_t)l * MS + (m - MP)) * 64;
    v[u] = *(const float4*)(ckvp[u] + lane * 4);
    kx[u] = kpep[u][lane];
    cs[u] = *(const float2*)(ROPE + ((size_t)pos_of(m) * 32 + (lane & 31)) * 2);
  }
  const float4 g = *(const float4*)(p.kv_norm + l * 256 + lane * 4);
#pragma unroll
  for (int u = 0; u < 2; ++u) {
    const int m = item * 8 + wv * 2 + u;
    const float ss = wave_sum(v[u].x * v[u].x + v[u].y * v[u].y + v[u].z * v[u].z + v[u].w * v[u].w);
    const float rstd = rsqrtf(ss * (1.0f / 256.0f) + EPS);
    float4 o4 = v[u];
    o4.x *= rstd * g.x; o4.y *= rstd * g.y; o4.z *= rstd * g.z; o4.w *= rstd * g.w;
    *(float4*)(ckvp[u] + lane * 4) = o4;
    const float other = __shfl_xor(kx[u], 32, 64);
    const float c = cs[u].x, sn = cs[u].y;
    const float ro = (lane < 32) ? (kx[u] * c - other * sn) : (other * sn + kx[u] * c);
    kpep[u][lane] = ro;
    if (m < MP) {
      u16* KPE = (u16*)(p.ws + OFF_KPE) + (size_t)m * 64;
      KPE[lane] = f2bf(ro);
    } else {
      const int b = (m - MP) >> 4, t = (m - MP) & 15;
      u16* SKV = (u16*)(p.ws + OFF_SKV) + ((size_t)b * 2112 + 2048 + t) * 320;
      u16* SVT = (u16*)(p.ws + OFF_SVT) + (size_t)b * 256 * 2112 + 2048 + t;
      ushort4 o;
      o.x = f2bf(o4.x); o.y = f2bf(o4.y); o.z = f2bf(o4.z); o.w = f2bf(o4.w);
      *(ushort4*)(SKV + lane * 4) = o;
      SVT[(size_t)(lane * 4 + 0) * 2112] = o.x;
      SVT[(size_t)(lane * 4 + 1) * 2112] = o.y;
      SVT[(size_t)(lane * 4 + 2) * 2112] = o.z;
      SVT[(size_t)(lane * 4 + 3) * 2112] = o.w;
      SKV[256 + lane] = f2bf(ro);
    }
  }
}

DEV void cache_item(const Params& p, int l, int item, unsigned char* smem) {
  const int tid = TIDX();
  const int b = item / 33, kt = item % 33;
  u16* SKV = (u16*)(p.ws + OFF_SKV) + (size_t)b * 2112 * 320;
  u16* SVT = (u16*)(p.ws + OFF_SVT) + (size_t)b * 256 * 2112;
  if (kt == 32) {
    for (int e = tid; e < 48 * 320; e += NT) SKV[(size_t)2064 * 320 + e] = 0;
    for (int e = tid; e < 256 * 48; e += NT) SVT[(size_t)(e / 48) * 2112 + 2064 + (e % 48)] = 0;
    return;
  }
  float* s = (float*)smem;
  const float* src = p.cache_ckv + (((size_t)l * 32 + b) * 2048 + kt * 64) * 256;
  const float* srck = p.cache_kpe + (((size_t)l * 32 + b) * 2048 + kt * 64) * 64;
  for (int dh = 0; dh < 2; ++dh) {
    __syncthreads();
    for (int e = tid; e < 64 * 128; e += NT) {
      int key = e >> 7, d = e & 127;
      float v = src[(size_t)key * 256 + dh * 128 + d];
      s[key * 129 + d] = v;
      SKV[(size_t)(kt * 64 + key) * 320 + dh * 128 + d] = f2bf(v);
    }
    __syncthreads();
    const int k = tid & 63, dq = tid >> 6;
    for (int i = 0; i < 32; ++i) {
      int d = dq * 32 + i;
      SVT[(size_t)(dh * 128 + d) * 2112 + kt * 64 + k] = f2bf(s[k * 129 + d]);
    }
  }
  for (int e = tid; e < 64 * 64; e += NT) {
    int key = e >> 6, d = e & 63;
    SKV[(size_t)(kt * 64 + key) * 320 + 256 + d] = f2bf(srck[(size_t)key * 64 + d]);
  }
}

DEV void phase_p2(const Params& p, int l, unsigned char* smem) {
  const int tid = TIDX(), lane = tid & 63, w = tid >> 6;
  const int nb = gridDim.x;
  const u16* WL = (const u16*)(p.ws + OFF_W) + (size_t)l * W_LAYER;
  const u16* CQ = (const u16*)(p.ws + OFF_R2);
  const u16* CKVR = CQ + (size_t)MT * 768;
  u16* Q = (u16*)(p.ws + OFF_R3);
  u16* QS = (u16*)(p.ws + OFF_QS);
  u16* Kb = (u16*)(p.ws + OFF_R4);
  u16* VT = (u16*)(p.ws + OFF_VT);
  const float* ROPE = (const float*)(p.ws + OFF_ROPE);
  float* ss = gemm_ss(smem);
  int idx = vbid(), base = 0;
  const int nq = 512 * 12 + 4 * 20;
  for (; idx < base + nq; idx += nb) {
    int t = idx - base;
    int mt, nt;
    const u16* Wt;
    bool samp = t >= 512 * 12;
    if (!samp) { mt = t / 12; nt = t % 12; Wt = WL + WO_QP; }
    else { t -= 512 * 12; mt = 512 + t / 20; nt = t % 20; Wt = WL + WO_QS; }
    f32x16 acc[2][2];
    zero_acc(acc);
    gemm_main<1>(acc, CQ + (size_t)mt * 128 * 768, 768, Wt + (size_t)nt * 128 * 768, 768, 768, smem);
    const int g = nt * 2 + (w & 1);
    const bool rope = samp ? (g % 5 == 4) : (g % 3 == 2);
    u16* sC = (u16*)smem;
#pragma unroll
    for (int mi = 0; mi < 2; ++mi)
#pragma unroll
      for (int r = 0; r < 16; ++r) {
        const int row = (w >> 1) * 64 + mi * 32 + (r & 3) + 8 * (r >> 2) + 4 * (lane >> 5);
        const int m = mt * 128 + row;
        const float rs = rsqrtf(ss[row] * (1.0f / 768.0f) + EPS) * QSCALE;
        float v0 = acc[mi][0][r] * rs, v1 = acc[mi][1][r] * rs;
        if (rope) {
          const int pos = pos_of(m);
          const float c = ROPE[(pos * 32 + (lane & 31)) * 2], s = ROPE[(pos * 32 + (lane & 31)) * 2 + 1];
          const float a = v0 * c - v1 * s, b = v0 * s + v1 * c;
          v0 = a; v1 = b;
        }
        const int col = (w & 1) * 64 + (lane & 31);
        sC[row * LDC + col] = f2bf(v0);
        sC[row * LDC + col + 32] = f2bf(v1);
      }
    if (!samp) tile_store(smem, Q + (size_t)mt * 128 * 1536 + nt * 128, 1536);
    else tile_store(smem, QS + (size_t)(mt - 512) * 128 * 2560 + nt * 128, 2560);
  }
  base += nq;
  for (; idx < base + 4096; idx += nb) {
    int t = idx - base;
    int mt = t >> 3, nt = t & 7;
    f32x16 acc[2][2];
    zero_acc(acc);
    gemm_main<1, 2>(acc, CKVR + (size_t)mt * 128 * 256, 256, WL + WO_UK + (size_t)nt * 128 * 256, 256, 256, smem);
    {
      u16* sC = (u16*)smem;
      acc_foreach([&](int mi, int ni, int r, int row, int col) __attribute__((always_inline)) {
        const float rs = rsqrtf(ss[row] * (1.0f / 256.0f) + EPS);
        sC[row * LDC + col] = f2bf(acc[mi][ni][r] * rs);
      });
      tile_store(smem, Kb + (size_t)mt * 128 * 1024 + nt * 128, 1024);
    }
  }
  base += 4096;
  for (; idx < base + 4096; idx += nb) {
    int t = idx - base;
    int b = t >> 8, mt = (t >> 5) & 7, nt = t & 31;
    f32x16 acc[2][2];
    zero_acc(acc);
    gemm_main<2, 2>(acc, WL + WO_UVS + (size_t)mt * 128 * 256, 256, CKVR + ((size_t)b * 4096 + nt * 128) * 256, 256, 256, smem);
    {
      u16* sC = (u16*)smem;
      acc_foreach([&](int mi, int ni, int r, int row, int col) __attribute__((always_inline)) {
        const float rs = rsqrtf(ss[col] * (1.0f / 256.0f) + EPS);
        sC[row * LDC + col] = f2bf(acc[mi][ni][r] * rs);
      });
      tile_store(smem, VT + ((size_t)b * 1024 + mt * 128) * 4096 + nt * 128, 4096);
    }
  }
  base += 4096;
  for (; idx < base + MT / 8; idx += nb) post1_rows(p, l, idx - base);
  base += MT / 8;
  for (; idx < base + 32 * 33; idx += nb) cache_item(p, l, idx - base, smem);
  base += 32 * 33;
}

#ifndef ATT_PF
#define ATT_PF true
#endif
template <int DK, bool PF>
DEV void attn_item(const u16* __restrict__ qrow, const u16* __restrict__ ka, int ldka, const u16* __restrict__ kb, int ldkb,
                   const u16* __restrict__ vt, int ldvt, int ntiles, int my_tiles, int kvlen, u16* orow,
                   unsigned char* smem) {
  constexpr int DKA = DK - 64, KST = DK + 8, VST = 68;
  u16* sK = (u16*)smem;
  u16* sV = sK + 64 * KST;
  const int tid = TIDX(), lane = tid & 63, hh = lane >> 5, l31 = lane & 31;
  constexpr bool QREG = (DK <= 192);
  bf16x8 qf[DK / 16];
  if (QREG) {
#pragma unroll
    for (int ks = 0; ks < DK / 16; ++ks) qf[ks] = *(const bf16x8*)(qrow + ks * 16 + hh * 8);
  }
  f32x16 o[4];
#pragma unroll
  for (int d = 0; d < 4; ++d)
#pragma unroll
    for (int r = 0; r < 16; ++r) o[d][r] = 0.f;
  float mrun = -1e30f, lrun = 0.f;
  constexpr int CA = DKA / 32;
  bf16x8 rk[CA + 2], rv[4];
  const int skey = tid >> 2, sq = tid & 3;
  const u16* gka = ka + (size_t)skey * ldka + sq * CA * 8;
  const u16* gkb = kb + (size_t)skey * ldkb + sq * 16;
  const u16* gv = vt + (size_t)(tid >> 1) * ldvt + (tid & 1) * 32;
  u16* lka = sK + skey * KST + sq * CA * 8;
  u16* lkb = sK + skey * KST + DKA + sq * 16;
  u16* lv = sV + (tid >> 1) * VST + (tid & 1) * 32;
  auto load_tile = [&](int t) __attribute__((always_inline)) {
    const size_t ko = (size_t)t * 64;
#pragma unroll
    for (int i = 0; i < CA; ++i) rk[i] = *(const bf16x8*)(gka + ko * ldka + i * 8);
#pragma unroll
    for (int i = 0; i < 2; ++i) rk[CA + i] = *(const bf16x8*)(gkb + ko * ldkb + i * 8);
#pragma unroll
    for (int i = 0; i < 4; ++i) rv[i] = *(const bf16x8*)(gv + ko + i * 8);
  };
  auto store_tile = [&]() __attribute__((always_inline)) {
#pragma unroll
    for (int i = 0; i < CA; ++i) *(bf16x8*)(lka + i * 8) = rk[i];
#pragma unroll
    for (int i = 0; i < 2; ++i) *(bf16x8*)(lkb + i * 8) = rk[CA + i];
#pragma unroll
    for (int i = 0; i < 4; ++i) {
      union { bf16x8 v; uint2 u[2]; } cv;
      cv.v = rv[i];
      *(uint2*)(lv + i * 8) = cv.u[0];
      *(uint2*)(lv + i * 8 + 4) = cv.u[1];
    }
  };
  if (PF) load_tile(0);
#pragma unroll 1
  for (int t = 0; t < ntiles; ++t) {
    __syncthreads();
    if (!PF) load_tile(t);
    store_tile();
    __syncthreads();
    if (PF && t + 1 < ntiles) load_tile(t + 1);
    if (t < my_tiles) {
      const u16* qp = qrow + hh * 8;
      if (!QREG) asm volatile("" : "+v"(qp));
      const int key0 = t * 64;
#pragma unroll 1
      for (int mi = 0; mi < 2; ++mi) {
        f32x16 s;
#pragma unroll
        for (int r = 0; r < 16; ++r) s[r] = 0.f;
        const u16* kp = sK + (mi * 32 + l31) * KST + hh * 8;
        constexpr int KB = QREG ? 12 : 4;
#pragma unroll
        for (int k0 = 0; k0 < DK / 16; k0 += KB) {
          bf16x8 kf[KB];
#pragma unroll
          for (int i = 0; i < KB; ++i) kf[i] = *(const bf16x8*)(kp + (k0 + i) * 16);
          __builtin_amdgcn_sched_barrier(0);
#pragma unroll
          for (int i = 0; i < KB; ++i) {
            bf16x8 qv;
            if (QREG) qv = qf[k0 + i];
            else qv = *(const bf16x8*)(qp + (k0 + i) * 16);
            s = __builtin_amdgcn_mfma_f32_32x32x16_bf16(kf[i], qv, s, 0, 0, 0);
          }
        }
        bf16x8 vf[8];
        {
          const u16* vp = sV + l31 * VST + mi * 32 + 4 * hh;
#pragma unroll
          for (int oc = 0; oc < 2; ++oc)
#pragma unroll
            for (int d = 0; d < 4; ++d) {
              union { bf16x8 v; uint2 u[2]; } cv;
              cv.u[0] = *(const uint2*)(vp + d * 32 * VST + oc * 16);
              cv.u[1] = *(const uint2*)(vp + d * 32 * VST + oc * 16 + 8);
              vf[oc * 4 + d] = cv.v;
            }
          __builtin_amdgcn_sched_barrier(0);
        }
        if (key0 + 64 > kvlen) {
#pragma unroll
          for (int r = 0; r < 16; ++r) {
            int key = key0 + mi * 32 + (r & 3) + 8 * (r >> 2) + 4 * hh;
            if (key >= kvlen) s[r] = -1e30f;
          }
        }
        float mx = -1e30f;
#pragma unroll
        for (int r = 0; r < 16; ++r) mx = fmaxf(mx, s[r]);
        mx = fmaxf(mx, __shfl_xor(mx, 32, 64));
        if (__builtin_amdgcn_ballot_w64(mx > mrun) != 0ull) {
          const float mnew = fmaxf(mrun, mx);
          const float alpha = __builtin_amdgcn_exp2f(mrun - mnew);
          mrun = mnew;
          lrun *= alpha;
#pragma unroll
          for (int d = 0; d < 4; ++d)
#pragma unroll
            for (int r = 0; r < 16; ++r) o[d][r] *= alpha;
        }
        union { bf16x8 v[2]; unsigned u[8]; } pfu;
        float ps = 0.f;
#pragma unroll
        for (int r = 0; r < 16; r += 2) {
          float p0 = __builtin_amdgcn_exp2f(s[r] - mrun);
          float p1 = __builtin_amdgcn_exp2f(s[r + 1] - mrun);
          ps += p0 + p1;
          pfu.u[r >> 1] = pk2bf(p0, p1);
        }
        lrun += ps;
#pragma unroll
        for (int oc = 0; oc < 2; ++oc)
#pragma unroll
          for (int d = 0; d < 4; ++d) o[d] = __builtin_amdgcn_mfma_f32_32x32x16_bf16(vf[oc * 4 + d], pfu.v[oc], o[d], 0, 0, 0);
      }
    }
  }
  const float ltot = lrun + __shfl_xor(lrun, 32, 64);
  const float inv = 1.0f / ltot;
#pragma unroll
  for (int d = 0; d < 4; ++d)
#pragma unroll
    for (int g = 0; g < 4; ++g) {
      uint2 ov;
      ov.x = pk2bf(o[d][g * 4 + 0] * inv, o[d][g * 4 + 1] * inv);
      ov.y = pk2bf(o[d][g * 4 + 2] * inv, o[d][g * 4 + 3] * inv);
      *(uint2*)(orow + d * 32 + g * 8 + hh * 4) = ov;
    }
  __syncthreads();
}

DEV void lru_item(const Params& p, int l, int sb, int nbk, int half, unsigned char* smem) {
  const int tid = TIDX(), lane = tid & 63, w = tid >> 6, hh = lane >> 5, l31 = lane & 31;
  const bool samp = sb >= 16;
  const int S = samp ? 16 : 4096;
  const int row0 = samp ? MP + (sb - 16) * 16 : sb * 4096;
  const int kc0 = nbk * 128, oc0 = nbk * 128 + half * 64;
  const u16* XA = (const u16*)(p.ws + OFF_R1);
  u16* YL = (u16*)(p.ws + OFF_R2);
  const u16* WL = (const u16*)(p.ws + OFF_W) + (size_t)l * W_LAYER;
  u16* sXC = (u16*)smem;
  float* sA = (float*)(smem + 17408);
  float* sB = sA + 4096;
  float* segA = sB + 4096;
  float* segB = segA + 256;
  float* hc = segB + 256;
  float* cw = hc + 64;
  float* cb = cw + 512;
  const int tm = w >> 1, tn = w & 1;
  __syncthreads();
  for (int e = tid; e < 512; e += NT) cw[e] = p.conv_w[(size_t)l * 4096 + (e >> 7) * 1024 + kc0 + (e & 127)];
  if (tid < 128) cb[tid] = p.conv_b[l * 1024 + kc0 + tid];
  if (tid < 64) hc[tid] = samp ? p.state_lru[((size_t)l * 32 + (sb - 16)) * 1024 + oc0 + tid] : 0.f;
  bf16x8 waf[8], wxf[8];
  {
    const u16* wa = WL + WO_LA + (size_t)nbk * 16384 + (size_t)(half * 64 + tn * 32 + l31) * 128 + hh * 8;
    const u16* wx = WL + WO_LX + (size_t)nbk * 16384 + (size_t)(half * 64 + tn * 32 + l31) * 128 + hh * 8;
#pragma unroll
    for (int ks = 0; ks < 8; ++ks) {
      waf[ks] = *(const bf16x8*)(wa + ks * 16);
      wxf[ks] = *(const bf16x8*)(wx + ks * 16);
    }
  }
  const int och = oc0 + tn * 32 + l31;
  const float ba = p.lru_ba[l * 1024 + och], bx = p.lru_bx[l * 1024 + och];
  const float lam = p.lru_lambda[l * 1024 + och];
  const float ex_ = __expf(-lam);
  const float sp = (-lam > 20.f) ? -lam
                   : (ex_ < 0.01f ? ex_ * (1.0f - ex_ * (0.5f - ex_ * (0.33333334f - 0.25f * ex_))) : __logf(1.0f + ex_));
  __syncthreads();
  for (int t0 = 0; t0 < S; t0 += 64) {
    {
      const int cc = (tid & 15) * 8, tq = tid >> 4;
      bf16x8 xr[7];
#pragma unroll
      for (int j = 0; j < 7; ++j) {
        int ts = t0 + tq * 4 - 3 + j;
        ts = ts < 0 ? 0 : (ts > S - 1 ? S - 1 : ts);
        xr[j] = *(const bf16x8*)(XA + (size_t)(row0 + ts) * 1024 + kc0 + cc);
      }
      float xf[7][8];
#pragma unroll
      for (int j = 0; j < 7; ++j) {
        const int ts = t0 + tq * 4 - 3 + j;
        const bool ok = ts >= 0;
#pragma unroll
        for (int c = 0; c < 8; ++c) xf[j][c] = ok ? bf2f((u16)xr[j][c]) : 0.f;
      }
      if (samp && t0 == 0 && tq == 0) {
#pragma unroll
        for (int j = 0; j < 3; ++j) {
          const float* st = p.state_conv + (((size_t)l * 32 + (sb - 16)) * 3 + j) * 1024 + kc0 + cc;
#pragma unroll
          for (int c = 0; c < 8; ++c) xf[j][c] = st[c];
        }
      }
#pragma unroll
      for (int i = 0; i < 4; ++i) {
        const int tl = tq * 4 + i;
        bf16x8 o;
#pragma unroll
        for (int c = 0; c < 8; ++c) {
          float v = cb[cc + c];
#pragma unroll
          for (int k = 0; k < 4; ++k) v += xf[i + k][c] * cw[k * 128 + cc + c];
          o[c] = (short)f2bf(v);
        }
        *(bf16x8*)(sXC + tl * 136 + cc) = o;
      }
    }
    __syncthreads();
    f32x16 aR, aI;
#pragma unroll
    for (int r = 0; r < 16; ++r) { aR[r] = 0.f; aI[r] = 0.f; }
#pragma unroll
    for (int ks = 0; ks < 8; ++ks) {
      bf16x8 a = *(const bf16x8*)(sXC + (tm * 32 + l31) * 136 + ks * 16 + hh * 8);
      aR = __builtin_amdgcn_mfma_f32_32x32x16_bf16(a, waf[ks], aR, 0, 0, 0);
      aI = __builtin_amdgcn_mfma_f32_32x32x16_bf16(a, wxf[ks], aI, 0, 0, 0);
    }
#pragma unroll
    for (int r = 0; r < 16; ++r) {
      const int tl = tm * 32 + (r & 3) + 8 * (r >> 2) + 4 * hh;
      const int cl = tn * 32 + l31;
      float av, bv;
      {
        const float rg = __builtin_amdgcn_rcpf(1.0f + __expf(-(aR[r] + ba)));
        const float ig = __builtin_amdgcn_rcpf(1.0f + __expf(-(aI[r] + bx)));
        const float la = -8.0f * rg * sp;
        const float a_ = __expf(la);
        const float x2 = 2.0f * la;
        const float ser = -x2 * (1.0f + x2 * (0.5f + x2 * (0.16666667f + x2 * (0.041666668f + x2 * 0.0083333338f))));
        const float em = (x2 > -0.25f) ? ser : 1.0f - __expf(x2);
        const float mult = __builtin_amdgcn_sqrtf(em);
        const float xcv = bf2f(sXC[tl * 136 + half * 64 + cl]);
        const bool valid = (t0 + tl < S);
        av = valid ? a_ : 1.f;
        bv = valid ? mult * ig * xcv : 0.f;
      }
      sA[tl * 64 + cl] = av;
      sB[tl * 64 + cl] = bv;
    }
    __syncthreads();
    {
      const int c = lane, sg = w;
      float A_ = 1.f, B_ = 0.f;
#pragma unroll
      for (int i = 0; i < 16; ++i) {
        const float a = sA[(sg * 16 + i) * 64 + c], b = sB[(sg * 16 + i) * 64 + c];
        B_ = a * B_ + b;
        A_ *= a;
      }
      segA[sg * 64 + c] = A_;
      segB[sg * 64 + c] = B_;
      __syncthreads();
      float h = hc[c];
      for (int s2 = 0; s2 < sg; ++s2) h = segA[s2 * 64 + c] * h + segB[s2 * 64 + c];
      __syncthreads();
#pragma unroll
      for (int i = 0; i < 16; ++i) {
        const int tl = sg * 16 + i;
        const float a = sA[tl * 64 + c], b = sB[tl * 64 + c];
        h = a * h + b;
        if (t0 + tl < S) YL[(size_t)(row0 + t0 + tl) * 1024 + oc0 + c] = f2bf(h);
      }
      if (sg == 3) hc[c] = h;
    }
    __syncthreads();
  }
  if (tid < 64) {
    const float h = hc[tid];
    if (samp) p.out[OUT_LRUS + ((size_t)l * 32 + (sb - 16)) * 1024 + oc0 + tid] = h;
    else p.out[OUT_LRUP + ((size_t)l * 16 + sb) * 1024 + oc0 + tid] = h;
  }
  __syncthreads();
}

DEV void phase_p3(const Params& p, int l, unsigned char* smem) {
  __shared__ int s_item;
  const int tid = TIDX(), lane = tid & 63, w = tid >> 6;
#pragma unroll 1
  for (int it = blockIdx.x; it < 256; it += gridDim.x) lru_item(p, l, it >> 4, (it >> 1) & 7, it & 1, smem);
#pragma unroll 1
  for (int it0 = blockIdx.x; it0 < 320; it0 += gridDim.x) {
    if (it0 < 256) continue;
    const int it = it0 - 256;
    const int b = it >> 1, dvh = it & 1;
    const int r = w * 32 + (lane & 31), h = r >> 4, t = r & 15;
    const u16* qrow = (const u16*)(p.ws + OFF_QS) + ((size_t)b * 16 + t) * 2560 + h * 320;
    const u16* ka = (const u16*)(p.ws + OFF_SKV) + (size_t)b * 2112 * 320;
    const u16* vt = (const u16*)(p.ws + OFF_SVT) + ((size_t)b * 256 + dvh * 128) * 2112;
    u16* orow = (u16*)(p.ws + OFF_OLAT) + ((size_t)b * 16 + t) * 2048 + h * 256 + dvh * 128;
    attn_item<320, false>(qrow, ka, 320, ka + 256, 320, vt, 2112, 33, 33, 2064, orow, smem);
  }
  const int xcd = blockIdx.x & 7;
#pragma unroll 1
  for (int qi = 0; qi < 8; ++qi) {
    const int q = (xcd + qi) & 7;
    unsigned* qc = (unsigned*)(p.ws + OFF_CNT) + 8 + l * 8 + q;
#pragma unroll 1
    for (;;) {
      __syncthreads();
      if (tid == 0) s_item = (int)atomicAdd(qc, 1u);
      __syncthreads();
      const int it = s_item;
      if (it >= 512) break;
      const int half_ = it >> 8, j_ = it & 255;
      const int qt = (half_ ? 15 : 31) - (j_ & 15), bh = (j_ >> 4) * 8 + q, b = bh >> 3, h = bh & 7;
      u16* Q = (u16*)(p.ws + OFF_R3);
      const int r = w * 32 + (lane & 31);
      u16* qrow = Q + ((size_t)b * 4096 + qt * 128 + r) * 1536 + h * 192;
      const u16* ka = (const u16*)(p.ws + OFF_R4) + (size_t)b * 4096 * 1024 + h * 128;
      const u16* kb = (const u16*)(p.ws + OFF_KPE) + (size_t)b * 4096 * 64;
      const u16* vt = (const u16*)(p.ws + OFF_VT) + ((size_t)b * 1024 + h * 128) * 4096;
      attn_item<192, ATT_PF>(qrow, ka, 1024, kb, 64, vt, 4096, 2 * (qt + 1), 2 * qt + 1 + (w >> 1), 1 << 30, qrow, smem);
    }
  }
#pragma unroll 1
  for (int it = blockIdx.x; it < 512; it += gridDim.x) lru_item(p, l, 16 + (it >> 4), (it >> 1) & 7, it & 1, smem);
}

template <int MI>
DEV void p4_tile(const Params& p, int l, int m0, int nt, unsigned char* smem) {
  const u16* WL = (const u16*)(p.ws + OFF_W) + (size_t)l * W_LAYER;
  const u16* H = (const u16*)(p.ws + OFF_H);
  const u16* Q = (const u16*)(p.ws + OFF_R3);
  const u16* OLAT = (const u16*)(p.ws + OFF_OLAT);
  u16* YB = (u16*)(p.ws + OFF_R1);
  u16* YA = (u16*)(p.ws + OFF_R2);
  u16* sC = (u16*)smem;
  f32x16 acc[MI][2];
  if (nt < 8) {
    if constexpr (MI == 2) {
      if (m0 >= MP) {
        f32x16 att[MI][2];
        zero_acc_t<MI>(att);
        gemm_mm<MI>(att, OLAT + (size_t)(m0 - MP) * 2048 + nt * 256, 2048, WL + WO_UVP + (size_t)nt * 128 * 256, 256, 256, smem);
        zero_acc_t<MI>(acc);
        gemm_mm<MI>(acc, H + (size_t)m0 * 1024, 1024, WL + WO_G + (size_t)(1024 + nt * 128) * 1024, 1024, 1024, smem);
        acc_foreach_t<MI>([&](int mi, int ni, int r, int row, int col) __attribute__((always_inline)) {
          sC[row * LDC + col] = f2bf(att[mi][ni][r] * siluf_(acc[mi][ni][r]));
        });
        tile_store_t<MI>(smem, YB + (size_t)m0 * 1024 + nt * 128, 1024);
        return;
      }
    }
    zero_acc_t<MI>(acc);
    gemm_mm<MI>(acc, H + (size_t)m0 * 1024, 1024, WL + WO_G + (size_t)(1024 + nt * 128) * 1024, 1024, 1024, smem);
    tile_load_t<MI>(smem, Q + (size_t)m0 * 1536 + nt * 192, 1536);
    acc_foreach_t<MI>([&](int mi, int ni, int r, int row, int col) __attribute__((always_inline)) {
      sC[row * LDC + col] = f2bf(bf2f(sC[row * LDC + col]) * siluf_(acc[mi][ni][r]));
    });
    tile_store_t<MI>(smem, YB + (size_t)m0 * 1024 + nt * 128, 1024);
  } else {
    const int n0 = (nt - 8) * 128;
    zero_acc_t<MI>(acc);
    gemm_mm<MI>(acc, H + (size_t)m0 * 1024, 1024, WL + WO_G + (size_t)n0 * 1024, 1024, 1024, smem);
    tile_load_t<MI>(smem, YA + (size_t)m0 * 1024 + n0, 1024);
    acc_foreach_t<MI>([&](int mi, int ni, int r, int row, int col) __attribute__((always_inline)) {
      sC[row * LDC + col] = f2bf(bf2f(sC[row * LDC + col]) * siluf_(acc[mi][ni][r]));
    });
    tile_store_t<MI>(smem, YA + (size_t)m0 * 1024 + n0, 1024);
  }
}
DEV void phase_p4(const Params& p, int l, unsigned char* smem) {
  const int nb = gridDim.x;
  int idx = vbid(), base = 0;
#pragma unroll 1
  for (; idx < base + 256 * 16; idx += nb) {
    const int t = idx - base;
    p4_tile<4>(p, l, (t >> 4) * 256, t & 15, smem);
  }
  base += 256 * 16;
#pragma unroll 1
  for (; idx < base + 4 * 16; idx += nb) {
    const int t = idx - base;
    p4_tile<2>(p, l, MP + (t >> 4) * 128, t & 15, smem);
  }
}

constexpr int SM_GATE = 2 * 128 * LDT * 2 + 1024;
DEV void gemm_gates(f32x16 (&acc)[2][4], const u16* __restrict__ A, const u16* __restrict__ B0, const u16* __restrict__ B1,
                    unsigned char* smem) {
  u16* sA = (u16*)smem;
  u16* sB = sA + 128 * LDT;
  const int tid = TIDX(), lane = tid & 63, w = tid >> 6, wm = w >> 1, wn = w & 1;
  const int srow = tid >> 3, scol = (tid & 7) * 8;
  const u16* ap = A + (size_t)srow * 1024 + scol;
  const u16* b0p = B0 + (size_t)srow * 1024 + scol;
  const u16* b1p = B1 + (size_t)srow * 1024 + scol;
  bf16x8 ra[4], rb[8];
#pragma unroll
  for (int i = 0; i < 4; ++i) {
    ra[i] = *(const bf16x8*)(ap + (size_t)(32 * i) * 1024);
    rb[i] = *(const bf16x8*)(b0p + (size_t)(32 * i) * 1024);
    rb[4 + i] = *(const bf16x8*)(b1p + (size_t)(32 * i) * 1024);
  }
  const int fro = (lane & 31) * LDT + (lane >> 5) * 8;
#pragma unroll 1
  for (int kt = 0; kt < 16; ++kt) {
    __syncthreads();
#pragma unroll
    for (int i = 0; i < 4; ++i) *(bf16x8*)(sA + (srow + 32 * i) * LDT + scol) = ra[i];
#pragma unroll
    for (int i = 0; i < 8; ++i) *(bf16x8*)(sB + (srow + 32 * i) * LDT + scol) = rb[i];
    __syncthreads();
    if (kt + 1 < 16) {
      ap += 64;
      b0p += 64;
      b1p += 64;
#pragma unroll
      for (int i = 0; i < 4; ++i) {
        ra[i] = *(const bf16x8*)(ap + (size_t)(32 * i) * 1024);
        rb[i] = *(const bf16x8*)(b0p + (size_t)(32 * i) * 1024);
        rb[4 + i] = *(const bf16x8*)(b1p + (size_t)(32 * i) * 1024);
      }
    }
#pragma unroll 2
    for (int ks = 0; ks < 4; ++ks) {
      bf16x8 af[2], bfr[4];
#pragma unroll
      for (int i = 0; i < 2; ++i) af[i] = *(const bf16x8*)(sA + (wm * 64 + i * 32) * LDT + fro + ks * 16);
#pragma unroll
      for (int i = 0; i < 4; ++i)
        bfr[i] = *(const bf16x8*)(sB + ((i >> 1) * 128 + wn * 64 + (i & 1) * 32) * LDT + fro + ks * 16);
      __builtin_amdgcn_s_setprio(1);
#pragma unroll
      for (int mi = 0; mi < 2; ++mi)
#pragma unroll
        for (int ni = 0; ni < 4; ++ni)
          acc[mi][ni] = __builtin_amdgcn_mfma_f32_32x32x16_bf16(af[mi], bfr[ni], acc[mi][ni], 0, 0, 0);
      __builtin_amdgcn_s_setprio(0);
    }
  }
  __syncthreads();
}
DEV void phase_p5(const Params& p, int l, unsigned char* smem) {
  const u16* WL = (const u16*)(p.ws + OFF_W) + (size_t)l * W_LAYER;
  const u16* H = (const u16*)(p.ws + OFF_H);
  const u16* YB = (const u16*)(p.ws + OFF_R1);
  const u16* YA = (const u16*)(p.ws + OFF_R2);
  u16* MRG = (u16*)(p.ws + OFF_R3);
  u16* sC = (u16*)smem;
  const int ntiles = 516 * 8;
  for (int t = vbid(); t < ntiles; t += gridDim.x) {
    const int mt = t >> 3, nt = t & 7;
    unsigned ga[2][2][8];
    unsigned* sG = (unsigned*)(smem + SM_GATE);
    const int tid = TIDX();
    {
      f32x16 g[2][4];
#pragma unroll
      for (int a_ = 0; a_ < 2; ++a_)
#pragma unroll
        for (int b_ = 0; b_ < 4; ++b_)
#pragma unroll
          for (int r = 0; r < 16; ++r) g[a_][b_][r] = 0.f;
      gemm_gates(g, H + (size_t)mt * 128 * 1024, WL + WO_G + (size_t)(2048 + nt * 128) * 1024,
                 WL + WO_G + (size_t)(3072 + nt * 128) * 1024, smem);
#pragma unroll
      for (int a_ = 0; a_ < 2; ++a_)
#pragma unroll
        for (int b_ = 0; b_ < 2; ++b_) {
#pragma unroll
          for (int r = 0; r < 8; ++r)
            sG[((a_ * 2 + b_) * 8 + r) * 256 + tid] = pk2bf(sigmoidf_(g[a_][2 + b_][2 * r]), sigmoidf_(g[a_][2 + b_][2 * r + 1]));
          __builtin_amdgcn_sched_barrier(0);
        }
#pragma unroll
      for (int a_ = 0; a_ < 2; ++a_)
#pragma unroll
        for (int b_ = 0; b_ < 2; ++b_) {
#pragma unroll
          for (int r = 0; r < 8; ++r) ga[a_][b_][r] = pk2bf(sigmoidf_(g[a_][b_][2 * r]), sigmoidf_(g[a_][b_][2 * r + 1]));
          __builtin_amdgcn_sched_barrier(0);
        }
    }
    auto gate_a = [&](int mi, int ni, int r) __attribute__((always_inline)) -> float {
      const unsigned gq = ga[mi][ni][r >> 1];
      return __uint_as_float((r & 1) ? (gq & 0xffff0000u) : (gq << 16));
    };
    auto gate_b = [&](int mi, int ni, int r) __attribute__((always_inline)) -> float {
      const unsigned gq = sG[((mi * 2 + ni) * 8 + (r >> 1)) * 256 + tid];
      return __uint_as_float((r & 1) ? (gq & 0xffff0000u) : (gq << 16));
    };
    f32x16 acc[2][2];
    unsigned res[2][2][8];
    zero_acc(acc);
    gemm_main<0>(acc, YA + (size_t)mt * 128 * 1024, 1024, WL + WO_BA + (size_t)nt * 128 * 1024, 1024, 1024, smem);
#pragma unroll
    for (int mi = 0; mi < 2; ++mi)
#pragma unroll
      for (int ni = 0; ni < 2; ++ni)
#pragma unroll
        for (int r = 0; r < 8; ++r)
          res[mi][ni][r] = pk2bf(acc[mi][ni][2 * r] * gate_a(mi, ni, 2 * r), acc[mi][ni][2 * r + 1] * gate_a(mi, ni, 2 * r + 1));
    zero_acc(acc);
    gemm_main<0>(acc, YB + (size_t)mt * 128 * 1024, 1024, WL + WO_BB + (size_t)nt * 128 * 1024, 1024, 1024, smem);
    __syncthreads();
    acc_foreach([&](int mi, int ni, int r, int row, int col) __attribute__((always_inline)) {
      const unsigned rq = res[mi][ni][r >> 1];
      const float rv = __uint_as_float((r & 1) ? (rq & 0xffff0000u) : (rq << 16));
      sC[row * LDC + col] = f2bf(rv + acc[mi][ni][r] * gate_b(mi, ni, r));
    });
    tile_store(smem, MRG + (size_t)mt * 128 * 1024 + nt * 128, 1024);
  }
}

template <int MI>
DEV void p6_tile(const Params& p, int l, int m0, int nt, unsigned char* smem) {
  const u16* WL = (const u16*)(p.ws + OFF_W) + (size_t)l * W_LAYER;
  const u16* MRG = (const u16*)(p.ws + OFF_R3);
  u16* O = (u16*)(p.ws + OFF_R4);
  u16* sC = (u16*)smem;
  f32x16 acc[MI][2];
  zero_acc_t<MI>(acc);
  gemm_mm<MI>(acc, MRG + (size_t)m0 * 1024, 1024, WL + WO_OUT + (size_t)nt * 128 * 1024, 1024, 1024, smem);
  acc_foreach_t<MI>([&](int mi, int ni, int r, int row, int col) __attribute__((always_inline)) {
    sC[row * LDC + col] = f2bf(acc[mi][ni][r]);
  });
  tile_store_t<MI>(smem, O + (size_t)m0 * 1024 + nt * 128, 1024);
}
DEV void phase_p6(const Params& p, int l, unsigned char* smem) {
  const int nb = gridDim.x;
  int idx = vbid(), base = 0;
#pragma unroll 1
  for (; idx < base + 256 * 8; idx += nb) {
    const int t = idx - base;
    p6_tile<4>(p, l, (t >> 3) * 256, t & 7, smem);
  }
  base += 256 * 8;
#pragma unroll 1
  for (; idx < base + 4 * 8; idx += nb) {
    const int t = idx - base;
    p6_tile<2>(p, l, MP + (t >> 3) * 128, t & 7, smem);
  }
}

constexpr int SM_TOTAL = SM_GATE + 32768;
__global__ void __launch_bounds__(NT, 2) mega(Params p) {
  __shared__ __attribute__((aligned(16))) unsigned char smem[SM_TOTAL];
  cg::grid_group grid = cg::this_grid();
  __shared__ uint4 xb_words;
  if (threadIdx.x == 0) xb_words = make_uint4(0u, 0u, 0u, 0u);
#define PH(call)                                             \
  {                                                          \
    Params q = p;                                            \
    size_t z_ = 0;                                           \
    asm volatile("" : "+s"(z_));                             \
    q.ws = p.ws + z_;                                        \
    q.out = p.out + z_;                                      \
    call;                                                    \
  }
  PH(phase_prep(q, smem));
  grid.sync();
  (void)xcd_barrier_post((unsigned*)(p.ws + OFF_BAR), (volatile LAS unsigned*)&xb_words);
#define XBAR() xcd_barrier((unsigned*)(p.ws + OFF_BAR), (volatile LAS unsigned*)&xb_words)
  PH(phase_norm0(q));
  XBAR();
#pragma unroll 1
  for (int l = 0; l < 2; ++l) {
    PH(phase_gemm1(q, l, smem));
    XBAR();
    PH(phase_p2(q, l, smem));
    XBAR();
    PH(phase_p3(q, l, smem));
    XBAR();
    PH(phase_p4(q, l, smem));
    XBAR();
    PH(phase_p5(q, l, smem));
    XBAR();
    PH(phase_p6(q, l, smem));
    XBAR();
    PH(phase_final(q, l));
    if (l == 0) XBAR();
  }
}

extern "C" void kernel_launch(void* const* d_in, const int* in_sizes, int n_in, void* d_out, int out_size, void* d_ws,
                              size_t ws_size, hipStream_t stream) {
  static int grid_blocks = 0;
  if (!grid_blocks) {
    int dev = 0, cus = 0, per_cu = 0;
    hipGetDevice(&dev);
    hipDeviceGetAttribute(&cus, hipDeviceAttributeMultiprocessorCount, dev);
    hipOccupancyMaxActiveBlocksPerMultiprocessor(&per_cu, mega, NT, 0);
    if (per_cu > 2) per_cu = 2;
    grid_blocks = cus * per_cu;
  }
  if (ws_size < WS_NEED) {
    fprintf(stderr, "workspace too small: %zu < %zu\n", ws_size, (size_t)WS_NEED);
    return;
  }
  Params p{};
  const float** pp = (const float**)&p;
  for (int i = 0; i < 28; ++i) pp[i] = (const float*)d_in[i];
  p.out = (float*)d_out;
  p.ws = (unsigned char*)d_ws;
  void* args[] = {&p};
  hipError_t e = hipLaunchCooperativeKernel((void*)mega, dim3(grid_blocks), dim3(NT), args, 0, stream);
  if (e != hipSuccess) fprintf(stderr, "cooperative launch failed: %s (grid %d)\n", hipGetErrorString(e), grid_blocks);
}
```

```cpp
#include <hip/hip_runtime.h>
#include <hip/hip_cooperative_groups.h>
#include <cstdio>
namespace cg = cooperative_groups;

typedef unsigned short u16;
typedef __attribute__((ext_vector_type(8))) short bf16x8;
typedef __attribute__((ext_vector_type(16))) float f32x16;

#define DEV __device__ __forceinline__
#define NT 256

constexpr int MP = 65536, MS = 512, MT = 66048;
constexpr int IN_DIM = 6208;
constexpr float EPS = 1e-6f;
constexpr float QSCALE = 0.07216878364870322f * 1.4426950408889634f;

constexpr size_t SZ_ACT = (size_t)MT * 1024 * 2;
constexpr size_t OFF_H = 0;
constexpr size_t OFF_R1 = OFF_H + SZ_ACT;
constexpr size_t OFF_R2 = OFF_R1 + SZ_ACT;
constexpr size_t OFF_R3 = OFF_R2 + SZ_ACT;
constexpr size_t OFF_R4 = OFF_R3 + (size_t)MP * 1536 * 2;
constexpr size_t OFF_KPE = OFF_R4 + SZ_ACT;
constexpr size_t OFF_VT = OFF_KPE + (size_t)MT * 64 * 2;
constexpr size_t OFF_SKV = OFF_VT + (size_t)16 * 1024 * 4096 * 2;
constexpr size_t OFF_SVT = OFF_SKV + (size_t)32 * 2112 * 320 * 2;
constexpr size_t OFF_QS = OFF_SVT + (size_t)32 * 256 * 2112 * 2;
constexpr size_t OFF_OLAT = OFF_QS + (size_t)MS * 2560 * 2;
constexpr size_t OFF_MOD = OFF_OLAT + (size_t)MS * 2048 * 2;
constexpr size_t OFF_ROPE = OFF_MOD + (size_t)2 * 48 * 3072 * 4;
constexpr size_t OFF_CNT = OFF_ROPE + (size_t)4096 * 32 * 2 * 4;
constexpr size_t OFF_W = OFF_CNT + 256;
constexpr size_t WO_W1 = 0;
constexpr size_t WO_G = WO_W1 + (size_t)2176 * 1024;
constexpr size_t WO_QP = WO_G + (size_t)4096 * 1024;
constexpr size_t WO_QS = WO_QP + (size_t)1536 * 768;
constexpr size_t WO_UK = WO_QS + (size_t)2560 * 768;
constexpr size_t WO_UVS = WO_UK + 262144;
constexpr size_t WO_UVP = WO_UVS + 262144;
constexpr size_t WO_BA = WO_UVP + 262144;
constexpr size_t WO_BB = WO_BA + 1048576;
constexpr size_t WO_OUT = WO_BB + 1048576;
constexpr size_t WO_LA = WO_OUT + 1048576;
constexpr size_t WO_LX = WO_LA + 131072;
constexpr size_t W_LAYER = WO_LX + 131072;
constexpr size_t OFF_BAR = OFF_W + 2 * W_LAYER * 2;
constexpr size_t WS_NEED = OFF_BAR + 16384;

constexpr size_t OUT_YP = 0;
constexpr size_t OUT_YS = 67108864;
constexpr size_t OUT_CKVP = 67633152;
constexpr size_t OUT_KPEP = 101187584;
constexpr size_t OUT_CONVP = 109576192;
constexpr size_t OUT_LRUP = 109674496;
constexpr size_t OUT_CKVS = 109707264;
constexpr size_t OUT_KPES = 109969408;
constexpr size_t OUT_CONVS = 110034944;
constexpr size_t OUT_LRUS = 110231552;

struct Params {
  const float *x_p, *x_s, *c_p, *c_s, *cache_ckv, *cache_kpe, *state_conv, *state_lru;
  const float *ada_w, *ada_b, *pre_norm, *post_norm, *w_in, *conv_w, *conv_b, *lru_wa, *lru_ba, *lru_wx, *lru_bx;
  const float *lru_lambda, *q_norm, *w_q_up, *kv_norm, *w_uk, *w_uv, *w_ba, *w_bb, *w_out;
  float* out;
  unsigned char* ws;
};

DEV int TIDX() {
  int t = threadIdx.x;
  asm volatile("" : "+v"(t));
  return t;
}
typedef __attribute__((ext_vector_type(2))) float f32x2_t;
typedef __attribute__((ext_vector_type(2))) __bf16 bf16x2_t;
DEV unsigned pk2bf(float a, float b) {
  f32x2_t v = {a, b};
  bf16x2_t r = __builtin_convertvector(v, bf16x2_t);
  return __builtin_bit_cast(unsigned, r);
}
DEV u16 f2bf(float f) { return (u16)(pk2bf(f, 0.f) & 0xffffu); }
DEV float bf2f(u16 h) { return __uint_as_float(((unsigned)h) << 16); }
DEV float sigmoidf_(float x) { return 1.0f / (1.0f + __expf(-x)); }
DEV float siluf_(float x) { return x / (1.0f + __expf(-x)); }
DEV float wave_sum(float v) {
#pragma unroll
  for (int o = 32; o > 0; o >>= 1) v += __shfl_xor(v, o, 64);
  return v;
}
DEV int vbid() {
  const int b = blockIdx.x, n = gridDim.x;
  return ((n & 7) == 0) ? (b & 7) * (n >> 3) + (b >> 3) : b;
}
DEV int mod_row(int m) { return m < MP ? (m >> 12) : 16 + ((m - MP) >> 4); }
DEV int pos_of(int m) { return m < MP ? (m & 4095) : 2048 + ((m - MP) & 15); }

constexpr int LDT = 72;
#ifndef P5_DEPTH
#define P5_DEPTH 1
#endif
template <int SS, int DEPTH = 1>
DEV void gemm_main(f32x16 (&acc)[2][2], const u16* __restrict__ A, int lda, const u16* __restrict__ B, int ldb,
                   int K, unsigned char* smem) {
  u16* sA = (u16*)smem;
  u16* sB = sA + 128 * LDT;
  float* ss = (float*)(sB + 128 * LDT);
  const int tid = TIDX(), lane = tid & 63, w = tid >> 6, wm = w >> 1, wn = w & 1;
  const int srow = tid >> 3, scol = (tid & 7) * 8;
  const u16* ap = A + (size_t)srow * lda + scol;
  const u16* bp = B + (size_t)srow * ldb + scol;
  bf16x8 ra[DEPTH][4], rb[DEPTH][4];
  float ssq[4] = {0.f, 0.f, 0.f, 0.f};
  const int nk = K >> 6;
#pragma unroll
  for (int d = 0; d < DEPTH; ++d)
#pragma unroll
    for (int i = 0; i < 4; ++i) {
      ra[d][i] = *(const bf16x8*)(ap + d * 64 + (size_t)(32 * i) * lda);
      rb[d][i] = *(const bf16x8*)(bp + d * 64 + (size_t)(32 * i) * ldb);
    }
  ap += DEPTH * 64;
  bp += DEPTH * 64;
  const int fro = (lane & 31) * LDT + (lane >> 5) * 8;
#pragma unroll 1
  for (int kt = 0; kt < nk; kt += DEPTH) {
#pragma unroll
    for (int d = 0; d < DEPTH; ++d) {
      __syncthreads();
#pragma unroll
      for (int i = 0; i < 4; ++i) {
        *(bf16x8*)(sA + (srow + 32 * i) * LDT + scol) = ra[d][i];
        *(bf16x8*)(sB + (srow + 32 * i) * LDT + scol) = rb[d][i];
        if (SS) {
          bf16x8 v = (SS == 1) ? ra[d][i] : rb[d][i];
#pragma unroll
          for (int j = 0; j < 8; ++j) {
            float f = bf2f((u16)v[j]);
            ssq[i] += f * f;
          }
        }
      }
      __syncthreads();
      if (kt + d + DEPTH < nk) {
#pragma unroll
        for (int i = 0; i < 4; ++i) {
          ra[d][i] = *(const bf16x8*)(ap + (size_t)(32 * i) * lda);
          rb[d][i] = *(const bf16x8*)(bp + (size_t)(32 * i) * ldb);
        }
        ap += 64;
        bp += 64;
      }
#pragma unroll
      for (int ks = 0; ks < 4; ++ks) {
        bf16x8 af[2], bfr[2];
#pragma unroll
        for (int i = 0; i < 2; ++i) {
          af[i] = *(const bf16x8*)(sA + (wm * 64 + i * 32) * LDT + fro + ks * 16);
          bfr[i] = *(const bf16x8*)(sB + (wn * 64 + i * 32) * LDT + fro + ks * 16);
        }
        __builtin_amdgcn_s_setprio(1);
#pragma unroll
        for (int mi = 0; mi < 2; ++mi)
#pragma unroll
          for (int ni = 0; ni < 2; ++ni)
            acc[mi][ni] = __builtin_amdgcn_mfma_f32_32x32x16_bf16(af[mi], bfr[ni], acc[mi][ni], 0, 0, 0);
        __builtin_amdgcn_s_setprio(0);
      }
    }
  }
  if (SS) {
#pragma unroll
    for (int i = 0; i < 4; ++i) {
      float v = ssq[i];
      v += __shfl_xor(v, 1, 64);
      v += __shfl_xor(v, 2, 64);
      v += __shfl_xor(v, 4, 64);
      if ((tid & 7) == 0) ss[srow + 32 * i] = v;
    }
    __syncthreads();
  }
}
DEV void zero_acc(f32x16 (&acc)[2][2]) {
#pragma unroll
  for (int a = 0; a < 2; ++a)
#pragma unroll
    for (int b = 0; b < 2; ++b)
#pragma unroll
      for (int r = 0; r < 16; ++r) acc[a][b][r] = 0.f;
}
DEV float* gemm_ss(unsigned char* smem) { return (float*)(smem + 2 * 128 * LDT * 2); }

template <class F>
DEV void acc_foreach(F f) {
  const int tid_ = TIDX();
  const int lane = tid_ & 63, w = tid_ >> 6;
#pragma unroll
  for (int mi = 0; mi < 2; ++mi)
#pragma unroll
    for (int ni = 0; ni < 2; ++ni)
#pragma unroll
      for (int r = 0; r < 16; ++r)
        f(mi, ni, r, (w >> 1) * 64 + mi * 32 + (r & 3) + 8 * (r >> 2) + 4 * (lane >> 5), (w & 1) * 64 + ni * 32 + (lane & 31));
}
constexpr int LDC = 136;
DEV void tile_store(unsigned char* smem, u16* dst, size_t ldd) {
  const u16* sC = (const u16*)smem;
  __syncthreads();
  const int tid_ = TIDX();
#pragma unroll
  for (int i = 0; i < 8; ++i) {
    const int c = tid_ + 256 * i, row = c >> 4, cc = (c & 15) * 8;
    __builtin_nontemporal_store(*(const bf16x8*)(sC + row * LDC + cc), (bf16x8*)(dst + (size_t)row * ldd + cc));
  }
}


template <int MI>
DEV void gemm_mm(f32x16 (&acc)[MI][2], const u16* __restrict__ A, int lda, const u16* __restrict__ B, int ldb, int K,
                 unsigned char* smem) {
  constexpr int BM = MI * 64;
  u16* sA = (u16*)smem;
  u16* sB = sA + BM * LDT;
  const int tid = TIDX(), lane = tid & 63, w = tid >> 6, wm = w >> 1, wn = w & 1;
  const int srow = tid >> 3, scol = (tid & 7) * 8;
  const u16* ap = A + (size_t)srow * lda + scol;
  const u16* bp = B + (size_t)srow * ldb + scol;
  bf16x8 ra[MI * 2], rb[4];
#pragma unroll
  for (int i = 0; i < MI * 2; ++i) ra[i] = *(const bf16x8*)(ap + (size_t)(32 * i) * lda);
#pragma unroll
  for (int i = 0; i < 4; ++i) rb[i] = *(const bf16x8*)(bp + (size_t)(32 * i) * ldb);
  const int nk = K >> 6;
  const int fro = (lane & 31) * LDT + (lane >> 5) * 8;
#pragma unroll 1
  for (int kt = 0; kt < nk; ++kt) {
    __syncthreads();
#pragma unroll
    for (int i = 0; i < MI * 2; ++i) *(bf16x8*)(sA + (srow + 32 * i) * LDT + scol) = ra[i];
#pragma unroll
    for (int i = 0; i < 4; ++i) *(bf16x8*)(sB + (srow + 32 * i) * LDT + scol) = rb[i];
    __syncthreads();
    if (kt + 1 < nk) {
      ap += 64;
      bp += 64;
#pragma unroll
      for (int i = 0; i < MI * 2; ++i) ra[i] = *(const bf16x8*)(ap + (size_t)(32 * i) * lda);
#pragma unroll
      for (int i = 0; i < 4; ++i) rb[i] = *(const bf16x8*)(bp + (size_t)(32 * i) * ldb);
    }
#pragma unroll
    for (int ks = 0; ks < 4; ++ks) {
      bf16x8 af[MI], bfr[2];
#pragma unroll
      for (int i = 0; i < MI; ++i) af[i] = *(const bf16x8*)(sA + (wm * (MI * 32) + i * 32) * LDT + fro + ks * 16);
#pragma unroll
      for (int i = 0; i < 2; ++i) bfr[i] = *(const bf16x8*)(sB + (wn * 64 + i * 32) * LDT + fro + ks * 16);
      __builtin_amdgcn_s_setprio(1);
#pragma unroll
      for (int mi = 0; mi < MI; ++mi)
#pragma unroll
        for (int ni = 0; ni < 2; ++ni)
          acc[mi][ni] = __builtin_amdgcn_mfma_f32_32x32x16_bf16(af[mi], bfr[ni], acc[mi][ni], 0, 0, 0);
      __builtin_amdgcn_s_setprio(0);
    }
  }
  __syncthreads();
}
template <int MI>
DEV void zero_acc_t(f32x16 (&acc)[MI][2]) {
#pragma unroll
  for (int a = 0; a < MI; ++a)
#pragma unroll
    for (int b = 0; b < 2; ++b)
#pragma unroll
      for (int r = 0; r < 16; ++r) acc[a][b][r] = 0.f;
}
template <int MI, class F>
DEV void acc_foreach_t(F f) {
  const int tid_ = TIDX();
  const int lane = tid_ & 63, w = tid_ >> 6;
#pragma unroll
  for (int mi = 0; mi < MI; ++mi)
#pragma unroll
    for (int ni = 0; ni < 2; ++ni)
#pragma unroll
      for (int r = 0; r < 16; ++r)
        f(mi, ni, r, (w >> 1) * (MI * 32) + mi * 32 + (r & 3) + 8 * (r >> 2) + 4 * (lane >> 5), (w & 1) * 64 + ni * 32 + (lane & 31));
}
template <int MI>
DEV void tile_load_t(unsigned char* smem, const u16* src, size_t lds_) {
  u16* sC = (u16*)smem;
  const int tid_ = TIDX();
#pragma unroll
  for (int i = 0; i < MI * 4; ++i) {
    const int c = tid_ + 256 * i, row = c >> 4, cc = (c & 15) * 8;
    *(bf16x8*)(sC + row * LDC + cc) = __builtin_nontemporal_load((const bf16x8*)(src + (size_t)row * lds_ + cc));
  }
  __syncthreads();
}
template <int MI>
DEV void tile_store_t(unsigned char* smem, u16* dst, size_t ldd) {
  const u16* sC = (const u16*)smem;
  __syncthreads();
  const int tid_ = TIDX();
#pragma unroll
  for (int i = 0; i < MI * 4; ++i) {
    const int c = tid_ + 256 * i, row = c >> 4, cc = (c & 15) * 8;
    __builtin_nontemporal_store(*(const bf16x8*)(sC + row * LDC + cc), (bf16x8*)(dst + (size_t)row * ldd + cc));
  }
}

#define XB_TMO      128
#define XB_XCNT(j)  (256  + 64 * (j))
#define XB_XSUB(j)  (1280 + 64 * (j))
#define XB_XGEN(j)  (2304 + 64 * (j))
#define XB_TOP      3328
#define XB_TOPGEN   3392
#define XCD_BAR_WORDS 3456
#define XB_SPIN_CAP (1u << 20)
#define LAS __attribute__((address_space(3)))
DEV unsigned xb_ld(unsigned* p) { return __hip_atomic_load(p, __ATOMIC_RELAXED, __HIP_MEMORY_SCOPE_AGENT); }
DEV unsigned xb_add(unsigned* p, unsigned v) { return __hip_atomic_fetch_add(p, v, __ATOMIC_RELAXED, __HIP_MEMORY_SCOPE_AGENT); }
DEV unsigned xb_xcc_id() { return (unsigned)__builtin_amdgcn_s_getreg((3 << 11) | 20) & 0xFu; }
#define XB_SPIN(cond, bar) do { unsigned _sp = 0; while (cond) { __builtin_amdgcn_s_sleep(1); \
    if ((++_sp & 255u) == 0u) { if (xb_ld(&(bar)[XB_TMO])) break; if (_sp > XB_SPIN_CAP) { atomicAdd(&(bar)[XB_TMO], 1u); break; } } } } while (0)
struct XcdBarrier {
  unsigned* bar;
  unsigned x;
  volatile LAS unsigned* st;
};
DEV XcdBarrier xcd_barrier_post(unsigned* bar, volatile LAS unsigned* st) {
  XcdBarrier b;
  b.bar = bar;
  b.x = xb_xcc_id();
  b.st = st;
  if (threadIdx.x == 0) (void)xb_add(&bar[XB_XCNT(b.x)], 1u);
  return b;
}
DEV void xcd_barrier_complete(unsigned* bar, unsigned x, unsigned& nloc, unsigned& nx) {
  const unsigned G = gridDim.x * gridDim.y * gridDim.z;
  unsigned sum, cnt, mine, sp = 0u;
  for (;;) {
    sum = 0u; cnt = 0u; mine = 0u;
#pragma unroll
    for (unsigned j = 0; j < 16; ++j) {
      const unsigned c = xb_ld(&bar[XB_XCNT(j)]);
      sum += c;
      cnt += (c > 0u) ? 1u : 0u;
      mine = (j == x) ? c : mine;
    }
    if (sum == G) break;
    __builtin_amdgcn_s_sleep(1);
    if ((++sp & 255u) == 0u) {
      if (xb_ld(&bar[XB_TMO])) break;
      if (sp > XB_SPIN_CAP) { atomicAdd(&bar[XB_TMO], 1u); break; }
    }
  }
  nloc = mine > 0u ? mine : 1u;
  nx = cnt > 0u ? cnt : 1u;
}
DEV void xcd_barrier(unsigned* bar_, volatile LAS unsigned* st_) {
  asm volatile("s_waitcnt vmcnt(0)" ::: "memory");
  __syncthreads();
  if (threadIdx.x == 0) {
    XcdBarrier b;
    b.bar = bar_;
    b.x = xb_xcc_id();
    b.st = st_;
    unsigned* bar = b.bar;
    __builtin_amdgcn_s_waitcnt(0);
    unsigned nloc = b.st[0], nx = b.st[1];
    if (nloc == 0u) {
      xcd_barrier_complete(bar, b.x, nloc, nx);
      b.st[0] = nloc;
      b.st[1] = nx;
    }
    const unsigned old = xb_add(&bar[XB_XSUB(b.x)], 1u);
    const unsigned gen = old / nloc;
    if (old + 1u == (gen + 1u) * nloc) {
      __builtin_amdgcn_fence(__ATOMIC_RELEASE, "agent");
      asm volatile("s_waitcnt vmcnt(0)" ::: "memory");
      const unsigned og = xb_add(&bar[XB_TOP], 1u);
      const unsigned tg = og / nx;
      if (og + 1u == (tg + 1u) * nx) xb_add(&bar[XB_TOPGEN], 1u);
      else XB_SPIN(xb_ld(&bar[XB_TOPGEN]) == tg, bar);
      __builtin_amdgcn_fence(__ATOMIC_ACQUIRE, "agent");
      xb_add(&bar[XB_XGEN(b.x)], 1u);
      asm volatile("s_waitcnt vmcnt(0)" ::: "memory");
    } else {
      XB_SPIN(xb_ld(&bar[XB_XGEN(b.x)]) == gen, bar);
      __builtin_amdgcn_fence(__ATOMIC_ACQUIRE, "agent");
      asm volatile("s_waitcnt vmcnt(0)" ::: "memory");
    }
  }
  __syncthreads();
}

DEV void transpose_tile(const float* __restrict__ src, int lds_, u16* __restrict__ dst, int ldd, const float* scale,
                        int k0, int n0, unsigned char* smem) {
  float* s = (float*)smem;
  const int tid = TIDX();
  __syncthreads();
  {
    const int n = tid & 63, kq = tid >> 6;
#pragma unroll 4
    for (int i = 0; i < 16; ++i) {
      int kk = kq * 16 + i;
      s[kk * 65 + n] = src[(size_t)(k0 + kk) * lds_ + n0 + n];
    }
  }
  __syncthreads();
  {
    const int k = tid & 63, nq = tid >> 6;
    const float sc = scale ? scale[k0 + k] : 1.0f;
#pragma unroll 4
    for (int i = 0; i < 16; ++i) {
      int n = nq * 16 + i;
      dst[(size_t)(n0 + n) * ldd + k0 + k] = f2bf(s[k * 65 + n] * sc);
    }
  }
}

DEV void qlat_tile(const float* __restrict__ wq, const float* __restrict__ wuk, const float* __restrict__ g,
                   u16* __restrict__ dst, int h, int r0, int k0, unsigned char* smem) {
  float* sQ = (float*)smem;
  float* sU = sQ + 64 * 65;
  const int tid = TIDX();
  float acc[16];
#pragma unroll
  for (int i = 0; i < 16; ++i) acc[i] = 0.f;
  for (int nh = 0; nh < 2; ++nh) {
    __syncthreads();
    {
      const int n = tid & 63, q = tid >> 6;
      for (int i = 0; i < 16; ++i) {
        int rr = q * 16 + i;
        sQ[rr * 65 + n] = wq[(size_t)(k0 + rr) * 1536 + h * 192 + nh * 64 + n];
        sU[rr * 65 + n] = wuk[(size_t)(r0 + rr) * 1024 + h * 128 + nh * 64 + n];
      }
    }
    __syncthreads();
    const int k = tid & 63, rq = tid >> 6;
    for (int n = 0; n < 64; ++n) {
      float qv = sQ[k * 65 + n];
#pragma unroll
      for (int i = 0; i < 16; ++i) acc[i] += qv * sU[(rq * 16 + i) * 65 + n];
    }
  }
  const int k = tid & 63, rq = tid >> 6;
  const float sc = g[k0 + k];
#pragma unroll
  for (int i = 0; i < 16; ++i) dst[(size_t)(h * 320 + r0 + rq * 16 + i) * 768 + k0 + k] = f2bf(acc[i] * sc);
}

DEV void mod_item(const Params& p, int item, unsigned char* smem) {
  const int l = item / 48, cg_ = item % 48;
  float* sc = (float*)smem;
  float* red = sc + 48 * 256;
  (void)red;
  const int tid = TIDX(), col = tid & 63, kq = tid >> 6;
  const float* W = p.ada_w + (size_t)l * 1024 * 3072 + cg_ * 64 + col;
  float acc[48];
#pragma unroll
  for (int b = 0; b < 48; ++b) acc[b] = 0.f;
  for (int kc = 0; kc < 4; ++kc) {
    __syncthreads();
    for (int e = tid; e < 48 * 256; e += NT) {
      int b = e >> 8, k = e & 255;
      float c = b < 16 ? p.c_p[b * 1024 + kc * 256 + k] : p.c_s[(b - 16) * 1024 + kc * 256 + k];
      sc[e] = siluf_(c);
    }
    __syncthreads();
#pragma unroll 1
    for (int i0 = 0; i0 < 64; i0 += 8) {
      float wv[8];
#pragma unroll
      for (int i = 0; i < 8; ++i) wv[i] = W[(size_t)(kc * 256 + kq * 64 + i0 + i) * 3072];
#pragma unroll
      for (int i = 0; i < 8; ++i) {
        const int k = kq * 64 + i0 + i;
#pragma unroll
        for (int b = 0; b < 48; ++b) acc[b] += sc[b * 256 + k] * wv[i];
      }
    }
  }
  __syncthreads();
#pragma unroll
  for (int b = 0; b < 48; ++b) sc[(kq * 48 + b) * 64 + col] = acc[b];
  __syncthreads();
  float* MOD = (float*)(p.ws + OFF_MOD);
  for (int e = tid; e < 48 * 64; e += NT) {
    int b = e >> 6, c = e & 63;
    float v = sc[(0 * 48 + b) * 64 + c] + sc[(1 * 48 + b) * 64 + c] + sc[(2 * 48 + b) * 64 + c] + sc[(3 * 48 + b) * 64 + c];
    int gc = cg_ * 64 + c;
    MOD[((size_t)l * 48 + b) * 3072 + gc] = v + p.ada_b[l * 3072 + gc];
  }
}

DEV void phase_prep(const Params& p, unsigned char* smem) {
  const int tid = TIDX();
  if (blockIdx.x == 0) {
    if (tid < 64) ((unsigned*)(p.ws + OFF_CNT))[tid] = 0u;
    for (int e = tid; e < XCD_BAR_WORDS; e += NT) ((unsigned*)(p.ws + OFF_BAR))[e] = 0u;
  }
  const bool split = gridDim.x >= 192;
  if (split && blockIdx.x < 96) {
    mod_item(p, blockIdx.x, smem);
    return;
  }
  const int nb = split ? (int)gridDim.x - 96 : (int)gridDim.x;
  int idx = split ? (int)blockIdx.x - 96 : (int)blockIdx.x, base = 0;
  if (!split) {
    for (; idx < base + 96; idx += nb) mod_item(p, idx - base, smem);
    base += 96;
  }
  for (int l = 0; l < 2; ++l) {
    u16* WL = (u16*)(p.ws + OFF_W) + (size_t)l * W_LAYER;
    const float* win = p.w_in + (size_t)l * 1024 * IN_DIM;
#define TJOB(SRC, LDS_, KK, NN, DST, LDD, SCALE)                                     \
  {                                                                                  \
    const int nkt = (KK) / 64, ntl = nkt * ((NN) / 64);                              \
    for (; idx < base + ntl; idx += nb) {                                            \
      int t = idx - base;                                                            \
      transpose_tile((SRC), (LDS_), (DST), (LDD), (SCALE), (t % nkt) * 64, (t / nkt) * 64, smem); \
    }                                                                                \
    base += ntl;                                                                     \
  }
    TJOB(win, IN_DIM, 1024, 1024, WL + WO_W1, 1024, nullptr);
    TJOB(win + 2048, IN_DIM, 1024, 1088, WL + WO_W1 + (size_t)1024 * 1024, 1024, nullptr);
    TJOB(win + 1024, IN_DIM, 1024, 1024, WL + WO_G, 1024, nullptr);
    TJOB(win + 3136, IN_DIM, 1024, 3072, WL + WO_G + (size_t)1024 * 1024, 1024, nullptr);
    TJOB(p.w_q_up + (size_t)l * 768 * 1536, 1536, 768, 1536, WL + WO_QP, 768, p.q_norm + l * 768);
    for (int h = 0; h < 8; ++h)
      TJOB(p.w_q_up + (size_t)l * 768 * 1536 + h * 192 + 128, 1536, 768, 64, WL + WO_QS + (size_t)(h * 320 + 256) * 768, 768,
           p.q_norm + l * 768);
    TJOB(p.w_uk + (size_t)l * 262144, 1024, 256, 1024, WL + WO_UK, 256, p.kv_norm + l * 256);
    TJOB(p.w_uv + (size_t)l * 262144, 1024, 256, 1024, WL + WO_UVS, 256, p.kv_norm + l * 256);
    TJOB(p.w_uv + (size_t)l * 262144, 1024, 256, 1024, WL + WO_UVP, 256, nullptr);
    TJOB(p.w_ba + (size_t)l * 1048576, 1024, 1024, 1024, WL + WO_BA, 1024, nullptr);
    TJOB(p.w_bb + (size_t)l * 1048576, 1024, 1024, 1024, WL + WO_BB, 1024, nullptr);
    TJOB(p.w_out + (size_t)l * 1048576, 1024, 1024, 1024, WL + WO_OUT, 1024, nullptr);
    for (int b8 = 0; b8 < 8; ++b8) {
      TJOB(p.lru_wa + (size_t)l * 131072 + b8 * 16384, 128, 128, 128, WL + WO_LA + b8 * 16384, 128, nullptr);
      TJOB(p.lru_wx + (size_t)l * 131072 + b8 * 16384, 128, 128, 128, WL + WO_LX + b8 * 16384, 128, nullptr);
    }
    for (; idx < base + 384; idx += nb) {
      int t = idx - base;
      int h = t / 48, rt = (t % 48) / 12, kt = t % 12;
      qlat_tile(p.w_q_up + (size_t)l * 768 * 1536, p.w_uk + (size_t)l * 262144, p.q_norm + l * 768, WL + WO_QS, h,
                rt * 64, kt * 64, smem);
    }
    base += 384;
    for (; idx < base + 16; idx += nb) {
      int t = idx - base;
      u16* d = WL + WO_W1 + (size_t)2112 * 1024 + t * 4096;
      for (int e = tid; e < 4096; e += NT) d[e] = 0;
    }
    base += 16;
  }
  float* ROPE = (float*)(p.ws + OFF_ROPE);
  for (; idx < base + 512; idx += nb) {
    int e = (idx - base) * 256 + tid;
    int pos = e >> 5, j = e & 31;
    float inv = exp2f(-(float)j * (13.287712379549449f / 32.0f));
    float ang = (float)pos * inv;
    ROPE[2 * e] = cosf(ang);
    ROPE[2 * e + 1] = sinf(ang);
  }
  base += 512;
}

DEV void norm_row(const Params& p, int l, int m, const float (&xv)[16], int lane) {
  float ss = 0.f;
#pragma unroll
  for (int i = 0; i < 16; ++i) ss += xv[i] * xv[i];
  ss = wave_sum(ss);
  const float rstd = rsqrtf(ss * (1.0f / 1024.0f) + EPS);
  const float* MOD = (const float*)(p.ws + OFF_MOD) + ((size_t)l * 48 + mod_row(m)) * 3072;
  u16* H = (u16*)(p.ws + OFF_H) + (size_t)m * 1024;
#pragma unroll
  for (int i = 0; i < 4; ++i) {
    int c = i * 256 + lane * 4;
    float4 g = *(const float4*)(p.pre_norm + l * 1024 + c);
    float4 sh = *(const float4*)(MOD + c);
    float4 sc = *(const float4*)(MOD + 1024 + c);
    ushort4 o;
    o.x = f2bf(xv[i * 4 + 0] * rstd * g.x * (1.f + sc.x) + sh.x);
    o.y = f2bf(xv[i * 4 + 1] * rstd * g.y * (1.f + sc.y) + sh.y);
    o.z = f2bf(xv[i * 4 + 2] * rstd * g.z * (1.f + sc.z) + sh.z);
    o.w = f2bf(xv[i * 4 + 3] * rstd * g.w * (1.f + sc.w) + sh.w);
    *(ushort4*)(H + c) = o;
  }
}

DEV void phase_norm0(const Params& p) {
  const int tid_ = TIDX();
  const int lane = tid_ & 63, wv = tid_ >> 6;
  for (int m = blockIdx.x * 4 + wv; m < MT; m += gridDim.x * 4) {
    const float* x = m < MP ? p.x_p + (size_t)m * 1024 : p.x_s + (size_t)(m - MP) * 1024;
    float xv[16];
#pragma unroll
    for (int i = 0; i < 4; ++i) {
      float4 v = *(const float4*)(x + i * 256 + lane * 4);
      xv[i * 4] = v.x; xv[i * 4 + 1] = v.y; xv[i * 4 + 2] = v.z; xv[i * 4 + 3] = v.w;
    }
    norm_row(p, 0, m, xv, lane);
  }
}

DEV void phase_final(const Params& p, int l) {
  const int tid_ = TIDX();
  const int lane = tid_ & 63, wv = tid_ >> 6;
  const u16* O = (const u16*)(p.ws + OFF_R4);
  for (int m = blockIdx.x * 4 + wv; m < MT; m += gridDim.x * 4) {
    float* y = m < MP ? p.out + OUT_YP + (size_t)m * 1024 : p.out + OUT_YS + (size_t)(m - MP) * 1024;
    const float* x = (l == 0) ? (m < MP ? p.x_p + (size_t)m * 1024 : p.x_s + (size_t)(m - MP) * 1024) : y;
    float xv[16], ov[16];
    float ss = 0.f;
#pragma unroll
    for (int i = 0; i < 4; ++i) {
      int c = i * 256 + lane * 4;
      float4 v = *(const float4*)(x + c);
      xv[i * 4] = v.x; xv[i * 4 + 1] = v.y; xv[i * 4 + 2] = v.z; xv[i * 4 + 3] = v.w;
      ushort4 o = *(const ushort4*)(O + (size_t)m * 1024 + c);
      ov[i * 4] = bf2f(o.x); ov[i * 4 + 1] = bf2f(o.y); ov[i * 4 + 2] = bf2f(o.z); ov[i * 4 + 3] = bf2f(o.w);
    }
#pragma unroll
    for (int i = 0; i < 16; ++i) ss += ov[i] * ov[i];
    ss = wave_sum(ss);
    const float rstd = rsqrtf(ss * (1.0f / 1024.0f) + EPS);
    const float* MOD = (const float*)(p.ws + OFF_MOD) + ((size_t)l * 48 + mod_row(m)) * 3072 + 2048;
#pragma unroll
    for (int i = 0; i < 4; ++i) {
      int c = i * 256 + lane * 4;
      float4 g = *(const float4*)(p.post_norm + l * 1024 + c);
      float4 gt = *(const float4*)(MOD + c);
      xv[i * 4 + 0] += gt.x * ov[i * 4 + 0] * rstd * g.x;
      xv[i * 4 + 1] += gt.y * ov[i * 4 + 1] * rstd * g.y;
      xv[i * 4 + 2] += gt.z * ov[i * 4 + 2] * rstd * g.z;
      xv[i * 4 + 3] += gt.w * ov[i * 4 + 3] * rstd * g.w;
      *(float4*)(y + c) = make_float4(xv[i * 4], xv[i * 4 + 1], xv[i * 4 + 2], xv[i * 4 + 3]);
    }
    if (l == 0) norm_row(p, 1, m, xv, lane);
  }
}

template <int MI>
DEV void gemm1_tile(const Params& p, int l, int m0, int nt, unsigned char* smem) {
  constexpr int BM = MI * 64;
  const u16* H = (const u16*)(p.ws + OFF_H);
  const u16* W1 = (const u16*)(p.ws + OFF_W) + (size_t)l * W_LAYER + WO_W1;
  u16* XA = (u16*)(p.ws + OFF_R1);
  u16* CQ = (u16*)(p.ws + OFF_R2);
  u16* CKVR = CQ + (size_t)MT * 768;
  u16* sC = (u16*)smem;
  f32x16 acc[MI][2];
  zero_acc_t<MI>(acc);
  gemm_mm<MI>(acc, H + (size_t)m0 * 1024, 1024, W1 + (size_t)nt * 128 * 1024, 1024, 1024, smem);
  if (nt < 14) {
    acc_foreach_t<MI>([&](int mi, int ni, int r, int row, int col) __attribute__((always_inline)) {
      sC[row * LDC + col] = f2bf(acc[mi][ni][r]);
    });
    if (nt < 8) tile_store_t<MI>(smem, XA + (size_t)m0 * 1024 + nt * 128, 1024);
    else tile_store_t<MI>(smem, CQ + (size_t)m0 * 768 + (nt - 8) * 128, 768);
    if (nt < 8 && (m0 >= MP || ((m0 + BM) & 4095) == 0)) {
      acc_foreach_t<MI>([&](int mi, int ni, int r, int row, int col) __attribute__((always_inline)) {
        const int m = m0 + row, n = nt * 128 + col;
        const float v = acc[mi][ni][r];
        if (m < MP) {
          int j = (m & 4095) - 4093;
          if (j >= 0) p.out[OUT_CONVP + ((size_t)(l * 16 + (m >> 12)) * 3 + j) * 1024 + n] = v;
        } else {
          int j = ((m - MP) & 15) - 13;
          if (j >= 0) p.out[OUT_CONVS + ((size_t)(l * 32 + ((m - MP) >> 4)) * 3 + j) * 1024 + n] = v;
        }
      });
    }
  } else if (nt < 16) {
    float* ob = m0 < MP ? p.out + OUT_CKVP + ((size_t)l * MP + m0) * 256 + (nt - 14) * 128
                        : p.out + OUT_CKVS + ((size_t)l * MS + (m0 - MP)) * 256 + (nt - 14) * 128;
    acc_foreach_t<MI>([&](int mi, int ni, int r, int row, int col) __attribute__((always_inline)) {
      const float v = acc[mi][ni][r];
      sC[row * LDC + col] = f2bf(v);
      ob[(size_t)row * 256 + col] = v;
    });
    tile_store_t<MI>(smem, CKVR + (size_t)m0 * 256 + (nt - 14) * 128, 256);
  } else {
    float* ob = m0 < MP ? p.out + OUT_KPEP + ((size_t)l * MP + m0) * 64 : p.out + OUT_KPES + ((size_t)l * MS + (m0 - MP)) * 64;
    acc_foreach_t<MI>([&](int mi, int ni, int r, int row, int col) __attribute__((always_inline)) {
      if (col < 64) ob[(size_t)row * 64 + col] = acc[mi][ni][r];
    });
  }
}
DEV void phase_gemm1(const Params& p, int l, unsigned char* smem) {
  const int nb = gridDim.x;
  int idx = vbid(), base = 0;
#pragma unroll 1
  for (; idx < base + 256 * 17; idx += nb) {
    const int t = idx - base;
    gemm1_tile<4>(p, l, (t / 17) * 256, t % 17, smem);
  }
  base += 256 * 17;
#pragma unroll 1
  for (; idx < base + 4 * 17; idx += nb) {
    const int t = idx - base;
    gemm1_tile<2>(p, l, MP + (t / 17) * 128, t % 17, smem);
  }
}

DEV void post1_rows(const Params& p, int l, int item) {
  const int tid_ = TIDX();
  const int lane = tid_ & 63, wv = tid_ >> 6;
  const float* ROPE = (const float*)(p.ws + OFF_ROPE);
  float4 v[2];
  float kx[2];
  float2 cs[2];
  float* ckvp[2];
  float* kpep[2];
#pragma unroll
  for (int u = 0; u < 2; ++u) {
    const int m = item * 8 + wv * 2 + u;
    ckvp[u] = m < MP ? p.out + OUT_CKVP + ((size_t)l * MP + m) * 256 : p.out + OUT_CKVS + ((size_t)l * MS + (m - MP)) * 256;
    kpep[u] = m < MP ? p.out + OUT_KPEP + ((size_t)l * MP + m) * 64 : p.out + OUT_KPES + ((size_t)l * MS + (m - MP)) * 64;
    v[u] = *(const float4*)(ckvp[u] + lane * 4);
    kx[u] = kpep[u][lane];
    cs[u] = *(const float2*)(ROPE + ((size_t)pos_of(m) * 32 + (lane & 31)) * 2);
  }
  const float4 g = *(const float4*)(p.kv_norm + l * 256 + lane * 4);
#pragma unroll
  for (int u = 0; u < 2; ++u) {
    const int m = item * 8 + wv * 2 + u;
    const float ss = wave_sum(v[u].x * v[u].x + v[u].y * v[u].y + v[u].z * v[u].z + v[u].w * v[u].w);
    const float rstd = rsqrtf(ss * (1.0f / 256.0f) + EPS);
    float4 o4 = v[u];
    o4.x *= rstd * g.x; o4.y *= rstd * g.y; o4.z *= rstd * g.z; o4.w *= rstd * g.w;
    *(float4*)(ckvp[u] + lane * 4) = o4;
    const float other = __shfl_xor(kx[u], 32, 64);
    const float c = cs[u].x, sn = cs[u].y;
    const float ro = (lane < 32) ? (kx[u] * c - other * sn) : (other * sn + kx[u] * c);
    kpep[u][lane] = ro;
    if (m < MP) {
      u16* KPE = (u16*)(p.ws + OFF_KPE) + (size_t)m * 64;
      KPE[lane] = f2bf(ro);
    } else {
      const int b = (m - MP) >> 4, t = (m - MP) & 15;
      u16* SKV = (u16*)(p.ws + OFF_SKV) + ((size_t)b * 2112 + 2048 + t) * 320;
      u16* SVT = (u16*)(p.ws + OFF_SVT) + (size_t)b * 256 * 2112 + 2048 + t;
      ushort4 o;
      o.x = f2bf(o4.x); o.y = f2bf(o4.y); o.z = f2bf(o4.z); o.w = f2bf(o4.w);
      *(ushort4*)(SKV + lane * 4) = o;
      SVT[(size_t)(lane * 4 + 0) * 2112] = o.x;
      SVT[(size_t)(lane * 4 + 1) * 2112] = o.y;
      SVT[(size_t)(lane * 4 + 2) * 2112] = o.z;
      SVT[(size_t)(lane * 4 + 3) * 2112] = o.w;
      SKV[256 + lane] = f2bf(ro);
    }
  }
}

DEV void cache_item(const Params& p, int l, int item, unsigned char* smem) {
  const int tid = TIDX();
  const int b = item / 33, kt = item % 33;
  u16* SKV = (u16*)(p.ws + OFF_SKV) + (size_t)b * 2112 * 320;
  u16* SVT = (u16*)(p.ws + OFF_SVT) + (size_t)b * 256 * 2112;
  if (kt == 32) {
    for (int e = tid; e < 48 * 320; e += NT) SKV[(size_t)2064 * 320 + e] = 0;
    for (int e = tid; e < 256 * 48; e += NT) SVT[(size_t)(e / 48) * 2112 + 2064 + (e % 48)] = 0;
    return;
  }
  float* s = (float*)smem;
  const float* src = p.cache_ckv + (((size_t)l * 32 + b) * 2048 + kt * 64) * 256;
  const float* srck = p.cache_kpe + (((size_t)l * 32 + b) * 2048 + kt * 64) * 64;
  for (int dh = 0; dh < 2; ++dh) {
    __syncthreads();
    for (int e = tid; e < 64 * 128; e += NT) {
      int key = e >> 7, d = e & 127;
      float v = src[(size_t)key * 256 + dh * 128 + d];
      s[key * 129 + d] = v;
      SKV[(size_t)(kt * 64 + key) * 320 + dh * 128 + d] = f2bf(v);
    }
    __syncthreads();
    const int k = tid & 63, dq = tid >> 6;
    for (int i = 0; i < 32; ++i) {
      int d = dq * 32 + i;
      SVT[(size_t)(dh * 128 + d) * 2112 + kt * 64 + k] = f2bf(s[k * 129 + d]);
    }
  }
  for (int e = tid; e < 64 * 64; e += NT) {
    int key = e >> 6, d = e & 63;
    SKV[(size_t)(kt * 64 + key) * 320 + 256 + d] = f2bf(srck[(size_t)key * 64 + d]);
  }
}

DEV void phase_p2(const Params& p, int l, unsigned char* smem) {
  const int tid = TIDX(), lane = tid & 63, w = tid >> 6;
  const int nb = gridDim.x;
  const u16* WL = (const u16*)(p.ws + OFF_W) + (size_t)l * W_LAYER;
  const u16* CQ = (const u16*)(p.ws + OFF_R2);
  const u16* CKVR = CQ + (size_t)MT * 768;
  u16* Q = (u16*)(p.ws + OFF_R3);
  u16* QS = (u16*)(p.ws + OFF_QS);
  u16* Kb = (u16*)(p.ws + OFF_R4);
  u16* VT = (u16*)(p.ws + OFF_VT);
  const float* ROPE = (const float*)(p.ws + OFF_ROPE);
  float* ss = gemm_ss(smem);
  int idx = vbid(), base = 0;
  const int nq = 512 * 12 + 4 * 20;
  for (; idx < base + nq; idx += nb) {
    int t = idx - base;
    int mt, nt;
    const u16* Wt;
    bool samp = t >= 512 * 12;
    if (!samp) { mt = t / 12; nt = t % 12; Wt = WL + WO_QP; }
    else { t -= 512 * 12; mt = 512 + t / 20; nt = t % 20; Wt = WL + WO_QS; }
    f32x16 acc[2][2];
    zero_acc(acc);
    gemm_main<1>(acc, CQ + (size_t)mt * 128 * 768, 768, Wt + (size_t)nt * 128 * 768, 768, 768, smem);
    const int g = nt * 2 + (w & 1);
    const bool rope = samp ? (g % 5 == 4) : (g % 3 == 2);
    u16* sC = (u16*)smem;
#pragma unroll
    for (int mi = 0; mi < 2; ++mi)
#pragma unroll
      for (int r = 0; r < 16; ++r) {
        const int row = (w >> 1) * 64 + mi * 32 + (r & 3) + 8 * (r >> 2) + 4 * (lane >> 5);
        const int m = mt * 128 + row;
        const float rs = rsqrtf(ss[row] * (1.0f / 768.0f) + EPS) * QSCALE;
        float v0 = acc[mi][0][r] * rs, v1 = acc[mi][1][r] * rs;
        if (rope) {
          const int pos = pos_of(m);
          const float c = ROPE[(pos * 32 + (lane & 31)) * 2], s = ROPE[(pos * 32 + (lane & 31)) * 2 + 1];
          const float a = v0 * c - v1 * s, b = v0 * s + v1 * c;
          v0 = a; v1 = b;
        }
        const int col = (w & 1) * 64 + (lane & 31);
        sC[row * LDC + col] = f2bf(v0);
        sC[row * LDC + col + 32] = f2bf(v1);
      }
    if (!samp) tile_store(smem, Q + (size_t)mt * 128 * 1536 + nt * 128, 1536);
    else tile_store(smem, QS + (size_t)(mt - 512) * 128 * 2560 + nt * 128, 2560);
  }
  base += nq;
  for (; idx < base + 4096; idx += nb) {
    int t = idx - base;
    int mt = t >> 3, nt = t & 7;
    f32x16 acc[2][2];
    zero_acc(acc);
    gemm_main<1, 2>(acc, CKVR + (size_t)mt * 128 * 256, 256, WL + WO_UK + (size_t)nt * 128 * 256, 256, 256, smem);
    {
      u16* sC = (u16*)smem;
      acc_foreach([&](int mi, int ni, int r, int row, int col) __attribute__((always_inline)) {
        const float rs = rsqrtf(ss[row] * (1.0f / 256.0f) + EPS);
        sC[row * LDC + col] = f2bf(acc[mi][ni][r] * rs);
      });
      tile_store(smem, Kb + (size_t)mt * 128 * 1024 + nt * 128, 1024);
    }
  }
  base += 4096;
  for (; idx < base + 4096; idx += nb) {
    int t = idx - base;
    int b = t >> 8, mt = (t >> 5) & 7, nt = t & 31;
    f32x16 acc[2][2];
    zero_acc(acc);
    gemm_main<2, 2>(acc, WL + WO_UVS + (size_t)mt * 128 * 256, 256, CKVR + ((size_t)b * 4096 + nt * 128) * 256, 256, 256, smem);
    {
      u16* sC = (u16*)smem;
      acc_foreach([&](int mi, int ni, int r, int row, int col) __attribute__((always_inline)) {
        const float rs = rsqrtf(ss[col] * (1.0f / 256.0f) + EPS);
        sC[row * LDC + col] = f2bf(acc[mi][ni][r] * rs);
      });
      tile_store(smem, VT + ((size_t)b * 1024 + mt * 128) * 4096 + nt * 128, 4096);
    }
  }
  base += 4096;
  for (; idx < base + MT / 8; idx += nb) post1_rows(p, l, idx - base);
  base += MT / 8;
  for (; idx < base + 32 * 33; idx += nb) cache_item(p, l, idx - base, smem);
  base += 32 * 33;
}

#ifndef ATT_PF
#define ATT_PF true
#endif
template <int DK, bool PF>
DEV void attn_item(const u16* __restrict__ qrow, const u16* __restrict__ ka, int ldka, const u16* __restrict__ kb, int ldkb,
                   const u16* __restrict__ vt, int ldvt, int ntiles, int my_tiles, int kvlen, u16* orow,
                   unsigned char* smem) {
  constexpr int DKA = DK - 64, KST = DK + 8, VST = 68;
  u16* sK = (u16*)smem;
  u16* sV = sK + 64 * KST;
  const int tid = TIDX(), lane = tid & 63, hh = lane >> 5, l31 = lane & 31;
  constexpr bool QREG = (DK <= 192);
  bf16x8 qf[DK / 16];
  if (QREG) {
#pragma unroll
    for (int ks = 0; ks < DK / 16; ++ks) qf[ks] = *(const bf16x8*)(qrow + ks * 16 + hh * 8);
  }
  f32x16 o[4];
#pragma unroll
  for (int d = 0; d < 4; ++d)
#pragma unroll
    for (int r = 0; r < 16; ++r) o[d][r] = 0.f;
  float mrun = -1e30f, lrun = 0.f;
  constexpr int CA = DKA / 32;
  bf16x8 rk[CA + 2], rv[4];
  const int skey = tid >> 2, sq = tid & 3;
  const u16* gka = ka + (size_t)skey * ldka + sq * CA * 8;
  const u16* gkb = kb + (size_t)skey * ldkb + sq * 16;
  const u16* gv = vt + (size_t)(tid >> 1) * ldvt + (tid & 1) * 32;
  u16* lka = sK + skey * KST + sq * CA * 8;
  u16* lkb = sK + skey * KST + DKA + sq * 16;
  u16* lv = sV + (tid >> 1) * VST + (tid & 1) * 32;
  auto load_tile = [&](int t) __attribute__((always_inline)) {
    const size_t ko = (size_t)t * 64;
#pragma unroll
    for (int i = 0; i < CA; ++i) rk[i] = *(const bf16x8*)(gka + ko * ldka + i * 8);
#pragma unroll
    for (int i = 0; i < 2; ++i) rk[CA + i] = *(const bf16x8*)(gkb + ko * ldkb + i * 8);
#pragma unroll
    for (int i = 0; i < 4; ++i) rv[i] = *(const bf16x8*)(gv + ko + i * 8);
  };
  auto store_tile = [&]() __attribute__((always_inline)) {
#pragma unroll
    for (int i = 0; i < CA; ++i) *(bf16x8*)(lka + i * 8) = rk[i];
#pragma unroll
    for (int i = 0; i < 2; ++i) *(bf16x8*)(lkb + i * 8) = rk[CA + i];
#pragma unroll
    for (int i = 0; i < 4; ++i) {
      union { bf16x8 v; uint2 u[2]; } cv;
      cv.v = rv[i];
      *(uint2*)(lv + i * 8) = cv.u[0];
      *(uint2*)(lv + i * 8 + 4) = cv.u[1];
    }
  };
  if (PF) load_tile(0);
#pragma unroll 1
  for (int t = 0; t < ntiles; ++t) {
    __syncthreads();
    if (!PF) load_tile(t);
    store_tile();
    __syncthreads();
    if (PF && t + 1 < ntiles) load_tile(t + 1);
    if (t < my_tiles) {
      const u16* qp = qrow + hh * 8;
      if (!QREG) asm volatile("" : "+v"(qp));
      const int key0 = t * 64;
#pragma unroll 1
      for (int mi = 0; mi < 2; ++mi) {
        f32x16 s;
#pragma unroll
        for (int r = 0; r < 16; ++r) s[r] = 0.f;
        const u16* kp = sK + (mi * 32 + l31) * KST + hh * 8;
        constexpr int KB = QREG ? 12 : 4;
#pragma unroll
        for (int k0 = 0; k0 < DK / 16; k0 += KB) {
          bf16x8 kf[KB];
#pragma unroll
          for (int i = 0; i < KB; ++i) kf[i] = *(const bf16x8*)(kp + (k0 + i) * 16);
          __builtin_amdgcn_sched_barrier(0);
#pragma unroll
          for (int i = 0; i < KB; ++i) {
            bf16x8 qv;
            if (QREG) qv = qf[k0 + i];
            else qv = *(const bf16x8*)(qp + (k0 + i) * 16);
            s = __builtin_amdgcn_mfma_f32_32x32x16_bf16(kf[i], qv, s, 0, 0, 0);
          }
        }
        bf16x8 vf[8];
        {
          const u16* vp = sV + l31 * VST + mi * 32 + 4 * hh;
#pragma unroll
          for (int oc = 0; oc < 2; ++oc)
#pragma unroll
            for (int d = 0; d < 4; ++d) {
              union { bf16x8 v; uint2 u[2]; } cv;
              cv.u[0] = *(const uint2*)(vp + d * 32 * VST + oc * 16);
              cv.u[1] = *(const uint2*)(vp + d * 32 * VST + oc * 16 + 8);
              vf[oc * 4 + d] = cv.v;
            }
          __builtin_amdgcn_sched_barrier(0);
        }
        if (key0 + 64 > kvlen) {
#pragma unroll
          for (int r = 0; r < 16; ++r) {
            int key = key0 + mi * 32 + (r & 3) + 8 * (r >> 2) + 4 * hh;
            if (key >= kvlen) s[r] = -1e30f;
          }
        }
        float mx = -1e30f;
#pragma unroll
        for (int r = 0; r < 16; ++r) mx = fmaxf(mx, s[r]);
        mx = fmaxf(mx, __shfl_xor(mx, 32, 64));
        if (__builtin_amdgcn_ballot_w64(mx > mrun) != 0ull) {
          const float mnew = fmaxf(mrun, mx);
          const float alpha = __builtin_amdgcn_exp2f(mrun - mnew);
          mrun = mnew;
          lrun *= alpha;
#pragma unroll
          for (int d = 0; d < 4; ++d)
#pragma unroll
            for (int r = 0; r < 16; ++r) o[d][r] *= alpha;
        }
        union { bf16x8 v[2]; unsigned u[8]; } pfu;
        float ps = 0.f;
#pragma unroll
        for (int r = 0; r < 16; r += 2) {
          float p0 = __builtin_amdgcn_exp2f(s[r] - mrun);
          float p1 = __builtin_amdgcn_exp2f(s[r + 1] - mrun);
          ps += p0 + p1;
          pfu.u[r >> 1] = pk2bf(p0, p1);
        }
        lrun += ps;
#pragma unroll
        for (int oc = 0; oc < 2; ++oc)
#pragma unroll
          for (int d = 0; d < 4; ++d) o[d] = __builtin_amdgcn_mfma_f32_32x32x16_bf16(vf[oc * 4 + d], pfu.v[oc], o[d], 0, 0, 0);
      }
    }
  }
  const float ltot = lrun + __shfl_xor(lrun, 32, 64);
  const float inv = 1.0f / ltot;
#pragma unroll
  for (int d = 0; d < 4; ++d)
#pragma unroll
    for (int g = 0; g < 4; ++g) {
      uint2 ov;
      ov.x = pk2bf(o[d][g * 4 + 0] * inv, o[d][g * 4 + 1] * inv);
      ov.y = pk2bf(o[d][g * 4 + 2] * inv, o[d][g * 4 + 3] * inv);
      *(uint2*)(orow + d * 32 + g * 8 + hh * 4) = ov;
    }
  __syncthreads();
}

DEV void lru_item(const Params& p, int l, int sb, int nbk, int half, unsigned char* smem) {
  const int tid = TIDX(), lane = tid & 63, w = tid >> 6, hh = lane >> 5, l31 = lane & 31;
  const bool samp = sb >= 16;
  const int S = samp ? 16 : 4096;
  const int row0 = samp ? MP + (sb - 16) * 16 : sb * 4096;
  const int kc0 = nbk * 128, oc0 = nbk * 128 + half * 64;
  const u16* XA = (const u16*)(p.ws + OFF_R1);
  u16* YL = (u16*)(p.ws + OFF_R2);
  const u16* WL = (const u16*)(p.ws + OFF_W) + (size_t)l * W_LAYER;
  u16* sXC = (u16*)smem;
  float* sA = (float*)(smem + 17408);
  float* sB = sA + 4096;
  float* segA = sB + 4096;
  float* segB = segA + 256;
  float* hc = segB + 256;
  float* cw = hc + 64;
  float* cb = cw + 512;
  const int tm = w >> 1, tn = w & 1;
  __syncthreads();
  for (int e = tid; e < 512; e += NT) cw[e] = p.conv_w[(size_t)l * 4096 + (e >> 7) * 1024 + kc0 + (e & 127)];
  if (tid < 128) cb[tid] = p.conv_b[l * 1024 + kc0 + tid];
  if (tid < 64) hc[tid] = samp ? p.state_lru[((size_t)l * 32 + (sb - 16)) * 1024 + oc0 + tid] : 0.f;
  bf16x8 waf[8], wxf[8];
  {
    const u16* wa = WL + WO_LA + (size_t)nbk * 16384 + (size_t)(half * 64 + tn * 32 + l31) * 128 + hh * 8;
    const u16* wx = WL + WO_LX + (size_t)nbk * 16384 + (size_t)(half * 64 + tn * 32 + l31) * 128 + hh * 8;
#pragma unroll
    for (int ks = 0; ks < 8; ++ks) {
      waf[ks] = *(const bf16x8*)(wa + ks * 16);
      wxf[ks] = *(const bf16x8*)(wx + ks * 16);
    }
  }
  const int och = oc0 + tn * 32 + l31;
  const float ba = p.lru_ba[l * 1024 + och], bx = p.lru_bx[l * 1024 + och];
  const float lam = p.lru_lambda[l * 1024 + och];
  const float ex_ = __expf(-lam);
  const float sp = (-lam > 20.f) ? -lam
                   : (ex_ < 0.01f ? ex_ * (1.0f - ex_ * (0.5f - ex_ * (0.33333334f - 0.25f * ex_))) : __logf(1.0f + ex_));
  __syncthreads();
  for (int t0 = 0; t0 < S; t0 += 64) {
    {
      const int cc = (tid & 15) * 8, tq = tid >> 4;
      bf16x8 xr[7];
#pragma unroll
      for (int j = 0; j < 7; ++j) {
        int ts = t0 + tq * 4 - 3 + j;
        ts = ts < 0 ? 0 : (ts > S - 1 ? S - 1 : ts);
        xr[j] = *(const bf16x8*)(XA + (size_t)(row0 + ts) * 1024 + kc0 + cc);
      }
      float xf[7][8];
#pragma unroll
      for (int j = 0; j < 7; ++j) {
        const int ts = t0 + tq * 4 - 3 + j;
        const bool ok = ts >= 0;
#pragma unroll
        for (int c = 0; c < 8; ++c) xf[j][c] = ok ? bf2f((u16)xr[j][c]) : 0.f;
      }
      if (samp && t0 == 0 && tq == 0) {
#pragma unroll
        for (int j = 0; j < 3; ++j) {
          const float* st = p.state_conv + (((size_t)l * 32 + (sb - 16)) * 3 + j) * 1024 + kc0 + cc;
#pragma unroll
          for (int c = 0; c < 8; ++c) xf[j][c] = st[c];
        }
      }
#pragma unroll
      for (int i = 0; i < 4; ++i) {
        const int tl = tq * 4 + i;
        bf16x8 o;
#pragma unroll
        for (int c = 0; c < 8; ++c) {
          float v = cb[cc + c];
#pragma unroll
          for (int k = 0; k < 4; ++k) v += xf[i + k][c] * cw[k * 128 + cc + c];
          o[c] = (short)f2bf(v);
        }
        *(bf16x8*)(sXC + tl * 136 + cc) = o;
      }
    }
    __syncthreads();
    f32x16 aR, aI;
#pragma unroll
    for (int r = 0; r < 16; ++r) { aR[r] = 0.f; aI[r] = 0.f; }
#pragma unroll
    for (int ks = 0; ks < 8; ++ks) {
      bf16x8 a = *(const bf16x8*)(sXC + (tm * 32 + l31) * 136 + ks * 16 + hh * 8);
      aR = __builtin_amdgcn_mfma_f32_32x32x16_bf16(a, waf[ks], aR, 0, 0, 0);
      aI = __builtin_amdgcn_mfma_f32_32x32x16_bf16(a, wxf[ks], aI, 0, 0, 0);
    }
#pragma unroll
    for (int r = 0; r < 16; ++r) {
      const int tl = tm * 32 + (r & 3) + 8 * (r >> 2) + 4 * hh;
      const int cl = tn * 32 + l31;
      float av, bv;
      {
        const float rg = __builtin_amdgcn_rcpf(1.0f + __expf(-(aR[r] + ba)));
        const float ig = __builtin_amdgcn_rcpf(1.0f + __expf(-(aI[r] + bx)));
        const float la = -8.0f * rg * sp;
        const float a_ = __expf(la);
        const float x2 = 2.0f * la;
        const float ser = -x2 * (1.0f + x2 * (0.5f + x2 * (0.16666667f + x2 * (0.041666668f + x2 * 0.0083333338f))));
        const float em = (x2 > -0.25f) ? ser : 1.0f - __expf(x2);
        const float mult = __builtin_amdgcn_sqrtf(em);
        const float xcv = bf2f(sXC[tl * 136 + half * 64 + cl]);
        const bool valid = (t0 + tl < S);
        av = valid ? a_ : 1.f;
        bv = valid ? mult * ig * xcv : 0.f;
      }
      sA[tl * 64 + cl] = av;
      sB[tl * 64 + cl] = bv;
    }
    __syncthreads();
    {
      const int c = lane, sg = w;
      float A_ = 1.f, B_ = 0.f;
#pragma unroll
      for (int i = 0; i < 16; ++i) {
        const float a = sA[(sg * 16 + i) * 64 + c], b = sB[(sg * 16 + i) * 64 + c];
        B_ = a * B_ + b;
        A_ *= a;
      }
      segA[sg * 64 + c] = A_;
      segB[sg * 64 + c] = B_;
      __syncthreads();
      float h = hc[c];
      for (int s2 = 0; s2 < sg; ++s2) h = segA[s2 * 64 + c] * h + segB[s2 * 64 + c];
      __syncthreads();
#pragma unroll
      for (int i = 0; i < 16; ++i) {
        const int tl = sg * 16 + i;
        const float a = sA[tl * 64 + c], b = sB[tl * 64 + c];
        h = a * h + b;
        if (t0 + tl < S) YL[(size_t)(row0 + t0 + tl) * 1024 + oc0 + c] = f2bf(h);
      }
      if (sg == 3) hc[c] = h;
    }
    __syncthreads();
  }
  if (tid < 64) {
    const float h = hc[tid];
    if (samp) p.out[OUT_LRUS + ((size_t)l * 32 + (sb - 16)) * 1024 + oc0 + tid] = h;
    else p.out[OUT_LRUP + ((size_t)l * 16 + sb) * 1024 + oc0 + tid] = h;
  }
  __syncthreads();
}

DEV void phase_p3(const Params& p, int l, unsigned char* smem) {
  __shared__ int s_item;
  const int tid = TIDX(), lane = tid & 63, w = tid >> 6;
#pragma unroll 1
  for (int it = blockIdx.x; it < 256; it += gridDim.x) lru_item(p, l, it >> 4, (it >> 1) & 7, it & 1, smem);
#pragma unroll 1
  for (int it0 = blockIdx.x; it0 < 320; it0 += gridDim.x) {
    if (it0 < 256) continue;
    const int it = it0 - 256;
    const int b = it >> 1, dvh = it & 1;
    const int r = w * 32 + (lane & 31), h = r >> 4, t = r & 15;
    const u16* qrow = (const u16*)(p.ws + OFF_QS) + ((size_t)b * 16 + t) * 2560 + h * 320;
    const u16* ka = (const u16*)(p.ws + OFF_SKV) + (size_t)b * 2112 * 320;
    const u16* vt = (const u16*)(p.ws + OFF_SVT) + ((size_t)b * 256 + dvh * 128) * 2112;
    u16* orow = (u16*)(p.ws + OFF_OLAT) + ((size_t)b * 16 + t) * 2048 + h * 256 + dvh * 128;
    attn_item<320, false>(qrow, ka, 320, ka + 256, 320, vt, 2112, 33, 33, 2064, orow, smem);
  }
  const int xcd = blockIdx.x & 7;
#pragma unroll 1
  for (int qi = 0; qi < 8; ++qi) {
    const int q = (xcd + qi) & 7;
    unsigned* qc = (unsigned*)(p.ws + OFF_CNT) + 8 + l * 8 + q;
#pragma unroll 1
    for (;;) {
      __syncthreads();
      if (tid == 0) s_item = (int)atomicAdd(qc, 1u);
      __syncthreads();
      const int it = s_item;
      if (it >= 512) break;
      const int half_ = it >> 8, j_ = it & 255;
      const int qt = (half_ ? 15 : 31) - (j_ & 15), bh = (j_ >> 4) * 8 + q, b = bh >> 3, h = bh & 7;
      u16* Q = (u16*)(p.ws + OFF_R3);
      const int r = w * 32 + (lane & 31);
      u16* qrow = Q + ((size_t)b * 4096 + qt * 128 + r) * 1536 + h * 192;
      const u16* ka = (const u16*)(p.ws + OFF_R4) + (size_t)b * 4096 * 1024 + h * 128;
      const u16* kb = (const u16*)(p.ws + OFF_KPE) + (size_t)b * 4096 * 64;
      const u16* vt = (const u16*)(p.ws + OFF_VT) + ((size_t)b * 1024 + h * 128) * 4096;
      attn_item<192, ATT_PF>(qrow, ka, 1024, kb, 64, vt, 4096, 2 * (qt + 1), 2 * qt + 1 + (w >> 1), 1 << 30, qrow, smem);
    }
  }
#pragma unroll 1
  for (int it = blockIdx.x; it < 512; it += gridDim.x) lru_item(p, l, 16 + (it >> 4), (it >> 1) & 7, it & 1, smem);
}

template <int MI>
DEV void p4_tile(const Params& p, int l, int m0, int nt, unsigned char* smem) {
  const u16* WL = (const u16*)(p.ws + OFF_W) + (size_t)l * W_LAYER;
  const u16* H = (const u16*)(p.ws + OFF_H);
  const u16* Q = (const u16*)(p.ws + OFF_R3);
  const u16* OLAT = (const u16*)(p.ws + OFF_OLAT);
  u16* YB = (u16*)(p.ws + OFF_R1);
  u16* YA = (u16*)(p.ws + OFF_R2);
  u16* sC = (u16*)smem;
  f32x16 acc[MI][2];
  if (nt < 8) {
    if constexpr (MI == 2) {
      if (m0 >= MP) {
        f32x16 att[MI][2];
        zero_acc_t<MI>(att);
        gemm_mm<MI>(att, OLAT + (size_t)(m0 - MP) * 2048 + nt * 256, 2048, WL + WO_UVP + (size_t)nt * 128 * 256, 256, 256, smem);
        zero_acc_t<MI>(acc);
        gemm_mm<MI>(acc, H + (size_t)m0 * 1024, 1024, WL + WO_G + (size_t)(1024 + nt * 128) * 1024, 1024, 1024, smem);
        acc_foreach_t<MI>([&](int mi, int ni, int r, int row, int col) __attribute__((always_inline)) {
          sC[row * LDC + col] = f2bf(att[mi][ni][r] * siluf_(acc[mi][ni][r]));
        });
        tile_store_t<MI>(smem, YB + (size_t)m0 * 1024 + nt * 128, 1024);
        return;
      }
    }
    zero_acc_t<MI>(acc);
    gemm_mm<MI>(acc, H + (size_t)m0 * 1024, 1024, WL + WO_G + (size_t)(1024 + nt * 128) * 1024, 1024, 1024, smem);
    tile_load_t<MI>(smem, Q + (size_t)m0 * 1536 + nt * 192, 1536);
    acc_foreach_t<MI>([&](int mi, int ni, int r, int row, int col) __attribute__((always_inline)) {
      sC[row * LDC + col] = f2bf(bf2f(sC[row * LDC + col]) * siluf_(acc[mi][ni][r]));
    });
    tile_store_t<MI>(smem, YB + (size_t)m0 * 1024 + nt * 128, 1024);
  } else {
    const int n0 = (nt - 8) * 128;
    zero_acc_t<MI>(acc);
    gemm_mm<MI>(acc, H + (size_t)m0 * 1024, 1024, WL + WO_G + (size_t)n0 * 1024, 1024, 1024, smem);
    tile_load_t<MI>(smem, YA + (size_t)m0 * 1024 + n0, 1024);
    acc_foreach_t<MI>([&](int mi, int ni, int r, int row, int col) __attribute__((always_inline)) {
      sC[row * LDC + col] = f2bf(bf2f(sC[row * LDC + col]) * siluf_(acc[mi][ni][r]));
    });
    tile_store_t<MI>(smem, YA + (size_t)m0 * 1024 + n0, 1024);
  }
}
DEV void phase_p4(const Params& p, int l, unsigned char* smem) {
  const int nb = gridDim.x;
  int idx = vbid(), base = 0;
#pragma unroll 1
  for (; idx < base + 256 * 16; idx += nb) {
    const int t = idx - base;
    p4_tile<4>(p, l, (t >> 4) * 256, t & 15, smem);
  }
  base += 256 * 16;
#pragma unroll 1
  for (; idx < base + 4 * 16; idx += nb) {
    const int t = idx - base;
    p4_tile<2>(p, l, MP + (t >> 4) * 128, t & 15, smem);
  }
}

constexpr int SM_GATE = 2 * 128 * LDT * 2 + 1024;
DEV void gemm_gates(f32x16 (&acc)[2][4], const u16* __restrict__ A, const u16* __restrict__ B0, const u16* __restrict__ B1,
                    unsigned char* smem) {
  u16* sA = (u16*)smem;
  u16* sB = sA + 128 * LDT;
  const int tid = TIDX(), lane = tid & 63, w = tid >> 6, wm = w >> 1, wn = w & 1;
  const int srow = tid >> 3, scol = (tid & 7) * 8;
  const u16* ap = A + (size_t)srow * 1024 + scol;
  const u16* b0p = B0 + (size_t)srow * 1024 + scol;
  const u16* b1p = B1 + (size_t)srow * 1024 + scol;
  bf16x8 ra[4], rb[8];
#pragma unroll
  for (int i = 0; i < 4; ++i) {
    ra[i] = *(const bf16x8*)(ap + (size_t)(32 * i) * 1024);
    rb[i] = *(const bf16x8*)(b0p + (size_t)(32 * i) * 1024);
    rb[4 + i] = *(const bf16x8*)(b1p + (size_t)(32 * i) * 1024);
  }
  const int fro = (lane & 31) * LDT + (lane >> 5) * 8;
#pragma unroll 1
  for (int kt = 0; kt < 16; ++kt) {
    __syncthreads();
#pragma unroll
    for (int i = 0; i < 4; ++i) *(bf16x8*)(sA + (srow + 32 * i) * LDT + scol) = ra[i];
#pragma unroll
    for (int i = 0; i < 8; ++i) *(bf16x8*)(sB + (srow + 32 * i) * LDT + scol) = rb[i];
    __syncthreads();
    if (kt + 1 < 16) {
      ap += 64;
      b0p += 64;
      b1p += 64;
#pragma unroll
      for (int i = 0; i < 4; ++i) {
        ra[i] = *(const bf16x8*)(ap + (size_t)(32 * i) * 1024);
        rb[i] = *(const bf16x8*)(b0p + (size_t)(32 * i) * 1024);
        rb[4 + i] = *(const bf16x8*)(b1p + (size_t)(32 * i) * 1024);
      }
    }
#pragma unroll 2
    for (int ks = 0; ks < 4; ++ks) {
      bf16x8 af[2], bfr[4];
#pragma unroll
      for (int i = 0; i < 2; ++i) af[i] = *(const bf16x8*)(sA + (wm * 64 + i * 32) * LDT + fro + ks * 16);
#pragma unroll
      for (int i = 0; i < 4; ++i)
        bfr[i] = *(const bf16x8*)(sB + ((i >> 1) * 128 + wn * 64 + (i & 1) * 32) * LDT + fro + ks * 16);
      __builtin_amdgcn_s_setprio(1);
#pragma unroll
      for (int mi = 0; mi < 2; ++mi)
#pragma unroll
        for (int ni = 0; ni < 4; ++ni)
          acc[mi][ni] = __builtin_amdgcn_mfma_f32_32x32x16_bf16(af[mi], bfr[ni], acc[mi][ni], 0, 0, 0);
      __builtin_amdgcn_s_setprio(0);
    }
  }
  __syncthreads();
}
DEV void phase_p5(const Params& p, int l, unsigned char* smem) {
  const u16* WL = (const u16*)(p.ws + OFF_W) + (size_t)l * W_LAYER;
  const u16* H = (const u16*)(p.ws + OFF_H);
  const u16* YB = (const u16*)(p.ws + OFF_R1);
  const u16* YA = (const u16*)(p.ws + OFF_R2);
  u16* MRG = (u16*)(p.ws + OFF_R3);
  u16* sC = (u16*)smem;
  const int ntiles = 516 * 8;
  for (int t = vbid(); t < ntiles; t += gridDim.x) {
    const int mt = t >> 3, nt = t & 7;
    unsigned ga[2][2][8];
    unsigned* sG = (unsigned*)(smem + SM_GATE);
    const int tid = TIDX();
    {
      f32x16 g[2][4];
#pragma unroll
      for (int a_ = 0; a_ < 2; ++a_)
#pragma unroll
        for (int b_ = 0; b_ < 4; ++b_)
#pragma unroll
          for (int r = 0; r < 16; ++r) g[a_][b_][r] = 0.f;
      gemm_gates(g, H + (size_t)mt * 128 * 1024, WL + WO_G + (size_t)(2048 + nt * 128) * 1024,
                 WL + WO_G + (size_t)(3072 + nt * 128) * 1024, smem);
#pragma unroll
      for (int a_ = 0; a_ < 2; ++a_)
#pragma unroll
        for (int b_ = 0; b_ < 2; ++b_) {
#pragma unroll
          for (int r = 0; r < 8; ++r)
            sG[((a_ * 2 + b_) * 8 + r) * 256 + tid] = pk2bf(sigmoidf_(g[a_][2 + b_][2 * r]), sigmoidf_(g[a_][2 + b_][2 * r + 1]));
          __builtin_amdgcn_sched_barrier(0);
        }
#pragma unroll
      for (int a_ = 0; a_ < 2; ++a_)
#pragma unroll
        for (int b_ = 0; b_ < 2; ++b_) {
#pragma unroll
          for (int r = 0; r < 8; ++r) ga[a_][b_][r] = pk2bf(sigmoidf_(g[a_][b_][2 * r]), sigmoidf_(g[a_][b_][2 * r + 1]));
          __builtin_amdgcn_sched_barrier(0);
        }
    }
    auto gate_a = [&](int mi, int ni, int r) __attribute__((always_inline)) -> float {
      const unsigned gq = ga[mi][ni][r >> 1];
      return __uint_as_float((r & 1) ? (gq & 0xffff0000u) : (gq << 16));
    };
    auto gate_b = [&](int mi, int ni, int r) __attribute__((always_inline)) -> float {
      const unsigned gq = sG[((mi * 2 + ni) * 8 + (r >> 1)) * 256 + tid];
      return __uint_as_float((r & 1) ? (gq & 0xffff0000u) : (gq << 16));
    };
    f32x16 acc[2][2];
    unsigned res[2][2][8];
    zero_acc(acc);
    gemm_main<0>(acc, YA + (size_t)mt * 128 * 1024, 1024, WL + WO_BA + (size_t)nt * 128 * 1024, 1024, 1024, smem);
#pragma unroll
    for (int mi = 0; mi < 2; ++mi)
#pragma unroll
      for (int ni = 0; ni < 2; ++ni)
#pragma unroll
        for (int r = 0; r < 8; ++r)
          res[mi][ni][r] = pk2bf(acc[mi][ni][2 * r] * gate_a(mi, ni, 2 * r), acc[mi][ni][2 * r + 1] * gate_a(mi, ni, 2 * r + 1));
    zero_acc(acc);
    gemm_main<0>(acc, YB + (size_t)mt * 128 * 1024, 1024, WL + WO_BB + (size_t)nt * 128 * 1024, 1024, 1024, smem);
    __syncthreads();
    acc_foreach([&](int mi, int ni, int r, int row, int col) __attribute__((always_inline)) {
      const unsigned rq = res[mi][ni][r >> 1];
      const float rv = __uint_as_float((r & 1) ? (rq & 0xffff0000u) : (rq << 16));
      sC[row * LDC + col] = f2bf(rv + acc[mi][ni][r] * gate_b(mi, ni, r));
    });
    tile_store(smem, MRG + (size_t)mt * 128 * 1024 + nt * 128, 1024);
  }
}

template <int MI>
DEV void p6_tile(const Params& p, int l, int m0, int nt, unsigned char* smem) {
  const u16* WL = (const u16*)(p.ws + OFF_W) + (size_t)l * W_LAYER;
  const u16* MRG = (const u16*)(p.ws + OFF_R3);
  u16* O = (u16*)(p.ws + OFF_R4);
  u16* sC = (u16*)smem;
  f32x16 acc[MI][2];
  zero_acc_t<MI>(acc);
  gemm_mm<MI>(acc, MRG + (size_t)m0 * 1024, 1024, WL + WO_OUT + (size_t)nt * 128 * 1024, 1024, 1024, smem);
  acc_foreach_t<MI>([&](int mi, int ni, int r, int row, int col) __attribute__((always_inline)) {
    sC[row * LDC + col] = f2bf(acc[mi][ni][r]);
  });
  tile_store_t<MI>(smem, O + (size_t)m0 * 1024 + nt * 128, 1024);
}
DEV void phase_p6(const Params& p, int l, unsigned char* smem) {
  const int nb = gridDim.x;
  int idx = vbid(), base = 0;
#pragma unroll 1
  for (; idx < base + 256 * 8; idx += nb) {
    const int t = idx - base;
    p6_tile<4>(p, l, (t >> 3) * 256, t & 7, smem);
  }
  base += 256 * 8;
#pragma unroll 1
  for (; idx < base + 4 * 8; idx += nb) {
    const int t = idx - base;
    p6_tile<2>(p, l, MP + (t >> 3) * 128, t & 7, smem);
  }
}

constexpr int SM_TOTAL = SM_GATE + 32768;
__global__ void __launch_bounds__(NT, 2) mega(Params p) {
  __shared__ __attribute__((aligned(16))) unsigned char smem[SM_TOTAL];
  cg::grid_group grid = cg::this_grid();
  __shared__ uint4 xb_words;
  if (threadIdx.x == 0) xb_words = make_uint4(0u, 0u, 0u, 0u);
#define PH(call)                                             \
  {                                                          \
    Params q = p;                                            \
    size_t z_ = 0;                                           \
    asm volatile("" : "+s"(z_));                             \
    q.ws = p.ws + z_;                                        \
    q.out = p.out + z_;                                      \
    call;                                                    \
  }
  PH(phase_prep(q, smem));
  grid.sync();
  (void)xcd_barrier_post((unsigned*)(p.ws + OFF_BAR), (volatile LAS unsigned*)&xb_words);
#define XBAR() xcd_barrier((unsigned*)(p.ws + OFF_BAR), (volatile LAS unsigned*)&xb_words)
  PH(phase_norm0(q));
  XBAR();
#pragma unroll 1
  for (int l = 0; l < 2; ++l) {
    PH(phase_gemm1(q, l, smem));
    XBAR();
    PH(phase_p2(q, l, smem));
    XBAR();
    PH(phase_p3(q, l, smem));
    XBAR();
    PH(phase_p4(q, l, smem));
    XBAR();
    PH(phase_p5(q, l, smem));
    XBAR();
    PH(phase_p6(q, l, smem));
    XBAR();
    PH(phase_final(q, l));
    if (l == 0) XBAR();
  }
}

extern "C" void kernel_launch(void* const* d_in, const int* in_sizes, int n_in, void* d_out, int out_size, void* d_ws,
                              size_t ws_size, hipStream_t stream) {
  static int grid_blocks = 0;
  if (!grid_blocks) {
    int dev = 0, cus = 0, per_cu = 0;
    hipGetDevice(&dev);
    hipDeviceGetAttribute(&cus, hipDeviceAttributeMultiprocessorCount, dev);
    hipOccupancyMaxActiveBlocksPerMultiprocessor(&per_cu, mega, NT, 0);
    if (per_cu > 2) per_cu = 2;
    grid_blocks = cus * per_cu;
  }
  if (ws_size < WS_NEED) {
    fprintf(stderr, "workspace too small: %zu < %zu\n", ws_size, (size_t)WS_NEED);
    return;
  }
  Params p{};
  const float** pp = (const float**)&p;
  for (int i = 0; i < 28; ++i) pp[i] = (const float*)d_in[i];
  p.out = (float*)d_out;
  p.ws = (unsigned char*)d_ws;
  void* args[] = {&p};
  hipError_t e = hipLaunchCooperativeKernel((void*)mega, dim3(grid_blocks), dim3(NT), args, 0, stream);
  if (e != hipSuccess) fprintf(stderr, "cooperative launch failed: %s (grid %d)\n", hipGetErrorString(e), grid_blocks);
}
```

```cpp
#include <hip/hip_runtime.h>
#include <hip/hip_cooperative_groups.h>
#include <cstdio>
namespace cg = cooperative_groups;

typedef unsigned short u16;
typedef __attribute__((ext_vector_type(8))) short bf16x8;
typedef __attribute__((ext_vector_type(16))) float f32x16;

#define DEV __device__ __forceinline__
#define NT 256

constexpr int MP = 65536, MS = 512, MT = 66048;
constexpr int IN_DIM = 6208;
constexpr float EPS = 1e-6f;
constexpr float QSCALE = 0.07216878364870322f * 1.4426950408889634f;

constexpr size_t SZ_ACT = (size_t)MT * 1024 * 2;
constexpr size_t OFF_H = 0;
constexpr size_t OFF_R1 = OFF_H + SZ_ACT;
constexpr size_t OFF_R2 = OFF_R1 + SZ_ACT;
constexpr size_t OFF_R3 = OFF_R2 + SZ_ACT;
constexpr size_t OFF_R4 = OFF_R3 + (size_t)MP * 1536 * 2;
constexpr size_t OFF_KPE = OFF_R4 + SZ_ACT;
constexpr size_t OFF_VT = OFF_KPE + (size_t)MT * 64 * 2;
constexpr size_t OFF_SKV = OFF_VT + (size_t)16 * 1024 * 4096 * 2;
constexpr size_t OFF_SVT = OFF_SKV + (size_t)32 * 2112 * 320 * 2;
constexpr size_t OFF_QS = OFF_SVT + (size_t)32 * 256 * 2112 * 2;
constexpr size_t OFF_OLAT = OFF_QS + (size_t)MS * 2560 * 2;
constexpr size_t OFF_MOD = OFF_OLAT + (size_t)MS * 2048 * 2;
constexpr size_t OFF_ROPE = OFF_MOD + (size_t)2 * 48 * 3072 * 4;
constexpr size_t OFF_CNT = OFF_ROPE + (size_t)4096 * 32 * 2 * 4;
constexpr size_t OFF_W = OFF_CNT + 256;
constexpr size_t WO_W1 = 0;
constexpr size_t WO_G = WO_W1 + (size_t)2176 * 1024;
constexpr size_t WO_QP = WO_G + (size_t)4096 * 1024;
constexpr size_t WO_QS = WO_QP + (size_t)1536 * 768;
constexpr size_t WO_UK = WO_QS + (size_t)2560 * 768;
constexpr size_t WO_UVS = WO_UK + 262144;
constexpr size_t WO_UVP = WO_UVS + 262144;
constexpr size_t WO_BA = WO_UVP + 262144;
constexpr size_t WO_BB = WO_BA + 1048576;
constexpr size_t WO_OUT = WO_BB + 1048576;
constexpr size_t WO_LA = WO_OUT + 1048576;
constexpr size_t WO_LX = WO_LA + 131072;
constexpr size_t W_LAYER = WO_LX + 131072;
constexpr size_t OFF_BAR = OFF_W + 2 * W_LAYER * 2;
constexpr size_t WS_NEED = OFF_BAR + 16384;

constexpr size_t OUT_YP = 0;
constexpr size_t OUT_YS = 67108864;
constexpr size_t OUT_CKVP = 67633152;
constexpr size_t OUT_KPEP = 101187584;
constexpr size_t OUT_CONVP = 109576192;
constexpr size_t OUT_LRUP = 109674496;
constexpr size_t OUT_CKVS = 109707264;
constexpr size_t OUT_KPES = 109969408;
constexpr size_t OUT_CONVS = 110034944;
constexpr size_t OUT_LRUS = 110231552;

struct Params {
  const float *x_p, *x_s, *c_p, *c_s, *cache_ckv, *cache_kpe, *state_conv, *state_lru;
  const float *ada_w, *ada_b, *pre_norm, *post_norm, *w_in, *conv_w, *conv_b, *lru_wa, *lru_ba, *lru_wx, *lru_bx;
  const float *lru_lambda, *q_norm, *w_q_up, *kv_norm, *w_uk, *w_uv, *w_ba, *w_bb, *w_out;
  float* out;
  unsigned char* ws;
};

DEV int TIDX() {
  int t = threadIdx.x;
  asm volatile("" : "+v"(t));
  return t;
}
typedef __attribute__((ext_vector_type(2))) float f32x2_t;
typedef __attribute__((ext_vector_type(2))) __bf16 bf16x2_t;
DEV unsigned pk2bf(float a, float b) {
  f32x2_t v = {a, b};
  bf16x2_t r = __builtin_convertvector(v, bf16x2_t);
  return __builtin_bit_cast(unsigned, r);
}
DEV u16 f2bf(float f) { return (u16)(pk2bf(f, 0.f) & 0xffffu); }
DEV float bf2f(u16 h) { return __uint_as_float(((unsigned)h) << 16); }
DEV float sigmoidf_(float x) { return 1.0f / (1.0f + __expf(-x)); }
DEV float siluf_(float x) { return x / (1.0f + __expf(-x)); }
DEV float wave_sum(float v) {
#pragma unroll
  for (int o = 32; o > 0; o >>= 1) v += __shfl_xor(v, o, 64);
  return v;
}
DEV int vbid() {
  const int b = blockIdx.x, n = gridDim.x;
  return ((n & 7) == 0) ? (b & 7) * (n >> 3) + (b >> 3) : b;
}
DEV int mod_row(int m) { return m < MP ? (m >> 12) : 16 + ((m - MP) >> 4); }
DEV int pos_of(int m) { return m < MP ? (m & 4095) : 2048 + ((m - MP) & 15); }

constexpr int LDT = 72;
#ifndef P5_DEPTH
#define P5_DEPTH 1
#endif
template <int SS, int DEPTH = 1>
DEV void gemm_main(f32x16 (&acc)[2][2], const u16* __restrict__ A, int lda, const u16* __restrict__ B, int ldb,
                   int K, unsigned char* smem) {
  u16* sA = (u16*)smem;
  u16* sB = sA + 128 * LDT;
  float* ss = (float*)(sB + 128 * LDT);
  const int tid = TIDX(), lane = tid & 63, w = tid >> 6, wm = w >> 1, wn = w & 1;
  const int srow = tid >> 3, scol = (tid & 7) * 8;
  const u16* ap = A + (size_t)srow * lda + scol;
  const u16* bp = B + (size_t)srow * ldb + scol;
  bf16x8 ra[DEPTH][4], rb[DEPTH][4];
  float ssq[4] = {0.f, 0.f, 0.f, 0.f};
  const int nk = K >> 6;
#pragma unroll
  for (int d = 0; d < DEPTH; ++d)
#pragma unroll
    for (int i = 0; i < 4; ++i) {
      ra[d][i] = *(const bf16x8*)(ap + d * 64 + (size_t)(32 * i) * lda);
      rb[d][i] = *(const bf16x8*)(bp + d * 64 + (size_t)(32 * i) * ldb);
    }
  ap += DEPTH * 64;
  bp += DEPTH * 64;
  const int fro = (lane & 31) * LDT + (lane >> 5) * 8;
#pragma unroll 1
  for (int kt = 0; kt < nk; kt += DEPTH) {
#pragma unroll
    for (int d = 0; d < DEPTH; ++d) {
      __syncthreads();
#pragma unroll
      for (int i = 0; i < 4; ++i) {
        *(bf16x8*)(sA + (srow + 32 * i) * LDT + scol) = ra[d][i];
        *(bf16x8*)(sB + (srow + 32 * i) * LDT + scol) = rb[d][i];
        if (SS) {
          bf16x8 v = (SS == 1) ? ra[d][i] : rb[d][i];
#pragma unroll
          for (int j = 0; j < 8; ++j) {
            float f = bf2f((u16)v[j]);
            ssq[i] += f * f;
          }
        }
      }
      __syncthreads();
      if (kt + d + DEPTH < nk) {
#pragma unroll
        for (int i = 0; i < 4; ++i) {
          ra[d][i] = *(const bf16x8*)(ap + (size_t)(32 * i) * lda);
          rb[d][i] = *(const bf16x8*)(bp + (size_t)(32 * i) * ldb);
        }
        ap += 64;
        bp += 64;
      }
#pragma unroll
      for (int ks = 0; ks < 4; ++ks) {
        bf16x8 af[2], bfr[2];
#pragma unroll
        for (int i = 0; i < 2; ++i) {
          af[i] = *(const bf16x8*)(sA + (wm * 64 + i * 32) * LDT + fro + ks * 16);
          bfr[i] = *(const bf16x8*)(sB + (wn * 64 + i * 32) * LDT + fro + ks * 16);
        }
        __builtin_amdgcn_s_setprio(1);
#pragma unroll
        for (int mi = 0; mi < 2; ++mi)
#pragma unroll
          for (int ni = 0; ni < 2; ++ni)
            acc[mi][ni] = __builtin_amdgcn_mfma_f32_32x32x16_bf16(af[mi], bfr[ni], acc[mi][ni], 0, 0, 0);
        __builtin_amdgcn_s_setprio(0);
      }
    }
  }
  if (SS) {
#pragma unroll
    for (int i = 0; i < 4; ++i) {
      float v = ssq[i];
      v += __shfl_xor(v, 1, 64);
      v += __shfl_xor(v, 2, 64);
      v += __shfl_xor(v, 4, 64);
      if ((tid & 7) == 0) ss[srow + 32 * i] = v;
    }
    __syncthreads();
  }
}
DEV void zero_acc(f32x16 (&acc)[2][2]) {
#pragma unroll
  for (int a = 0; a < 2; ++a)
#pragma unroll
    for (int b = 0; b < 2; ++b)
#pragma unroll
      for (int r = 0; r < 16; ++r) acc[a][b][r] = 0.f;
}
DEV float* gemm_ss(unsigned char* smem) { return (float*)(smem + 2 * 128 * LDT * 2); }

template <class F>
DEV void acc_foreach(F f) {
  const int tid_ = TIDX();
  const int lane = tid_ & 63, w = tid_ >> 6;
#pragma unroll
  for (int mi = 0; mi < 2; ++mi)
#pragma unroll
    for (int ni = 0; ni < 2; ++ni)
#pragma unroll
      for (int r = 0; r < 16; ++r)
        f(mi, ni, r, (w >> 1) * 64 + mi * 32 + (r & 3) + 8 * (r >> 2) + 4 * (lane >> 5), (w & 1) * 64 + ni * 32 + (lane & 31));
}
constexpr int LDC = 136;
DEV void tile_store(unsigned char* smem, u16* dst, size_t ldd) {
  const u16* sC = (const u16*)smem;
  __syncthreads();
  const int tid_ = TIDX();
#pragma unroll
  for (int i = 0; i < 8; ++i) {
    const int c = tid_ + 256 * i, row = c >> 4, cc = (c & 15) * 8;
    __builtin_nontemporal_store(*(const bf16x8*)(sC + row * LDC + cc), (bf16x8*)(dst + (size_t)row * ldd + cc));
  }
}


template <int MI>
DEV void gemm_mm(f32x16 (&acc)[MI][2], const u16* __restrict__ A, int lda, const u16* __restrict__ B, int ldb, int K,
                 unsigned char* smem) {
  constexpr int BM = MI * 64;
  u16* sA = (u16*)smem;
  u16* sB = sA + BM * LDT;
  const int tid = TIDX(), lane = tid & 63, w = tid >> 6, wm = w >> 1, wn = w & 1;
  const int srow = tid >> 3, scol = (tid & 7) * 8;
  const u16* ap = A + (size_t)srow * lda + scol;
  const u16* bp = B + (size_t)srow * ldb + scol;
  bf16x8 ra[MI * 2], rb[4];
#pragma unroll
  for (int i = 0; i < MI * 2; ++i) ra[i] = *(const bf16x8*)(ap + (size_t)(32 * i) * lda);
#pragma unroll
  for (int i = 0; i < 4; ++i) rb[i] = *(const bf16x8*)(bp + (size_t)(32 * i) * ldb);
  const int nk = K >> 6;
  const int fro = (lane & 31) * LDT + (lane >> 5) * 8;
#pragma unroll 1
  for (int kt = 0; kt < nk; ++kt) {
    __syncthreads();
#pragma unroll
    for (int i = 0; i < MI * 2; ++i) *(bf16x8*)(sA + (srow + 32 * i) * LDT + scol) = ra[i];
#pragma unroll
    for (int i = 0; i < 4; ++i) *(bf16x8*)(sB + (srow + 32 * i) * LDT + scol) = rb[i];
    __syncthreads();
    if (kt + 1 < nk) {
      ap += 64;
      bp += 64;
#pragma unroll
      for (int i = 0; i < MI * 2; ++i) ra[i] = *(const bf16x8*)(ap + (size_t)(32 * i) * lda);
#pragma unroll
      for (int i = 0; i < 4; ++i) rb[i] = *(const bf16x8*)(bp + (size_t)(32 * i) * ldb);
    }
    bf16x8 af[2][MI], bfr[2][2];
#pragma unroll
    for (int i = 0; i < MI; ++i) af[0][i] = *(const bf16x8*)(sA + (wm * (MI * 32) + i * 32) * LDT + fro);
#pragma unroll
    for (int i = 0; i < 2; ++i) bfr[0][i] = *(const bf16x8*)(sB + (wn * 64 + i * 32) * LDT + fro);
#pragma unroll
    for (int ks = 0; ks < 4; ++ks) {
      if (ks + 1 < 4) {
#pragma unroll
        for (int i = 0; i < MI; ++i)
          af[(ks + 1) & 1][i] = *(const bf16x8*)(sA + (wm * (MI * 32) + i * 32) * LDT + fro + (ks + 1) * 16);
#pragma unroll
        for (int i = 0; i < 2; ++i)
          bfr[(ks + 1) & 1][i] = *(const bf16x8*)(sB + (wn * 64 + i * 32) * LDT + fro + (ks + 1) * 16);
      }
      __builtin_amdgcn_sched_barrier(0);
      __builtin_amdgcn_s_setprio(1);
#pragma unroll
      for (int mi = 0; mi < MI; ++mi)
#pragma unroll
        for (int ni = 0; ni < 2; ++ni)
          acc[mi][ni] = __builtin_amdgcn_mfma_f32_32x32x16_bf16(af[ks & 1][mi], bfr[ks & 1][ni], acc[mi][ni], 0, 0, 0);
      __builtin_amdgcn_s_setprio(0);
      __builtin_amdgcn_sched_barrier(0);
    }
  }
  __syncthreads();
}
template <int MI>
DEV void zero_acc_t(f32x16 (&acc)[MI][2]) {
#pragma unroll
  for (int a = 0; a < MI; ++a)
#pragma unroll
    for (int b = 0; b < 2; ++b)
#pragma unroll
      for (int r = 0; r < 16; ++r) acc[a][b][r] = 0.f;
}
template <int MI, class F>
DEV void acc_foreach_t(F f) {
  const int tid_ = TIDX();
  const int lane = tid_ & 63, w = tid_ >> 6;
#pragma unroll
  for (int mi = 0; mi < MI; ++mi)
#pragma unroll
    for (int ni = 0; ni < 2; ++ni)
#pragma unroll
      for (int r = 0; r < 16; ++r)
        f(mi, ni, r, (w >> 1) * (MI * 32) + mi * 32 + (r & 3) + 8 * (r >> 2) + 4 * (lane >> 5), (w & 1) * 64 + ni * 32 + (lane & 31));
}
template <int MI>
DEV void tile_load_t(unsigned char* smem, const u16* src, size_t lds_) {
  u16* sC = (u16*)smem;
  const int tid_ = TIDX();
#pragma unroll
  for (int i = 0; i < MI * 4; ++i) {
    const int c = tid_ + 256 * i, row = c >> 4, cc = (c & 15) * 8;
    *(bf16x8*)(sC + row * LDC + cc) = __builtin_nontemporal_load((const bf16x8*)(src + (size_t)row * lds_ + cc));
  }
  __syncthreads();
}
template <int MI>
DEV void tile_store_t(unsigned char* smem, u16* dst, size_t ldd) {
  const u16* sC = (const u16*)smem;
  __syncthreads();
  const int tid_ = TIDX();
#pragma unroll
  for (int i = 0; i < MI * 4; ++i) {
    const int c = tid_ + 256 * i, row = c >> 4, cc = (c & 15) * 8;
    __builtin_nontemporal_store(*(const bf16x8*)(sC + row * LDC + cc), (bf16x8*)(dst + (size_t)row * ldd + cc));
  }
}

#define XB_TMO      128
#define XB_XCNT(j)  (256  + 64 * (j))
#define XB_XSUB(j)  (1280 + 64 * (j))
#define XB_XGEN(j)  (2304 + 64 * (j))
#define XB_TOP      3328
#define XB_TOPGEN   3392
#define XCD_BAR_WORDS 3456
#define XB_SPIN_CAP (1u << 20)
#define LAS __attribute__((address_space(3)))
DEV unsigned xb_ld(unsigned* p) { return __hip_atomic_load(p, __ATOMIC_RELAXED, __HIP_MEMORY_SCOPE_AGENT); }
DEV unsigned xb_add(unsigned* p, unsigned v) { return __hip_atomic_fetch_add(p, v, __ATOMIC_RELAXED, __HIP_MEMORY_SCOPE_AGENT); }
DEV unsigned xb_xcc_id() { return (unsigned)__builtin_amdgcn_s_getreg((3 << 11) | 20) & 0xFu; }
#define XB_SPIN(cond, bar) do { unsigned _sp = 0; while (cond) { __builtin_amdgcn_s_sleep(1); \
    if ((++_sp & 255u) == 0u) { if (xb_ld(&(bar)[XB_TMO])) break; if (_sp > XB_SPIN_CAP) { atomicAdd(&(bar)[XB_TMO], 1u); break; } } } } while (0)
struct XcdBarrier {
  unsigned* bar;
  unsigned x;
  volatile LAS unsigned* st;
};
DEV XcdBarrier xcd_barrier_post(unsigned* bar, volatile LAS unsigned* st) {
  XcdBarrier b;
  b.bar = bar;
  b.x = xb_xcc_id();
  b.st = st;
  if (threadIdx.x == 0) (void)xb_add(&bar[XB_XCNT(b.x)], 1u);
  return b;
}
DEV void xcd_barrier_complete(unsigned* bar, unsigned x, unsigned& nloc, unsigned& nx) {
  const unsigned G = gridDim.x * gridDim.y * gridDim.z;
  unsigned sum, cnt, mine, sp = 0u;
  for (;;) {
    sum = 0u; cnt = 0u; mine = 0u;
#pragma unroll
    for (unsigned j = 0; j < 16; ++j) {
      const unsigned c = xb_ld(&bar[XB_XCNT(j)]);
      sum += c;
      cnt += (c > 0u) ? 1u : 0u;
      mine = (j == x) ? c : mine;
    }
    if (sum == G) break;
    __builtin_amdgcn_s_sleep(1);
    if ((++sp & 255u) == 0u) {
      if (xb_ld(&bar[XB_TMO])) break;
      if (sp > XB_SPIN_CAP) { atomicAdd(&bar[XB_TMO], 1u); break; }
    }
  }
  nloc = mine > 0u ? mine : 1u;
  nx = cnt > 0u ? cnt : 1u;
}
DEV void xcd_barrier(unsigned* bar_, volatile LAS unsigned* st_) {
  asm volatile("s_waitcnt vmcnt(0)" ::: "memory");
  __syncthreads();
  if (threadIdx.x == 0) {
    XcdBarrier b;
    b.bar = bar_;
    b.x = xb_xcc_id();
    b.st = st_;
    unsigned* bar = b.bar;
    __builtin_amdgcn_s_waitcnt(0);
    unsigned nloc = b.st[0], nx = b.st[1];
    if (nloc == 0u) {
      xcd_barrier_complete(bar, b.x, nloc, nx);
      b.st[0] = nloc;
      b.st[1] = nx;
    }
    const unsigned old = xb_add(&bar[XB_XSUB(b.x)], 1u);
    const unsigned gen = old / nloc;
    if (old + 1u == (gen + 1u) * nloc) {
      __builtin_amdgcn_fence(__ATOMIC_RELEASE, "agent");
      asm volatile("s_waitcnt vmcnt(0)" ::: "memory");
      const unsigned og = xb_add(&bar[XB_TOP], 1u);
      const unsigned tg = og / nx;
      if (og + 1u == (tg + 1u) * nx) xb_add(&bar[XB_TOPGEN], 1u);
      else XB_SPIN(xb_ld(&bar[XB_TOPGEN]) == tg, bar);
      __builtin_amdgcn_fence(__ATOMIC_ACQUIRE, "agent");
      xb_add(&bar[XB_XGEN(b.x)], 1u);
      asm volatile("s_waitcnt vmcnt(0)" ::: "memory");
    } else {
      XB_SPIN(xb_ld(&bar[XB_XGEN(b.x)]) == gen, bar);
      __builtin_amdgcn_fence(__ATOMIC_ACQUIRE, "agent");
      asm volatile("s_waitcnt vmcnt(0)" ::: "memory");
    }
  }
  __syncthreads();
}

DEV void transpose_tile(const float* __restrict__ src, int lds_, u16* __restrict__ dst, int ldd, const float* scale,
                        int k0, int n0, unsigned char* smem) {
  float* s = (float*)smem;
  const int tid = TIDX();
  __syncthreads();
  {
    const int n = tid & 63, kq = tid >> 6;
#pragma unroll 4
    for (int i = 0; i < 16; ++i) {
      int kk = kq * 16 + i;
      s[kk * 65 + n] = src[(size_t)(k0 + kk) * lds_ + n0 + n];
    }
  }
  __syncthreads();
  {
    const int k = tid & 63, nq = tid >> 6;
    const float sc = scale ? scale[k0 + k] : 1.0f;
#pragma unroll 4
    for (int i = 0; i < 16; ++i) {
      int n = nq * 16 + i;
      dst[(size_t)(n0 + n) * ldd + k0 + k] = f2bf(s[k * 65 + n] * sc);
    }
  }
}

DEV void qlat_tile(const float* __restrict__ wq, const float* __restrict__ wuk, const float* __restrict__ g,
                   u16* __restrict__ dst, int h, int r0, int k0, unsigned char* smem) {
  float* sQ = (float*)smem;
  float* sU = sQ + 64 * 65;
  const int tid = TIDX();
  float acc[16];
#pragma unroll
  for (int i = 0; i < 16; ++i) acc[i] = 0.f;
  for (int nh = 0; nh < 2; ++nh) {
    __syncthreads();
    {
      const int n = tid & 63, q = tid >> 6;
      for (int i = 0; i < 16; ++i) {
        int rr = q * 16 + i;
        sQ[rr * 65 + n] = wq[(size_t)(k0 + rr) * 1536 + h * 192 + nh * 64 + n];
        sU[rr * 65 + n] = wuk[(size_t)(r0 + rr) * 1024 + h * 128 + nh * 64 + n];
      }
    }
    __syncthreads();
    const int k = tid & 63, rq = tid >> 6;
    for (int n = 0; n < 64; ++n) {
      float qv = sQ[k * 65 + n];
#pragma unroll
      for (int i = 0; i < 16; ++i) acc[i] += qv * sU[(rq * 16 + i) * 65 + n];
    }
  }
  const int k = tid & 63, rq = tid >> 6;
  const float sc = g[k0 + k];
#pragma unroll
  for (int i = 0; i < 16; ++i) dst[(size_t)(h * 320 + r0 + rq * 16 + i) * 768 + k0 + k] = f2bf(acc[i] * sc);
}

DEV void mod_item(const Params& p, int item, unsigned char* smem) {
  const int l = item / 48, cg_ = item % 48;
  float* sc = (float*)smem;
  float* red = sc + 48 * 256;
  (void)red;
  const int tid = TIDX(), col = tid & 63, kq = tid >> 6;
  const float* W = p.ada_w + (size_t)l * 1024 * 3072 + cg_ * 64 + col;
  float acc[48];
#pragma unroll
  for (int b = 0; b < 48; ++b) acc[b] = 0.f;
  for (int kc = 0; kc < 4; ++kc) {
    __syncthreads();
    for (int e = tid; e < 48 * 256; e += NT) {
      int b = e >> 8, k = e & 255;
      float c = b < 16 ? p.c_p[b * 1024 + kc * 256 + k] : p.c_s[(b - 16) * 1024 + kc * 256 + k];
      sc[e] = siluf_(c);
    }
    __syncthreads();
#pragma unroll 1
    for (int i0 = 0; i0 < 64; i0 += 8) {
      float wv[8];
#pragma unroll
      for (int i = 0; i < 8; ++i) wv[i] = W[(size_t)(kc * 256 + kq * 64 + i0 + i) * 3072];
#pragma unroll
      for (int i = 0; i < 8; ++i) {
        const int k = kq * 64 + i0 + i;
#pragma unroll
        for (int b = 0; b < 48; ++b) acc[b] += sc[b * 256 + k] * wv[i];
      }
    }
  }
  __syncthreads();
#pragma unroll
  for (int b = 0; b < 48; ++b) sc[(kq * 48 + b) * 64 + col] = acc[b];
  __syncthreads();
  float* MOD = (float*)(p.ws + OFF_MOD);
  for (int e = tid; e < 48 * 64; e += NT) {
    int b = e >> 6, c = e & 63;
    float v = sc[(0 * 48 + b) * 64 + c] + sc[(1 * 48 + b) * 64 + c] + sc[(2 * 48 + b) * 64 + c] + sc[(3 * 48 + b) * 64 + c];
    int gc = cg_ * 64 + c;
    MOD[((size_t)l * 48 + b) * 3072 + gc] = v + p.ada_b[l * 3072 + gc];
  }
}

DEV void phase_prep(const Params& p, unsigned char* smem) {
  const int tid = TIDX();
  if (blockIdx.x == 0) {
    if (tid < 64) ((unsigned*)(p.ws + OFF_CNT))[tid] = 0u;
    for (int e = tid; e < XCD_BAR_WORDS; e += NT) ((unsigned*)(p.ws + OFF_BAR))[e] = 0u;
  }
  const bool split = gridDim.x >= 192;
  if (split && blockIdx.x < 96) {
    mod_item(p, blockIdx.x, smem);
    return;
  }
  const int nb = split ? (int)gridDim.x - 96 : (int)gridDim.x;
  int idx = split ? (int)blockIdx.x - 96 : (int)blockIdx.x, base = 0;
  if (!split) {
    for (; idx < base + 96; idx += nb) mod_item(p, idx - base, smem);
    base += 96;
  }
  for (int l = 0; l < 2; ++l) {
    u16* WL = (u16*)(p.ws + OFF_W) + (size_t)l * W_LAYER;
    const float* win = p.w_in + (size_t)l * 1024 * IN_DIM;
#define TJOB(SRC, LDS_, KK, NN, DST, LDD, SCALE)                                     \
  {                                                                                  \
    const int nkt = (KK) / 64, ntl = nkt * ((NN) / 64);                              \
    for (; idx < base + ntl; idx += nb) {                                            \
      int t = idx - base;                                                            \
      transpose_tile((SRC), (LDS_), (DST), (LDD), (SCALE), (t % nkt) * 64, (t / nkt) * 64, smem); \
    }                                                                                \
    base += ntl;                                                                     \
  }
    TJOB(win, IN_DIM, 1024, 1024, WL + WO_W1, 1024, nullptr);
    TJOB(win + 2048, IN_DIM, 1024, 1088, WL + WO_W1 + (size_t)1024 * 1024, 1024, nullptr);
    TJOB(win + 1024, IN_DIM, 1024, 1024, WL + WO_G, 1024, nullptr);
    TJOB(win + 3136, IN_DIM, 1024, 3072, WL + WO_G + (size_t)1024 * 1024, 1024, nullptr);
    TJOB(p.w_q_up + (size_t)l * 768 * 1536, 1536, 768, 1536, WL + WO_QP, 768, p.q_norm + l * 768);
    for (int h = 0; h < 8; ++h)
      TJOB(p.w_q_up + (size_t)l * 768 * 1536 + h * 192 + 128, 1536, 768, 64, WL + WO_QS + (size_t)(h * 320 + 256) * 768, 768,
           p.q_norm + l * 768);
    TJOB(p.w_uk + (size_t)l * 262144, 1024, 256, 1024, WL + WO_UK, 256, p.kv_norm + l * 256);
    TJOB(p.w_uv + (size_t)l * 262144, 1024, 256, 1024, WL + WO_UVS, 256, p.kv_norm + l * 256);
    TJOB(p.w_uv + (size_t)l * 262144, 1024, 256, 1024, WL + WO_UVP, 256, nullptr);
    TJOB(p.w_ba + (size_t)l * 1048576, 1024, 1024, 1024, WL + WO_BA, 1024, nullptr);
    TJOB(p.w_bb + (size_t)l * 1048576, 1024, 1024, 1024, WL + WO_BB, 1024, nullptr);
    TJOB(p.w_out + (size_t)l * 1048576, 1024, 1024, 1024, WL + WO_OUT, 1024, nullptr);
    for (int b8 = 0; b8 < 8; ++b8) {
      TJOB(p.lru_wa + (size_t)l * 131072 + b8 * 16384, 128, 128, 128, WL + WO_LA + b8 * 16384, 128, nullptr);
      TJOB(p.lru_wx + (size_t)l * 131072 + b8 * 16384, 128, 128, 128, WL + WO_LX + b8 * 16384, 128, nullptr);
    }
    for (; idx < base + 384; idx += nb) {
      int t = idx - base;
      int h = t / 48, rt = (t % 48) / 12, kt = t % 12;
      qlat_tile(p.w_q_up + (size_t)l * 768 * 1536, p.w_uk + (size_t)l * 262144, p.q_norm + l * 768, WL + WO_QS, h,
                rt * 64, kt * 64, smem);
    }
    base += 384;
    for (; idx < base + 16; idx += nb) {
      int t = idx - base;
      u16* d = WL + WO_W1 + (size_t)2112 * 1024 + t * 4096;
      for (int e = tid; e < 4096; e += NT) d[e] = 0;
    }
    base += 16;
  }
  float* ROPE = (float*)(p.ws + OFF_ROPE);
  for (; idx < base + 512; idx += nb) {
    int e = (idx - base) * 256 + tid;
    int pos = e >> 5, j = e & 31;
    float inv = exp2f(-(float)j * (13.287712379549449f / 32.0f));
    float ang = (float)pos * inv;
    ROPE[2 * e] = cosf(ang);
    ROPE[2 * e + 1] = sinf(ang);
  }
  base += 512;
}

DEV void norm_row(const Params& p, int l, int m, const float (&xv)[16], int lane) {
  float ss = 0.f;
#pragma unroll
  for (int i = 0; i < 16; ++i) ss += xv[i] * xv[i];
  ss = wave_sum(ss);
  const float rstd = rsqrtf(ss * (1.0f / 1024.0f) + EPS);
  const float* MOD = (const float*)(p.ws + OFF_MOD) + ((size_t)l * 48 + mod_row(m)) * 3072;
  u16* H = (u16*)(p.ws + OFF_H) + (size_t)m * 1024;
#pragma unroll
  for (int i = 0; i < 4; ++i) {
    int c = i * 256 + lane * 4;
    float4 g = *(const float4*)(p.pre_norm + l * 1024 + c);
    float4 sh = *(const float4*)(MOD + c);
    float4 sc = *(const float4*)(MOD + 1024 + c);
    ushort4 o;
    o.x = f2bf(xv[i * 4 + 0] * rstd * g.x * (1.f + sc.x) + sh.x);
    o.y = f2bf(xv[i * 4 + 1] * rstd * g.y * (1.f + sc.y) + sh.y);
    o.z = f2bf(xv[i * 4 + 2] * rstd * g.z * (1.f + sc.z) + sh.z);
    o.w = f2bf(xv[i * 4 + 3] * rstd * g.w * (1.f + sc.w) + sh.w);
    *(ushort4*)(H + c) = o;
  }
}

DEV void phase_norm0(const Params& p) {
  const int tid_ = TIDX();
  const int lane = tid_ & 63, wv = tid_ >> 6;
  for (int m = blockIdx.x * 4 + wv; m < MT; m += gridDim.x * 4) {
    const float* x = m < MP ? p.x_p + (size_t)m * 1024 : p.x_s + (size_t)(m - MP) * 1024;
    float xv[16];
#pragma unroll
    for (int i = 0; i < 4; ++i) {
      float4 v = *(const float4*)(x + i * 256 + lane * 4);
      xv[i * 4] = v.x; xv[i * 4 + 1] = v.y; xv[i * 4 + 2] = v.z; xv[i * 4 + 3] = v.w;
    }
    norm_row(p, 0, m, xv, lane);
  }
}

DEV void phase_final(const Params& p, int l) {
  const int tid_ = TIDX();
  const int lane = tid_ & 63, wv = tid_ >> 6;
  const u16* O = (const u16*)(p.ws + OFF_R4);
  for (int m = blockIdx.x * 4 + wv; m < MT; m += gridDim.x * 4) {
    float* y = m < MP ? p.out + OUT_YP + (size_t)m * 1024 : p.out + OUT_YS + (size_t)(m - MP) * 1024;
    const float* x = (l == 0) ? (m < MP ? p.x_p + (size_t)m * 1024 : p.x_s + (size_t)(m - MP) * 1024) : y;
    float xv[16], ov[16];
    float ss = 0.f;
#pragma unroll
    for (int i = 0; i < 4; ++i) {
      int c = i * 256 + lane * 4;
      float4 v = *(const float4*)(x + c);
      xv[i * 4] = v.x; xv[i * 4 + 1] = v.y; xv[i * 4 + 2] = v.z; xv[i * 4 + 3] = v.w;
      ushort4 o = *(const ushort4*)(O + (size_t)m * 1024 + c);
      ov[i * 4] = bf2f(o.x); ov[i * 4 + 1] = bf2f(o.y); ov[i * 4 + 2] = bf2f(o.z); ov[i * 4 + 3] = bf2f(o.w);
    }
#pragma unroll
    for (int i = 0; i < 16; ++i) ss += ov[i] * ov[i];
    ss = wave_sum(ss);
    const float rstd = rsqrtf(ss * (1.0f / 1024.0f) + EPS);
    const float* MOD = (const float*)(p.ws + OFF_MOD) + ((size_t)l * 48 + mod_row(m)) * 3072 + 2048;
#pragma unroll
    for (int i = 0; i < 4; ++i) {
      int c = i * 256 + lane * 4;
      float4 g = *(const float4*)(p.post_norm + l * 1024 + c);
      float4 gt = *(const float4*)(MOD + c);
      xv[i * 4 + 0] += gt.x * ov[i * 4 + 0] * rstd * g.x;
      xv[i * 4 + 1] += gt.y * ov[i * 4 + 1] * rstd * g.y;
      xv[i * 4 + 2] += gt.z * ov[i * 4 + 2] * rstd * g.z;
      xv[i * 4 + 3] += gt.w * ov[i * 4 + 3] * rstd * g.w;
      *(float4*)(y + c) = make_float4(xv[i * 4], xv[i * 4 + 1], xv[i * 4 + 2], xv[i * 4 + 3]);
    }
    if (l == 0) norm_row(p, 1, m, xv, lane);
  }
}

template <int MI>
DEV void gemm1_tile(const Params& p, int l, int m0, int nt, unsigned char* smem) {
  constexpr int BM = MI * 64;
  const u16* H = (const u16*)(p.ws + OFF_H);
  const u16* W1 = (const u16*)(p.ws + OFF_W) + (size_t)l * W_LAYER + WO_W1;
  u16* XA = (u16*)(p.ws + OFF_R1);
  u16* CQ = (u16*)(p.ws + OFF_R2);
  u16* CKVR = CQ + (size_t)MT * 768;
  u16* sC = (u16*)smem;
  f32x16 acc[MI][2];
  zero_acc_t<MI>(acc);
  gemm_mm<MI>(acc, H + (size_t)m0 * 1024, 1024, W1 + (size_t)nt * 128 * 1024, 1024, 1024, smem);
  if (nt < 14) {
    acc_foreach_t<MI>([&](int mi, int ni, int r, int row, int col) __attribute__((always_inline)) {
      sC[row * LDC + col] = f2bf(acc[mi][ni][r]);
    });
    if (nt < 8) tile_store_t<MI>(smem, XA + (size_t)m0 * 1024 + nt * 128, 1024);
    else tile_store_t<MI>(smem, CQ + (size_t)m0 * 768 + (nt - 8) * 128, 768);
    if (nt < 8 && (m0 >= MP || ((m0 + BM) & 4095) == 0)) {
      acc_foreach_t<MI>([&](int mi, int ni, int r, int row, int col) __attribute__((always_inline)) {
        const int m = m0 + row, n = nt * 128 + col;
        const float v = acc[mi][ni][r];
        if (m < MP) {
          int j = (m & 4095) - 4093;
          if (j >= 0) p.out[OUT_CONVP + ((size_t)(l * 16 + (m >> 12)) * 3 + j) * 1024 + n] = v;
        } else {
          int j = ((m - MP) & 15) - 13;
          if (j >= 0) p.out[OUT_CONVS + ((size_t)(l * 32 + ((m - MP) >> 4)) * 3 + j) * 1024 + n] = v;
        }
      });
    }
  } else if (nt < 16) {
    float* ob = m0 < MP ? p.out + OUT_CKVP + ((size_t)l * MP + m0) * 256 + (nt - 14) * 128
                        : p.out + OUT_CKVS + ((size_t)l * MS + (m0 - MP)) * 256 + (nt - 14) * 128;
    acc_foreach_t<MI>([&](int mi, int ni, int r, int row, int col) __attribute__((always_inline)) {
      const float v = acc[mi][ni][r];
      sC[row * LDC + col] = f2bf(v);
      ob[(size_t)row * 256 + col] = v;
    });
    tile_store_t<MI>(smem, CKVR + (size_t)m0 * 256 + (nt - 14) * 128, 256);
  } else {
    float* ob = m0 < MP ? p.out + OUT_KPEP + ((size_t)l * MP + m0) * 64 : p.out + OUT_KPES + ((size_t)l * MS + (m0 - MP)) * 64;
    acc_foreach_t<MI>([&](int mi, int ni, int r, int row, int col) __attribute__((always_inline)) {
      if (col < 64) ob[(size_t)row * 64 + col] = acc[mi][ni][r];
    });
  }
}
DEV void phase_gemm1(const Params& p, int l, unsigned char* smem) {
  const int nb = gridDim.x;
  int idx = vbid(), base = 0;
#pragma unroll 1
  for (; idx < base + 256 * 17; idx += nb) {
    const int t = idx - base;
    gemm1_tile<4>(p, l, (t / 17) * 256, t % 17, smem);
  }
  base += 256 * 17;
#pragma unroll 1
  for (; idx < base + 4 * 17; idx += nb) {
    const int t = idx - base;
    gemm1_tile<2>(p, l, MP + (t / 17) * 128, t % 17, smem);
  }
}

DEV void post1_rows(const Params& p, int l, int item) {
  const int tid_ = TIDX();
  const int lane = tid_ & 63, wv = tid_ >> 6;
  const float* ROPE = (const float*)(p.ws + OFF_ROPE);
  float4 v[2];
  float kx[2];
  float2 cs[2];
  float* ckvp[2];
  float* kpep[2];
#pragma unroll
  for (int u = 0; u < 2; ++u) {
    const int m = item * 8 + wv * 2 + u;
    ckvp[u] = m < MP ? p.out + OUT_CKVP + ((size_t)l * MP + m) * 256 : p.out + OUT_CKVS + ((size_t)l * MS + (m - MP)) * 256;
    kpep[u] = m < MP ? p.out + OUT_KPEP + ((size_t)l * MP + m) * 64 : p.out + OUT_KPES + ((size_t)l * MS + (m - MP)) * 64;
    v[u] = *(const float4*)(ckvp[u] + lane * 4);
    kx[u] = kpep[u][lane];
    cs[u] = *(const float2*)(ROPE + ((size_t)pos_of(m) * 32 + (lane & 31)) * 2);
  }
  const float4 g = *(const float4*)(p.kv_norm + l * 256 + lane * 4);
#pragma unroll
  for (int u = 0; u < 2; ++u) {
    const int m = item * 8 + wv * 2 + u;
    const float ss = wave_sum(v[u].x * v[u].x + v[u].y * v[u].y + v[u].z * v[u].z + v[u].w * v[u].w);
    const float rstd = rsqrtf(ss * (1.0f / 256.0f) + EPS);
    float4 o4 = v[u];
    o4.x *= rstd * g.x; o4.y *= rstd * g.y; o4.z *= rstd * g.z; o4.w *= rstd * g.w;
    *(float4*)(ckvp[u] + lane * 4) = o4;
    const float other = __shfl_xor(kx[u], 32, 64);
    const float c = cs[u].x, sn = cs[u].y;
    const float ro = (lane < 32) ? (kx[u] * c - other * sn) : (other * sn + kx[u] * c);
    kpep[u][lane] = ro;
    if (m < MP) {
      u16* KPE = (u16*)(p.ws + OFF_KPE) + (size_t)m * 64;
      KPE[lane] = f2bf(ro);
    } else {
      const int b = (m - MP) >> 4, t = (m - MP) & 15;
      u16* SKV = (u16*)(p.ws + OFF_SKV) + ((size_t)b * 2112 + 2048 + t) * 320;
      u16* SVT = (u16*)(p.ws + OFF_SVT) + (size_t)b * 256 * 2112 + 2048 + t;
      ushort4 o;
      o.x = f2bf(o4.x); o.y = f2bf(o4.y); o.z = f2bf(o4.z); o.w = f2bf(o4.w);
      *(ushort4*)(SKV + lane * 4) = o;
      SVT[(size_t)(lane * 4 + 0) * 2112] = o.x;
      SVT[(size_t)(lane * 4 + 1) * 2112] = o.y;
      SVT[(size_t)(lane * 4 + 2) * 2112] = o.z;
      SVT[(size_t)(lane * 4 + 3) * 2112] = o.w;
      SKV[256 + lane] = f2bf(ro);
    }
  }
}

DEV void cache_item(const Params& p, int l, int item, unsigned char* smem) {
  const int tid = TIDX();
  const int b = item / 33, kt = item % 33;
  u16* SKV = (u16*)(p.ws + OFF_SKV) + (size_t)b * 2112 * 320;
  u16* SVT = (u16*)(p.ws + OFF_SVT) + (size_t)b * 256 * 2112;
  if (kt == 32) {
    for (int e = tid; e < 48 * 320; e += NT) SKV[(size_t)2064 * 320 + e] = 0;
    for (int e = tid; e < 256 * 48; e += NT) SVT[(size_t)(e / 48) * 2112 + 2064 + (e % 48)] = 0;
    return;
  }
  float* s = (float*)smem;
  const float* src = p.cache_ckv + (((size_t)l * 32 + b) * 2048 + kt * 64) * 256;
  const float* srck = p.cache_kpe + (((size_t)l * 32 + b) * 2048 + kt * 64) * 64;
  for (int dh = 0; dh < 2; ++dh) {
    __syncthreads();
    for (int e = tid; e < 64 * 128; e += NT) {
      int key = e >> 7, d = e & 127;
      float v = src[(size_t)key * 256 + dh * 128 + d];
      s[key * 129 + d] = v;
      SKV[(size_t)(kt * 64 + key) * 320 + dh * 128 + d] = f2bf(v);
    }
    __syncthreads();
    const int k = tid & 63, dq = tid >> 6;
    for (int i = 0; i < 32; ++i) {
      int d = dq * 32 + i;
      SVT[(size_t)(dh * 128 + d) * 2112 + kt * 64 + k] = f2bf(s[k * 129 + d]);
    }
  }
  for (int e = tid; e < 64 * 64; e += NT) {
    int key = e >> 6, d = e & 63;
    SKV[(size_t)(kt * 64 + key) * 320 + 256 + d] = f2bf(srck[(size_t)key * 64 + d]);
  }
}

DEV void phase_p2(const Params& p, int l, unsigned char* smem) {
  const int tid = TIDX(), lane = tid & 63, w = tid >> 6;
  const int nb = gridDim.x;
  const u16* WL = (const u16*)(p.ws + OFF_W) + (size_t)l * W_LAYER;
  const u16* CQ = (const u16*)(p.ws + OFF_R2);
  const u16* CKVR = CQ + (size_t)MT * 768;
  u16* Q = (u16*)(p.ws + OFF_R3);
  u16* QS = (u16*)(p.ws + OFF_QS);
  u16* Kb = (u16*)(p.ws + OFF_R4);
  u16* VT = (u16*)(p.ws + OFF_VT);
  const float* ROPE = (const float*)(p.ws + OFF_ROPE);
  float* ss = gemm_ss(smem);
  int idx = vbid(), base = 0;
  const int nq = 512 * 12 + 4 * 20;
  for (; idx < base + nq; idx += nb) {
    int t = idx - base;
    int mt, nt;
    const u16* Wt;
    bool samp = t >= 512 * 12;
    if (!samp) { mt = t / 12; nt = t % 12; Wt = WL + WO_QP; }
    else { t -= 512 * 12; mt = 512 + t / 20; nt = t % 20; Wt = WL + WO_QS; }
    f32x16 acc[2][2];
    zero_acc(acc);
    gemm_main<1>(acc, CQ + (size_t)mt * 128 * 768, 768, Wt + (size_t)nt * 128 * 768, 768, 768, smem);
    const int g = nt * 2 + (w & 1);
    const bool rope = samp ? (g % 5 == 4) : (g % 3 == 2);
    u16* sC = (u16*)smem;
#pragma unroll
    for (int mi = 0; mi < 2; ++mi)
#pragma unroll
      for (int r = 0; r < 16; ++r) {
        const int row = (w >> 1) * 64 + mi * 32 + (r & 3) + 8 * (r >> 2) + 4 * (lane >> 5);
        const int m = mt * 128 + row;
        const float rs = rsqrtf(ss[row] * (1.0f / 768.0f) + EPS) * QSCALE;
        float v0 = acc[mi][0][r] * rs, v1 = acc[mi][1][r] * rs;
        if (rope) {
          const int pos = pos_of(m);
          const float c = ROPE[(pos * 32 + (lane & 31)) * 2], s = ROPE[(pos * 32 + (lane & 31)) * 2 + 1];
          const float a = v0 * c - v1 * s, b = v0 * s + v1 * c;
          v0 = a; v1 = b;
        }
        const int col = (w & 1) * 64 + (lane & 31);
        sC[row * LDC + col] = f2bf(v0);
        sC[row * LDC + col + 32] = f2bf(v1);
      }
    if (!samp) tile_store(smem, Q + (size_t)mt * 128 * 1536 + nt * 128, 1536);
    else tile_store(smem, QS + (size_t)(mt - 512) * 128 * 2560 + nt * 128, 2560);
  }
  base += nq;
  for (; idx < base + 4096; idx += nb) {
    int t = idx - base;
    int mt = t >> 3, nt = t & 7;
    f32x16 acc[2][2];
    zero_acc(acc);
    gemm_main<1, 2>(acc, CKVR + (size_t)mt * 128 * 256, 256, WL + WO_UK + (size_t)nt * 128 * 256, 256, 256, smem);
    {
      u16* sC = (u16*)smem;
      acc_foreach([&](int mi, int ni, int r, int row, int col) __attribute__((always_inline)) {
        const float rs = rsqrtf(ss[row] * (1.0f / 256.0f) + EPS);
        sC[row * LDC + col] = f2bf(acc[mi][ni][r] * rs);
      });
      tile_store(smem, Kb + (size_t)mt * 128 * 1024 + nt * 128, 1024);
    }
  }
  base += 4096;
  for (; idx < base + 4096; idx += nb) {
    int t = idx - base;
    int b = t >> 8, mt = (t >> 5) & 7, nt = t & 31;
    f32x16 acc[2][2];
    zero_acc(acc);
    gemm_main<2, 2>(acc, WL + WO_UVS + (size_t)mt * 128 * 256, 256, CKVR + ((size_t)b * 4096 + nt * 128) * 256, 256, 256, smem);
    {
      u16* sC = (u16*)smem;
      acc_foreach([&](int mi, int ni, int r, int row, int col) __attribute__((always_inline)) {
        const float rs = rsqrtf(ss[col] * (1.0f / 256.0f) + EPS);
        sC[row * LDC + col] = f2bf(acc[mi][ni][r] * rs);
      });
      tile_store(smem, VT + ((size_t)b * 1024 + mt * 128) * 4096 + nt * 128, 4096);
    }
  }
  base += 4096;
  for (; idx < base + MT / 8; idx += nb) post1_rows(p, l, idx - base);
  base += MT / 8;
  for (; idx < base + 32 * 33; idx += nb) cache_item(p, l, idx - base, smem);
  base += 32 * 33;
}

#ifndef ATT_PF
#define ATT_PF true
#endif
template <int DK, bool PF>
DEV void attn_item(const u16* __restrict__ qrow, const u16* __restrict__ ka, int ldka, const u16* __restrict__ kb, int ldkb,
                   const u16* __restrict__ vt, int ldvt, int ntiles, int my_tiles, int kvlen, u16* orow,
                   unsigned char* smem) {
  constexpr int DKA = DK - 64, KST = DK + 8, VST = 68;
  u16* sK = (u16*)smem;
  u16* sV = sK + 64 * KST;
  const int tid = TIDX(), lane = tid & 63, hh = lane >> 5, l31 = lane & 31;
  constexpr bool QREG = (DK <= 192);
  bf16x8 qf[DK / 16];
  if (QREG) {
#pragma unroll
    for (int ks = 0; ks < DK / 16; ++ks) qf[ks] = *(const bf16x8*)(qrow + ks * 16 + hh * 8);
  }
  f32x16 o[4];
#pragma unroll
  for (int d = 0; d < 4; ++d)
#pragma unroll
    for (int r = 0; r < 16; ++r) o[d][r] = 0.f;
  float mrun = -1e30f, lrun = 0.f;
  constexpr int CA = DKA / 32;
  bf16x8 rk[CA + 2], rv[4];
  const int skey = tid >> 2, sq = tid & 3;
  const u16* gka = ka + (size_t)skey * ldka + sq * CA * 8;
  const u16* gkb = kb + (size_t)skey * ldkb + sq * 16;
  const u16* gv = vt + (size_t)(tid >> 1) * ldvt + (tid & 1) * 32;
  u16* lka = sK + skey * KST + sq * CA * 8;
  u16* lkb = sK + skey * KST + DKA + sq * 16;
  u16* lv = sV + (tid >> 1) * VST + (tid & 1) * 32;
  auto load_tile = [&](int t) __attribute__((always_inline)) {
    const size_t ko = (size_t)t * 64;
#pragma unroll
    for (int i = 0; i < CA; ++i) rk[i] = *(const bf16x8*)(gka + ko * ldka + i * 8);
#pragma unroll
    for (int i = 0; i < 2; ++i) rk[CA + i] = *(const bf16x8*)(gkb + ko * ldkb + i * 8);
#pragma unroll
    for (int i = 0; i < 4; ++i) rv[i] = *(const bf16x8*)(gv + ko + i * 8);
  };
  auto store_tile = [&]() __attribute__((always_inline)) {
#pragma unroll
    for (int i = 0; i < CA; ++i) *(bf16x8*)(lka + i * 8) = rk[i];
#pragma unroll
    for (int i = 0; i < 2; ++i) *(bf16x8*)(lkb + i * 8) = rk[CA + i];
#pragma unroll
    for (int i = 0; i < 4; ++i) {
      union { bf16x8 v; uint2 u[2]; } cv;
      cv.v = rv[i];
      *(uint2*)(lv + i * 8) = cv.u[0];
      *(uint2*)(lv + i * 8 + 4) = cv.u[1];
    }
  };
  if (PF) load_tile(0);
#pragma unroll 1
  for (int t = 0; t < ntiles; ++t) {
    __syncthreads();
    if (!PF) load_tile(t);
    store_tile();
    __syncthreads();
    if (PF && t + 1 < ntiles) load_tile(t + 1);
    if (t < my_tiles) {
      const u16* qp = qrow + hh * 8;
      if (!QREG) asm volatile("" : "+v"(qp));
      const int key0 = t * 64;
#pragma unroll 1
      for (int mi = 0; mi < 2; ++mi) {
        f32x16 s;
#pragma unroll
        for (int r = 0; r < 16; ++r) s[r] = 0.f;
        const u16* kp = sK + (mi * 32 + l31) * KST + hh * 8;
        constexpr int KB = QREG ? 12 : 4;
#pragma unroll
        for (int k0 = 0; k0 < DK / 16; k0 += KB) {
          bf16x8 kf[KB];
#pragma unroll
          for (int i = 0; i < KB; ++i) kf[i] = *(const bf16x8*)(kp + (k0 + i) * 16);
          __builtin_amdgcn_sched_barrier(0);
#pragma unroll
          for (int i = 0; i < KB; ++i) {
            bf16x8 qv;
            if (QREG) qv = qf[k0 + i];
            else qv = *(const bf16x8*)(qp + (k0 + i) * 16);
            s = __builtin_amdgcn_mfma_f32_32x32x16_bf16(kf[i], qv, s, 0, 0, 0);
          }
        }
        bf16x8 vf[8];
        {
          const u16* vp = sV + l31 * VST + mi * 32 + 4 * hh;
#pragma unroll
          for (int oc = 0; oc < 2; ++oc)
#pragma unroll
            for (int d = 0; d < 4; ++d) {
              union { bf16x8 v; uint2 u[2]; } cv;
              cv.u[0] = *(const uint2*)(vp + d * 32 * VST + oc * 16);
              cv.u[1] = *(const uint2*)(vp + d * 32 * VST + oc * 16 + 8);
              vf[oc * 4 + d] = cv.v;
            }
          __builtin_amdgcn_sched_barrier(0);
        }
        if (key0 + 64 > kvlen) {
#pragma unroll
          for (int r = 0; r < 16; ++r) {
            int key = key0 + mi * 32 + (r & 3) + 8 * (r >> 2) + 4 * hh;
            if (key >= kvlen) s[r] = -1e30f;
          }
        }
        float mx = -1e30f;
#pragma unroll
        for (int r = 0; r < 16; ++r) mx = fmaxf(mx, s[r]);
        mx = fmaxf(mx, __shfl_xor(mx, 32, 64));
        if (__builtin_amdgcn_ballot_w64(mx > mrun) != 0ull) {
          const float mnew = fmaxf(mrun, mx);
          const float alpha = __builtin_amdgcn_exp2f(mrun - mnew);
          mrun = mnew;
          lrun *= alpha;
#pragma unroll
          for (int d = 0; d < 4; ++d)
#pragma unroll
            for (int r = 0; r < 16; ++r) o[d][r] *= alpha;
        }
        union { bf16x8 v[2]; unsigned u[8]; } pfu;
        float ps = 0.f;
#pragma unroll
        for (int r = 0; r < 16; r += 2) {
          float p0 = __builtin_amdgcn_exp2f(s[r] - mrun);
          float p1 = __builtin_amdgcn_exp2f(s[r + 1] - mrun);
          ps += p0 + p1;
          pfu.u[r >> 1] = pk2bf(p0, p1);
        }
        lrun += ps;
#pragma unroll
        for (int oc = 0; oc < 2; ++oc)
#pragma unroll
          for (int d = 0; d < 4; ++d) o[d] = __builtin_amdgcn_mfma_f32_32x32x16_bf16(vf[oc * 4 + d], pfu.v[oc], o[d], 0, 0, 0);
      }
    }
  }
  const float ltot = lrun + __shfl_xor(lrun, 32, 64);
  const float inv = 1.0f / ltot;
#pragma unroll
  for (int d = 0; d < 4; ++d)
#pragma unroll
    for (int g = 0; g < 4; ++g) {
      uint2 ov;
      ov.x = pk2bf(o[d][g * 4 + 0] * inv, o[d][g * 4 + 1] * inv);
      ov.y = pk2bf(o[d][g * 4 + 2] * inv, o[d][g * 4 + 3] * inv);
      *(uint2*)(orow + d * 32 + g * 8 + hh * 4) = ov;
    }
  __syncthreads();
}

DEV void lru_item(const Params& p, int l, int sb, int nbk, int half, unsigned char* smem) {
  const int tid = TIDX(), lane = tid & 63, w = tid >> 6, hh = lane >> 5, l31 = lane & 31;
  const bool samp = sb >= 16;
  const int S = samp ? 16 : 4096;
  const int row0 = samp ? MP + (sb - 16) * 16 : sb * 4096;
  const int kc0 = nbk * 128, oc0 = nbk * 128 + half * 64;
  const u16* XA = (const u16*)(p.ws + OFF_R1);
  u16* YL = (u16*)(p.ws + OFF_R2);
  const u16* WL = (const u16*)(p.ws + OFF_W) + (size_t)l * W_LAYER;
  u16* sXC = (u16*)smem;
  float* sA = (float*)(smem + 17408);
  float* sB = sA + 4096;
  float* segA = sB + 4096;
  float* segB = segA + 256;
  float* hc = segB + 256;
  float* cw = hc + 64;
  float* cb = cw + 512;
  const int tm = w >> 1, tn = w & 1;
  __syncthreads();
  for (int e = tid; e < 512; e += NT) cw[e] = p.conv_w[(size_t)l * 4096 + (e >> 7) * 1024 + kc0 + (e & 127)];
  if (tid < 128) cb[tid] = p.conv_b[l * 1024 + kc0 + tid];
  if (tid < 64) hc[tid] = samp ? p.state_lru[((size_t)l * 32 + (sb - 16)) * 1024 + oc0 + tid] : 0.f;
  bf16x8 waf[8], wxf[8];
  {
    const u16* wa = WL + WO_LA + (size_t)nbk * 16384 + (size_t)(half * 64 + tn * 32 + l31) * 128 + hh * 8;
    const u16* wx = WL + WO_LX + (size_t)nbk * 16384 + (size_t)(half * 64 + tn * 32 + l31) * 128 + hh * 8;
#pragma unroll
    for (int ks = 0; ks < 8; ++ks) {
      waf[ks] = *(const bf16x8*)(wa + ks * 16);
      wxf[ks] = *(const bf16x8*)(wx + ks * 16);
    }
  }
  const int och = oc0 + tn * 32 + l31;
  const float ba = p.lru_ba[l * 1024 + och], bx = p.lru_bx[l * 1024 + och];
  const float lam = p.lru_lambda[l * 1024 + och];
  const float ex_ = __expf(-lam);
  const float sp = (-lam > 20.f) ? -lam
                   : (ex_ < 0.01f ? ex_ * (1.0f - ex_ * (0.5f - ex_ * (0.33333334f - 0.25f * ex_))) : __logf(1.0f + ex_));
  __syncthreads();
  for (int t0 = 0; t0 < S; t0 += 64) {
    {
      const int cc = (tid & 15) * 8, tq = tid >> 4;
      bf16x8 xr[7];
#pragma unroll
      for (int j = 0; j < 7; ++j) {
        int ts = t0 + tq * 4 - 3 + j;
        ts = ts < 0 ? 0 : (ts > S - 1 ? S - 1 : ts);
        xr[j] = *(const bf16x8*)(XA + (size_t)(row0 + ts) * 1024 + kc0 + cc);
      }
      float xf[7][8];
#pragma unroll
      for (int j = 0; j < 7; ++j) {
        const int ts = t0 + tq * 4 - 3 + j;
        const bool ok = ts >= 0;
#pragma unroll
        for (int c = 0; c < 8; ++c) xf[j][c] = ok ? bf2f((u16)xr[j][c]) : 0.f;
      }
      if (samp && t0 == 0 && tq == 0) {
#pragma unroll
        for (int j = 0; j < 3; ++j) {
          const float* st = p.state_conv + (((size_t)l * 32 + (sb - 16)) * 3 + j) * 1024 + kc0 + cc;
#pragma unroll
          for (int c = 0; c < 8; ++c) xf[j][c] = st[c];
        }
      }
#pragma unroll
      for (int i = 0; i < 4; ++i) {
        const int tl = tq * 4 + i;
        bf16x8 o;
#pragma unroll
        for (int c = 0; c < 8; ++c) {
          float v = cb[cc + c];
#pragma unroll
          for (int k = 0; k < 4; ++k) v += xf[i + k][c] * cw[k * 128 + cc + c];
          o[c] = (short)f2bf(v);
        }
        *(bf16x8*)(sXC + tl * 136 + cc) = o;
      }
    }
    __syncthreads();
    f32x16 aR, aI;
#pragma unroll
    for (int r = 0; r < 16; ++r) { aR[r] = 0.f; aI[r] = 0.f; }
#pragma unroll
    for (int ks = 0; ks < 8; ++ks) {
      bf16x8 a = *(const bf16x8*)(sXC + (tm * 32 + l31) * 136 + ks * 16 + hh * 8);
      aR = __builtin_amdgcn_mfma_f32_32x32x16_bf16(a, waf[ks], aR, 0, 0, 0);
      aI = __builtin_amdgcn_mfma_f32_32x32x16_bf16(a, wxf[ks], aI, 0, 0, 0);
    }
#pragma unroll
    for (int r = 0; r < 16; ++r) {
      const int tl = tm * 32 + (r & 3) + 8 * (r >> 2) + 4 * hh;
      const int cl = tn * 32 + l31;
      float av, bv;
      {
        const float rg = __builtin_amdgcn_rcpf(1.0f + __expf(-(aR[r] + ba)));
        const float ig = __builtin_amdgcn_rcpf(1.0f + __expf(-(aI[r] + bx)));
        const float la = -8.0f * rg * sp;
        const float a_ = __expf(la);
        const float x2 = 2.0f * la;
        const float ser = -x2 * (1.0f + x2 * (0.5f + x2 * (0.16666667f + x2 * (0.041666668f + x2 * 0.0083333338f))));
        const float em = (x2 > -0.25f) ? ser : 1.0f - __expf(x2);
        const float mult = __builtin_amdgcn_sqrtf(em);
        const float xcv = bf2f(sXC[tl * 136 + half * 64 + cl]);
        const bool valid = (t0 + tl < S);
        av = valid ? a_ : 1.f;
        bv = valid ? mult * ig * xcv : 0.f;
      }
      sA[tl * 64 + cl] = av;
      sB[tl * 64 + cl] = bv;
    }
    __syncthreads();
    {
      const int c = lane, sg = w;
      float A_ = 1.f, B_ = 0.f;
#pragma unroll
      for (int i = 0; i < 16; ++i) {
        const float a = sA[(sg * 16 + i) * 64 + c], b = sB[(sg * 16 + i) * 64 + c];
        B_ = a * B_ + b;
        A_ *= a;
      }
      segA[sg * 64 + c] = A_;
      segB[sg * 64 + c] = B_;
      __syncthreads();
      float h = hc[c];
      for (int s2 = 0; s2 < sg; ++s2) h = segA[s2 * 64 + c] * h + segB[s2 * 64 + c];
      __syncthreads();
#pragma unroll
      for (int i = 0; i < 16; ++i) {
        const int tl = sg * 16 + i;
        const float a = sA[tl * 64 + c], b = sB[tl * 64 + c];
        h = a * h + b;
        if (t0 + tl < S) YL[(size_t)(row0 + t0 + tl) * 1024 + oc0 + c] = f2bf(h);
      }
      if (sg == 3) hc[c] = h;
    }
    __syncthreads();
  }
  if (tid < 64) {
    const float h = hc[tid];
    if (samp) p.out[OUT_LRUS + ((size_t)l * 32 + (sb - 16)) * 1024 + oc0 + tid] = h;
    else p.out[OUT_LRUP + ((size_t)l * 16 + sb) * 1024 + oc0 + tid] = h;
  }
  __syncthreads();
}

DEV void phase_p3(const Params& p, int l, unsigned char* smem) {
  __shared__ int s_item;
  const int tid = TIDX(), lane = tid & 63, w = tid >> 6;
#pragma unroll 1
  for (int it = blockIdx.x; it < 256; it += gridDim.x) lru_item(p, l, it >> 4, (it >> 1) & 7, it & 1, smem);
#pragma unroll 1
  for (int it0 = blockIdx.x; it0 < 320; it0 += gridDim.x) {
    if (it0 < 256) continue;
    const int it = it0 - 256;
    const int b = it >> 1, dvh = it & 1;
    const int r = w * 32 + (lane & 31), h = r >> 4, t = r & 15;
    const u16* qrow = (const u16*)(p.ws + OFF_QS) + ((size_t)b * 16 + t) * 2560 + h * 320;
    const u16* ka = (const u16*)(p.ws + OFF_SKV) + (size_t)b * 2112 * 320;
    const u16* vt = (const u16*)(p.ws + OFF_SVT) + ((size_t)b * 256 + dvh * 128) * 2112;
    u16* orow = (u16*)(p.ws + OFF_OLAT) + ((size_t)b * 16 + t) * 2048 + h * 256 + dvh * 128;
    attn_item<320, false>(qrow, ka, 320, ka + 256, 320, vt, 2112, 33, 33, 2064, orow, smem);
  }
  const int xcd = blockIdx.x & 7;
#pragma unroll 1
  for (int qi = 0; qi < 8; ++qi) {
    const int q = (xcd + qi) & 7;
    unsigned* qc = (unsigned*)(p.ws + OFF_CNT) + 8 + l * 8 + q;
#pragma unroll 1
    for (;;) {
      __syncthreads();
      if (tid == 0) s_item = (int)atomicAdd(qc, 1u);
      __syncthreads();
      const int it = s_item;
      if (it >= 512) break;
      const int half_ = it >> 8, j_ = it & 255;
      const int qt = (half_ ? 15 : 31) - (j_ & 15), bh = (j_ >> 4) * 8 + q, b = bh >> 3, h = bh & 7;
      u16* Q = (u16*)(p.ws + OFF_R3);
      const int r = w * 32 + (lane & 31);
      u16* qrow = Q + ((size_t)b * 4096 + qt * 128 + r) * 1536 + h * 192;
      const u16* ka = (const u16*)(p.ws + OFF_R4) + (size_t)b * 4096 * 1024 + h * 128;
      const u16* kb = (const u16*)(p.ws + OFF_KPE) + (size_t)b * 4096 * 64;
      const u16* vt = (const u16*)(p.ws + OFF_VT) + ((size_t)b * 1024 + h * 128) * 4096;
      attn_item<192, ATT_PF>(qrow, ka, 1024, kb, 64, vt, 4096, 2 * (qt + 1), 2 * qt + 1 + (w >> 1), 1 << 30, qrow, smem);
    }
  }
#pragma unroll 1
  for (int it = blockIdx.x; it < 512; it += gridDim.x) lru_item(p, l, 16 + (it >> 4), (it >> 1) & 7, it & 1, smem);
}

template <int MI>
DEV void p4_tile(const Params& p, int l, int m0, int nt, unsigned char* smem) {
  const u16* WL = (const u16*)(p.ws + OFF_W) + (size_t)l * W_LAYER;
  const u16* H = (const u16*)(p.ws + OFF_H);
  const u16* Q = (const u16*)(p.ws + OFF_R3);
  const u16* OLAT = (const u16*)(p.ws + OFF_OLAT);
  u16* YB = (u16*)(p.ws + OFF_R1);
  u16* YA = (u16*)(p.ws + OFF_R2);
  u16* sC = (u16*)smem;
  f32x16 acc[MI][2];
  if (nt < 8) {
    if constexpr (MI == 2) {
      if (m0 >= MP) {
        f32x16 att[MI][2];
        zero_acc_t<MI>(att);
        gemm_mm<MI>(att, OLAT + (size_t)(m0 - MP) * 2048 + nt * 256, 2048, WL + WO_UVP + (size_t)nt * 128 * 256, 256, 256, smem);
        zero_acc_t<MI>(acc);
        gemm_mm<MI>(acc, H + (size_t)m0 * 1024, 1024, WL + WO_G + (size_t)(1024 + nt * 128) * 1024, 1024, 1024, smem);
        acc_foreach_t<MI>([&](int mi, int ni, int r, int row, int col) __attribute__((always_inline)) {
          sC[row * LDC + col] = f2bf(att[mi][ni][r] * siluf_(acc[mi][ni][r]));
        });
        tile_store_t<MI>(smem, YB + (size_t)m0 * 1024 + nt * 128, 1024);
        return;
      }
    }
    zero_acc_t<MI>(acc);
    gemm_mm<MI>(acc, H + (size_t)m0 * 1024, 1024, WL + WO_G + (size_t)(1024 + nt * 128) * 1024, 1024, 1024, smem);
    tile_load_t<MI>(smem, Q + (size_t)m0 * 1536 + nt * 192, 1536);
    acc_foreach_t<MI>([&](int mi, int ni, int r, int row, int col) __attribute__((always_inline)) {
      sC[row * LDC + col] = f2bf(bf2f(sC[row * LDC + col]) * siluf_(acc[mi][ni][r]));
    });
    tile_store_t<MI>(smem, YB + (size_t)m0 * 1024 + nt * 128, 1024);
  } else {
    const int n0 = (nt - 8) * 128;
    zero_acc_t<MI>(acc);
    gemm_mm<MI>(acc, H + (size_t)m0 * 1024, 1024, WL + WO_G + (size_t)n0 * 1024, 1024, 1024, smem);
    tile_load_t<MI>(smem, YA + (size_t)m0 * 1024 + n0, 1024);
    acc_foreach_t<MI>([&](int mi, int ni, int r, int row, int col) __attribute__((always_inline)) {
      sC[row * LDC + col] = f2bf(bf2f(sC[row * LDC + col]) * siluf_(acc[mi][ni][r]));
    });
    tile_store_t<MI>(smem, YA + (size_t)m0 * 1024 + n0, 1024);
  }
}
DEV void phase_p4(const Params& p, int l, unsigned char* smem) {
  const int nb = gridDim.x;
  int idx = vbid(), base = 0;
#pragma unroll 1
  for (; idx < base + 256 * 16; idx += nb) {
    const int t = idx - base;
    p4_tile<4>(p, l, (t >> 4) * 256, t & 15, smem);
  }
  base += 256 * 16;
#pragma unroll 1
  for (; idx < base + 4 * 16; idx += nb) {
    const int t = idx - base;
    p4_tile<2>(p, l, MP + (t >> 4) * 128, t & 15, smem);
  }
}

constexpr int SM_GATE = 2 * 128 * LDT * 2 + 1024;
DEV void gemm_gates(f32x16 (&acc)[2][4], const u16* __restrict__ A, const u16* __restrict__ B0, const u16* __restrict__ B1,
                    unsigned char* smem) {
  u16* sA = (u16*)smem;
  u16* sB = sA + 128 * LDT;
  const int tid = TIDX(), lane = tid & 63, w = tid >> 6, wm = w >> 1, wn = w & 1;
  const int srow = tid >> 3, scol = (tid & 7) * 8;
  const u16* ap = A + (size_t)srow * 1024 + scol;
  const u16* b0p = B0 + (size_t)srow * 1024 + scol;
  const u16* b1p = B1 + (size_t)srow * 1024 + scol;
  bf16x8 ra[4], rb[8];
#pragma unroll
  for (int i = 0; i < 4; ++i) {
    ra[i] = *(const bf16x8*)(ap + (size_t)(32 * i) * 1024);
    rb[i] = *(const bf16x8*)(b0p + (size_t)(32 * i) * 1024);
    rb[4 + i] = *(const bf16x8*)(b1p + (size_t)(32 * i) * 1024);
  }
  const int fro = (lane & 31) * LDT + (lane >> 5) * 8;
#pragma unroll 1
  for (int kt = 0; kt < 16; ++kt) {
    __syncthreads();
#pragma unroll
    for (int i = 0; i < 4; ++i) *(bf16x8*)(sA + (srow + 32 * i) * LDT + scol) = ra[i];
#pragma unroll
    for (int i = 0; i < 8; ++i) *(bf16x8*)(sB + (srow + 32 * i) * LDT + scol) = rb[i];
    __syncthreads();
    if (kt + 1 < 16) {
      ap += 64;
      b0p += 64;
      b1p += 64;
#pragma unroll
      for (int i = 0; i < 4; ++i) {
        ra[i] = *(const bf16x8*)(ap + (size_t)(32 * i) * 1024);
        rb[i] = *(const bf16x8*)(b0p + (size_t)(32 * i) * 1024);
        rb[4 + i] = *(const bf16x8*)(b1p + (size_t)(32 * i) * 1024);
      }
    }
#pragma unroll 2
    for (int ks = 0; ks < 4; ++ks) {
      bf16x8 af[2], bfr[4];
#pragma unroll
      for (int i = 0; i < 2; ++i) af[i] = *(const bf16x8*)(sA + (wm * 64 + i * 32) * LDT + fro + ks * 16);
#pragma unroll
      for (int i = 0; i < 4; ++i)
        bfr[i] = *(const bf16x8*)(sB + ((i >> 1) * 128 + wn * 64 + (i & 1) * 32) * LDT + fro + ks * 16);
      __builtin_amdgcn_s_setprio(1);
#pragma unroll
      for (int mi = 0; mi < 2; ++mi)
#pragma unroll
        for (int ni = 0; ni < 4; ++ni)
          acc[mi][ni] = __builtin_amdgcn_mfma_f32_32x32x16_bf16(af[mi], bfr[ni], acc[mi][ni], 0, 0, 0);
      __builtin_amdgcn_s_setprio(0);
    }
  }
  __syncthreads();
}
DEV void phase_p5(const Params& p, int l, unsigned char* smem) {
  const u16* WL = (const u16*)(p.ws + OFF_W) + (size_t)l * W_LAYER;
  const u16* H = (const u16*)(p.ws + OFF_H);
  const u16* YB = (const u16*)(p.ws + OFF_R1);
  const u16* YA = (const u16*)(p.ws + OFF_R2);
  u16* MRG = (u16*)(p.ws + OFF_R3);
  u16* sC = (u16*)smem;
  const int ntiles = 516 * 8;
  for (int t = vbid(); t < ntiles; t += gridDim.x) {
    const int mt = t >> 3, nt = t & 7;
    unsigned ga[2][2][8];
    unsigned* sG = (unsigned*)(smem + SM_GATE);
    const int tid = TIDX();
    {
      f32x16 g[2][4];
#pragma unroll
      for (int a_ = 0; a_ < 2; ++a_)
#pragma unroll
        for (int b_ = 0; b_ < 4; ++b_)
#pragma unroll
          for (int r = 0; r < 16; ++r) g[a_][b_][r] = 0.f;
      gemm_gates(g, H + (size_t)mt * 128 * 1024, WL + WO_G + (size_t)(2048 + nt * 128) * 1024,
                 WL + WO_G + (size_t)(3072 + nt * 128) * 1024, smem);
#pragma unroll
      for (int a_ = 0; a_ < 2; ++a_)
#pragma unroll
        for (int b_ = 0; b_ < 2; ++b_) {
#pragma unroll
          for (int r = 0; r < 8; ++r)
            sG[((a_ * 2 + b_) * 8 + r) * 256 + tid] = pk2bf(sigmoidf_(g[a_][2 + b_][2 * r]), sigmoidf_(g[a_][2 + b_][2 * r + 1]));
          __builtin_amdgcn_sched_barrier(0);
        }
#pragma unroll
      for (int a_ = 0; a_ < 2; ++a_)
#pragma unroll
        for (int b_ = 0; b_ < 2; ++b_) {
#pragma unroll
          for (int r = 0; r < 8; ++r) ga[a_][b_][r] = pk2bf(sigmoidf_(g[a_][b_][2 * r]), sigmoidf_(g[a_][b_][2 * r + 1]));
          __builtin_amdgcn_sched_barrier(0);
        }
    }
    auto gate_a = [&](int mi, int ni, int r) __attribute__((always_inline)) -> float {
      const unsigned gq = ga[mi][ni][r >> 1];
      return __uint_as_float((r & 1) ? (gq & 0xffff0000u) : (gq << 16));
    };
    auto gate_b = [&](int mi, int ni, int r) __attribute__((always_inline)) -> float {
      const unsigned gq = sG[((mi * 2 + ni) * 8 + (r >> 1)) * 256 + tid];
      return __uint_as_float((r & 1) ? (gq & 0xffff0000u) : (gq << 16));
    };
    f32x16 acc[2][2];
    unsigned res[2][2][8];
    zero_acc(acc);
    gemm_main<0>(acc, YA + (size_t)mt * 128 * 1024, 1024, WL + WO_BA + (size_t)nt * 128 * 1024, 1024, 1024, smem);
#pragma unroll
    for (int mi = 0; mi < 2; ++mi)
#pragma unroll
      for (int ni = 0; ni < 2; ++ni)
#pragma unroll
        for (int r = 0; r < 8; ++r)
          res[mi][ni][r] = pk2bf(acc[mi][ni][2 * r] * gate_a(mi, ni, 2 * r), acc[mi][ni][2 * r + 1] * gate_a(mi, ni, 2 * r + 1));
    zero_acc(acc);
    gemm_main<0>(acc, YB + (size_t)mt * 128 * 1024, 1024, WL + WO_BB + (size_t)nt * 128 * 1024, 1024, 1024, smem);
    __syncthreads();
    acc_foreach([&](int mi, int ni, int r, int row, int col) __attribute__((always_inline)) {
      const unsigned rq = res[mi][ni][r >> 1];
      const float rv = __uint_as_float((r & 1) ? (rq & 0xffff0000u) : (rq << 16));
      sC[row * LDC + col] = f2bf(rv + acc[mi][ni][r] * gate_b(mi, ni, r));
    });
    tile_store(smem, MRG + (size_t)mt * 128 * 1024 + nt * 128, 1024);
  }
}

template <int MI>
DEV void p6_tile(const Params& p, int l, int m0, int nt, unsigned char* smem) {
  const u16* WL = (const u16*)(p.ws + OFF_W) + (size_t)l * W_LAYER;
  const u16* MRG = (const u16*)(p.ws + OFF_R3);
  u16* O = (u16*)(p.ws + OFF_R4);
  u16* sC = (u16*)smem;
  f32x16 acc[MI][2];
  zero_acc_t<MI>(acc);
  gemm_mm<MI>(acc, MRG + (size_t)m0 * 1024, 1024, WL + WO_OUT + (size_t)nt * 128 * 1024, 1024, 1024, smem);
  acc_foreach_t<MI>([&](int mi, int ni, int r, int row, int col) __attribute__((always_inline)) {
    sC[row * LDC + col] = f2bf(acc[mi][ni][r]);
  });
  tile_store_t<MI>(smem, O + (size_t)m0 * 1024 + nt * 128, 1024);
}
DEV void phase_p6(const Params& p, int l, unsigned char* smem) {
  const int nb = gridDim.x;
  int idx = vbid(), base = 0;
#pragma unroll 1
  for (; idx < base + 256 * 8; idx += nb) {
    const int t = idx - base;
    p6_tile<4>(p, l, (t >> 3) * 256, t & 7, smem);
  }
  base += 256 * 8;
#pragma unroll 1
  for (; idx < base + 4 * 8; idx += nb) {
    const int t = idx - base;
    p6_tile<2>(p, l, MP + (t >> 3) * 128, t & 7, smem);
  }
}

constexpr int SM_TOTAL = SM_GATE + 32768;
__global__ void __launch_bounds__(NT, 2) mega(Params p) {
  __shared__ __attribute__((aligned(16))) unsigned char smem[SM_TOTAL];
  cg::grid_group grid = cg::this_grid();
  __shared__ uint4 xb_words;
  if (threadIdx.x == 0) xb_words = make_uint4(0u, 0u, 0u, 0u);
#define PH(call)                                             \
  {                                                          \
    Params q = p;                                            \
    size_t z_ = 0;                                           \
    asm volatile("" : "+s"(z_));                             \
    q.ws = p.ws + z_;                                        \
    q.out = p.out + z_;                                      \
    call;                                                    \
  }
  PH(phase_prep(q, smem));
  grid.sync();
  (void)xcd_barrier_post((unsigned*)(p.ws + OFF_BAR), (volatile LAS unsigned*)&xb_words);
#define XBAR() xcd_barrier((unsigned*)(p.ws + OFF_BAR), (volatile LAS unsigned*)&xb_words)
  PH(phase_norm0(q));
  XBAR();
#pragma unroll 1
  for (int l = 0; l < 2; ++l) {
    PH(phase_gemm1(q, l, smem));
    XBAR();
    PH(phase_p2(q, l, smem));
    XBAR();
    PH(phase_p3(q, l, smem));
    XBAR();
    PH(phase_p4(q, l, smem));
    XBAR();
    PH(phase_p5(q, l, smem));
    XBAR();
    PH(phase_p6(q, l, smem));
    XBAR();
    PH(phase_final(q, l));
    if (l == 0) XBAR();
  }
}

extern "C" void kernel_launch(void* const* d_in, const int* in_sizes, int n_in, void* d_out, int out_size, void* d_ws,
                              size_t ws_size, hipStream_t stream) {
  static int grid_blocks = 0;
  if (!grid_blocks) {
    int dev = 0, cus = 0, per_cu = 0;
    hipGetDevice(&dev);
    hipDeviceGetAttribute(&cus, hipDeviceAttributeMultiprocessorCount, dev);
    hipOccupancyMaxActiveBlocksPerMultiprocessor(&per_cu, mega, NT, 0);
    if (per_cu > 2) per_cu = 2;
    grid_blocks = cus * per_cu;
  }
  if (ws_size < WS_NEED) {
    fprintf(stderr, "workspace too small: %zu < %zu\n", ws_size, (size_t)WS_NEED);
    return;
  }
  Params p{};
  const float** pp = (const float**)&p;
  for (int i = 0; i < 28; ++i) pp[i] = (const float*)d_in[i];
  p.out = (float*)d_out;
  p.ws = (unsigned char*)d_ws;
  void* args[] = {&p};
  hipError_t e = hipLaunchCooperativeKernel((void*)mega, dim3(grid_blocks), dim3(NT), args, 0, stream);
  if (e != hipSuccess) fprintf(stderr, "cooperative launch failed: %s (grid %d)\n", hipGetErrorString(e), grid_blocks);
}
```
